# Optimizing an MI355X kernel written in HIP

```python
import math
import jax, jax.numpy as jnp
from jax import lax
import numpy as np

D_MODEL = 2048
BATCH = 4
SEQ = 4096
DEPTH = 2

MEM_LEN = 256
Q_BLOCK = 128
NORM_EPS = 1e-6
ROPE_THETA = 10000.0

RWKV_HEADS = 16
RWKV_HEAD_DIM = 64
RWKV_DIM = RWKV_HEADS * RWKV_HEAD_DIM
RWKV_W_RANK = 64
RWKV_A_RANK = 64
RWKV_G_RANK = 128
RWKV_V_RANK = 32
RWKV_LN_EPS = 64e-5
RWKV_COLS = 3 * RWKV_DIM + RWKV_W_RANK + RWKV_A_RANK + RWKV_G_RANK

DIFF_HEADS = 4
DIFF_HEAD_DIM = 64
DIFF_V_DIM = 2 * DIFF_HEAD_DIM
DIFF_QK = DIFF_HEADS * 2 * DIFF_HEAD_DIM
DIFF_DIM = DIFF_HEADS * DIFF_V_DIM
DIFF_COLS = 2 * DIFF_QK + DIFF_DIM
DIFF_SUBLN_EPS = 1e-5

MLA_HEADS = 4
MLA_Q_RANK = 384
MLA_KV_RANK = 256
MLA_NOPE_DIM = 128
MLA_ROPE_DIM = 64
MLA_V_DIM = 128
MLA_DIM = MLA_HEADS * MLA_V_DIM
MLA_COLS = MLA_Q_RANK + MLA_KV_RANK + MLA_ROPE_DIM

MIX_DIM = RWKV_DIM + DIFF_DIM + MLA_DIM
IN_COLS = RWKV_COLS + DIFF_COLS + MLA_COLS

REL_BUCKETS = 32
REL_MAX_DIST = 128

CA_HEADS = 4
CA_HEAD_DIM = 128
CA_DIM = CA_HEADS * CA_HEAD_DIM

N_GROUPS = 4
EXPERTS_PER_GROUP = 8
N_EXPERTS = N_GROUPS * EXPERTS_PER_GROUP
D_EXPERT = 512
TOP_K_IN_GROUP = 2

kernel_name = 'hybrid_rwkv7_diffattn_mla_hmoe'


def rmsnorm(x, w, eps=NORM_EPS):
    x32 = x.astype(jnp.float32)
    y = x32 * lax.rsqrt(jnp.mean(x32 * x32, axis=-1, keepdims=True) + eps)
    return (y * w.astype(jnp.float32)).astype(x.dtype)


def token_shift(p, mu):
    prev = jnp.pad(p, ((0, 0), (1, 0), (0, 0)))[:, :-1]
    return p + mu * (prev - p)


def rope(x, positions):
    half = x.shape[-1] // 2
    inv_freq = ROPE_THETA ** (-jnp.arange(half, dtype=jnp.float32) / half)
    ang = positions.astype(jnp.float32)[..., None] * inv_freq
    ang = ang.reshape(ang.shape[:2] + (1,) * (x.ndim - 3) + (half,))
    cos, sin = jnp.cos(ang), jnp.sin(ang)
    x1 = x[..., :half].astype(jnp.float32)
    x2 = x[..., half:].astype(jnp.float32)
    return jnp.concatenate([x1 * cos - x2 * sin, x2 * cos + x1 * sin], axis=-1).astype(x.dtype)


def t5_bucket(rel):
    n = jnp.maximum(rel, 0)
    max_exact = REL_BUCKETS // 2
    large = max_exact + (jnp.log(jnp.maximum(n, max_exact).astype(jnp.float32) / max_exact)
                         / math.log(REL_MAX_DIST / max_exact) * (REL_BUCKETS - max_exact)).astype(jnp.int32)
    large = jnp.minimum(large, REL_BUCKETS - 1)
    return jnp.where(n < max_exact, n, large)


def t5_bias(pos_q, pos_k, table):
    bucket = t5_bucket(pos_q[:, :, None] - pos_k[:, None, :])
    return jnp.moveaxis(table[bucket].astype(jnp.float32), -1, 1)


def rwkv7_mix(p, mu, w0, w2, a0, a2, g2, k_k, k_a, r_k, ln_w, ln_b, vres):
    B, S, _ = p.shape
    f32 = jnp.float32
    xs = token_shift(p, mu)
    c3 = 3 * RWKV_DIM
    r = xs[..., :RWKV_DIM]
    k = xs[..., RWKV_DIM:2 * RWKV_DIM]
    v = xs[..., 2 * RWKV_DIM:c3]
    wl = xs[..., c3:c3 + RWKV_W_RANK]
    al = xs[..., c3 + RWKV_W_RANK:c3 + RWKV_W_RANK + RWKV_A_RANK]
    gl = xs[..., c3 + RWKV_W_RANK + RWKV_A_RANK:]
    w_log = -jax.nn.softplus(-(w0 + jnp.tanh(wl) @ w2).astype(f32)) - 0.5
    decay = jnp.exp(-jnp.exp(w_log))
    a = jax.nn.sigmoid((a0 + al @ a2).astype(f32))
    g = jax.nn.sigmoid(gl) @ g2
    heads = lambda t: t.reshape(B, S, RWKV_HEADS, RWKV_HEAD_DIM)
    kk = heads((k * k_k).astype(f32))
    kk = kk / jnp.maximum(jnp.linalg.norm(kk, axis=-1, keepdims=True), 1e-12)
    k = k * (1.0 + (a.astype(k.dtype) - 1.0) * k_a)
    v_raw = v
    if vres is not None:
        v_first, p_vl, mu_vl, v0, v2 = vres
        v = v + (v_first - v) * jax.nn.sigmoid(v0 + token_shift(p_vl, mu_vl) @ v2)
    seq = lambda t: jnp.moveaxis(heads(t.astype(f32)), 1, 0)

    def step(state, inp):
        r_t, w_t, k_t, v_t, kk_t, a_t = inp
        sa = jnp.einsum('bhvk,bhk->bhv', state, -kk_t)
        state = (state * w_t[:, :, None, :]
                 + sa[..., None] * (kk_t * a_t)[:, :, None, :]
                 + v_t[..., None] * k_t[:, :, None, :])
        return state, jnp.einsum('bhvk,bhk->bhv', state, r_t)

    state0 = jnp.zeros((B, RWKV_HEADS, RWKV_HEAD_DIM, RWKV_HEAD_DIM), f32)
    _, o_seq = lax.scan(step, state0, (seq(r), seq(decay), seq(k), seq(v), jnp.moveaxis(kk, 1, 0), seq(a)))
    y = jnp.moveaxis(o_seq, 0, 1)
    mean = jnp.mean(y, axis=-1, keepdims=True)
    var = jnp.mean(jnp.square(y - mean), axis=-1, keepdims=True)
    y = ((y - mean) * lax.rsqrt(var + RWKV_LN_EPS)).reshape(B, S, RWKV_DIM)
    y = y * ln_w.astype(f32) + ln_b.astype(f32)
    bonus = jnp.sum(heads(r).astype(f32) * heads(k).astype(f32) * r_k.astype(f32), axis=-1, keepdims=True) * heads(v).astype(f32)
    out = (y + bonus.reshape(B, S, RWKV_DIM)).astype(p.dtype) * g
    return out, v_raw


def diff_attention(p, positions, rel_bias, lam, lambda_init, subln_w):
    B, S, _ = p.shape
    f32 = jnp.float32
    q = p[..., :DIFF_QK].reshape(B, S, DIFF_HEADS, 2, DIFF_HEAD_DIM)
    k = p[..., DIFF_QK:2 * DIFF_QK].reshape(B, S, DIFF_HEADS, 2, DIFF_HEAD_DIM)
    v = p[..., 2 * DIFF_QK:].reshape(B, S, DIFF_HEADS, DIFF_V_DIM)
    scale = DIFF_HEAD_DIM ** -0.5
    nb = S // Q_BLOCK
    key_idx = jnp.arange(S)
    q_blk = jnp.moveaxis(q.reshape(B, nb, Q_BLOCK, DIFF_HEADS, 2, DIFF_HEAD_DIM), 1, 0)
    pos_blk = jnp.moveaxis(positions.reshape(B, nb, Q_BLOCK), 1, 0)
    idx_blk = key_idx.reshape(nb, Q_BLOCK)

    def block(args):
        qb, pb, ib = args
        s = jnp.einsum('bqhmd,bkhmd->bhmqk', qb, k).astype(f32) * scale
        s = s + t5_bias(pb, positions, rel_bias)[:, :, None]
        s = jnp.where(ib[:, None] >= key_idx[None, :], s, -jnp.inf)
        pr = jax.nn.softmax(s, axis=-1)
        attn = pr[:, :, 0] - lam * pr[:, :, 1]
        return jnp.einsum('bhqk,bkhd->bqhd', attn.astype(v.dtype), v)

    out = lax.map(block, (q_blk, pos_blk, idx_blk))
    out = jnp.moveaxis(out, 0, 1).reshape(B, S, DIFF_HEADS, DIFF_V_DIM)
    out = rmsnorm(out, subln_w, DIFF_SUBLN_EPS) * (1.0 - lambda_init)
    return out.reshape(B, S, DIFF_DIM)


def mla_attention(p, positions, q_norm, wq_b, kv_norm, wkv_b):
    B, S, _ = p.shape
    f32 = jnp.float32
    q_c = p[..., :MLA_Q_RANK]
    kv_c = p[..., MLA_Q_RANK:MLA_Q_RANK + MLA_KV_RANK]
    k_pe = rope(p[..., MLA_Q_RANK + MLA_KV_RANK:], positions)
    q = (rmsnorm(q_c, q_norm) @ wq_b).reshape(B, S, MLA_HEADS, MLA_NOPE_DIM + MLA_ROPE_DIM)
    q_nope = q[..., :MLA_NOPE_DIM]
    q_pe = rope(q[..., MLA_NOPE_DIM:], positions)
    kv = (rmsnorm(kv_c, kv_norm) @ wkv_b).reshape(B, S, MLA_HEADS, MLA_NOPE_DIM + MLA_V_DIM)
    k_nope = kv[..., :MLA_NOPE_DIM]
    v = kv[..., MLA_NOPE_DIM:]
    scale = (MLA_NOPE_DIM + MLA_ROPE_DIM) ** -0.5
    nb = S // Q_BLOCK
    key_idx = jnp.arange(S)
    qn_blk = jnp.moveaxis(q_nope.reshape(B, nb, Q_BLOCK, MLA_HEADS, MLA_NOPE_DIM), 1, 0)
    qp_blk = jnp.moveaxis(q_pe.reshape(B, nb, Q_BLOCK, MLA_HEADS, MLA_ROPE_DIM), 1, 0)
    idx_blk = key_idx.reshape(nb, Q_BLOCK)

    def block(args):
        qn, qp, ib = args
        s = (jnp.einsum('bqhd,bkhd->bhqk', qn, k_nope)
             + jnp.einsum('bqhr,bkr->bhqk', qp, k_pe)).astype(f32) * scale
        s = jnp.where(ib[:, None] >= key_idx[None, :], s, -jnp.inf)
        pr = jax.nn.softmax(s, axis=-1)
        return jnp.einsum('bhqk,bkhd->bqhd', pr.astype(v.dtype), v)

    out = lax.map(block, (qn_blk, qp_blk, idx_blk))
    return jnp.moveaxis(out, 0, 1).reshape(B, S, MLA_DIM)


def memory_cross_attention(h, m, wq, wkv, wo):
    B, S, _ = h.shape
    M = m.shape[1]
    q = (h @ wq).reshape(B, S, CA_HEADS, CA_HEAD_DIM)
    kv = (m @ wkv).reshape(B, M, 2, CA_HEADS, CA_HEAD_DIM)
    s = jnp.einsum('bqhd,bkhd->bhqk', q, kv[:, :, 0]).astype(jnp.float32) * CA_HEAD_DIM ** -0.5
    pr = jax.nn.softmax(s, axis=-1)
    o = jnp.einsum('bhqk,bkhd->bqhd', pr.astype(h.dtype), kv[:, :, 1]).reshape(B, S, CA_DIM)
    return o @ wo


def hier_moe(h, w_group, b_group, w_expert, b_expert, w_gate, w_up, w_down):
    B, S, D = h.shape
    f32 = jnp.float32
    T = B * S
    t = h.reshape(T, D)
    g_logits = (t @ w_group).astype(f32)
    g_probs = jax.nn.softmax(g_logits, axis=-1)
    g_sel = jnp.argmax(g_logits + b_group.astype(f32), axis=-1)
    p_group = jnp.take_along_axis(g_probs, g_sel[:, None], axis=1)
    e_logits = (t @ w_expert).astype(f32).reshape(T, N_GROUPS, EXPERTS_PER_GROUP)
    e_logits = e_logits[jnp.arange(T), g_sel]
    e_bias = b_expert.astype(f32).reshape(N_GROUPS, EXPERTS_PER_GROUP)[g_sel]
    _, e_idx = lax.top_k(e_logits + e_bias, TOP_K_IN_GROUP)
    e_w = jax.nn.softmax(jnp.take_along_axis(e_logits, e_idx, axis=1), axis=-1)
    within = jnp.sum(jax.nn.one_hot(e_idx, EXPERTS_PER_GROUP, dtype=f32) * e_w[..., None], axis=1)
    gates = (jax.nn.one_hot(g_sel, N_GROUPS, dtype=f32)[:, :, None] * within[:, None, :]).reshape(T, N_EXPERTS) * p_group

    def expert_step(acc, xs):
        wg, wu, wd, gate = xs
        hid = jax.nn.silu(t @ wg) * (t @ wu)
        return acc + gate[:, None].astype(t.dtype) * (hid @ wd), None

    y, _ = lax.scan(expert_step, jnp.zeros_like(t), (w_gate, w_up, w_down, gates.T))
    return y.reshape(B, S, D)


def setup_inputs(seed: int = 0) -> dict:
    key = jax.random.key(seed)
    keys = jax.random.split(key, 64)
    ks = [keys[i] for i in range(64)]
    f32 = jnp.float32

    def nrm(shape, scale):
        return jax.random.normal(ks.pop(), shape, f32) * scale

    def gain(shape):
        return 1.0 + nrm(shape, 0.02)

    def unif(shape):
        return jax.random.uniform(ks.pop(), shape, f32)

    L = DEPTH
    Lv = DEPTH - 1
    D = D_MODEL
    x = nrm((BATCH, SEQ, D), 1.0)
    mem = nrm((BATCH, MEM_LEN, D), 1.0)
    offsets = jax.random.randint(ks.pop(), (BATCH, 1), 0, 1024, dtype=jnp.int32)
    positions = offsets + jnp.arange(SEQ, dtype=jnp.int32)[None, :]
    return {
        'x': x,
        'mem': mem,
        'positions': positions,
        'rel_bias': nrm((REL_BUCKETS, DIFF_HEADS), 0.5),
        'final_norm': gain((D,)),
        'norm_mix': gain((L, D)),
        'w_in': nrm((L, D, IN_COLS), D ** -0.5),
        'w_in_vres': nrm((Lv, D, RWKV_V_RANK), D ** -0.5),
        'w_out': nrm((L, MIX_DIM, D), MIX_DIM ** -0.5),
        'tm_mu': unif((L, RWKV_COLS)),
        'tm_mu_vres': unif((Lv, RWKV_V_RANK)),
        'tm_w0': -1.5 + nrm((L, RWKV_DIM), 0.5),
        'tm_w2': nrm((L, RWKV_W_RANK, RWKV_DIM), 0.1),
        'tm_a0': nrm((L, RWKV_DIM), 0.1),
        'tm_a2': nrm((L, RWKV_A_RANK, RWKV_DIM), RWKV_A_RANK ** -0.5),
        'tm_v0': nrm((Lv, RWKV_DIM), 0.1),
        'tm_v2': nrm((Lv, RWKV_V_RANK, RWKV_DIM), RWKV_V_RANK ** -0.5),
        'tm_g2': nrm((L, RWKV_G_RANK, RWKV_DIM), RWKV_G_RANK ** -0.5),
        'tm_k_k': 0.85 + nrm((L, RWKV_DIM), 0.05),
        'tm_k_a': 1.0 + nrm((L, RWKV_DIM), 0.05),
        'tm_r_k': nrm((L, RWKV_HEADS, RWKV_HEAD_DIM), 0.1),
        'tm_ln_w': gain((L, RWKV_DIM)),
        'tm_ln_b': nrm((L, RWKV_DIM), 0.02),
        'da_lq1': nrm((L, DIFF_HEAD_DIM), 0.1),
        'da_lk1': nrm((L, DIFF_HEAD_DIM), 0.1),
        'da_lq2': nrm((L, DIFF_HEAD_DIM), 0.1),
        'da_lk2': nrm((L, DIFF_HEAD_DIM), 0.1),
        'da_subln': gain((L, DIFF_V_DIM)),
        'mla_q_norm': gain((L, MLA_Q_RANK)),
        'mla_wq_b': nrm((L, MLA_Q_RANK, MLA_HEADS * (MLA_NOPE_DIM + MLA_ROPE_DIM)), MLA_Q_RANK ** -0.5),
        'mla_kv_norm': gain((L, MLA_KV_RANK)),
        'mla_wkv_b': nrm((L, MLA_KV_RANK, MLA_HEADS * (MLA_NOPE_DIM + MLA_V_DIM)), MLA_KV_RANK ** -0.5),
        'norm_cross': gain((L, D)),
        'norm_mem': gain((L, D)),
        'ca_wq': nrm((L, D, CA_DIM), D ** -0.5),
        'ca_wkv': nrm((L, D, 2 * CA_DIM), D ** -0.5),
        'ca_wo': nrm((L, CA_DIM, D), CA_DIM ** -0.5),
        'norm_ffn': gain((L, D)),
        'moe_w_group': nrm((L, D, N_GROUPS), D ** -0.5),
        'moe_b_group': nrm((L, N_GROUPS), 0.01),
        'moe_w_expert': nrm((L, D, N_EXPERTS), D ** -0.5),
        'moe_b_expert': nrm((L, N_EXPERTS), 0.01),
        'moe_w_gate': nrm((L, N_EXPERTS, D, D_EXPERT), D ** -0.5),
        'moe_w_up': nrm((L, N_EXPERTS, D, D_EXPERT), D ** -0.5),
        'moe_w_down': nrm((L, N_EXPERTS, D_EXPERT, D), D_EXPERT ** -0.5),
    }


def reference(x, mem, positions, rel_bias, final_norm, norm_mix, w_in, w_in_vres, w_out,
              tm_mu, tm_mu_vres, tm_w0, tm_w2, tm_a0, tm_a2, tm_v0, tm_v2, tm_g2,
              tm_k_k, tm_k_a, tm_r_k, tm_ln_w, tm_ln_b,
              da_lq1, da_lk1, da_lq2, da_lk2, da_subln,
              mla_q_norm, mla_wq_b, mla_kv_norm, mla_wkv_b,
              norm_cross, norm_mem, ca_wq, ca_wkv, ca_wo,
              norm_ffn, moe_w_group, moe_b_group, moe_w_expert, moe_b_expert,
              moe_w_gate, moe_w_up, moe_w_down):
    f32 = jnp.float32
    v_first = None
    for l in range(DEPTH):
        h = rmsnorm(x, norm_mix[l])
        if l == 0:
            proj = h @ w_in[l]
            vres = None
        else:
            proj = h @ jnp.concatenate([w_in[l], w_in_vres[l - 1]], axis=1)
            vres = (v_first, proj[..., IN_COLS:], tm_mu_vres[l - 1], tm_v0[l - 1], tm_v2[l - 1])
        y_a, v_l = rwkv7_mix(proj[..., :RWKV_COLS], tm_mu[l], tm_w0[l], tm_w2[l], tm_a0[l], tm_a2[l],
                             tm_g2[l], tm_k_k[l], tm_k_a[l], tm_r_k[l], tm_ln_w[l], tm_ln_b[l], vres)
        if l == 0:
            v_first = v_l
        lambda_init = 0.8 - 0.6 * math.exp(-0.3 * l)
        lam = (jnp.exp(jnp.sum(da_lq1[l].astype(f32) * da_lk1[l].astype(f32)))
               - jnp.exp(jnp.sum(da_lq2[l].astype(f32) * da_lk2[l].astype(f32))) + lambda_init)
        y_b = diff_attention(proj[..., RWKV_COLS:RWKV_COLS + DIFF_COLS], positions, rel_bias,
                             lam, lambda_init, da_subln[l])
        y_c = mla_attention(proj[..., RWKV_COLS + DIFF_COLS:IN_COLS], positions,
                            mla_q_norm[l], mla_wq_b[l], mla_kv_norm[l], mla_wkv_b[l])
        x = x + jnp.concatenate([y_a, y_b, y_c], axis=-1) @ w_out[l]
        x = x + memory_cross_attention(rmsnorm(x, norm_cross[l]), rmsnorm(mem, norm_mem[l]),
                                       ca_wq[l], ca_wkv[l], ca_wo[l])
        x = x + hier_moe(rmsnorm(x, norm_ffn[l]), moe_w_group[l], moe_b_group[l], moe_w_expert[l],
                         moe_b_expert[l], moe_w_gate[l], moe_w_up[l], moe_w_down[l])
    return rmsnorm(x, final_norm)
```

```cpp
#include <hip/hip_runtime.h>
#include <stdint.h>
#include <math.h>

#ifndef MK_ONE_LAUNCH
#define MK_ONE_LAUNCH 1
#endif

#define DI __device__ __forceinline__
#define LAS __attribute__((address_space(3)))
#define GAS __attribute__((address_space(1)))

typedef unsigned short bf16_t;
typedef short bf16x8 __attribute__((ext_vector_type(8)));
typedef short s16x4 __attribute__((ext_vector_type(4)));
typedef float f32x2 __attribute__((ext_vector_type(2)));
typedef float f32x4 __attribute__((ext_vector_type(4)));
typedef float f32x16 __attribute__((ext_vector_type(16)));
typedef unsigned u32x2 __attribute__((ext_vector_type(2)));
typedef unsigned u32x4 __attribute__((ext_vector_type(4)));
typedef __bf16 bf16x2_t __attribute__((ext_vector_type(2)));
typedef short v4i16_t __attribute__((ext_vector_type(4)));
typedef _Float16 h2_t __attribute__((ext_vector_type(2)));
typedef _Float16 h4_t __attribute__((ext_vector_type(4)));

constexpr int NB = 4, SEQ = 4096, DM = 2048, NT = NB * SEQ;
constexpr int MEMLEN = 256, NMEM = NB * MEMLEN;
constexpr int RW_DIM = 1024, RW_COLS = 3328, IN_COLS = 5568, INP = 5632;
constexpr int PATT_COLS = 2304;
constexpr int NEXP = 32, DEXP = 512;
constexpr int MOE_ROWS = 40960;
constexpr float LOG2E = 1.4426950408889634f;

constexpr size_t MiB = 1u << 20, KiB = 1024;
constexpr size_t WS_CTL = 0;
constexpr size_t WS_ROPE = 1 * MiB;
constexpr size_t WS_EID = 5 * MiB;
constexpr size_t WS_GATE = 5 * MiB + 128 * KiB;
constexpr size_t WS_CNT = 5 * MiB + 256 * KiB;
constexpr size_t WS_ROWMAP = 5 * MiB + 320 * KiB;
constexpr size_t WS_ROWDST = 5 * MiB + 512 * KiB;
constexpr size_t WS_TILEEXP = 5 * MiB + 704 * KiB;
constexpr size_t WS_WRB = 7 * MiB;
constexpr size_t WS_LOGITS = 852 * MiB;
constexpr size_t WS_SSQM = 6 * MiB;
constexpr size_t WS_SSQC = 6 * MiB + 64 * KiB;
constexpr size_t WS_SSQF = 6 * MiB + 128 * KiB;
constexpr size_t WS_LUT = 6 * MiB + 512 * KiB;
constexpr size_t WS_WINT = 8 * MiB;
constexpr size_t WS_WOUTT = 30 * MiB;
constexpr size_t WS_CAWQT = 38 * MiB;
constexpr size_t WS_CAWKVT = 40 * MiB;
constexpr size_t WS_CAWOT = 44 * MiB;
constexpr size_t WS_WQBT = 46 * MiB;
constexpr size_t WS_WKVBT = 47 * MiB;
constexpr size_t WS_LORABT = 48 * MiB;
constexpr size_t WS_WGU = 52 * MiB;
constexpr size_t WS_WD = 180 * MiB;
constexpr size_t WS_H = 248 * MiB;
constexpr size_t WS_PRW = 312 * MiB;
constexpr size_t WS_PATT = 416 * MiB;
constexpr size_t WS_U = 488 * MiB;
constexpr size_t WS_HID = 488 * MiB, WS_C2 = 528 * MiB;
constexpr size_t WS_APERM = 312 * MiB;
constexpr size_t WS_LORAA = 680 * MiB;
constexpr size_t WS_LORAO = 692 * MiB;
constexpr size_t WS_VFIRST = 820 * MiB;
constexpr size_t WS_QN = 852 * MiB, WS_KVN = 864 * MiB, WS_QM = 872 * MiB, WS_KVM = 896 * MiB, WS_KPE = 928 * MiB;
constexpr size_t WS_CAQ = 852 * MiB, WS_CAO = 868 * MiB;
constexpr size_t WS_MEMN = 932 * MiB, WS_MEMKV = 936 * MiB;
constexpr size_t WS_XB = 940 * MiB;
constexpr size_t WS_PARTC = 1004 * MiB;
constexpr size_t WS_PARTF = 1006 * MiB;
constexpr size_t WS_END = 1008 * MiB;
constexpr int CW_BAR = 4096;

constexpr int LDS_MAIN = 131072;
constexpr int LDS_MISC = LDS_MAIN;
constexpr int LDS_BYTES = 147456;

DI unsigned pk2(float lo, float hi) { f32x2 v = {lo, hi}; bf16x2_t b = __builtin_convertvector(v, bf16x2_t); return __builtin_bit_cast(unsigned, b); }
DI bf16_t f2bf(float f) { return (bf16_t)(pk2(f, 0.f) & 0xffffu); }
DI float bf2f(bf16_t b) { return __uint_as_float(((unsigned)b) << 16); }
DI float bflo(unsigned u) { return __uint_as_float(u << 16); }
DI float bfhi(unsigned u) { return __uint_as_float(u & 0xffff0000u); }
#define DPP_F(x, ctl) __builtin_bit_cast(float, __builtin_amdgcn_update_dpp(0, __builtin_bit_cast(int, x), ctl, 0xf, 0xf, true))
#define RDL_F(x, l) __builtin_bit_cast(float, __builtin_amdgcn_readlane(__builtin_bit_cast(int, x), l))
DI float wave_sum(float v) {
    v += DPP_F(v, 0xB1);
    v += DPP_F(v, 0x4E);
    v += DPP_F(v, 0x141);
    v += DPP_F(v, 0x140);
    const float r0 = RDL_F(v, 0), r1 = RDL_F(v, 16), r2 = RDL_F(v, 32), r3 = RDL_F(v, 48);
    return (r0 + r1) + (r2 + r3);
}
DI float wave_max(float v) {
    v = fmaxf(v, DPP_F(v, 0xB1)); v = fmaxf(v, DPP_F(v, 0x4E)); v = fmaxf(v, DPP_F(v, 0x141)); v = fmaxf(v, DPP_F(v, 0x140));
    const float r0 = RDL_F(v, 0), r1 = RDL_F(v, 16), r2 = RDL_F(v, 32), r3 = RDL_F(v, 48);
    return fmaxf(fmaxf(r0, r1), fmaxf(r2, r3));
}
DI float sigmoidf_(float x) { return 1.f / (1.f + __expf(-x)); }

#define XB_TMO      128
#define XB_XCNT(j)  (256  + 64 * (j))
#define XB_XSUB(j)  (1280 + 64 * (j))
#define XB_XGEN(j)  (2304 + 64 * (j))
#define XB_TOP      3328
#define XB_TOPGEN   3392
#define XCD_BAR_WORDS 3456
#define XB_SPIN_CAP (1u << 24)

DI unsigned xb_ld(unsigned* p)              { return __hip_atomic_load(p, __ATOMIC_RELAXED, __HIP_MEMORY_SCOPE_AGENT); }
DI unsigned xb_add(unsigned* p, unsigned v) { return __hip_atomic_fetch_add(p, v, __ATOMIC_RELAXED, __HIP_MEMORY_SCOPE_AGENT); }
DI unsigned xb_xcc_id() { return (unsigned)__builtin_amdgcn_s_getreg((3 << 11) | 20) & 0xFu; }
#define XB_SPIN(cond, bar) do { unsigned _sp = 0; while (cond) { __builtin_amdgcn_s_sleep(1); \
    if ((++_sp & 255u) == 0u) { if (xb_ld(&(bar)[XB_TMO])) break; if (_sp > XB_SPIN_CAP) { atomicAdd(&(bar)[XB_TMO], 1u); break; } } } } while (0)

struct XcdBarrier { unsigned* bar; unsigned x; volatile LAS unsigned* st; };

DI XcdBarrier xcd_barrier_post(unsigned* bar, volatile LAS unsigned* st) {
    XcdBarrier b; b.bar = bar; b.x = xb_xcc_id(); b.st = st;
    if (threadIdx.x == 0) (void)xb_add(&bar[XB_XCNT(b.x)], 1u);
    return b;
}
DI void xcd_barrier_complete(unsigned* bar, unsigned x, unsigned& nloc, unsigned& nx) {
    const unsigned G = gridDim.x * gridDim.y * gridDim.z;
    unsigned sum, cnt, mine, sp = 0u;
    for (;;) {
        sum = 0u; cnt = 0u; mine = 0u;
#pragma unroll
        for (unsigned j = 0; j < 16; ++j) { const unsigned c = xb_ld(&bar[XB_XCNT(j)]); sum += c; cnt += (c > 0u) ? 1u : 0u; mine = (j == x) ? c : mine; }
        if (sum == G) break;
        __builtin_amdgcn_s_sleep(1);
        if ((++sp & 255u) == 0u) { if (xb_ld(&bar[XB_TMO])) break; if (sp > XB_SPIN_CAP) { atomicAdd(&bar[XB_TMO], 1u); break; } }
    }
    nloc = mine > 0u ? mine : 1u; nx = cnt > 0u ? cnt : 1u;
}
DI void xcd_barrier(const XcdBarrier& b) {
    asm volatile("s_waitcnt vmcnt(0)" ::: "memory");
    __syncthreads();
    if (threadIdx.x == 0) {
        unsigned* bar = b.bar;
        __builtin_amdgcn_s_waitcnt(0);
        unsigned nloc = b.st[0], nx = b.st[1];
        if (nloc == 0u) { xcd_barrier_complete(bar, b.x, nloc, nx); b.st[0] = nloc; b.st[1] = nx; }
        const unsigned old = xb_add(&bar[XB_XSUB(b.x)], 1u);
        const unsigned gen = old / nloc;
        if (old + 1u == (gen + 1u) * nloc) {
            __builtin_amdgcn_fence(__ATOMIC_RELEASE, "agent");
            asm volatile("s_waitcnt vmcnt(0)" ::: "memory");
            const unsigned og = xb_add(&bar[XB_TOP], 1u);
            const unsigned tg = og / nx;
            if (og + 1u == (tg + 1u) * nx) xb_add(&bar[XB_TOPGEN], 1u);
            else XB_SPIN(xb_ld(&bar[XB_TOPGEN]) == tg, bar);
            __builtin_amdgcn_fence(__ATOMIC_ACQUIRE, "agent");
            xb_add(&bar[XB_XGEN(b.x)], 1u);
            asm volatile("s_waitcnt vmcnt(0)" ::: "memory");
        } else {
            XB_SPIN(xb_ld(&bar[XB_XGEN(b.x)]) == gen, bar);
            __builtin_amdgcn_fence(__ATOMIC_ACQUIRE, "agent");
            asm volatile("s_waitcnt vmcnt(0)" ::: "memory");
        }
    }
    __syncthreads();
}

namespace pg8 {
constexpr int BM = 256, BK = 64, HALF = 128, HTB = HALF * BK * 2, STAGE_BYTES = 8 * HTB, NXCD = 8, WGM = 8;
__host__ __device__ __forceinline__ int lds_byte(int r, int c) { const int st = (r >> 4) * 2 + (c >> 5), rr = r & 15, cc = c & 31, ob = rr * 64 + cc * 2; return st * 1024 + (ob ^ (((ob >> 9) & 1) << 5)); }
__host__ __device__ __forceinline__ void stage_rc(int b, int& R, int& C) { const int st = b / 1024, sb = b % 1024, swz = sb ^ (((sb >> 9) & 1) << 5); R = (st >> 1) * 16 + swz / 64; C = (st & 1) * 32 + (swz % 64) / 2; }
__host__ __device__ __forceinline__ int perm32(int rho) { const int n = rho >> 4, i = rho & 15; return 8 * (i >> 2) + 4 * n + (i & 3); }

struct Unit { int pm, pn; long bbase; };
struct Gemm { const bf16_t* A; const bf16_t* Bt; int lda, ldb, K; const int* rowmap; };

struct StaticOrder {
    int nM, nN, nwg, G, c, ldb;
    DI void init(int M, int N, int G_, int c_, int ldb_) { nM = M / BM; nN = N / BM; nwg = nM * nN; G = G_; c = c_; ldb = ldb_; }
    DI bool next(int i, Unit& u) const {
        const long L = (long)i * G + c; if (L >= nwg) return false;
        int wgid = (int)L; { const int q = nwg / NXCD, r = nwg % NXCD, xcd = wgid % NXCD, off = wgid / NXCD; wgid = (xcd < r ? xcd * (q + 1) : r * (q + 1) + (xcd - r) * q) + off; }
        const int nig = WGM * nN, gid = wgid / nig, fm = gid * WGM, gsz = (nM - fm) < WGM ? (nM - fm) : WGM;
        u.pm = fm + ((wgid % nig) % gsz); u.pn = (wgid % nig) / gsz; u.bbase = (long)u.pn * BM * ldb; return true;
    }
};
struct MoeOrder {
    const int* tileexp; int ntiles, nN, G, c, ldb; long estride;
    DI bool next(int i, Unit& u) const {
        const long L = (long)i * G + c; if (L >= (long)ntiles * nN) return false;
        const int tile = (int)(L / nN), pn = (int)(L % nN); const int e = tileexp[tile];
        u.pm = tile; u.pn = pn; u.bbase = (long)e * estride + (long)pn * BM * ldb; return true;
    }
};

template <class Epi, class Sched, bool GATHER = false>
DI void gemm_phase(LAS unsigned char* lds, const Gemm g, const Sched& S, const Epi& E) {
    int tid = threadIdx.x; asm volatile("" : "+v"(tid));
    const int wid = __builtin_amdgcn_readfirstlane(tid >> 6), lane = tid & 63, wr = wid >> 2, wc = wid & 3, fr = lane & 15, fq = lane >> 4;
    const int K = g.K, nt = K / BK;
    unsigned voffA[2], voffB[2]; int RA[2], CA[2];
#pragma unroll
    for (int i = 0; i < 2; ++i) { int R, C; stage_rc(tid * 16 + i * 8192, R, C); const int Rb = Epi::PERM ? ((R & ~31) + perm32(R & 31)) : R;
        RA[i] = R; CA[i] = C; voffA[i] = (unsigned)(R * g.lda + C) * 2u; voffB[i] = (unsigned)(Rb * g.ldb + C) * 2u; }
    const size_t kstep = (size_t)(BK * 2);
    const size_t hstepA = (size_t)HALF * g.lda * 2, hstepB = (size_t)HALF * g.ldb * 2;
    const unsigned ldsw = (unsigned)wid * 1024u;
    const int aoff = lds_byte(wr * 64 + fr, fq * 8), boff = lds_byte(wc * 32 + fr, fq * 8);
#define PG8_SA(b, h) (((b) * 2 + (h)) * HTB)
#define PG8_SB(b, h) ((4 + (b) * 2 + (h)) * HTB)
#define PG8_STAGE(bufoff, gbase, voff) do { _Pragma("unroll") for (int _i = 0; _i < 2; ++_i) \
        __builtin_amdgcn_global_load_lds((const unsigned*)((const char*)(gbase) + (voff)[_i]), (LAS unsigned*)(lds + (bufoff) + ldsw + _i * 8192), 16, 0, 0); } while (0)
    unsigned gA[2][2], ngA[2][2];
#define PG8_STAGE_A(b, h, ptr, isnext) do { if constexpr (GATHER) { if (isnext) PG8_STAGE(PG8_SA(b, h), ptr, ngA[h]); else PG8_STAGE(PG8_SA(b, h), ptr, gA[h]); } \
        else PG8_STAGE(PG8_SA(b, h), (ptr) + (h) * hstepA, voffA); } while (0)
#define PG8_GATHER_OFFS(dst, un) do { _Pragma("unroll") for (int h_ = 0; h_ < 2; ++h_) _Pragma("unroll") for (int i_ = 0; i_ < 2; ++i_) \
        dst[h_][i_] = (unsigned)(g.rowmap[(un).pm * BM + h_ * HALF + RA[i_]] * g.lda + CA[i_]) * 2u; } while (0)
#define PG8_LDA(dst, b, h) do { _Pragma("unroll") for (int m = 0; m < 4; ++m) _Pragma("unroll") for (int k = 0; k < 2; ++k) dst[m][k] = *(const LAS bf16x8*)(lds + PG8_SA(b, h) + aoff + m * 2048 + k * 1024); } while (0)
#define PG8_LDB(dst, b, h) do { _Pragma("unroll") for (int n = 0; n < 2; ++n) _Pragma("unroll") for (int k = 0; k < 2; ++k) dst[n][k] = *(const LAS bf16x8*)(lds + PG8_SB(b, h) + boff + n * 2048 + k * 1024); } while (0)
#define PG8_MMA(ai, bj, At, Bt) do { __builtin_amdgcn_s_setprio(1); _Pragma("unroll") for (int m = 0; m < 4; ++m) _Pragma("unroll") for (int n = 0; n < 2; ++n) _Pragma("unroll") for (int k = 0; k < 2; ++k) \
        acc[ai][bj][m][n] = __builtin_amdgcn_mfma_f32_16x16x32_bf16(Bt[n][k], At[m][k], acc[ai][bj][m][n], 0, 0, 0); __builtin_amdgcn_s_setprio(0); } while (0)
#define PG8_WAIT_V(n) asm volatile("s_waitcnt vmcnt(" #n ")" ::: "memory")
#define PG8_WAIT_L(n) asm volatile("s_waitcnt lgkmcnt(" #n ")" ::: "memory")
#define PG8_BAR __builtin_amdgcn_s_barrier()
#define PG8_SCHED __builtin_amdgcn_sched_barrier(0)
    Unit cur, nxt; int ui = 0;
    if (!S.next(0, cur)) return;
    f32x4 acc[2][2][4][2];
#pragma unroll
    for (int a = 0; a < 2; ++a)
#pragma unroll
        for (int b = 0; b < 2; ++b)
#pragma unroll
            for (int m = 0; m < 4; ++m)
#pragma unroll
                for (int n = 0; n < 2; ++n) acc[a][b][m][n] = (f32x4){0.f, 0.f, 0.f, 0.f};
    bf16x8 At[4][2], B0[2][2], B1[2][2];
    const char* cA; const char* cB = (const char*)g.Bt + cur.bbase * 2;
    if constexpr (GATHER) { cA = (const char*)g.A; PG8_GATHER_OFFS(gA, cur); PG8_GATHER_OFFS(ngA, cur); }
    else cA = (const char*)g.A + (size_t)cur.pm * BM * g.lda * 2;
    PG8_STAGE(PG8_SB(0, 0), cB, voffB); PG8_STAGE(PG8_SB(0, 1), cB + hstepB, voffB); PG8_STAGE_A(0, 0, cA, false); PG8_STAGE_A(0, 1, cA, false);
    if (wr == 1) PG8_BAR;
    PG8_WAIT_V(2); PG8_BAR;
    PG8_STAGE(PG8_SB(1, 0), cB + kstep, voffB); PG8_STAGE_A(1, 0, cA + kstep, false); PG8_STAGE(PG8_SB(1, 1), cB + hstepB + kstep, voffB);
    PG8_WAIT_V(6); PG8_BAR;
    for (;;) {
        const bool has_next = S.next(ui + 1, nxt);
        const char* nA; const char* nB = has_next ? (const char*)g.Bt + nxt.bbase * 2 : cB;
        if constexpr (GATHER) { nA = cA; if (has_next) PG8_GATHER_OFFS(ngA, nxt); }
        else nA = has_next ? (const char*)g.A + (size_t)nxt.pm * BM * g.lda * 2 : cA;
        for (int t = 0; t < nt; t += 2) {
            const bool last = (t == nt - 2);
            const char* a1 = cA + (size_t)(t + 1) * kstep;
            const char* a2 = last ? nA : cA + (size_t)(t + 2) * kstep; const char* b2 = last ? nB : cB + (size_t)(t + 2) * kstep;
            const char* a3 = a2 + kstep; const char* b3 = b2 + kstep;
            PG8_LDB(B0, 0, 0); PG8_LDB(B1, 0, 1); PG8_SCHED; PG8_LDA(At, 0, 0); PG8_STAGE_A(1, 1, a1, false);
            PG8_WAIT_V(8); PG8_WAIT_L(0); PG8_BAR; PG8_MMA(0, 0, At, B0); PG8_MMA(0, 1, At, B1); PG8_BAR; PG8_SCHED;
            PG8_LDA(At, 0, 1); PG8_STAGE(PG8_SB(0, 0), b2, voffB); PG8_STAGE(PG8_SB(0, 1), b2 + hstepB, voffB); PG8_STAGE_A(0, 0, a2, last);
            PG8_WAIT_V(8); PG8_WAIT_L(0); PG8_BAR; PG8_MMA(1, 0, At, B0); PG8_MMA(1, 1, At, B1); PG8_BAR; PG8_SCHED;
            PG8_LDB(B0, 1, 0); PG8_LDB(B1, 1, 1); PG8_SCHED; PG8_LDA(At, 1, 0); PG8_STAGE_A(0, 1, a2, last);
            PG8_WAIT_V(8); PG8_WAIT_L(0); PG8_BAR; PG8_MMA(0, 0, At, B0); PG8_MMA(0, 1, At, B1); PG8_BAR; PG8_SCHED;
            PG8_LDA(At, 1, 1); PG8_STAGE(PG8_SB(1, 0), b3, voffB); PG8_STAGE(PG8_SB(1, 1), b3 + hstepB, voffB); PG8_STAGE_A(1, 0, a3, last);
            PG8_WAIT_V(8); PG8_WAIT_L(0); PG8_BAR; PG8_MMA(1, 0, At, B0); PG8_MMA(1, 1, At, B1); PG8_BAR; PG8_SCHED;
        }
        if (wr == 0) PG8_BAR;
        E(acc, cur, wr, wc, fr, fq);
        if (!has_next) break;
#pragma unroll
        for (int a = 0; a < 2; ++a)
#pragma unroll
            for (int b = 0; b < 2; ++b)
#pragma unroll
                for (int m = 0; m < 4; ++m)
#pragma unroll
                    for (int n = 0; n < 2; ++n) acc[a][b][m][n] = (f32x4){0.f, 0.f, 0.f, 0.f};
        cur = nxt; cA = nA; cB = nB; ++ui;
        if constexpr (GATHER) {
#pragma unroll
            for (int h_ = 0; h_ < 2; ++h_)
#pragma unroll
                for (int i_ = 0; i_ < 2; ++i_) gA[h_][i_] = ngA[h_][i_]; }
        if (wr == 1) PG8_BAR;
    }
    PG8_WAIT_V(0);
    PG8_BAR;
#undef PG8_SA
#undef PG8_SB
#undef PG8_STAGE
#undef PG8_STAGE_A
#undef PG8_LDA
#undef PG8_LDB
#undef PG8_MMA
#undef PG8_WAIT_V
#undef PG8_WAIT_L
#undef PG8_BAR
#undef PG8_SCHED
#undef PG8_GATHER_OFFS
}

DI float row_ssq32(const float* part, int row) { const f32x4* p = (const f32x4*)(part + (size_t)row * 32); float t = 0.f;
#pragma unroll
    for (int i = 0; i < 8; ++i) { const f32x4 v = p[i]; t += (v[0] + v[1]) + (v[2] + v[3]); }
    return t; }
DI float row_rstd(const float* ssq, int np, int row) {
    float t;
    if (np == 1) t = ssq[row];
    else { const f32x4* p = (const f32x4*)(ssq + (size_t)row * 32); t = 0.f;
#pragma unroll
        for (int i = 0; i < 8; ++i) { const f32x4 v = p[i]; t += (v[0] + v[1]) + (v[2] + v[3]); } }
    return rsqrtf(t * (1.f / 2048.f) + 1e-6f);
}
struct EpiBf16 {
    static constexpr bool PERM = true;
    bf16_t* O; int ldc; bf16_t* O2; int ldc2; int split_tile; const float* ssq; int np;
    DI void operator()(const f32x4 (&acc)[2][2][4][2], const Unit& u, int wr, int wc, int fr, int fq) const {
        bf16_t* base = O; int ld = ldc; int colt = u.pn * BM;
        if (u.pn >= split_tile) { base = O2; ld = ldc2; colt = (u.pn - split_tile) * BM; }
        const int row0 = u.pm * BM + wr * 64 + fr, col0 = colt + wc * 32 + 8 * fq;
#pragma unroll
        for (int ai = 0; ai < 2; ++ai)
#pragma unroll
            for (int m = 0; m < 4; ++m) { const int row = row0 + ai * HALF + m * 16; bf16_t* rowp = base + (size_t)row * ld + col0;
                const float rs = ssq ? row_rstd(ssq, np, row) : 1.f;
#pragma unroll
                for (int bj = 0; bj < 2; ++bj) { const f32x4 v0 = acc[ai][bj][m][0] * rs, v1 = acc[ai][bj][m][1] * rs;
                    u32x4 w; w.x = pk2(v0[0], v0[1]); w.y = pk2(v0[2], v0[3]); w.z = pk2(v1[0], v1[1]); w.w = pk2(v1[2], v1[3]);
                    *(u32x4*)(rowp + bj * HALF) = w; } }
    }
};
struct EpiResid {
    static constexpr bool PERM = true;
    const float* basef; const bf16_t* baseb; bf16_t* out; int ldc; float* part_out;
    DI void operator()(const f32x4 (&acc)[2][2][4][2], const Unit& u, int wr, int wc, int fr, int fq) const {
        const int row0 = u.pm * BM + wr * 64 + fr, col0 = u.pn * BM + wc * 32 + 8 * fq;
#pragma unroll
        for (int ai = 0; ai < 2; ++ai)
#pragma unroll
            for (int m = 0; m < 4; ++m) { const int row = row0 + ai * HALF + m * 16; const size_t off = (size_t)row * ldc + col0; float sq = 0.f;
#pragma unroll
                for (int bj = 0; bj < 2; ++bj) { f32x4 v0 = acc[ai][bj][m][0], v1 = acc[ai][bj][m][1];
                    if (basef) { v0 += *(const f32x4*)(basef + off + bj * HALF); v1 += *(const f32x4*)(basef + off + bj * HALF + 4); }
                    else { const u32x4 b = *(const u32x4*)(baseb + off + bj * HALF);
                        v0 += (f32x4){bflo(b.x), bfhi(b.x), bflo(b.y), bfhi(b.y)}; v1 += (f32x4){bflo(b.z), bfhi(b.z), bflo(b.w), bfhi(b.w)}; }
                    u32x4 w; w.x = pk2(v0[0], v0[1]); w.y = pk2(v0[2], v0[3]); w.z = pk2(v1[0], v1[1]); w.w = pk2(v1[2], v1[3]);
                    *(u32x4*)(out + off + bj * HALF) = w;
                    const float a0 = bflo(w.x), a1 = bfhi(w.x), a2 = bflo(w.y), a3 = bfhi(w.y), a4 = bflo(w.z), a5 = bfhi(w.z), a6 = bflo(w.w), a7 = bfhi(w.w);
                    sq += ((a0 * a0 + a1 * a1) + (a2 * a2 + a3 * a3)) + ((a4 * a4 + a5 * a5) + (a6 * a6 + a7 * a7)); }
                sq += __shfl_xor(sq, 16); sq += __shfl_xor(sq, 32);
                if (fq == 0) part_out[(size_t)row * 32 + u.pn * 4 + wc] = sq; }
    }
};
struct EpiF32 {
    static constexpr bool PERM = false;
    float* out; int ldc; const float* ssq; int np; float* ssq_pub;
    DI void operator()(const f32x4 (&acc)[2][2][4][2], const Unit& u, int wr, int wc, int fr, int fq) const {
        const int row0 = u.pm * BM + wr * 64 + fr, col0 = u.pn * BM + wc * 32 + 4 * fq;
#pragma unroll
        for (int ai = 0; ai < 2; ++ai)
#pragma unroll
            for (int m = 0; m < 4; ++m) { const int row = row0 + ai * HALF + m * 16; const size_t off = (size_t)row * ldc + col0;
                float rs = 1.f;
                if (ssq) { const float t = (np == 1) ? ssq[row] : row_ssq32(ssq, row); rs = rsqrtf(t * (1.f / 2048.f) + 1e-6f); if (ssq_pub && u.pn == 0 && wc == 0 && fq == 0) ssq_pub[row] = t; }
#pragma unroll
                for (int bj = 0; bj < 2; ++bj)
#pragma unroll
                    for (int n = 0; n < 2; ++n) *(f32x4*)(out + off + bj * HALF + n * 16) = acc[ai][bj][m][n] * rs; }
    }
};
struct EpiSiluMul {
    static constexpr bool PERM = true;
    bf16_t* O; int ldc; const float* ssq; const int* rowmap;
    DI void operator()(const f32x4 (&acc)[2][2][4][2], const Unit& u, int wr, int wc, int fr, int fq) const {
        const int row0 = u.pm * BM + wr * 64 + fr, col0 = (u.pn * BM + wc * 32 + 8 * fq) >> 1;
#pragma unroll
        for (int ai = 0; ai < 2; ++ai)
#pragma unroll
            for (int m = 0; m < 4; ++m) { const int row = row0 + ai * HALF + m * 16; bf16_t* rowp = O + (size_t)row * ldc + col0;
                const float rs = row_rstd(ssq, 1, rowmap[row]);
#pragma unroll
                for (int bj = 0; bj < 2; ++bj) { const f32x4 v0 = acc[ai][bj][m][0] * rs, v1 = acc[ai][bj][m][1] * rs;
                    const float h0 = v0[0] / (1.f + __expf(-v0[0])) * v0[1], h1 = v0[2] / (1.f + __expf(-v0[2])) * v0[3];
                    const float h2 = v1[0] / (1.f + __expf(-v1[0])) * v1[1], h3 = v1[2] / (1.f + __expf(-v1[2])) * v1[3];
                    u32x2 w; w.x = pk2(h0, h1); w.y = pk2(h2, h3);
                    *(u32x2*)(rowp + bj * (HALF / 2)) = w; } }
    }
};
struct EpiScatter {
    static constexpr bool PERM = true;
    bf16_t* O; int ldc; const int* dst;
    DI void operator()(const f32x4 (&acc)[2][2][4][2], const Unit& u, int wr, int wc, int fr, int fq) const {
        const int row0 = u.pm * BM + wr * 64 + fr, col0 = u.pn * BM + wc * 32 + 8 * fq;
#pragma unroll
        for (int ai = 0; ai < 2; ++ai)
#pragma unroll
            for (int m = 0; m < 4; ++m) { const int d = dst[row0 + ai * HALF + m * 16];
                if (d >= 0) { bf16_t* rowp = O + (size_t)d * ldc + col0;
#pragma unroll
                    for (int bj = 0; bj < 2; ++bj) { const f32x4 v0 = acc[ai][bj][m][0], v1 = acc[ai][bj][m][1];
                        u32x4 w; w.x = pk2(v0[0], v0[1]); w.y = pk2(v0[2], v0[3]); w.z = pk2(v1[0], v1[1]); w.w = pk2(v1[2], v1[3]);
                        *(u32x4*)(rowp + bj * HALF) = w; } } }
    }
};
}

struct Args { const void* in[45]; float* out; unsigned char* ws; int ph_lo, ph_hi; };
static_assert(sizeof(void*) == 8 && sizeof(Args) == 384, "Args layout");

#define CAS __attribute__((address_space(4)))
typedef const CAS char* kaptr_t;
typedef const float* const CAS* inptr_t;
struct Ctx {
    LAS unsigned char* lds; unsigned char* ws; inptr_t in; float* X;
    int tid, lane, wave, G, wg, gw, ngw, att_sel;
};

struct TrDesc { const float* W; bf16_t* WT; int N, ldk, row_off, row_mul, nblk, item; const float* ks; };
DI void tr_load(const TrDesc& d, float (&tv)[32], int lane) {
    const int kb = d.item / d.nblk, nb = d.item % d.nblk, k0 = 64 * kb, n0 = 32 * nb;
#pragma unroll
    for (int i = 0; i < 32; ++i) { const int kk = 2 * i + (lane >> 5); tv[i] = d.W[(size_t)(k0 + kk) * d.N + n0 + (lane & 31)]; }
}
DI void tr_store(const TrDesc& d, const float (&tv)[32], LAS float* scr, int lane) {
    const int kb = d.item / d.nblk, nb = d.item % d.nblk, k0 = 64 * kb, n0 = 32 * nb;
#pragma unroll
    for (int i = 0; i < 32; ++i) { const int kk = 2 * i + (lane >> 5); scr[kk * 33 + (lane & 31)] = d.ks ? tv[i] * d.ks[k0 + kk] : tv[i]; }
    asm volatile("s_waitcnt lgkmcnt(0)" ::: "memory");
    const int c = lane & 7;
#pragma unroll
    for (int j = 0; j < 4; ++j) { const int n = (lane >> 3) + 8 * j; const LAS float* s = scr + (8 * c) * 33 + n;
        u32x4 o; o.x = pk2(s[0 * 33], s[1 * 33]); o.y = pk2(s[2 * 33], s[3 * 33]); o.z = pk2(s[4 * 33], s[5 * 33]); o.w = pk2(s[6 * 33], s[7 * 33]);
        *(u32x4*)(d.WT + (size_t)(d.row_off + (n0 + n) * d.row_mul) * d.ldk + k0 + 8 * c) = o; }
    asm volatile("s_waitcnt lgkmcnt(0)" ::: "memory");
}

DI void norm_row(const float* xin, const bf16_t* xinb, bf16_t* xout, const bf16_t* c0, const bf16_t* c1, float g0, float g1, const float* w, bf16_t* hout, float* fout, int lane, float* ssq_w = nullptr) {
    f32x4 v[8]; float ss = 0.f;
    if (xin) {
#pragma unroll
        for (int j = 0; j < 8; ++j) { v[j] = ((const f32x4*)xin)[lane + 64 * j]; }
    } else {
#pragma unroll
        for (int j = 0; j < 8; ++j) { const u32x2 a = ((const u32x2*)xinb)[lane + 64 * j]; v[j] = (f32x4){bflo(a.x), bfhi(a.x), bflo(a.y), bfhi(a.y)}; }
    }
    if (c0) {
#pragma unroll
        for (int j = 0; j < 8; ++j) { const u32x2 a = ((const u32x2*)c0)[lane + 64 * j], b = ((const u32x2*)c1)[lane + 64 * j];
            v[j][0] += g0 * bflo(a.x) + g1 * bflo(b.x); v[j][1] += g0 * bfhi(a.x) + g1 * bfhi(b.x);
            v[j][2] += g0 * bflo(a.y) + g1 * bflo(b.y); v[j][3] += g0 * bfhi(a.y) + g1 * bfhi(b.y); }
    }
#pragma unroll
    for (int j = 0; j < 8; ++j) ss += (v[j][0] * v[j][0] + v[j][1] * v[j][1]) + (v[j][2] * v[j][2] + v[j][3] * v[j][3]);
    if (xout) {
#pragma unroll
        for (int j = 0; j < 8; ++j) { u32x2 o; o.x = pk2(v[j][0], v[j][1]); o.y = pk2(v[j][2], v[j][3]); ((u32x2*)xout)[lane + 64 * j] = o; }
    }
    const float sst = wave_sum(ss);
    if (ssq_w) { if (lane == 0) *ssq_w = sst; }
    if (!w) return;
    const float rstd = rsqrtf(sst * (1.f / DM) + 1e-6f);
#pragma unroll
    for (int j = 0; j < 8; ++j) { const f32x4 ww = ((const f32x4*)w)[lane + 64 * j]; const f32x4 y = v[j] * rstd * ww;
        if (hout) { u32x2 o; o.x = pk2(y[0], y[1]); o.y = pk2(y[2], y[3]); ((u32x2*)hout)[lane + 64 * j] = o; }
        if (fout) ((f32x4*)fout)[lane + 64 * j] = y; }
}

constexpr int I_EXP = 512;
constexpr int N_MOE_ITEMS = 3 * NEXP * I_EXP;
DI TrDesc moe_tr_desc(int l, int r, inptr_t in, unsigned char* ws) {
    const int e = r / (3 * I_EXP), q = r % (3 * I_EXP), mat = q / I_EXP, ii = q % I_EXP;
    const size_t eo = ((size_t)l * NEXP + e);
    if (mat == 0) return TrDesc{in[42] + eo * DM * DEXP, (bf16_t*)(ws + WS_WGU) + (size_t)e * 1024 * DM, DEXP, DM, 0, 2, 16, ii, in[37] + (size_t)l * DM};
    if (mat == 1) return TrDesc{in[43] + eo * DM * DEXP, (bf16_t*)(ws + WS_WGU) + (size_t)e * 1024 * DM, DEXP, DM, 1, 2, 16, ii, in[37] + (size_t)l * DM};
    return TrDesc{in[44] + eo * DEXP * DM, (bf16_t*)(ws + WS_WD) + (size_t)e * DM * DEXP, DM, DEXP, 0, 1, 64, ii, nullptr};
}
DI void phase_convert(const Ctx& C, int l) {
    inptr_t in = C.in;
    unsigned char* ws = C.ws;
    LAS float* scr = (LAS float*)(C.lds + C.wave * 16384);
    bf16_t* WINT = (bf16_t*)(ws + WS_WINT);
    const int I_WIN = 32 * 174, I_VR = 32, I_WOUT = 32 * 64, I_CAQ = 32 * 16, I_CAKV = 32 * 32, I_CAO = 8 * 64, I_WQB = 6 * 24, I_WKVB = 4 * 32;
    const int n_small = I_WIN + I_VR + I_WOUT + I_CAQ + I_CAKV + I_CAO + I_WQB + I_WKVB;
    const int n_items = n_small;
    auto decode = [&](int it) -> TrDesc {
        int r = it;
        if (r < I_WIN) return TrDesc{in[6] + (size_t)l * DM * IN_COLS, WINT, IN_COLS, DM, 0, 1, 174, r, in[5] + (size_t)l * DM}; r -= I_WIN;
        if (r < I_VR) return TrDesc{in[7], WINT, 32, DM, IN_COLS, 1, 1, r, in[5] + DM}; r -= I_VR;
        if (r < I_WOUT) return TrDesc{in[8] + (size_t)l * DM * DM, (bf16_t*)(ws + WS_WOUTT), DM, DM, 0, 1, 64, r, nullptr}; r -= I_WOUT;
        if (r < I_CAQ) return TrDesc{in[34] + (size_t)l * DM * 512, (bf16_t*)(ws + WS_CAWQT), 512, DM, 0, 1, 16, r, in[32] + (size_t)l * DM}; r -= I_CAQ;
        if (r < I_CAKV) return TrDesc{in[35] + (size_t)l * DM * 1024, (bf16_t*)(ws + WS_CAWKVT), 1024, DM, 0, 1, 32, r, nullptr}; r -= I_CAKV;
        if (r < I_CAO) return TrDesc{in[36] + (size_t)l * 512 * DM, (bf16_t*)(ws + WS_CAWOT), DM, 512, 0, 1, 64, r, nullptr}; r -= I_CAO;
        if (r < I_WQB) return TrDesc{in[29] + (size_t)l * 384 * 768, (bf16_t*)(ws + WS_WQBT), 768, 384, 0, 1, 24, r, nullptr}; r -= I_WQB;
        if (r < I_WKVB) return TrDesc{in[31] + (size_t)l * 256 * 1024, (bf16_t*)(ws + WS_WKVBT), 1024, 256, 0, 1, 32, r, nullptr}; r -= I_WKVB;
        return TrDesc{in[31] + (size_t)l * 256 * 1024, (bf16_t*)(ws + WS_WKVBT), 1024, 256, 0, 1, 32, 0, nullptr};
    };
    {
        const int first = (l == 0 && C.gw >= I_WIN && C.gw < I_WIN + I_VR) ? C.gw + C.ngw : C.gw;
        float ta[32], tb[32];
        int it = first;
        if (it < n_items) { TrDesc d0 = decode(it); tr_load(d0, ta, C.lane);
            for (;;) {
                int it2 = it + C.ngw; if (l == 0 && it2 >= I_WIN && it2 < I_WIN + I_VR) it2 += C.ngw;
                const bool has2 = it2 < n_items; TrDesc d1 = d0;
                if (has2) { d1 = decode(it2); tr_load(d1, tb, C.lane); }
                tr_store(d0, ta, scr, C.lane);
                if (!has2) break;
                int it3 = it2 + C.ngw; if (l == 0 && it3 >= I_WIN && it3 < I_WIN + I_VR) it3 += C.ngw;
                const bool has3 = it3 < n_items;
                if (has3) { d0 = decode(it3); tr_load(d0, ta, C.lane); }
                tr_store(d1, tb, scr, C.lane);
                if (!has3) break;
                it = it3;
            }
        }
    }
    const int gt = C.wg * 512 + C.tid, ngt = C.G * 512;
    if (l == 0) for (int i = gt; i < 64 * DM / 8; i += ngt) ((u32x4*)(WINT + (size_t)IN_COLS * DM))[i] = (u32x4){0u, 0u, 0u, 0u};
    {
        bf16_t* LB = (bf16_t*)(ws + WS_LORABT);
        const float* w2 = in[12] + (size_t)l * 64 * 1024; const float* a2 = in[14] + (size_t)l * 64 * 1024; const float* g2 = in[17] + (size_t)l * 128 * 1024; const float* v2 = in[16];
        for (int i = gt; i < 4096 * 384; i += ngt) {
            const int n = i / 384, k = i % 384, blk = n >> 10, c = n & 1023; float v = 0.f;
            if (blk == 0) { if (k < 64) v = w2[k * 1024 + c]; }
            else if (blk == 1) { if (k >= 64 && k < 128) v = a2[(k - 64) * 1024 + c]; }
            else if (blk == 2) { if (k >= 128 && k < 256) v = g2[(k - 128) * 1024 + c]; }
            else { if (l == 1 && k >= 256 && k < 288) v = v2[(k - 256) * 1024 + c]; }
            LB[i] = f2bf(v);
        }
    }
    {
        bf16_t* WRB = (bf16_t*)(ws + WS_WRB); const float* nf = in[37] + (size_t)l * DM; const float* wg = in[38] + (size_t)l * DM * 4; const float* we = in[40] + (size_t)l * DM * 32;
        for (int i = gt; i < 256 * DM; i += ngt) { const int o = i / DM, k = i % DM; const float v = (o < 32) ? we[k * 32 + o] : ((o < 36) ? wg[k * 4 + (o - 32)] : 0.f); WRB[i] = f2bf(v * nf[k]); }
    }
    if (l == 0) {
        float* LUT = (float*)(ws + WS_LUT); const float* rb = in[3];
        for (int i = gt; i < 4 * 128; i += ngt) { const int h = i >> 7, n = i & 127; int bk;
            if (n < 16) bk = n; else { bk = 16 + (int)(log2f((float)n * 0.0625f) * (16.f / 3.f)); if (bk > 31) bk = 31; }
            LUT[i] = rb[bk * 4 + h] * LOG2E; }
        f32x2* RT = (f32x2*)(ws + WS_ROPE); const int* pos = (const int*)in[2];
        for (int i = gt; i < NT * 32; i += ngt) { const int t = i >> 5, j = i & 31; const float invf = powf(10000.f, -(float)j / 32.f); const float ang = (float)pos[t] * invf; float s, c; sincosf(ang, &s, &c); RT[i] = (f32x2){c, s}; }
    }
    for (int m = C.gw; m < NMEM; m += C.ngw) norm_row(in[1] + (size_t)m * DM, nullptr, nullptr, nullptr, nullptr, 0.f, 0.f, in[33] + (size_t)l * DM, (bf16_t*)(ws + WS_MEMN) + (size_t)m * DM, nullptr, C.lane);
    {
        const bf16_t* C2 = (const bf16_t*)(ws + WS_C2); const float* gate = (const float*)(ws + WS_GATE); bf16_t* XB = (bf16_t*)(ws + WS_XB); float* SSQM = (float*)(ws + WS_SSQM);
        for (int m = C.gw; m < NT; m += C.ngw) {
            if (l == 0) norm_row(in[0] + (size_t)m * DM, nullptr, XB + (size_t)m * DM, nullptr, nullptr, 0.f, 0.f, nullptr, nullptr, nullptr, C.lane, SSQM + m);
            else norm_row(nullptr, XB + (size_t)m * DM, XB + (size_t)m * DM, C2 + (size_t)(2 * m) * DM, C2 + (size_t)(2 * m + 1) * DM, gate[2 * m], gate[2 * m + 1], nullptr, nullptr, nullptr, C.lane, SSQM + m);
        }
    }
}

DI void phase_ew1(const Ctx& C, int l) {
    inptr_t in = C.in; unsigned char* ws = C.ws;
    const bf16_t* PRW = (const bf16_t*)(ws + WS_PRW); const bf16_t* PATT = (const bf16_t*)(ws + WS_PATT);
    bf16_t* LA = (bf16_t*)(ws + WS_LORAA); bf16_t* QN = (bf16_t*)(ws + WS_QN); bf16_t* KVN = (bf16_t*)(ws + WS_KVN); bf16_t* KPE = (bf16_t*)(ws + WS_KPE);
    const float* mu = in[9] + (size_t)l * RW_COLS; const float* muv = in[10];
    const float* qnw = in[28] + (size_t)l * 384; const float* kvnw = in[30] + (size_t)l * 256;
    const f32x2* RT = (const f32x2*)(ws + WS_ROPE);
    const int lane = C.lane;
#pragma unroll 4
    for (int t = C.gw; t < NT; t += C.ngw) {
        const bool first = (t % SEQ) == 0;
        const bf16_t* p = PRW + (size_t)t * RW_COLS; const bf16_t* pa = PATT + (size_t)t * PATT_COLS;
#pragma unroll
        for (int j = 0; j < 4; ++j) { const int c = lane + 64 * j, col = 3072 + c;
            const float cur = bf2f(p[col]); const float prev = first ? 0.f : bf2f(p[col - RW_COLS]);
            const float xs = cur + mu[col] * (prev - cur);
            float v; if (c < 64) v = tanhf(xs); else if (c < 128) v = xs; else v = sigmoidf_(xs);
            LA[(size_t)t * 384 + c] = f2bf(v); }
        {
#pragma unroll
            for (int j = 0; j < 2; ++j) { const int c = lane + 64 * j; float v = 0.f;
                if (l == 1 && c < 32) { const float cur = bf2f(pa[2240 + c]); const float prev = first ? 0.f : bf2f(pa[2240 + c - PATT_COLS]); v = cur + muv[c] * (prev - cur); }
                LA[(size_t)t * 384 + 256 + c] = f2bf(v); } }
        float q[6], kv[4]; float sq = 0.f, skv = 0.f;
#pragma unroll
        for (int j = 0; j < 6; ++j) { q[j] = bf2f(pa[1536 + lane + 64 * j]); sq += q[j] * q[j]; }
#pragma unroll
        for (int j = 0; j < 4; ++j) { kv[j] = bf2f(pa[1920 + lane + 64 * j]); skv += kv[j] * kv[j]; }
        const float rq = rsqrtf(wave_sum(sq) * (1.f / 384.f) + 1e-6f), rkv = rsqrtf(wave_sum(skv) * (1.f / 256.f) + 1e-6f);
#pragma unroll
        for (int j = 0; j < 6; ++j) QN[(size_t)t * 384 + lane + 64 * j] = f2bf(q[j] * rq * qnw[lane + 64 * j]);
#pragma unroll
        for (int j = 0; j < 4; ++j) KVN[(size_t)t * 256 + lane + 64 * j] = f2bf(kv[j] * rkv * kvnw[lane + 64 * j]);
        { const float x = bf2f(pa[2176 + lane]); const float xo = __shfl_xor(x, 32); const f32x2 cs = RT[t * 32 + (lane & 31)];
          const float y = (lane < 32) ? (x * cs.x - xo * cs.y) : (x * cs.x + xo * cs.y);
          KPE[(size_t)t * 64 + lane] = f2bf(y); }
    }
}

DI void phase_ew2(const Ctx& C, int l) {
    inptr_t in = C.in; unsigned char* ws = C.ws;
    const bf16_t* PRW = (const bf16_t*)(ws + WS_PRW); const bf16_t* LO = (const bf16_t*)(ws + WS_LORAO);
    bf16_t* SR = (bf16_t*)(ws + WS_U); bf16_t* SW = SR + (size_t)NT * 1024; bf16_t* SK = SW + (size_t)NT * 1024; bf16_t* SV = SK + (size_t)NT * 1024;
    bf16_t* SA = SV + (size_t)NT * 1024; bf16_t* SB = SA + (size_t)NT * 1024; bf16_t* VF = (bf16_t*)(ws + WS_VFIRST);
    const float* mu = in[9] + (size_t)l * RW_COLS; const float* w0 = in[11] + (size_t)l * 1024; const float* a0 = in[13] + (size_t)l * 1024; const float* v0 = in[15];
    const float* kkw = in[18] + (size_t)l * 1024; const float* kaw = in[19] + (size_t)l * 1024;
    const int lane = C.lane;
#pragma unroll 1
    for (int j = 0; j < 2; ++j) {
        const int c0 = 8 * lane + 512 * j;
        float mu8[3][8], w0v[8], a0v[8], kkv[8], kav[8], v0v[8];
#pragma unroll
        for (int e = 0; e < 2; ++e) {
#pragma unroll
            for (int q = 0; q < 3; ++q) { const f32x4 m = *(const f32x4*)(mu + q * 1024 + c0 + 4 * e);
#pragma unroll
                for (int i = 0; i < 4; ++i) mu8[q][4 * e + i] = m[i]; }
            const f32x4 x0 = *(const f32x4*)(w0 + c0 + 4 * e), x1 = *(const f32x4*)(a0 + c0 + 4 * e), x2 = *(const f32x4*)(kkw + c0 + 4 * e), x3 = *(const f32x4*)(kaw + c0 + 4 * e);
            f32x4 x4 = (f32x4){0.f, 0.f, 0.f, 0.f}; if (l == 1) x4 = *(const f32x4*)(v0 + c0 + 4 * e);
#pragma unroll
            for (int i = 0; i < 4; ++i) { w0v[4 * e + i] = x0[i]; a0v[4 * e + i] = x1[i]; kkv[4 * e + i] = x2[i]; kav[4 * e + i] = x3[i]; v0v[4 * e + i] = x4[i]; } }
#pragma unroll 2
        for (int t = C.gw; t < NT; t += C.ngw) {
            const bool first = (t % SEQ) == 0;
            const bf16_t* p = PRW + (size_t)t * RW_COLS; const bf16_t* lo = LO + (size_t)t * 4096;
            float xs[3][8];
#pragma unroll
            for (int q = 0; q < 3; ++q) { const int col = q * 1024 + c0;
                const u32x4 cu = *(const u32x4*)(p + col); u32x4 pv = (u32x4){0u, 0u, 0u, 0u}; if (!first) pv = *(const u32x4*)(p + col - RW_COLS);
#pragma unroll
                for (int e = 0; e < 4; ++e) { const float c_lo = bflo(cu[e]), c_hi = bfhi(cu[e]), p_lo = bflo(pv[e]), p_hi = bfhi(pv[e]);
                    xs[q][2 * e] = c_lo + mu8[q][2 * e] * (p_lo - c_lo); xs[q][2 * e + 1] = c_hi + mu8[q][2 * e + 1] * (p_hi - c_hi); } }
            const u32x4 lw = *(const u32x4*)(lo + c0), la = *(const u32x4*)(lo + 1024 + c0);
            u32x4 lv = (u32x4){0u, 0u, 0u, 0u}, vfv = (u32x4){0u, 0u, 0u, 0u};
            if (l == 1) { lv = *(const u32x4*)(lo + 3072 + c0); vfv = *(const u32x4*)(VF + (size_t)t * 1024 + c0); }
            float omw[8], av[8], kk[8], k2[8], v2[8]; float ssq = 0.f;
#pragma unroll
            for (int e = 0; e < 8; ++e) {
                const float lwf = (e & 1) ? bfhi(lw[e >> 1]) : bflo(lw[e >> 1]), laf = (e & 1) ? bfhi(la[e >> 1]) : bflo(la[e >> 1]);
                const float wi = w0v[e] + lwf;
                omw[e] = 1.f - __expf(-0.6065306597f * sigmoidf_(wi));
                av[e] = sigmoidf_(a0v[e] + laf);
                kk[e] = xs[1][e] * kkv[e]; ssq += kk[e] * kk[e];
                k2[e] = xs[1][e] * (1.f + (av[e] - 1.f) * kav[e]);
                v2[e] = xs[2][e];
                if (l == 1) { const float lvf = (e & 1) ? bfhi(lv[e >> 1]) : bflo(lv[e >> 1]), vff = (e & 1) ? bfhi(vfv[e >> 1]) : bflo(vfv[e >> 1]);
                    v2[e] = xs[2][e] + (vff - xs[2][e]) * sigmoidf_(v0v[e] + lvf); }
            }
            ssq += DPP_F(ssq, 0xB1); ssq += DPP_F(ssq, 0x4E); ssq += DPP_F(ssq, 0x141);
            const float inv = 1.f / fmaxf(sqrtf(ssq), 1e-12f);
            u32x4 oR, oW, oK, oV, oA, oB, oF;
#pragma unroll
            for (int e = 0; e < 4; ++e) { const float ka = kk[2 * e] * inv, kb = kk[2 * e + 1] * inv;
                oR[e] = pk2(xs[0][2 * e], xs[0][2 * e + 1]); oW[e] = pk2(omw[2 * e], omw[2 * e + 1]); oK[e] = pk2(k2[2 * e], k2[2 * e + 1]); oV[e] = pk2(v2[2 * e], v2[2 * e + 1]);
                oA[e] = pk2(ka, kb); oB[e] = pk2(ka * av[2 * e], kb * av[2 * e + 1]); oF[e] = pk2(xs[2][2 * e], xs[2][2 * e + 1]); }
            const size_t o = (size_t)t * 1024 + c0;
            *(u32x4*)(SR + o) = oR; *(u32x4*)(SW + o) = oW; *(u32x4*)(SK + o) = oK; *(u32x4*)(SV + o) = oV; *(u32x4*)(SA + o) = oA; *(u32x4*)(SB + o) = oB;
            if (l == 0) *(u32x4*)(VF + o) = oF;
        }
    }
    bf16_t* QM = (bf16_t*)(ws + WS_QM); const f32x2* RT = (const f32x2*)(ws + WS_ROPE);
    const int gt = C.wg * 512 + C.tid, ngt = C.G * 512;
    for (int i = gt; i < NT * 4 * 32; i += ngt) { const int t = i >> 7, h = (i >> 5) & 3, j = i & 31;
        bf16_t* q = QM + (size_t)t * 768 + h * 192 + 128; const float x1 = bf2f(q[j]), x2 = bf2f(q[j + 32]); const f32x2 cs = RT[t * 32 + j];
        q[j] = f2bf(x1 * cs.x - x2 * cs.y); q[j + 32] = f2bf(x2 * cs.x + x1 * cs.y); }
}

DI float fma_s(float a, float b, float c) { float d; asm("v_fma_f32 %0, %1, %2, %3" : "=v"(d) : "v"(a), "v"(b), "v"(c)); return d; }
#define ROW_ALLREDUCE(x) do { \
    x += __builtin_bit_cast(float, __builtin_amdgcn_update_dpp(0, __builtin_bit_cast(int, x), 0x128, 0xf, 0xf, true)); \
    x += __builtin_bit_cast(float, __builtin_amdgcn_update_dpp(0, __builtin_bit_cast(int, x), 0x124, 0xf, 0xf, true)); \
    x += __builtin_bit_cast(float, __builtin_amdgcn_update_dpp(0, __builtin_bit_cast(int, x), 0x122, 0xf, 0xf, true)); \
    x += __builtin_bit_cast(float, __builtin_amdgcn_update_dpp(0, __builtin_bit_cast(int, x), 0x121, 0xf, 0xf, true)); } while (0)

DI void phase_scan(const Ctx& C, int l) {
    unsigned char* ws = C.ws; inptr_t in = C.in;
    const bf16_t* SR = (const bf16_t*)(ws + WS_U); float* Yf = (float*)(ws + WS_H);
    constexpr int CH = 32, VECB = CH * 128, BUFB = 5 * VECB + CH * 64, OB = 2 * BUFB;
    LAS unsigned char* lds = C.lds;
    const int tid = C.tid, lane = C.lane, wave = C.wave;
    for (int u = C.wg; u < 256; u += C.G) {
        const int bh = u >> 2, rg = u & 3, b = bh >> 4, h = bh & 15;
        const size_t tb = (size_t)b * SEQ; const int cb = h * 64;
        const int lt = tid - 256;
        u32x4 pre[3][6];
#define LD_CHUNK(set, c_) do { const size_t t_ = tb + (size_t)(c_) * CH + (lt >> 3); const int j_ = lt & 7; \
            _Pragma("unroll") for (int vq = 0; vq < 5; ++vq) { const int arr = (vq < 3) ? vq : vq + 1; \
                pre[set][vq] = *(const u32x4*)(SR + (size_t)arr * NT * 1024 + t_ * 1024 + cb + 8 * j_); } \
            if (lt < 64) { const size_t tv_ = tb + (size_t)(c_) * CH + (lt >> 1); \
                pre[set][5] = *(const u32x4*)(SR + (size_t)3 * NT * 1024 + tv_ * 1024 + cb + 16 * rg + 8 * (lt & 1)); } } while (0)
#define ST_CHUNK(set, buf_) do { const int step_ = lt >> 3, j_ = lt & 7; \
            _Pragma("unroll") for (int vq = 0; vq < 5; ++vq) { const u32x4 p = pre[set][vq]; f32x4 lo = {bflo(p.x), bfhi(p.x), bflo(p.y), bfhi(p.y)}, hi = {bflo(p.z), bfhi(p.z), bflo(p.w), bfhi(p.w)}; \
                if (vq == 1) { lo = 1.f - lo; hi = 1.f - hi; } \
                if (vq == 3) { lo = -lo; hi = -hi; } \
                const h4_t hl = __builtin_convertvector(lo, h4_t), hh = __builtin_convertvector(hi, h4_t); \
                LAS h4_t* d = (LAS h4_t*)(lds + (buf_) * BUFB + vq * VECB + step_ * 128 + j_ * 16); d[0] = hl; d[1] = hh; } \
            if (lt < 64) { const u32x4 p = pre[set][5]; const f32x4 lo = {bflo(p.x), bfhi(p.x), bflo(p.y), bfhi(p.y)}, hi = {bflo(p.z), bfhi(p.z), bflo(p.w), bfhi(p.w)}; \
                const h4_t hl = __builtin_convertvector(lo, h4_t), hh = __builtin_convertvector(hi, h4_t); \
                LAS h4_t* d = (LAS h4_t*)(lds + (buf_) * BUFB + 5 * VECB + (lt >> 1) * 64 + (lt & 1) * 32); \
                d[0] = (h4_t){hl[0], hl[0], hl[1], hl[1]}; d[1] = (h4_t){hl[2], hl[2], hl[3], hl[3]}; d[2] = (h4_t){hh[0], hh[0], hh[1], hh[1]}; d[3] = (h4_t){hh[2], hh[2], hh[3], hh[3]}; } } while (0)
        h2_t S01 = {(_Float16)0.f, (_Float16)0.f}, S23 = {(_Float16)0.f, (_Float16)0.f};
        const int ks = lane & 15, rowl = wave * 4 + (lane >> 4);
        constexpr int NCH = SEQ / CH;
        float tq[32]; int mo_it = (C.wg * 4 + (wave - 4)); bool mo_pending = false; TrDesc mo_d{};
        LAS float* mo_scr = (LAS float*)(lds + OB + 2 * CH * 64) + (wave - 4) * (64 * 33);
        if (wave >= 4) { LD_CHUNK(0, 0); LD_CHUNK(1, 1); LD_CHUNK(2, 2); ST_CHUNK(0, 0); LD_CHUNK(0, 3); }
        __syncthreads();
#define SCAN_ITER(c, setn) do { \
            const int buf = (c) & 1; \
            if (wave >= 4) { \
                if ((c) + 1 < NCH) { ST_CHUNK(setn, buf ^ 1); if ((c) + 4 < NCH) LD_CHUNK(setn, (c) + 4); } \
                if ((c) > 0 && lt < 128) { \
                    const int step = lt >> 2, q4 = lt & 3; const f32x4 o = *(const LAS f32x4*)(lds + OB + (((c) - 1) & 1) * (CH * 64) + step * 64 + q4 * 16); \
                    *(f32x4*)(Yf + (tb + (size_t)((c) - 1) * CH + step) * 1024 + cb + 16 * rg + 4 * q4) = o; } \
                if (((c) & 1) == 0) { if (mo_pending) { tr_store(mo_d, tq, mo_scr, lane); mo_pending = false; } \
                    if (mo_it < N_MOE_ITEMS) { mo_d = moe_tr_desc(l, mo_it, in, ws); tr_load(mo_d, tq, lane); mo_pending = true; mo_it += 1024; } } \
            } else { SCAN_BODY(buf); } \
            __syncthreads(); } while (0)
#define SC_LD(X, s_) do { const int so_ = ((s_) & (CH - 1)) * 128; X##r = *(const LAS h4_t*)(bp + 0 * VECB + so_); X##w = *(const LAS h4_t*)(bp + 1 * VECB + so_); X##k = *(const LAS h4_t*)(bp + 2 * VECB + so_); \
            X##a = *(const LAS h4_t*)(bp + 3 * VECB + so_); X##b = *(const LAS h4_t*)(bp + 4 * VECB + so_); X##v = vp[((s_) & (CH - 1)) * 16]; } while (0)
#define DPPF(x, ctl) __builtin_bit_cast(float, __builtin_amdgcn_update_dpp(0, __builtin_bit_cast(int, x), ctl, 0xf, 0xf, true))
#define H_LO(x) __builtin_shufflevector(x, x, 0, 1)
#define H_HI(x) __builtin_shufflevector(x, x, 2, 3)
#define SC_DOT(x) __builtin_amdgcn_fdot2(S01, H_LO(x), __builtin_amdgcn_fdot2(S23, H_HI(x), 0.f, false), false)
#define SC_FIRST(X) do { float sa = SC_DOT(X##a); \
            const h2_t t01 = S01 * H_LO(X##w) + X##v * H_LO(X##k), t23 = S23 * H_HI(X##w) + X##v * H_HI(X##k); \
            ROW_ALLREDUCE(sa); \
            const _Float16 sh = (_Float16)sa; const h2_t sa2 = {sh, sh}; \
            S01 = sa2 * H_LO(X##b) + t01; S23 = sa2 * H_HI(X##b) + t23; } while (0)
#define SC_PAIR(X, Y, s_) do { float o = SC_DOT(X##r); float sa = SC_DOT(Y##a); \
            const h2_t t01 = S01 * H_LO(Y##w) + Y##v * H_LO(Y##k), t23 = S23 * H_HI(Y##w) + Y##v * H_HI(Y##k); \
            sa += DPPF(sa, 0x128); o += DPPF(o, 0x128); sa += DPPF(sa, 0x124); o += DPPF(o, 0x124); sa += DPPF(sa, 0x122); o += DPPF(o, 0x122); sa += DPPF(sa, 0x121); o += DPPF(o, 0x121); \
            const _Float16 sh = (_Float16)sa; const h2_t sa2 = {sh, sh}; \
            S01 = sa2 * H_LO(Y##b) + t01; S23 = sa2 * H_HI(Y##b) + t23; \
            if (ks == 0) op[((s_) - 1) * 16] = o; } while (0)
#define SC_LAST(X, s_) do { float o = SC_DOT(X##r); ROW_ALLREDUCE(o); if (ks == 0) op[(s_) * 16] = o; } while (0)
#define SCAN_BODY(buf_) do { \
            const LAS unsigned char* bp = lds + (buf_) * BUFB + ks * 8; \
            const LAS h2_t* vp = (const LAS h2_t*)(lds + (buf_) * BUFB + 5 * VECB) + rowl; \
            LAS float* op = (LAS float*)(lds + OB + (buf_) * (CH * 64)) + rowl; \
            h4_t Ar, Aw, Ak, Aa, Ab, Br, Bw, Bk, Ba, Bb, Cr, Cw, Ck, Ca, Cb, Dr, Dw, Dk, Da, Db; h2_t Av, Bv, Cv, Dv; \
            SC_LD(A, 0); SC_LD(B, 1); SC_LD(C, 2); SC_LD(D, 3); \
            SC_FIRST(A); \
            _Pragma("unroll 2") for (int s = 0; s < CH - 4; s += 4) { \
                SC_PAIR(A, B, s + 1); SC_LD(A, s + 4); \
                SC_PAIR(B, C, s + 2); SC_LD(B, s + 5); \
                SC_PAIR(C, D, s + 3); SC_LD(C, s + 6); \
                SC_PAIR(D, A, s + 4); SC_LD(D, s + 7); } \
            SC_PAIR(A, B, CH - 3); SC_PAIR(B, C, CH - 2); SC_PAIR(C, D, CH - 1); SC_LAST(D, CH - 1); } while (0)
#pragma unroll 1
        for (int c = 0; c < NCH; c += 3) { SCAN_ITER(c, 1); if (c + 1 < NCH) SCAN_ITER(c + 1, 2); if (c + 2 < NCH) SCAN_ITER(c + 2, 0); }
#undef SC_LD
#undef SC_FIRST
#undef SC_PAIR
#undef SC_LAST
#undef DPPF
#undef H_LO
#undef H_HI
#undef SC_DOT
#undef SCAN_BODY
#undef SCAN_ITER
#undef LD_CHUNK
#undef ST_CHUNK
        if (wave >= 4) { if (mo_pending) tr_store(mo_d, tq, mo_scr, lane);
            for (; mo_it < N_MOE_ITEMS; mo_it += 1024) { const TrDesc d = moe_tr_desc(l, mo_it, in, ws); tr_load(d, tq, lane); tr_store(d, tq, mo_scr, lane); } }
        if (wave >= 4 && lt < 128) { const int c = NCH; const int step = lt >> 2, q4 = lt & 3; const f32x4 o = *(const LAS f32x4*)(lds + OB + ((c - 1) & 1) * (CH * 64) + step * 64 + q4 * 16);
            *(f32x4*)(Yf + (tb + (size_t)(c - 1) * CH + step) * 1024 + cb + 16 * rg + 4 * q4) = o; }
        __syncthreads();
    }
}

DI void phase_post(const Ctx& C, int l) {
    inptr_t in = C.in; unsigned char* ws = C.ws;
    const float* Yf = (const float*)(ws + WS_H); const bf16_t* LO = (const bf16_t*)(ws + WS_LORAO);
    const bf16_t* SR = (const bf16_t*)(ws + WS_U); const bf16_t* SK = SR + (size_t)2 * NT * 1024; const bf16_t* SV = SR + (size_t)3 * NT * 1024;
    bf16_t* Y = (bf16_t*)(ws + WS_PRW);
    const float* rk = in[20] + (size_t)l * 1024; const float* lnw = in[21] + (size_t)l * 1024; const float* lnb = in[22] + (size_t)l * 1024;
    const int lane = C.lane;
    for (int t = C.gw; t < NT; t += C.ngw) {
#pragma unroll
        for (int j = 0; j < 2; ++j) {
            const int c0 = 8 * lane + 512 * j; const size_t o = (size_t)t * 1024 + c0;
            const f32x4 y0 = *(const f32x4*)(Yf + o), y1 = *(const f32x4*)(Yf + o + 4);
            const u32x4 rr = *(const u32x4*)(SR + o), kq = *(const u32x4*)(SK + o), vq = *(const u32x4*)(SV + o), gq = *(const u32x4*)(LO + (size_t)t * 4096 + 2048 + c0);
            float y[8], rk8[8], lw8[8], lb8[8];
#pragma unroll
            for (int e = 0; e < 2; ++e) { const f32x4 a = *(const f32x4*)(rk + c0 + 4 * e), b = *(const f32x4*)(lnw + c0 + 4 * e), c = *(const f32x4*)(lnb + c0 + 4 * e);
#pragma unroll
                for (int i = 0; i < 4; ++i) { rk8[4 * e + i] = a[i]; lw8[4 * e + i] = b[i]; lb8[4 * e + i] = c[i]; y[4 * e + i] = e ? y1[i] : y0[i]; } }
            float sm = 0.f, bs = 0.f; float r8[8], k8[8], v8[8], g8[8];
#pragma unroll
            for (int e = 0; e < 8; ++e) { r8[e] = (e & 1) ? bfhi(rr[e >> 1]) : bflo(rr[e >> 1]); k8[e] = (e & 1) ? bfhi(kq[e >> 1]) : bflo(kq[e >> 1]);
                v8[e] = (e & 1) ? bfhi(vq[e >> 1]) : bflo(vq[e >> 1]); g8[e] = (e & 1) ? bfhi(gq[e >> 1]) : bflo(gq[e >> 1]);
                sm += y[e]; bs += r8[e] * k8[e] * rk8[e]; }
            sm += DPP_F(sm, 0xB1); sm += DPP_F(sm, 0x4E); sm += DPP_F(sm, 0x141);
            bs += DPP_F(bs, 0xB1); bs += DPP_F(bs, 0x4E); bs += DPP_F(bs, 0x141);
            const float mean = sm * (1.f / 64.f); float vs = 0.f;
#pragma unroll
            for (int e = 0; e < 8; ++e) { y[e] -= mean; vs += y[e] * y[e]; }
            vs += DPP_F(vs, 0xB1); vs += DPP_F(vs, 0x4E); vs += DPP_F(vs, 0x141);
            const float rs = rsqrtf(vs * (1.f / 64.f) + 64e-5f);
            u32x4 ov;
#pragma unroll
            for (int e = 0; e < 4; ++e) { const float o0 = (y[2 * e] * rs * lw8[2 * e] + lb8[2 * e] + bs * v8[2 * e]) * g8[2 * e], o1 = (y[2 * e + 1] * rs * lw8[2 * e + 1] + lb8[2 * e + 1] + bs * v8[2 * e + 1]) * g8[2 * e + 1];
                ov[e] = pk2(o0, o1); }
            *(u32x4*)(Y + (size_t)t * 2048 + c0) = ov;
        }
    }
}

struct AttnP {
    const bf16_t* Q; int qpitch, qcol0;
    const bf16_t* K1; int k1pitch, k1col0;
    const bf16_t* K2; int k2pitch, k2col0;
    const bf16_t* V; int vpitch, vcol0;
    bf16_t* O; int opitch, ocol0;
    size_t qrow0, krow0;
    int q0;
    int nkeys;
    float c1;
    const int* pos; const float* lut;
    float lam, outscale; const float* subw;
};

template <int DQK, int DK1, int MODE, int KT, int PFD>
DI void attn_unit(LAS unsigned char* lds, const AttnP& P) {
    constexpr int DV = 128, KP = DQK * 2 + 16, VP = DV * 2 + 64;
    constexpr int NBLK = KT / 32;
    constexpr int KTILE = KT * KP, VTILE = KT * VP;
    constexpr int NVT = (MODE == 0) ? 1 : 2;
    constexpr int VSLOT = NVT * VTILE + 256;
    constexpr int OFF_V = 2 * KTILE, OFF_POS = NVT * VTILE, OFF_LUT = OFF_V + 2 * VSLOT, OFF_END = OFF_LUT + 512;
    constexpr int OFF_OST = 4 * 17408, OSTP = 272;
    static_assert(OFF_END <= LDS_MAIN && OFF_OST + 4 * 32 * OSTP <= LDS_MAIN, "attention LDS");
    constexpr int KCH = DQK / 8, K1CH = DK1 / 8;
    constexpr int NKC = 2 * KT * KCH, NVC = NVT * KT * 16, NKCH = NKC / 512, NVCH = NVC / 512, NCHK = NKCH + NVCH;
    static_assert(NKC % 512 == 0 && NVC % 512 == 0, "chunks");
    constexpr float NEG = -1e30f, THR = 8.f;
    constexpr int KSTEP = (MODE == 0) ? KT : 2 * KT;
    int tid = threadIdx.x; asm volatile("" : "+v"(tid));
    const int lane = tid & 63, wave = __builtin_amdgcn_readfirstlane(tid >> 6);
    const int qg = wave >> 1, st = wave & 1, r32 = lane & 31, h2 = lane >> 5;
    const int qw0 = P.q0 + 32 * qg;
    const int myq = qw0 + r32;
    bf16x8 qf[DQK / 16];
    {
        const bf16_t* qp = P.Q + (P.qrow0 + myq) * (size_t)P.qpitch + P.qcol0 + ((MODE == 0) ? st * 64 : 0) + 8 * h2;
#pragma unroll
        for (int ks = 0; ks < DQK / 16; ++ks) qf[ks] = *(const bf16x8*)(qp + 16 * ks);
    }
    int mypos = 0, posq0 = 0;
    if constexpr (MODE == 0) { mypos = P.pos[myq]; posq0 = P.pos[qw0]; if (tid < 128) ((LAS float*)(lds + OFF_LUT))[tid] = P.lut[tid]; }
    f32x16 o[4];
#pragma unroll
    for (int d = 0; d < 4; ++d)
#pragma unroll
        for (int i = 0; i < 16; ++i) o[d][i] = 0.f;
    float m_run = NEG, l_run = 0.f;
    const int nsteps = P.nkeys / KSTEP;
    const char* gp[NCHK]; unsigned adv[NCHK]; unsigned ldst[NCHK];
#pragma unroll
    for (int i = 0; i < NKCH; ++i) { const int c = tid + 512 * i; const int s = c / (KT * KCH), rc = c % (KT * KCH), row = rc / KCH, ch = rc % KCH;
        const int key = (MODE == 0) ? row : s * KT + row;
        if (ch < K1CH) { gp[i] = (const char*)(P.K1 + (P.krow0 + key) * (size_t)P.k1pitch + P.k1col0 + ((MODE == 0) ? s * 64 : 0) + ch * 8); adv[i] = (unsigned)(KSTEP * P.k1pitch * 2); }
        else { gp[i] = (const char*)(P.K2 + (P.krow0 + key) * (size_t)P.k2pitch + P.k2col0 + (ch - K1CH) * 8); adv[i] = (unsigned)(KSTEP * P.k2pitch * 2); }
        ldst[i] = (unsigned)(s * KTILE + row * KP + ch * 16); }
#pragma unroll
    for (int i = 0; i < NVCH; ++i) { const int c2 = tid + 512 * i; const int s = c2 / (KT * 16), rc = c2 % (KT * 16), row = rc / 16, ch = rc % 16;
        const int key = (MODE == 0) ? row : s * KT + row;
        gp[NKCH + i] = (const char*)(P.V + (P.krow0 + key) * (size_t)P.vpitch + P.vcol0 + ch * 8); adv[NKCH + i] = (unsigned)(KSTEP * P.vpitch * 2);
        ldst[NKCH + i] = (unsigned)(s * VTILE + row * VP + ch * 16); }
    u32x4 preK[PFD][NKCH], preV[PFD][NVCH]; int prepos[2] = {0, 0};
#define KSET(par) ((PFD == 2) ? ((par) ^ 1) : 0)
#define VSET(par) ((PFD == 2) ? (par) : 0)
#define ATT_PREFETCH_K(set_) do { _Pragma("unroll") for (int i = 0; i < NKCH; ++i) { preK[set_][i] = *(const u32x4*)gp[i]; gp[i] += adv[i]; } } while (0)
#define ATT_PREFETCH_V(set_, step_) do { _Pragma("unroll") for (int i = 0; i < NVCH; ++i) { preV[set_][i] = *(const u32x4*)gp[NKCH + i]; gp[NKCH + i] += adv[NKCH + i]; } \
        if constexpr (MODE == 0) { if (tid < KT) prepos[set_] = P.pos[(step_) * KT + tid]; } } while (0)
#define ATT_STAGE_K(set_) do { _Pragma("unroll") for (int i = 0; i < NKCH; ++i) *(LAS u32x4*)(lds + ldst[i]) = preK[set_][i]; } while (0)
#define ATT_STAGE_V(set_, vo_) do { _Pragma("unroll") for (int i = 0; i < NVCH; ++i) *(LAS u32x4*)(lds + (vo_) + ldst[NKCH + i]) = preV[set_][i]; \
        if constexpr (MODE == 0) { if (tid < KT) ((LAS int*)(lds + (vo_) + OFF_POS))[tid] = prepos[set_]; } } while (0)
#define ATT_QK(dst) do { const LAS unsigned char* kb_ = lds + st * KTILE + r32 * KP + 16 * h2; \
        _Pragma("unroll") for (int blk = 0; blk < NBLK; ++blk) { \
            _Pragma("unroll") for (int i = 0; i < 16; ++i) dst[blk][i] = 0.f; \
            _Pragma("unroll") for (int ks = 0; ks < DQK / 16; ++ks) { const bf16x8 kf = *(const LAS bf16x8*)(kb_ + blk * 32 * KP + ks * 32); dst[blk] = __builtin_amdgcn_mfma_f32_32x32x16_bf16(kf, qf[ks], dst[blk], 0, 0, 0); } } } while (0)
#define ATT_VLD(j_) do { const int d_ = (j_) / (2 * NBLK), r_ = (j_) % (2 * NBLK); const LAS unsigned char* vp_ = vb_ + (16 * r_) * VP + d_ * 64; \
            vlo_[(j_) & 1] = __builtin_bit_cast(s16x4, __builtin_amdgcn_ds_read_tr16_b64_v4i16((LAS v4i16_t*)vp_)); \
            vhi_[(j_) & 1] = __builtin_bit_cast(s16x4, __builtin_amdgcn_ds_read_tr16_b64_v4i16((LAS v4i16_t*)(vp_ + 8 * VP))); } while (0)
#define ATT_PV(vo_) do { const int sv_ = (MODE == 0) ? 0 : st; \
        const LAS unsigned char* vb_ = lds + (vo_) + sv_ * VTILE + (4 * h2 + ((lane & 15) >> 2)) * VP + ((lane >> 4) & 1) * 32 + (lane & 3) * 8; \
        s16x4 vlo_[2], vhi_[2]; ATT_VLD(0); \
        _Pragma("unroll") for (int j = 0; j < 8 * NBLK; ++j) { if (j + 1 < 8 * NBLK) ATT_VLD(j + 1); \
            const s16x4 lo_ = vlo_[j & 1], hi_ = vhi_[j & 1]; const bf16x8 vf_ = {lo_[0], lo_[1], lo_[2], lo_[3], hi_[0], hi_[1], hi_[2], hi_[3]}; \
            const int d_ = j / (2 * NBLK), r_ = j % (2 * NBLK); \
            o[d_] = __builtin_amdgcn_mfma_f32_32x32x16_bf16(vf_, pf[r_ >> 1][r_ & 1], o[d_], 0, 0, 0); } } while (0)
    f32x16 sc[NBLK]; bf16x8 pf[NBLK][2]; bool pv_pending = false;
    auto att_body = [&](int step, int vo_cur, int vo_prev) {
        const int k0 = step * KSTEP + ((MODE == 0) ? 0 : st * KT);
        const bool valid_next = (step + 1 < nsteps) && (MODE == 2 || k0 + KSTEP <= qw0 + 31);
        const bool valid = (MODE == 2) || (k0 <= qw0 + 31);
        if (pv_pending) ATT_PV(vo_prev);
        pv_pending = valid;
        if (valid) {
        const bool need_mask = (MODE != 2) && (k0 + KT - 1 > qw0);
        float bb = 0.f; bool near = false;
        if constexpr (MODE == 0) {
            const LAS float* lut = (const LAS float*)(lds + OFF_LUT);
            const LAS int* pk = (const LAS int*)(lds + vo_cur + OFF_POS);
            near = (posq0 - pk[KT - 1]) < 127;
            if (near) {
#pragma unroll
                for (int blk = 0; blk < NBLK; ++blk)
#pragma unroll
                    for (int i = 0; i < 16; ++i) { const int kl = 32 * blk + (i & 3) + 8 * (i >> 2) + 4 * h2; int rel = mypos - pk[kl]; rel = rel < 0 ? 0 : (rel > 127 ? 127 : rel);
                        sc[blk][i] = sc[blk][i] * P.c1 + lut[rel]; }
            } else bb = lut[127];
        }
        if (need_mask) {
#pragma unroll
            for (int blk = 0; blk < NBLK; ++blk)
#pragma unroll
                for (int i = 0; i < 16; ++i) { const int key = k0 + 32 * blk + (i & 3) + 8 * (i >> 2) + 4 * h2; if (key > myq) sc[blk][i] = NEG; }
        }
        const float cc = near ? 1.f : P.c1;
        float mx = sc[0][0];
#pragma unroll
        for (int blk = 0; blk < NBLK; ++blk)
#pragma unroll
            for (int i = 0; i < 16; ++i) mx = fmaxf(mx, sc[blk][i]);
        { const int mi = __builtin_bit_cast(int, mx); auto rr = __builtin_amdgcn_permlane32_swap(mi, mi, false, false); mx = fmaxf(__builtin_bit_cast(float, (int)rr[0]), __builtin_bit_cast(float, (int)rr[1])); }
        mx = mx * cc + bb;
        if (__any(mx > m_run + THR)) {
            const float m_new = fmaxf(m_run, mx);
            const float alpha = __builtin_amdgcn_exp2f(m_run - m_new);
            m_run = m_new; l_run *= alpha;
#pragma unroll
            for (int d = 0; d < 4; ++d)
#pragma unroll
                for (int i = 0; i < 16; ++i) o[d][i] *= alpha;
        }
        const float off = bb - m_run;
        float psum = 0.f;
#pragma unroll
        for (int blk = 0; blk < NBLK; ++blk)
#pragma unroll
            for (int i = 0; i < 16; ++i) { const float p = __builtin_amdgcn_exp2f(__builtin_fmaf(sc[blk][i], cc, off)); sc[blk][i] = p; psum += p; }
        l_run += psum;
#pragma unroll
        for (int blk = 0; blk < NBLK; ++blk)
#pragma unroll
            for (int s16 = 0; s16 < 2; ++s16) { u32x4 w; w.x = pk2(sc[blk][8 * s16 + 0], sc[blk][8 * s16 + 1]); w.y = pk2(sc[blk][8 * s16 + 2], sc[blk][8 * s16 + 3]);
                w.z = pk2(sc[blk][8 * s16 + 4], sc[blk][8 * s16 + 5]); w.w = pk2(sc[blk][8 * s16 + 6], sc[blk][8 * s16 + 7]); pf[blk][s16] = __builtin_bit_cast(bf16x8, w); }
        }
        if (valid_next) ATT_QK(sc);
        };
#define ATT_BODY(step, vc, vp) att_body(step, vc, vp)
    ATT_PREFETCH_K(0);
    __syncthreads();
    ATT_STAGE_K(0);
    if (nsteps > 1) ATT_PREFETCH_K(KSET(0));
    if (PFD == 2 && nsteps > 2) ATT_PREFETCH_K(0);
    ATT_PREFETCH_V(0, 0);
    if (PFD == 2 && nsteps > 1) ATT_PREFETCH_V(1, 1);
    __syncthreads();
    ATT_QK(sc);
#define ATT_BAR() asm volatile("s_waitcnt lgkmcnt(0)\n\ts_barrier" ::: "memory")
#define ATT_ITER(step, par) do { \
        const int vo_cur = OFF_V + (par) * VSLOT, vo_prev = OFF_V + ((par) ^ 1) * VSLOT; \
        ATT_BAR();                                                  \
        if ((step) + 1 < nsteps) ATT_STAGE_K(KSET(par)); \
        ATT_STAGE_V(VSET(par), vo_cur); \
        ATT_BAR();                                                  \
        if ((step) + 1 + PFD < nsteps) ATT_PREFETCH_K(KSET(par)); \
        if ((step) + PFD < nsteps) ATT_PREFETCH_V(VSET(par), (step) + PFD); \
        ATT_BODY(step, vo_cur, vo_prev); } while (0)
    for (int step = 0; step < nsteps; step += 2) { ATT_ITER(step, 0); if (step + 1 < nsteps) ATT_ITER(step + 1, 1); }
    if (pv_pending) ATT_PV(OFF_V + ((nsteps - 1) & 1) * VSLOT);
#undef ATT_PREFETCH_K
#undef ATT_PREFETCH_V
#undef ATT_STAGE_K
#undef ATT_STAGE_V
#undef ATT_QK
#undef ATT_PV
#undef ATT_VLD
#undef ATT_ITER
#undef ATT_BAR
#undef ATT_BODY
#undef KSET
#undef VSET
    l_run += __shfl_xor(l_run, 32);
    __syncthreads();
    LAS float* mb = (LAS float*)(lds + qg * 17408);
    if (st == 1) {
        if constexpr (MODE == 0) { const float inv = 1.f / l_run;
#pragma unroll
            for (int d = 0; d < 4; ++d)
#pragma unroll
                for (int i = 0; i < 16; ++i) mb[(d * 16 + i) * 64 + lane] = o[d][i] * inv;
        } else {
#pragma unroll
            for (int d = 0; d < 4; ++d)
#pragma unroll
                for (int i = 0; i < 16; ++i) mb[(d * 16 + i) * 64 + lane] = o[d][i];
            mb[4096 + lane] = m_run; mb[4160 + lane] = l_run;
        }
    }
    __syncthreads();
    if (st == 0) {
        if constexpr (MODE == 0) {
            const float inv = 1.f / l_run; float ss = 0.f;
#pragma unroll
            for (int d = 0; d < 4; ++d)
#pragma unroll
                for (int i = 0; i < 16; ++i) { const float v = o[d][i] * inv - P.lam * mb[(d * 16 + i) * 64 + lane]; o[d][i] = v; ss += v * v; }
            ss += __shfl_xor(ss, 32);
            const float rn = rsqrtf(ss * (1.f / 128.f) + 1e-5f) * P.outscale;
#pragma unroll
            for (int d = 0; d < 4; ++d)
#pragma unroll
                for (int i = 0; i < 16; ++i) { const int dv = 32 * d + (i & 3) + 8 * (i >> 2) + 4 * h2; o[d][i] = o[d][i] * rn * P.subw[dv]; }
        } else {
            const float m1 = mb[4096 + lane], l1 = mb[4160 + lane];
            const float mt = fmaxf(m_run, m1); const float a0 = __builtin_amdgcn_exp2f(m_run - mt), a1 = __builtin_amdgcn_exp2f(m1 - mt);
            const float inv = 1.f / (l_run * a0 + l1 * a1);
#pragma unroll
            for (int d = 0; d < 4; ++d)
#pragma unroll
                for (int i = 0; i < 16; ++i) o[d][i] = (o[d][i] * a0 + mb[(d * 16 + i) * 64 + lane] * a1) * inv;
        }
        LAS unsigned char* og = lds + OFF_OST + qg * (32 * OSTP);
#pragma unroll
        for (int d = 0; d < 4; ++d)
#pragma unroll
            for (int g4 = 0; g4 < 4; ++g4) { u32x2 w; w.x = pk2(o[d][4 * g4 + 0], o[d][4 * g4 + 1]); w.y = pk2(o[d][4 * g4 + 2], o[d][4 * g4 + 3]);
                *(LAS u32x2*)(og + r32 * OSTP + (32 * d + 8 * g4 + 4 * h2) * 2) = w; }
        asm volatile("s_waitcnt lgkmcnt(0)" ::: "memory");
        bf16_t* op = P.O + (P.qrow0 + qw0) * (size_t)P.opitch + P.ocol0;
#pragma unroll
        for (int i = 0; i < 8; ++i) { const int row = 4 * i + (lane >> 4), ch = lane & 15;
            const u32x4 v = *(const LAS u32x4*)(og + row * OSTP + ch * 16);
            *(u32x4*)(op + (size_t)row * P.opitch + ch * 8) = v; }
    }
    __syncthreads();
}

DI void phase_att(const Ctx& C, int l) {
    inptr_t in = C.in; unsigned char* ws = C.ws;
    const int ATT_SEL = C.att_sel;
    if (ATT_SEL & 1) phase_post(C, l);
    bf16_t* Y = (bf16_t*)(ws + WS_PRW); const bf16_t* PATT = (const bf16_t*)(ws + WS_PATT);
    const float lambda_init = 0.8f - 0.6f * expf(-0.3f * (float)l);
    float lam;
    { const float a = wave_sum(in[23][l * 64 + C.lane] * in[24][l * 64 + C.lane]), b = wave_sum(in[25][l * 64 + C.lane] * in[26][l * 64 + C.lane]); lam = expf(a) - expf(b) + lambda_init; }
    if (ATT_SEL & 2) for (int w = C.wg; w < 256; w += C.G) {
        const int bh = w >> 4, j = w & 15, b = bh >> 2, h = bh & 3;
#pragma unroll 1
        for (int k = 0; k < 2; ++k) { const int qb = k ? 31 - j : j;
            AttnP P; P.Q = PATT; P.qpitch = PATT_COLS; P.qcol0 = h * 128; P.K1 = PATT; P.k1pitch = PATT_COLS; P.k1col0 = 512 + h * 128; P.K2 = PATT; P.k2pitch = 0; P.k2col0 = 0;
            P.V = PATT; P.vpitch = PATT_COLS; P.vcol0 = 1024 + h * 128; P.O = Y; P.opitch = 2048; P.ocol0 = 1024 + h * 128;
            P.qrow0 = (size_t)b * SEQ; P.krow0 = (size_t)b * SEQ; P.q0 = qb * 128; P.nkeys = qb * 128 + 128; P.c1 = 0.125f * LOG2E;
            P.pos = (const int*)in[2] + b * SEQ; P.lut = (const float*)(ws + WS_LUT) + h * 128; P.lam = lam; P.outscale = 1.f - lambda_init; P.subw = in[27] + l * 128;
            attn_unit<64, 64, 0, 64, 1>(C.lds, P); }
    }
    const bf16_t* QM = (const bf16_t*)(ws + WS_QM); const bf16_t* KVM = (const bf16_t*)(ws + WS_KVM); const bf16_t* KPE = (const bf16_t*)(ws + WS_KPE);
    if (ATT_SEL & 4) for (int w = C.wg; w < 256; w += C.G) {
        const int bh = w >> 4, j = w & 15, b = bh >> 2, h = bh & 3;
#pragma unroll 1
        for (int k = 0; k < 2; ++k) { const int qb = k ? 31 - j : j;
            AttnP P; P.Q = QM; P.qpitch = 768; P.qcol0 = h * 192; P.K1 = KVM; P.k1pitch = 1024; P.k1col0 = h * 256; P.K2 = KPE; P.k2pitch = 64; P.k2col0 = 0;
            P.V = KVM; P.vpitch = 1024; P.vcol0 = h * 256 + 128; P.O = Y; P.opitch = 2048; P.ocol0 = 1536 + h * 128;
            P.qrow0 = (size_t)b * SEQ; P.krow0 = (size_t)b * SEQ; P.q0 = qb * 128; P.nkeys = qb * 128 + 128; P.c1 = 0.07216878364870322f * LOG2E;
            P.pos = nullptr; P.lut = nullptr; P.lam = 0.f; P.outscale = 0.f; P.subw = nullptr;
            attn_unit<192, 128, 1, 32, 1>(C.lds, P); }
    }
}

DI void phase_cross(const Ctx& C) {
    unsigned char* ws = C.ws;
    const bf16_t* CAQ = (const bf16_t*)(ws + WS_CAQ); const bf16_t* MKV = (const bf16_t*)(ws + WS_MEMKV); bf16_t* CAO = (bf16_t*)(ws + WS_CAO);
    for (int u = C.wg; u < 512; u += C.G) {
        const int bh = u >> 5, qb = u & 31, b = bh >> 2, h = bh & 3;
        AttnP P; P.Q = CAQ; P.qpitch = 512; P.qcol0 = h * 128; P.K1 = MKV; P.k1pitch = 1024; P.k1col0 = h * 128; P.K2 = MKV; P.k2pitch = 0; P.k2col0 = 0;
        P.V = MKV; P.vpitch = 1024; P.vcol0 = 512 + h * 128; P.O = CAO; P.opitch = 512; P.ocol0 = h * 128;
        P.qrow0 = (size_t)b * SEQ; P.krow0 = (size_t)b * MEMLEN; P.q0 = qb * 128; P.nkeys = MEMLEN; P.c1 = 0.08838834764831845f * LOG2E;
        P.pos = nullptr; P.lut = nullptr; P.lam = 0.f; P.outscale = 0.f; P.subw = nullptr;
        attn_unit<128, 128, 2, 64, 1>(C.lds, P);
    }
}

DI void phase_route(const Ctx& C, int l) {
    inptr_t in = C.in; unsigned char* ws = C.ws;
    const float* LG = (const float*)(ws + WS_LOGITS);
    const float* bg = in[39] + l * 4; const float* be = in[41] + l * 32;
    int* EID = (int*)(ws + WS_EID); float* GATE = (float*)(ws + WS_GATE); int* CNT = (int*)(ws + WS_CNT);
    LAS int* hist = (LAS int*)(C.lds);
    const int lane = C.lane;
    for (int wgt = C.wg; wgt < 256; wgt += C.G) {
        if (C.tid < 32) hist[C.tid] = 0;
        __syncthreads();
#pragma unroll 1
        for (int r = 0; r < 8; ++r) {
            const int t = wgt * 64 + C.wave * 8 + r;
            const float raw = (lane < 36) ? LG[(size_t)t * 256 + lane] : 0.f;
            const float g0 = RDL_F(raw, 32), g1 = RDL_F(raw, 33), g2 = RDL_F(raw, 34), g3 = RDL_F(raw, 35);
            int sel = 0; float best = g0 + bg[0];
            if (g1 + bg[1] > best) { best = g1 + bg[1]; sel = 1; }
            if (g2 + bg[2] > best) { best = g2 + bg[2]; sel = 2; }
            if (g3 + bg[3] > best) { best = g3 + bg[3]; sel = 3; }
            const float gm = fmaxf(fmaxf(g0, g1), fmaxf(g2, g3));
            const float e0 = __expf(g0 - gm), e1 = __expf(g1 - gm), e2 = __expf(g2 - gm), e3 = __expf(g3 - gm);
            const float es = sel == 0 ? e0 : (sel == 1 ? e1 : (sel == 2 ? e2 : e3));
            const float pgrp = es / ((e0 + e1) + (e2 + e3));
            float val = (lane < 32 && (lane >> 3) == sel) ? raw + be[lane & 31] : -INFINITY;
            const float m1 = wave_max(val); const int i1 = __ffsll((long long)__ballot(val == m1)) - 1;
            if (lane == i1) val = -INFINITY;
            const float m2 = wave_max(val); const int i2 = __ffsll((long long)__ballot(val == m2)) - 1;
            const float r1 = __shfl(raw, i1), r2 = __shfl(raw, i2);
            const float w1 = 1.f / (1.f + __expf(r2 - r1)), w2 = 1.f - w1;
            if (lane == 0) { EID[2 * t] = i1; EID[2 * t + 1] = i2; GATE[2 * t] = w1 * pgrp; GATE[2 * t + 1] = w2 * pgrp;
                atomicAdd((int*)&hist[i1], 1); atomicAdd((int*)&hist[i2], 1); }
        }
        __syncthreads();
        if (C.tid < 32) CNT[wgt * 32 + C.tid] = hist[C.tid];
        __syncthreads();
    }
}

DI void phase_dispatch(const Ctx& C) {
    unsigned char* ws = C.ws;
    const int* EID = (const int*)(ws + WS_EID); const int* CNT = (const int*)(ws + WS_CNT);
    int* ROWMAP = (int*)(ws + WS_ROWMAP); int* ROWDST = (int*)(ws + WS_ROWDST); int* TILEEXP = (int*)(ws + WS_TILEEXP);
    LAS int* tot = (LAS int*)(C.lds); LAS int* base = tot + 32; LAS int* off = base + 32; LAS int* eid = off + 40; LAS int* posl = eid + 128;
    const int tid = C.tid;
    for (int wgt = C.wg; wgt < 256; wgt += C.G) {
        { LAS int* cl = posl + 128;
#pragma unroll
          for (int i = 0; i < 16; ++i) cl[tid + 512 * i] = CNT[tid + 512 * i];
          __syncthreads();
          if (tid < 32) { int s = 0, bsum = 0; for (int w = 0; w < 256; ++w) { const int c = cl[w * 32 + tid]; if (w == wgt) bsum = s; s += c; } tot[tid] = s; base[tid] = bsum; } }
        if (tid >= 64 && tid < 192) eid[tid - 64] = EID[wgt * 128 + (tid - 64)];
        __syncthreads();
        if (tid == 0) { int o = 0; for (int e = 0; e < 32; ++e) { off[e] = o; o += (tot[e] + 255) & ~255; } off[32] = o; }
        __syncthreads();
        if (tid < 128) { const int e = eid[tid]; int rank = 0; for (int j = 0; j < tid; ++j) rank += (eid[j] == e) ? 1 : 0;
            const int pos = off[e] + base[e] + rank; ROWMAP[pos] = wgt * 64 + (tid >> 1); ROWDST[pos] = wgt * 128 + tid; }
        if (wgt < 32) { const int e = wgt; for (int p = off[e] + tot[e] + tid; p < off[e + 1]; p += 512) { ROWMAP[p] = 0; ROWDST[p] = -1; } }
        if (wgt == 0) { if (tid < 32) { for (int tl = off[tid] >> 8; tl < (off[tid + 1] >> 8); ++tl) TILEEXP[tl] = tid; } if (tid == 0) TILEEXP[200] = off[32] >> 8; }
        __syncthreads();
    }
}

#ifndef PHASE_MASK
#define PHASE_MASK 0x1ffff
#endif
#define IN(k) (lo <= (k) && (k) < hi)
#define EN(j) ((PHASE_MASK >> (j)) & 1)
#define SEAM(k) do { if (IN(k) && IN((k) + 1)) xcd_barrier(bar); } while (0)
#define PH_BEGIN() do { int t_ = threadIdx.x; asm volatile("" : "+v"(t_)); kaptr_t ka_ = (kaptr_t)__builtin_amdgcn_kernarg_segment_ptr(); asm volatile("" : "+s"(ka_)); \
        C.lds = (LAS unsigned char*)lds_raw; C.in = (inptr_t)ka_; C.X = *(float* const CAS*)(ka_ + 360); C.ws = *(unsigned char* const CAS*)(ka_ + 368); \
        C.tid = t_; C.lane = t_ & 63; C.wave = __builtin_amdgcn_readfirstlane(t_ >> 6); { int g_ = gridDim.x, b_ = blockIdx.x; asm volatile("" : "+s"(g_), "+s"(b_)); C.G = g_; C.wg = b_; } C.gw = C.wg * 8 + C.wave; C.ngw = C.G * 8; \
        ws = C.ws; in = C.in; } while (0)
constexpr int PPL = 16, NPHASE = 2 * PPL + 1;
template <int l>
DI void run_layer(unsigned char* lds_raw, const XcdBarrier& bar, int lo, int hi, int att_sel = 7) {
    Ctx C; unsigned char* ws; inptr_t in; C.att_sel = att_sel;
    constexpr int pb = l * PPL;

        if (EN(0) && IN(pb + 0)) { PH_BEGIN(); phase_convert(C, l); } SEAM(pb + 0);
        if (EN(1) && IN(pb + 1)) { PH_BEGIN();
            { pg8::Gemm g{(const bf16_t*)(ws + WS_XB), (const bf16_t*)(ws + WS_WINT), DM, DM, DM, nullptr}; pg8::StaticOrder S; S.init(NT, INP, C.G, C.wg, DM);
              pg8::EpiBf16 E{(bf16_t*)(ws + WS_PRW), RW_COLS, (bf16_t*)(ws + WS_PATT), PATT_COLS, 13, (const float*)(ws + WS_SSQM), 1};
              pg8::gemm_phase<pg8::EpiBf16, pg8::StaticOrder>(C.lds, g, S, E); }
            { pg8::Gemm g{(const bf16_t*)(ws + WS_MEMN), (const bf16_t*)(ws + WS_CAWKVT), DM, DM, DM, nullptr}; pg8::StaticOrder S; S.init(NMEM, 1024, C.G, (C.wg + C.G / 2) % C.G, DM);
              pg8::EpiBf16 E{(bf16_t*)(ws + WS_MEMKV), 1024, nullptr, 0, 1 << 30, nullptr, 1};
              pg8::gemm_phase<pg8::EpiBf16, pg8::StaticOrder>(C.lds, g, S, E); }
        } SEAM(pb + 1);
        if (EN(2) && IN(pb + 2)) { PH_BEGIN(); phase_ew1(C, l); } SEAM(pb + 2);
        if (EN(3) && IN(pb + 3)) { PH_BEGIN();
            { pg8::Gemm g{(const bf16_t*)(ws + WS_LORAA), (const bf16_t*)(ws + WS_LORABT), 384, 384, 384, nullptr}; pg8::StaticOrder S; S.init(NT, 4096, C.G, C.wg, 384);
              pg8::EpiBf16 E{(bf16_t*)(ws + WS_LORAO), 4096, nullptr, 0, 1 << 30, nullptr, 1};
              pg8::gemm_phase<pg8::EpiBf16, pg8::StaticOrder>(C.lds, g, S, E); }
            { pg8::Gemm g{(const bf16_t*)(ws + WS_QN), (const bf16_t*)(ws + WS_WQBT), 384, 384, 384, nullptr}; pg8::StaticOrder S; S.init(NT, 768, C.G, C.wg, 384);
              pg8::EpiBf16 E{(bf16_t*)(ws + WS_QM), 768, nullptr, 0, 1 << 30, nullptr, 1};
              pg8::gemm_phase<pg8::EpiBf16, pg8::StaticOrder>(C.lds, g, S, E); }
            { pg8::Gemm g{(const bf16_t*)(ws + WS_KVN), (const bf16_t*)(ws + WS_WKVBT), 256, 256, 256, nullptr}; pg8::StaticOrder S; S.init(NT, 1024, C.G, C.wg, 256);
              pg8::EpiBf16 E{(bf16_t*)(ws + WS_KVM), 1024, nullptr, 0, 1 << 30, nullptr, 1};
              pg8::gemm_phase<pg8::EpiBf16, pg8::StaticOrder>(C.lds, g, S, E); }
        } SEAM(pb + 3);
        if (EN(4) && IN(pb + 4)) { PH_BEGIN(); phase_ew2(C, l); } SEAM(pb + 4);
        if (EN(5) && IN(pb + 5)) { PH_BEGIN(); phase_scan(C, l); } SEAM(pb + 5);
        if (EN(6) && IN(pb + 6)) { PH_BEGIN(); phase_att(C, l); } SEAM(pb + 6);
        if (EN(7) && IN(pb + 7)) { PH_BEGIN();
            pg8::Gemm g{(const bf16_t*)(ws + WS_PRW), (const bf16_t*)(ws + WS_WOUTT), DM, DM, DM, nullptr}; pg8::StaticOrder S; S.init(NT, DM, C.G, C.wg, DM);
            pg8::EpiResid E{l == 0 ? in[0] : nullptr, (const bf16_t*)(ws + WS_XB), (bf16_t*)(ws + WS_XB), DM, (float*)(ws + WS_PARTC)};
            pg8::gemm_phase<pg8::EpiResid, pg8::StaticOrder>(C.lds, g, S, E);
        } SEAM(pb + 7);
        if (EN(8) && IN(pb + 8)) { PH_BEGIN();
            pg8::Gemm g{(const bf16_t*)(ws + WS_XB), (const bf16_t*)(ws + WS_CAWQT), DM, DM, DM, nullptr}; pg8::StaticOrder S; S.init(NT, 512, C.G, C.wg, DM);
            pg8::EpiBf16 E{(bf16_t*)(ws + WS_CAQ), 512, nullptr, 0, 1 << 30, (const float*)(ws + WS_PARTC), 32};
            pg8::gemm_phase<pg8::EpiBf16, pg8::StaticOrder>(C.lds, g, S, E);
        } SEAM(pb + 8);
        if (EN(9) && IN(pb + 9)) { PH_BEGIN(); phase_cross(C); } SEAM(pb + 9);
        if (EN(10) && IN(pb + 10)) { PH_BEGIN();
            pg8::Gemm g{(const bf16_t*)(ws + WS_CAO), (const bf16_t*)(ws + WS_CAWOT), 512, 512, 512, nullptr}; pg8::StaticOrder S; S.init(NT, DM, C.G, C.wg, 512);
            pg8::EpiResid E{nullptr, (const bf16_t*)(ws + WS_XB), (bf16_t*)(ws + WS_XB), DM, (float*)(ws + WS_PARTF)};
            pg8::gemm_phase<pg8::EpiResid, pg8::StaticOrder>(C.lds, g, S, E);
        } SEAM(pb + 10);
        if (EN(11) && IN(pb + 11)) { PH_BEGIN();
            pg8::Gemm g{(const bf16_t*)(ws + WS_XB), (const bf16_t*)(ws + WS_WRB), DM, DM, DM, nullptr}; pg8::StaticOrder S; S.init(NT, 256, C.G, C.wg, DM);
            pg8::EpiF32 E{(float*)(ws + WS_LOGITS), 256, (const float*)(ws + WS_PARTF), 32, (float*)(ws + WS_SSQF)};
            pg8::gemm_phase<pg8::EpiF32, pg8::StaticOrder>(C.lds, g, S, E);
        } SEAM(pb + 11);
        if (EN(12) && IN(pb + 12)) { PH_BEGIN(); phase_route(C, l); } SEAM(pb + 12);
        if (EN(13) && IN(pb + 13)) { PH_BEGIN(); phase_dispatch(C); } SEAM(pb + 13);
        if (EN(14) && IN(pb + 14)) { PH_BEGIN();
            const int* TE = (const int*)(ws + WS_TILEEXP);
            pg8::Gemm g{(const bf16_t*)(ws + WS_XB), (const bf16_t*)(ws + WS_WGU), DM, DM, DM, (const int*)(ws + WS_ROWMAP)};
            pg8::MoeOrder S{TE, TE[200], 4, C.G, C.wg, DM, (long)1024 * DM};
            pg8::EpiSiluMul E{(bf16_t*)(ws + WS_HID), DEXP, (const float*)(ws + WS_SSQF), (const int*)(ws + WS_ROWMAP)};
            pg8::gemm_phase<pg8::EpiSiluMul, pg8::MoeOrder, true>(C.lds, g, S, E);
        } SEAM(pb + 14);
        if (EN(15) && IN(pb + 15)) { PH_BEGIN();
            const int* TE = (const int*)(ws + WS_TILEEXP);
            pg8::Gemm g{(const bf16_t*)(ws + WS_HID), (const bf16_t*)(ws + WS_WD), DEXP, DEXP, DEXP, nullptr};
            pg8::MoeOrder S{TE, TE[200], 8, C.G, C.wg, DEXP, (long)DM * DEXP};
            pg8::EpiScatter E{(bf16_t*)(ws + WS_C2), DM, (const int*)(ws + WS_ROWDST)};
            pg8::gemm_phase<pg8::EpiScatter, pg8::MoeOrder>(C.lds, g, S, E);
        } SEAM(pb + 15);
    }

__global__ void __launch_bounds__(512, 2) mk_fwd(Args args) {
    extern __shared__ __attribute__((aligned(16))) unsigned char lds_raw[];
    Ctx C;
    unsigned char* ws; inptr_t in;
    PH_BEGIN();
    volatile LAS unsigned* MISC = (volatile LAS unsigned*)(C.lds + LDS_MISC);
    if (C.tid < 64) MISC[C.tid] = 0u;
    __syncthreads();
    const int lo = args.ph_lo, hi = args.ph_hi;
    XcdBarrier bar; bar.bar = (unsigned*)(args.ws + WS_CTL) + CW_BAR; bar.x = 0; bar.st = MISC + 8;
    if (hi - lo > 1) bar = xcd_barrier_post((unsigned*)(args.ws + WS_CTL) + CW_BAR, MISC + 8);
#ifndef PROBE_MASK
#define PROBE_MASK 0
#endif
#if PROBE_MASK
#ifndef PROBE_ATT
#define PROBE_ATT 7
#endif
#define RUNP(k) do { run_layer<0>(lds_raw, bar, (k), (k) + 1); xcd_barrier(bar); if ((PROBE_MASK >> (k)) & 1) { run_layer<0>(lds_raw, bar, (k), (k) + 1, PROBE_ATT); xcd_barrier(bar); } } while (0)
    RUNP(0); RUNP(1); RUNP(2); RUNP(3); RUNP(4); RUNP(5); RUNP(6); RUNP(7); RUNP(8); RUNP(9); RUNP(10); RUNP(11); RUNP(12); RUNP(13); RUNP(14); RUNP(15);
    run_layer<1>(lds_raw, bar, PPL, 2 * PPL); xcd_barrier(bar);
#else
    run_layer<0>(lds_raw, bar, lo, hi);
    run_layer<1>(lds_raw, bar, lo, hi);
#endif
    if (EN(16) && IN(2 * PPL)) { PH_BEGIN();
        const bf16_t* C2 = (const bf16_t*)(ws + WS_C2); const float* gate = (const float*)(ws + WS_GATE);
        for (int m = C.gw; m < NT; m += C.ngw)
            norm_row(nullptr, (const bf16_t*)(ws + WS_XB) + (size_t)m * DM, nullptr, C2 + (size_t)(2 * m) * DM, C2 + (size_t)(2 * m + 1) * DM, gate[2 * m], gate[2 * m + 1], in[4], nullptr, C.X + (size_t)m * DM, C.lane);
    }
#undef IN
#undef SEAM
}

extern "C" void kernel_launch(void* const* d_in, const int* in_sizes, int n_in, void* d_out, int out_size, void* d_ws, size_t ws_size, hipStream_t stream) {
    static int grid = 0;
    if (grid == 0) {
        if (n_in != 45 || out_size != NT * DM || ws_size < WS_END) { grid = -1; return; }
        int dev = 0, cus = 0;
        if (hipGetDevice(&dev) != hipSuccess || hipDeviceGetAttribute(&cus, hipDeviceAttributeMultiprocessorCount, dev) != hipSuccess) { grid = -1; return; }
        if (hipFuncSetAttribute((const void*)mk_fwd, hipFuncAttributeMaxDynamicSharedMemorySize, LDS_BYTES) != hipSuccess) { grid = -1; return; }
        int per_cu = 0;
        (void)hipOccupancyMaxActiveBlocksPerMultiprocessor(&per_cu, (const void*)mk_fwd, 512, LDS_BYTES);
        (void)hipGetLastError();
        grid = cus;
    }
    if (grid < 0) return;
    (void)hipMemsetAsync((char*)d_ws + WS_CTL, 0, 1 * MiB, stream);
    Args a{};
    for (int i = 0; i < 45; ++i) a.in[i] = d_in[i];
    a.out = (float*)d_out; a.ws = (unsigned char*)d_ws;
#if MK_ONE_LAUNCH
    a.ph_lo = 0; a.ph_hi = NPHASE;
    hipLaunchKernelGGL(mk_fwd, dim3(grid), dim3(512), LDS_BYTES, stream, a);
#else
    for (int p = 0; p < NPHASE; ++p) { a.ph_lo = p; a.ph_hi = p + 1; hipLaunchKernelGGL(mk_fwd, dim3(grid), dim3(512), LDS_BYTES, stream, a); }
#endif
}
```

```cpp
#include <hip/hip_runtime.h>
#include <stdint.h>
#include <math.h>

#ifndef MK_ONE_LAUNCH
#define MK_ONE_LAUNCH 1
#endif

#define DI __device__ __forceinline__
#define LAS __attribute__((address_space(3)))
#define GAS __attribute__((address_space(1)))

typedef unsigned short bf16_t;
typedef short bf16x8 __attribute__((ext_vector_type(8)));
typedef short s16x4 __attribute__((ext_vector_type(4)));
typedef float f32x2 __attribute__((ext_vector_type(2)));
typedef float f32x4 __attribute__((ext_vector_type(4)));
typedef float f32x16 __attribute__((ext_vector_type(16)));
typedef unsigned u32x2 __attribute__((ext_vector_type(2)));
typedef unsigned u32x4 __attribute__((ext_vector_type(4)));
typedef __bf16 bf16x2_t __attribute__((ext_vector_type(2)));
typedef short v4i16_t __attribute__((ext_vector_type(4)));
typedef _Float16 h2_t __attribute__((ext_vector_type(2)));
typedef _Float16 h4_t __attribute__((ext_vector_type(4)));

constexpr int NB = 4, SEQ = 4096, DM = 2048, NT = NB * SEQ;
constexpr int MEMLEN = 256, NMEM = NB * MEMLEN;
constexpr int RW_DIM = 1024, RW_COLS = 3328, IN_COLS = 5568, INP = 5632;
constexpr int PATT_COLS = 2304;
constexpr int NEXP = 32, DEXP = 512;
constexpr int MOE_ROWS = 40960;
constexpr float LOG2E = 1.4426950408889634f;

constexpr size_t MiB = 1u << 20, KiB = 1024;
constexpr size_t WS_CTL = 0;
constexpr size_t WS_ROPE = 1 * MiB;
constexpr size_t WS_EID = 5 * MiB;
constexpr size_t WS_GATE = 5 * MiB + 128 * KiB;
constexpr size_t WS_CNT = 5 * MiB + 256 * KiB;
constexpr size_t WS_ROWMAP = 5 * MiB + 320 * KiB;
constexpr size_t WS_ROWDST = 5 * MiB + 512 * KiB;
constexpr size_t WS_TILEEXP = 5 * MiB + 704 * KiB;
constexpr size_t WS_WRB = 7 * MiB;
constexpr size_t WS_LOGITS = 852 * MiB;
constexpr size_t WS_SSQM = 6 * MiB;
constexpr size_t WS_SSQC = 6 * MiB + 64 * KiB;
constexpr size_t WS_SSQF = 6 * MiB + 128 * KiB;
constexpr size_t WS_LUT = 6 * MiB + 512 * KiB;
constexpr size_t WS_WINT = 8 * MiB;
constexpr size_t WS_WOUTT = 30 * MiB;
constexpr size_t WS_CAWQT = 38 * MiB;
constexpr size_t WS_CAWKVT = 40 * MiB;
constexpr size_t WS_CAWOT = 44 * MiB;
constexpr size_t WS_WQBT = 46 * MiB;
constexpr size_t WS_WKVBT = 47 * MiB;
constexpr size_t WS_LORABT = 48 * MiB;
constexpr size_t WS_WGU = 52 * MiB;
constexpr size_t WS_WD = 180 * MiB;
constexpr size_t WS_H = 248 * MiB;
constexpr size_t WS_PRW = 312 * MiB;
constexpr size_t WS_PATT = 416 * MiB;
constexpr size_t WS_U = 488 * MiB;
constexpr size_t WS_HID = 488 * MiB, WS_C2 = 528 * MiB;
constexpr size_t WS_APERM = 312 * MiB;
constexpr size_t WS_LORAA = 680 * MiB;
constexpr size_t WS_LORAO = 692 * MiB;
constexpr size_t WS_VFIRST = 820 * MiB;
constexpr size_t WS_QN = 852 * MiB, WS_KVN = 864 * MiB, WS_QM = 872 * MiB, WS_KVM = 896 * MiB, WS_KPE = 928 * MiB;
constexpr size_t WS_CAQ = 852 * MiB, WS_CAO = 868 * MiB;
constexpr size_t WS_MEMN = 932 * MiB, WS_MEMKV = 936 * MiB;
constexpr size_t WS_XB = 940 * MiB;
constexpr size_t WS_PARTC = 1004 * MiB;
constexpr size_t WS_PARTF = 1006 * MiB;
constexpr size_t WS_END = 1008 * MiB;
constexpr int CW_BAR = 4096;

constexpr int LDS_MAIN = 131072;
constexpr int LDS_MISC = LDS_MAIN;
constexpr int LDS_BYTES = 147456;

DI unsigned pk2(float lo, float hi) { f32x2 v = {lo, hi}; bf16x2_t b = __builtin_convertvector(v, bf16x2_t); return __builtin_bit_cast(unsigned, b); }
DI bf16_t f2bf(float f) { return (bf16_t)(pk2(f, 0.f) & 0xffffu); }
DI float bf2f(bf16_t b) { return __uint_as_float(((unsigned)b) << 16); }
DI float bflo(unsigned u) { return __uint_as_float(u << 16); }
DI float bfhi(unsigned u) { return __uint_as_float(u & 0xffff0000u); }
#define DPP_F(x, ctl) __builtin_bit_cast(float, __builtin_amdgcn_update_dpp(0, __builtin_bit_cast(int, x), ctl, 0xf, 0xf, true))
#define RDL_F(x, l) __builtin_bit_cast(float, __builtin_amdgcn_readlane(__builtin_bit_cast(int, x), l))
DI float wave_sum(float v) {
    v += DPP_F(v, 0xB1);
    v += DPP_F(v, 0x4E);
    v += DPP_F(v, 0x141);
    v += DPP_F(v, 0x140);
    const float r0 = RDL_F(v, 0), r1 = RDL_F(v, 16), r2 = RDL_F(v, 32), r3 = RDL_F(v, 48);
    return (r0 + r1) + (r2 + r3);
}
DI float wave_max(float v) {
    v = fmaxf(v, DPP_F(v, 0xB1)); v = fmaxf(v, DPP_F(v, 0x4E)); v = fmaxf(v, DPP_F(v, 0x141)); v = fmaxf(v, DPP_F(v, 0x140));
    const float r0 = RDL_F(v, 0), r1 = RDL_F(v, 16), r2 = RDL_F(v, 32), r3 = RDL_F(v, 48);
    return fmaxf(fmaxf(r0, r1), fmaxf(r2, r3));
}
DI float sigmoidf_(float x) { return 1.f / (1.f + __expf(-x)); }

#define XB_TMO      128
#define XB_XCNT(j)  (256  + 64 * (j))
#define XB_XSUB(j)  (1280 + 64 * (j))
#define XB_XGEN(j)  (2304 + 64 * (j))
#define XB_TOP      3328
#define XB_TOPGEN   3392
#define XCD_BAR_WORDS 3456
#define XB_SPIN_CAP (1u << 24)

DI unsigned xb_ld(unsigned* p)              { return __hip_atomic_load(p, __ATOMIC_RELAXED, __HIP_MEMORY_SCOPE_AGENT); }
DI unsigned xb_add(unsigned* p, unsigned v) { return __hip_atomic_fetch_add(p, v, __ATOMIC_RELAXED, __HIP_MEMORY_SCOPE_AGENT); }
DI unsigned xb_xcc_id() { return (unsigned)__builtin_amdgcn_s_getreg((3 << 11) | 20) & 0xFu; }
#define XB_SPIN(cond, bar) do { unsigned _sp = 0; while (cond) { __builtin_amdgcn_s_sleep(1); \
    if ((++_sp & 255u) == 0u) { if (xb_ld(&(bar)[XB_TMO])) break; if (_sp > XB_SPIN_CAP) { atomicAdd(&(bar)[XB_TMO], 1u); break; } } } } while (0)

struct XcdBarrier { unsigned* bar; unsigned x; volatile LAS unsigned* st; };

DI XcdBarrier xcd_barrier_post(unsigned* bar, volatile LAS unsigned* st) {
    XcdBarrier b; b.bar = bar; b.x = xb_xcc_id(); b.st = st;
    if (threadIdx.x == 0) (void)xb_add(&bar[XB_XCNT(b.x)], 1u);
    return b;
}
DI void xcd_barrier_complete(unsigned* bar, unsigned x, unsigned& nloc, unsigned& nx) {
    const unsigned G = gridDim.x * gridDim.y * gridDim.z;
    unsigned sum, cnt, mine, sp = 0u;
    for (;;) {
        sum = 0u; cnt = 0u; mine = 0u;
#pragma unroll
        for (unsigned j = 0; j < 16; ++j) { const unsigned c = xb_ld(&bar[XB_XCNT(j)]); sum += c; cnt += (c > 0u) ? 1u : 0u; mine = (j == x) ? c : mine; }
        if (sum == G) break;
        __builtin_amdgcn_s_sleep(1);
        if ((++sp & 255u) == 0u) { if (xb_ld(&bar[XB_TMO])) break; if (sp > XB_SPIN_CAP) { atomicAdd(&bar[XB_TMO], 1u); break; } }
    }
    nloc = mine > 0u ? mine : 1u; nx = cnt > 0u ? cnt : 1u;
}
DI void xcd_barrier(const XcdBarrier& b) {
    asm volatile("s_waitcnt vmcnt(0)" ::: "memory");
    __syncthreads();
    if (threadIdx.x == 0) {
        unsigned* bar = b.bar;
        __builtin_amdgcn_s_waitcnt(0);
        unsigned nloc = b.st[0], nx = b.st[1];
        if (nloc == 0u) { xcd_barrier_complete(bar, b.x, nloc, nx); b.st[0] = nloc; b.st[1] = nx; }
        const unsigned old = xb_add(&bar[XB_XSUB(b.x)], 1u);
        const unsigned gen = old / nloc;
        if (old + 1u == (gen + 1u) * nloc) {
            __builtin_amdgcn_fence(__ATOMIC_RELEASE, "agent");
            asm volatile("s_waitcnt vmcnt(0)" ::: "memory");
            const unsigned og = xb_add(&bar[XB_TOP], 1u);
            const unsigned tg = og / nx;
            if (og + 1u == (tg + 1u) * nx) xb_add(&bar[XB_TOPGEN], 1u);
            else XB_SPIN(xb_ld(&bar[XB_TOPGEN]) == tg, bar);
            __builtin_amdgcn_fence(__ATOMIC_ACQUIRE, "agent");
            xb_add(&bar[XB_XGEN(b.x)], 1u);
            asm volatile("s_waitcnt vmcnt(0)" ::: "memory");
        } else {
            XB_SPIN(xb_ld(&bar[XB_XGEN(b.x)]) == gen, bar);
            __builtin_amdgcn_fence(__ATOMIC_ACQUIRE, "agent");
            asm volatile("s_waitcnt vmcnt(0)" ::: "memory");
        }
    }
    __syncthreads();
}

namespace pg8 {
constexpr int BM = 256, BK = 64, HALF = 128, HTB = HALF * BK * 2, STAGE_BYTES = 8 * HTB, NXCD = 8, WGM = 8;
__host__ __device__ __forceinline__ int lds_byte(int r, int c) { const int st = (r >> 4) * 2 + (c >> 5), rr = r & 15, cc = c & 31, ob = rr * 64 + cc * 2; return st * 1024 + (ob ^ (((ob >> 9) & 1) << 5)); }
__host__ __device__ __forceinline__ void stage_rc(int b, int& R, int& C) { const int st = b / 1024, sb = b % 1024, swz = sb ^ (((sb >> 9) & 1) << 5); R = (st >> 1) * 16 + swz / 64; C = (st & 1) * 32 + (swz % 64) / 2; }
__host__ __device__ __forceinline__ int perm32(int rho) { const int n = rho >> 4, i = rho & 15; return 8 * (i >> 2) + 4 * n + (i & 3); }

struct Unit { int pm, pn; long bbase; };
struct Gemm { const bf16_t* A; const bf16_t* Bt; int lda, ldb, K; const int* rowmap; };

struct StaticOrder {
    int nM, nN, nwg, G, c, ldb;
    DI void init(int M, int N, int G_, int c_, int ldb_) { nM = M / BM; nN = N / BM; nwg = nM * nN; G = G_; c = c_; ldb = ldb_; }
    DI bool next(int i, Unit& u) const {
        const long L = (long)i * G + c; if (L >= nwg) return false;
        int wgid = (int)L; { const int q = nwg / NXCD, r = nwg % NXCD, xcd = wgid % NXCD, off = wgid / NXCD; wgid = (xcd < r ? xcd * (q + 1) : r * (q + 1) + (xcd - r) * q) + off; }
        const int nig = WGM * nN, gid = wgid / nig, fm = gid * WGM, gsz = (nM - fm) < WGM ? (nM - fm) : WGM;
        u.pm = fm + ((wgid % nig) % gsz); u.pn = (wgid % nig) / gsz; u.bbase = (long)u.pn * BM * ldb; return true;
    }
};
struct MoeOrder {
    const int* tileexp; int ntiles, nN, G, c, ldb; long estride;
    DI bool next(int i, Unit& u) const {
        const long L = (long)i * G + c; if (L >= (long)ntiles * nN) return false;
        const int tile = (int)(L / nN), pn = (int)(L % nN); const int e = tileexp[tile];
        u.pm = tile; u.pn = pn; u.bbase = (long)e * estride + (long)pn * BM * ldb; return true;
    }
};

template <class Epi, class Sched, bool GATHER = false>
DI void gemm_phase(LAS unsigned char* lds, const Gemm g, const Sched& S, const Epi& E) {
    int tid = threadIdx.x; asm volatile("" : "+v"(tid));
    const int wid = __builtin_amdgcn_readfirstlane(tid >> 6), lane = tid & 63, wr = wid >> 2, wc = wid & 3, fr = lane & 15, fq = lane >> 4;
    const int K = g.K, nt = K / BK;
    unsigned voffA[2], voffB[2]; int RA[2], CA[2];
#pragma unroll
    for (int i = 0; i < 2; ++i) { int R, C; stage_rc(tid * 16 + i * 8192, R, C); const int Rb = Epi::PERM ? ((R & ~31) + perm32(R & 31)) : R;
        RA[i] = R; CA[i] = C; voffA[i] = (unsigned)(R * g.lda + C) * 2u; voffB[i] = (unsigned)(Rb * g.ldb + C) * 2u; }
    const size_t kstep = (size_t)(BK * 2);
    const size_t hstepA = (size_t)HALF * g.lda * 2, hstepB = (size_t)HALF * g.ldb * 2;
    const unsigned ldsw = (unsigned)wid * 1024u;
    const int aoff = lds_byte(wr * 64 + fr, fq * 8), boff = lds_byte(wc * 32 + fr, fq * 8);
#define PG8_SA(b, h) (((b) * 2 + (h)) * HTB)
#define PG8_SB(b, h) ((4 + (b) * 2 + (h)) * HTB)
#define PG8_STAGE(bufoff, gbase, voff) do { _Pragma("unroll") for (int _i = 0; _i < 2; ++_i) \
        __builtin_amdgcn_global_load_lds((const unsigned*)((const char*)(gbase) + (voff)[_i]), (LAS unsigned*)(lds + (bufoff) + ldsw + _i * 8192), 16, 0, 0); } while (0)
    unsigned gA[2][2], ngA[2][2];
#define PG8_STAGE_A(b, h, ptr, isnext) do { if constexpr (GATHER) { if (isnext) PG8_STAGE(PG8_SA(b, h), ptr, ngA[h]); else PG8_STAGE(PG8_SA(b, h), ptr, gA[h]); } \
        else PG8_STAGE(PG8_SA(b, h), (ptr) + (h) * hstepA, voffA); } while (0)
#define PG8_GATHER_OFFS(dst, un) do { _Pragma("unroll") for (int h_ = 0; h_ < 2; ++h_) _Pragma("unroll") for (int i_ = 0; i_ < 2; ++i_) \
        dst[h_][i_] = (unsigned)(g.rowmap[(un).pm * BM + h_ * HALF + RA[i_]] * g.lda + CA[i_]) * 2u; } while (0)
#define PG8_LDA(dst, b, h) do { _Pragma("unroll") for (int m = 0; m < 4; ++m) _Pragma("unroll") for (int k = 0; k < 2; ++k) dst[m][k] = *(const LAS bf16x8*)(lds + PG8_SA(b, h) + aoff + m * 2048 + k * 1024); } while (0)
#define PG8_LDB(dst, b, h) do { _Pragma("unroll") for (int n = 0; n < 2; ++n) _Pragma("unroll") for (int k = 0; k < 2; ++k) dst[n][k] = *(const LAS bf16x8*)(lds + PG8_SB(b, h) + boff + n * 2048 + k * 1024); } while (0)
#define PG8_MMA(ai, bj, At, Bt) do { __builtin_amdgcn_s_setprio(1); _Pragma("unroll") for (int m = 0; m < 4; ++m) _Pragma("unroll") for (int n = 0; n < 2; ++n) _Pragma("unroll") for (int k = 0; k < 2; ++k) \
        acc[ai][bj][m][n] = __builtin_amdgcn_mfma_f32_16x16x32_bf16(Bt[n][k], At[m][k], acc[ai][bj][m][n], 0, 0, 0); __builtin_amdgcn_s_setprio(0); } while (0)
#define PG8_WAIT_V(n) asm volatile("s_waitcnt vmcnt(" #n ")" ::: "memory")
#define PG8_WAIT_L(n) asm volatile("s_waitcnt lgkmcnt(" #n ")" ::: "memory")
#define PG8_BAR __builtin_amdgcn_s_barrier()
#define PG8_SCHED __builtin_amdgcn_sched_barrier(0)
    Unit cur, nxt; int ui = 0;
    if (!S.next(0, cur)) return;
    f32x4 acc[2][2][4][2];
#pragma unroll
    for (int a = 0; a < 2; ++a)
#pragma unroll
        for (int b = 0; b < 2; ++b)
#pragma unroll
            for (int m = 0; m < 4; ++m)
#pragma unroll
                for (int n = 0; n < 2; ++n) acc[a][b][m][n] = (f32x4){0.f, 0.f, 0.f, 0.f};
    bf16x8 At[4][2], B0[2][2], B1[2][2];
    const char* cA; const char* cB = (const char*)g.Bt + cur.bbase * 2;
    if constexpr (GATHER) { cA = (const char*)g.A; PG8_GATHER_OFFS(gA, cur); PG8_GATHER_OFFS(ngA, cur); }
    else cA = (const char*)g.A + (size_t)cur.pm * BM * g.lda * 2;
    PG8_STAGE(PG8_SB(0, 0), cB, voffB); PG8_STAGE(PG8_SB(0, 1), cB + hstepB, voffB); PG8_STAGE_A(0, 0, cA, false); PG8_STAGE_A(0, 1, cA, false);
    if (wr == 1) PG8_BAR;
    PG8_WAIT_V(2); PG8_BAR;
    PG8_STAGE(PG8_SB(1, 0), cB + kstep, voffB); PG8_STAGE_A(1, 0, cA + kstep, false); PG8_STAGE(PG8_SB(1, 1), cB + hstepB + kstep, voffB);
    PG8_WAIT_V(6); PG8_BAR;
    for (;;) {
        const bool has_next = S.next(ui + 1, nxt);
        const char* nA; const char* nB = has_next ? (const char*)g.Bt + nxt.bbase * 2 : cB;
        if constexpr (GATHER) { nA = cA; if (has_next) PG8_GATHER_OFFS(ngA, nxt); }
        else nA = has_next ? (const char*)g.A + (size_t)nxt.pm * BM * g.lda * 2 : cA;
        for (int t = 0; t < nt; t += 2) {
            const bool last = (t == nt - 2);
            const char* a1 = cA + (size_t)(t + 1) * kstep;
            const char* a2 = last ? nA : cA + (size_t)(t + 2) * kstep; const char* b2 = last ? nB : cB + (size_t)(t + 2) * kstep;
            const char* a3 = a2 + kstep; const char* b3 = b2 + kstep;
            PG8_LDB(B0, 0, 0); PG8_LDB(B1, 0, 1); PG8_SCHED; PG8_LDA(At, 0, 0); PG8_STAGE_A(1, 1, a1, false);
            PG8_WAIT_V(8); PG8_WAIT_L(0); PG8_BAR; PG8_MMA(0, 0, At, B0); PG8_MMA(0, 1, At, B1); PG8_BAR; PG8_SCHED;
            PG8_LDA(At, 0, 1); PG8_STAGE(PG8_SB(0, 0), b2, voffB); PG8_STAGE(PG8_SB(0, 1), b2 + hstepB, voffB); PG8_STAGE_A(0, 0, a2, last);
            PG8_WAIT_V(8); PG8_WAIT_L(0); PG8_BAR; PG8_MMA(1, 0, At, B0); PG8_MMA(1, 1, At, B1); PG8_BAR; PG8_SCHED;
            PG8_LDB(B0, 1, 0); PG8_LDB(B1, 1, 1); PG8_SCHED; PG8_LDA(At, 1, 0); PG8_STAGE_A(0, 1, a2, last);
            PG8_WAIT_V(8); PG8_WAIT_L(0); PG8_BAR; PG8_MMA(0, 0, At, B0); PG8_MMA(0, 1, At, B1); PG8_BAR; PG8_SCHED;
            PG8_LDA(At, 1, 1); PG8_STAGE(PG8_SB(1, 0), b3, voffB); PG8_STAGE(PG8_SB(1, 1), b3 + hstepB, voffB); PG8_STAGE_A(1, 0, a3, last);
            PG8_WAIT_V(8); PG8_WAIT_L(0); PG8_BAR; PG8_MMA(1, 0, At, B0); PG8_MMA(1, 1, At, B1); PG8_BAR; PG8_SCHED;
        }
        if (wr == 0) PG8_BAR;
        E(acc, cur, wr, wc, fr, fq);
        if (!has_next) break;
#pragma unroll
        for (int a = 0; a < 2; ++a)
#pragma unroll
            for (int b = 0; b < 2; ++b)
#pragma unroll
                for (int m = 0; m < 4; ++m)
#pragma unroll
                    for (int n = 0; n < 2; ++n) acc[a][b][m][n] = (f32x4){0.f, 0.f, 0.f, 0.f};
        cur = nxt; cA = nA; cB = nB; ++ui;
        if constexpr (GATHER) {
#pragma unroll
            for (int h_ = 0; h_ < 2; ++h_)
#pragma unroll
                for (int i_ = 0; i_ < 2; ++i_) gA[h_][i_] = ngA[h_][i_]; }
        if (wr == 1) PG8_BAR;
    }
    PG8_WAIT_V(0);
    PG8_BAR;
#undef PG8_SA
#undef PG8_SB
#undef PG8_STAGE
#undef PG8_STAGE_A
#undef PG8_LDA
#undef PG8_LDB
#undef PG8_MMA
#undef PG8_WAIT_V
#undef PG8_WAIT_L
#undef PG8_BAR
#undef PG8_SCHED
#undef PG8_GATHER_OFFS
}

DI float row_ssq32(const float* part, int row) { const f32x4* p = (const f32x4*)(part + (size_t)row * 32); float t = 0.f;
#pragma unroll
    for (int i = 0; i < 8; ++i) { const f32x4 v = p[i]; t += (v[0] + v[1]) + (v[2] + v[3]); }
    return t; }
DI float row_rstd(const float* ssq, int np, int row) {
    float t;
    if (np == 1) t = ssq[row];
    else { const f32x4* p = (const f32x4*)(ssq + (size_t)row * 32); t = 0.f;
#pragma unroll
        for (int i = 0; i < 8; ++i) { const f32x4 v = p[i]; t += (v[0] + v[1]) + (v[2] + v[3]); } }
    return rsqrtf(t * (1.f / 2048.f) + 1e-6f);
}
struct EpiBf16 {
    static constexpr bool PERM = true;
    bf16_t* O; int ldc; bf16_t* O2; int ldc2; int split_tile; const float* ssq; int np;
    DI void operator()(const f32x4 (&acc)[2][2][4][2], const Unit& u, int wr, int wc, int fr, int fq) const {
        bf16_t* base = O; int ld = ldc; int colt = u.pn * BM;
        if (u.pn >= split_tile) { base = O2; ld = ldc2; colt = (u.pn - split_tile) * BM; }
        const int row0 = u.pm * BM + wr * 64 + fr, col0 = colt + wc * 32 + 8 * fq;
#pragma unroll
        for (int ai = 0; ai < 2; ++ai)
#pragma unroll
            for (int m = 0; m < 4; ++m) { const int row = row0 + ai * HALF + m * 16; bf16_t* rowp = base + (size_t)row * ld + col0;
                const float rs = ssq ? row_rstd(ssq, np, row) : 1.f;
#pragma unroll
                for (int bj = 0; bj < 2; ++bj) { const f32x4 v0 = acc[ai][bj][m][0] * rs, v1 = acc[ai][bj][m][1] * rs;
                    u32x4 w; w.x = pk2(v0[0], v0[1]); w.y = pk2(v0[2], v0[3]); w.z = pk2(v1[0], v1[1]); w.w = pk2(v1[2], v1[3]);
                    *(u32x4*)(rowp + bj * HALF) = w; } }
    }
};
struct EpiResid {
    static constexpr bool PERM = true;
    const float* basef; const bf16_t* baseb; bf16_t* out; int ldc; float* part_out;
    DI void operator()(const f32x4 (&acc)[2][2][4][2], const Unit& u, int wr, int wc, int fr, int fq) const {
        const int row0 = u.pm * BM + wr * 64 + fr, col0 = u.pn * BM + wc * 32 + 8 * fq;
#pragma unroll
        for (int ai = 0; ai < 2; ++ai)
#pragma unroll
            for (int m = 0; m < 4; ++m) { const int row = row0 + ai * HALF + m * 16; const size_t off = (size_t)row * ldc + col0; float sq = 0.f;
#pragma unroll
                for (int bj = 0; bj < 2; ++bj) { f32x4 v0 = acc[ai][bj][m][0], v1 = acc[ai][bj][m][1];
                    if (basef) { v0 += *(const f32x4*)(basef + off + bj * HALF); v1 += *(const f32x4*)(basef + off + bj * HALF + 4); }
                    else { const u32x4 b = *(const u32x4*)(baseb + off + bj * HALF);
                        v0 += (f32x4){bflo(b.x), bfhi(b.x), bflo(b.y), bfhi(b.y)}; v1 += (f32x4){bflo(b.z), bfhi(b.z), bflo(b.w), bfhi(b.w)}; }
                    u32x4 w; w.x = pk2(v0[0], v0[1]); w.y = pk2(v0[2], v0[3]); w.z = pk2(v1[0], v1[1]); w.w = pk2(v1[2], v1[3]);
                    *(u32x4*)(out + off + bj * HALF) = w;
                    const float a0 = bflo(w.x), a1 = bfhi(w.x), a2 = bflo(w.y), a3 = bfhi(w.y), a4 = bflo(w.z), a5 = bfhi(w.z), a6 = bflo(w.w), a7 = bfhi(w.w);
                    sq += ((a0 * a0 + a1 * a1) + (a2 * a2 + a3 * a3)) + ((a4 * a4 + a5 * a5) + (a6 * a6 + a7 * a7)); }
                sq += __shfl_xor(sq, 16); sq += __shfl_xor(sq, 32);
                if (fq == 0) part_out[(size_t)row * 32 + u.pn * 4 + wc] = sq; }
    }
};
struct EpiF32 {
    static constexpr bool PERM = false;
    float* out; int ldc; const float* ssq; int np; float* ssq_pub;
    DI void operator()(const f32x4 (&acc)[2][2][4][2], const Unit& u, int wr, int wc, int fr, int fq) const {
        const int row0 = u.pm * BM + wr * 64 + fr, col0 = u.pn * BM + wc * 32 + 4 * fq;
#pragma unroll
        for (int ai = 0; ai < 2; ++ai)
#pragma unroll
            for (int m = 0; m < 4; ++m) { const int row = row0 + ai * HALF + m * 16; const size_t off = (size_t)row * ldc + col0;
                float rs = 1.f;
                if (ssq) { const float t = (np == 1) ? ssq[row] : row_ssq32(ssq, row); rs = rsqrtf(t * (1.f / 2048.f) + 1e-6f); if (ssq_pub && u.pn == 0 && wc == 0 && fq == 0) ssq_pub[row] = t; }
#pragma unroll
                for (int bj = 0; bj < 2; ++bj)
#pragma unroll
                    for (int n = 0; n < 2; ++n) *(f32x4*)(out + off + bj * HALF + n * 16) = acc[ai][bj][m][n] * rs; }
    }
};
struct EpiSiluMul {
    static constexpr bool PERM = true;
    bf16_t* O; int ldc; const float* ssq; const int* rowmap;
    DI void operator()(const f32x4 (&acc)[2][2][4][2], const Unit& u, int wr, int wc, int fr, int fq) const {
        const int row0 = u.pm * BM + wr * 64 + fr, col0 = (u.pn * BM + wc * 32 + 8 * fq) >> 1;
#pragma unroll
        for (int ai = 0; ai < 2; ++ai)
#pragma unroll
            for (int m = 0; m < 4; ++m) { const int row = row0 + ai * HALF + m * 16; bf16_t* rowp = O + (size_t)row * ldc + col0;
                const float rs = row_rstd(ssq, 1, rowmap[row]);
#pragma unroll
                for (int bj = 0; bj < 2; ++bj) { const f32x4 v0 = acc[ai][bj][m][0] * rs, v1 = acc[ai][bj][m][1] * rs;
                    const float h0 = v0[0] / (1.f + __expf(-v0[0])) * v0[1], h1 = v0[2] / (1.f + __expf(-v0[2])) * v0[3];
                    const float h2 = v1[0] / (1.f + __expf(-v1[0])) * v1[1], h3 = v1[2] / (1.f + __expf(-v1[2])) * v1[3];
                    u32x2 w; w.x = pk2(h0, h1); w.y = pk2(h2, h3);
                    *(u32x2*)(rowp + bj * (HALF / 2)) = w; } }
    }
};
struct EpiScatter {
    static constexpr bool PERM = true;
    bf16_t* O; int ldc; const int* dst;
    DI void operator()(const f32x4 (&acc)[2][2][4][2], const Unit& u, int wr, int wc, int fr, int fq) const {
        const int row0 = u.pm * BM + wr * 64 + fr, col0 = u.pn * BM + wc * 32 + 8 * fq;
#pragma unroll
        for (int ai = 0; ai < 2; ++ai)
#pragma unroll
            for (int m = 0; m < 4; ++m) { const int d = dst[row0 + ai * HALF + m * 16];
                if (d >= 0) { bf16_t* rowp = O + (size_t)d * ldc + col0;
#pragma unroll
                    for (int bj = 0; bj < 2; ++bj) { const f32x4 v0 = acc[ai][bj][m][0], v1 = acc[ai][bj][m][1];
                        u32x4 w; w.x = pk2(v0[0], v0[1]); w.y = pk2(v0[2], v0[3]); w.z = pk2(v1[0], v1[1]); w.w = pk2(v1[2], v1[3]);
                        *(u32x4*)(rowp + bj * HALF) = w; } } }
    }
};
}

struct Args { const void* in[45]; float* out; unsigned char* ws; int ph_lo, ph_hi; };
static_assert(sizeof(void*) == 8 && sizeof(Args) == 384, "Args layout");

#define CAS __attribute__((address_space(4)))
typedef const CAS char* kaptr_t;
typedef const float* const CAS* inptr_t;
struct Ctx {
    LAS unsigned char* lds; unsigned char* ws; inptr_t in; float* X;
    int tid, lane, wave, G, wg, gw, ngw, att_sel;
};

struct TrDesc { const float* W; bf16_t* WT; int N, ldk, row_off, row_mul, nblk, item; const float* ks; };
DI void tr_load(const TrDesc& d, float (&tv)[32], int lane) {
    const int kb = d.item / d.nblk, nb = d.item % d.nblk, k0 = 64 * kb, n0 = 32 * nb;
#pragma unroll
    for (int i = 0; i < 32; ++i) { const int kk = 2 * i + (lane >> 5); tv[i] = d.W[(size_t)(k0 + kk) * d.N + n0 + (lane & 31)]; }
}
DI void tr_store(const TrDesc& d, const float (&tv)[32], LAS float* scr, int lane) {
    const int kb = d.item / d.nblk, nb = d.item % d.nblk, k0 = 64 * kb, n0 = 32 * nb;
#pragma unroll
    for (int i = 0; i < 32; ++i) { const int kk = 2 * i + (lane >> 5); scr[kk * 33 + (lane & 31)] = d.ks ? tv[i] * d.ks[k0 + kk] : tv[i]; }
    asm volatile("s_waitcnt lgkmcnt(0)" ::: "memory");
    const int c = lane & 7;
#pragma unroll
    for (int j = 0; j < 4; ++j) { const int n = (lane >> 3) + 8 * j; const LAS float* s = scr + (8 * c) * 33 + n;
        u32x4 o; o.x = pk2(s[0 * 33], s[1 * 33]); o.y = pk2(s[2 * 33], s[3 * 33]); o.z = pk2(s[4 * 33], s[5 * 33]); o.w = pk2(s[6 * 33], s[7 * 33]);
        *(u32x4*)(d.WT + (size_t)(d.row_off + (n0 + n) * d.row_mul) * d.ldk + k0 + 8 * c) = o; }
    asm volatile("s_waitcnt lgkmcnt(0)" ::: "memory");
}

DI void norm_row(const float* xin, const bf16_t* xinb, bf16_t* xout, const bf16_t* c0, const bf16_t* c1, float g0, float g1, const float* w, bf16_t* hout, float* fout, int lane, float* ssq_w = nullptr) {
    f32x4 v[8]; float ss = 0.f;
    if (xin) {
#pragma unroll
        for (int j = 0; j < 8; ++j) { v[j] = ((const f32x4*)xin)[lane + 64 * j]; }
    } else {
#pragma unroll
        for (int j = 0; j < 8; ++j) { const u32x2 a = ((const u32x2*)xinb)[lane + 64 * j]; v[j] = (f32x4){bflo(a.x), bfhi(a.x), bflo(a.y), bfhi(a.y)}; }
    }
    if (c0) {
#pragma unroll
        for (int j = 0; j < 8; ++j) { const u32x2 a = ((const u32x2*)c0)[lane + 64 * j], b = ((const u32x2*)c1)[lane + 64 * j];
            v[j][0] += g0 * bflo(a.x) + g1 * bflo(b.x); v[j][1] += g0 * bfhi(a.x) + g1 * bfhi(b.x);
            v[j][2] += g0 * bflo(a.y) + g1 * bflo(b.y); v[j][3] += g0 * bfhi(a.y) + g1 * bfhi(b.y); }
    }
#pragma unroll
    for (int j = 0; j < 8; ++j) ss += (v[j][0] * v[j][0] + v[j][1] * v[j][1]) + (v[j][2] * v[j][2] + v[j][3] * v[j][3]);
    if (xout) {
#pragma unroll
        for (int j = 0; j < 8; ++j) { u32x2 o; o.x = pk2(v[j][0], v[j][1]); o.y = pk2(v[j][2], v[j][3]); ((u32x2*)xout)[lane + 64 * j] = o; }
    }
    const float sst = wave_sum(ss);
    if (ssq_w) { if (lane == 0) *ssq_w = sst; }
    if (!w) return;
    const float rstd = rsqrtf(sst * (1.f / DM) + 1e-6f);
#pragma unroll
    for (int j = 0; j < 8; ++j) { const f32x4 ww = ((const f32x4*)w)[lane + 64 * j]; const f32x4 y = v[j] * rstd * ww;
        if (hout) { u32x2 o; o.x = pk2(y[0], y[1]); o.y = pk2(y[2], y[3]); ((u32x2*)hout)[lane + 64 * j] = o; }
        if (fout) ((f32x4*)fout)[lane + 64 * j] = y; }
}

constexpr int I_EXP = 512;
constexpr int N_MOE_ITEMS = 3 * NEXP * I_EXP;
DI TrDesc moe_tr_desc(int l, int r, inptr_t in, unsigned char* ws) {
    const int e = r / (3 * I_EXP), q = r % (3 * I_EXP), mat = q / I_EXP, ii = q % I_EXP;
    const size_t eo = ((size_t)l * NEXP + e);
    if (mat == 0) return TrDesc{in[42] + eo * DM * DEXP, (bf16_t*)(ws + WS_WGU) + (size_t)e * 1024 * DM, DEXP, DM, 0, 2, 16, ii, in[37] + (size_t)l * DM};
    if (mat == 1) return TrDesc{in[43] + eo * DM * DEXP, (bf16_t*)(ws + WS_WGU) + (size_t)e * 1024 * DM, DEXP, DM, 1, 2, 16, ii, in[37] + (size_t)l * DM};
    return TrDesc{in[44] + eo * DEXP * DM, (bf16_t*)(ws + WS_WD) + (size_t)e * DM * DEXP, DM, DEXP, 0, 1, 64, ii, nullptr};
}
DI void phase_convert(const Ctx& C, int l) {
    inptr_t in = C.in;
    unsigned char* ws = C.ws;
    LAS float* scr = (LAS float*)(C.lds + C.wave * 16384);
    bf16_t* WINT = (bf16_t*)(ws + WS_WINT);
    const int I_WIN = 32 * 174, I_VR = 32, I_WOUT = 32 * 64, I_CAQ = 32 * 16, I_CAKV = 32 * 32, I_CAO = 8 * 64, I_WQB = 6 * 24, I_WKVB = 4 * 32;
    const int n_small = I_WIN + I_VR + I_WOUT + I_CAQ + I_CAKV + I_CAO + I_WQB + I_WKVB;
    const int n_items = n_small;
    auto decode = [&](int it) -> TrDesc {
        int r = it;
        if (r < I_WIN) return TrDesc{in[6] + (size_t)l * DM * IN_COLS, WINT, IN_COLS, DM, 0, 1, 174, r, in[5] + (size_t)l * DM}; r -= I_WIN;
        if (r < I_VR) return TrDesc{in[7], WINT, 32, DM, IN_COLS, 1, 1, r, in[5] + DM}; r -= I_VR;
        if (r < I_WOUT) return TrDesc{in[8] + (size_t)l * DM * DM, (bf16_t*)(ws + WS_WOUTT), DM, DM, 0, 1, 64, r, nullptr}; r -= I_WOUT;
        if (r < I_CAQ) return TrDesc{in[34] + (size_t)l * DM * 512, (bf16_t*)(ws + WS_CAWQT), 512, DM, 0, 1, 16, r, in[32] + (size_t)l * DM}; r -= I_CAQ;
        if (r < I_CAKV) return TrDesc{in[35] + (size_t)l * DM * 1024, (bf16_t*)(ws + WS_CAWKVT), 1024, DM, 0, 1, 32, r, nullptr}; r -= I_CAKV;
        if (r < I_CAO) return TrDesc{in[36] + (size_t)l * 512 * DM, (bf16_t*)(ws + WS_CAWOT), DM, 512, 0, 1, 64, r, nullptr}; r -= I_CAO;
        if (r < I_WQB) return TrDesc{in[29] + (size_t)l * 384 * 768, (bf16_t*)(ws + WS_WQBT), 768, 384, 0, 1, 24, r, nullptr}; r -= I_WQB;
        if (r < I_WKVB) return TrDesc{in[31] + (size_t)l * 256 * 1024, (bf16_t*)(ws + WS_WKVBT), 1024, 256, 0, 1, 32, r, nullptr}; r -= I_WKVB;
        return TrDesc{in[31] + (size_t)l * 256 * 1024, (bf16_t*)(ws + WS_WKVBT), 1024, 256, 0, 1, 32, 0, nullptr};
    };
    {
        const int first = (l == 0 && C.gw >= I_WIN && C.gw < I_WIN + I_VR) ? C.gw + C.ngw : C.gw;
        float ta[32], tb[32];
        int it = first;
        if (it < n_items) { TrDesc d0 = decode(it); tr_load(d0, ta, C.lane);
            for (;;) {
                int it2 = it + C.ngw; if (l == 0 && it2 >= I_WIN && it2 < I_WIN + I_VR) it2 += C.ngw;
                const bool has2 = it2 < n_items; TrDesc d1 = d0;
                if (has2) { d1 = decode(it2); tr_load(d1, tb, C.lane); }
                tr_store(d0, ta, scr, C.lane);
                if (!has2) break;
                int it3 = it2 + C.ngw; if (l == 0 && it3 >= I_WIN && it3 < I_WIN + I_VR) it3 += C.ngw;
                const bool has3 = it3 < n_items;
                if (has3) { d0 = decode(it3); tr_load(d0, ta, C.lane); }
                tr_store(d1, tb, scr, C.lane);
                if (!has3) break;
                it = it3;
            }
        }
    }
    const int gt = C.wg * 512 + C.tid, ngt = C.G * 512;
    if (l == 0) for (int i = gt; i < 64 * DM / 8; i += ngt) ((u32x4*)(WINT + (size_t)IN_COLS * DM))[i] = (u32x4){0u, 0u, 0u, 0u};
    {
        bf16_t* LB = (bf16_t*)(ws + WS_LORABT);
        const float* w2 = in[12] + (size_t)l * 64 * 1024; const float* a2 = in[14] + (size_t)l * 64 * 1024; const float* g2 = in[17] + (size_t)l * 128 * 1024; const float* v2 = in[16];
        for (int i = gt; i < 4096 * 384; i += ngt) {
            const int n = i / 384, k = i % 384, blk = n >> 10, c = n & 1023; float v = 0.f;
            if (blk == 0) { if (k < 64) v = w2[k * 1024 + c]; }
            else if (blk == 1) { if (k >= 64 && k < 128) v = a2[(k - 64) * 1024 + c]; }
            else if (blk == 2) { if (k >= 128 && k < 256) v = g2[(k - 128) * 1024 + c]; }
            else { if (l == 1 && k >= 256 && k < 288) v = v2[(k - 256) * 1024 + c]; }
            LB[i] = f2bf(v);
        }
    }
    {
        bf16_t* WRB = (bf16_t*)(ws + WS_WRB); const float* nf = in[37] + (size_t)l * DM; const float* wg = in[38] + (size_t)l * DM * 4; const float* we = in[40] + (size_t)l * DM * 32;
        for (int i = gt; i < 256 * DM; i += ngt) { const int o = i / DM, k = i % DM; const float v = (o < 32) ? we[k * 32 + o] : ((o < 36) ? wg[k * 4 + (o - 32)] : 0.f); WRB[i] = f2bf(v * nf[k]); }
    }
    if (l == 0) {
        float* LUT = (float*)(ws + WS_LUT); const float* rb = in[3];
        for (int i = gt; i < 4 * 128; i += ngt) { const int h = i >> 7, n = i & 127; int bk;
            if (n < 16) bk = n; else { bk = 16 + (int)(log2f((float)n * 0.0625f) * (16.f / 3.f)); if (bk > 31) bk = 31; }
            LUT[i] = rb[bk * 4 + h] * LOG2E; }
        f32x2* RT = (f32x2*)(ws + WS_ROPE); const int* pos = (const int*)in[2];
        for (int i = gt; i < NT * 32; i += ngt) { const int t = i >> 5, j = i & 31; const float invf = powf(10000.f, -(float)j / 32.f); const float ang = (float)pos[t] * invf; float s, c; sincosf(ang, &s, &c); RT[i] = (f32x2){c, s}; }
    }
    for (int m = C.gw; m < NMEM; m += C.ngw) norm_row(in[1] + (size_t)m * DM, nullptr, nullptr, nullptr, nullptr, 0.f, 0.f, in[33] + (size_t)l * DM, (bf16_t*)(ws + WS_MEMN) + (size_t)m * DM, nullptr, C.lane);
    {
        const bf16_t* C2 = (const bf16_t*)(ws + WS_C2); const float* gate = (const float*)(ws + WS_GATE); bf16_t* XB = (bf16_t*)(ws + WS_XB); float* SSQM = (float*)(ws + WS_SSQM);
        for (int m = C.gw; m < NT; m += C.ngw) {
            if (l == 0) norm_row(in[0] + (size_t)m * DM, nullptr, XB + (size_t)m * DM, nullptr, nullptr, 0.f, 0.f, nullptr, nullptr, nullptr, C.lane, SSQM + m);
            else norm_row(nullptr, XB + (size_t)m * DM, XB + (size_t)m * DM, C2 + (size_t)(2 * m) * DM, C2 + (size_t)(2 * m + 1) * DM, gate[2 * m], gate[2 * m + 1], nullptr, nullptr, nullptr, C.lane, SSQM + m);
        }
    }
}

DI void phase_ew1(const Ctx& C, int l) {
    inptr_t in = C.in; unsigned char* ws = C.ws;
    const bf16_t* PRW = (const bf16_t*)(ws + WS_PRW); const bf16_t* PATT = (const bf16_t*)(ws + WS_PATT);
    bf16_t* LA = (bf16_t*)(ws + WS_LORAA); bf16_t* QN = (bf16_t*)(ws + WS_QN); bf16_t* KVN = (bf16_t*)(ws + WS_KVN); bf16_t* KPE = (bf16_t*)(ws + WS_KPE);
    const float* mu = in[9] + (size_t)l * RW_COLS; const float* muv = in[10];
    const float* qnw = in[28] + (size_t)l * 384; const float* kvnw = in[30] + (size_t)l * 256;
    const f32x2* RT = (const f32x2*)(ws + WS_ROPE);
    const int lane = C.lane;
#pragma unroll 4
    for (int t = C.gw; t < NT; t += C.ngw) {
        const bool first = (t % SEQ) == 0;
        const bf16_t* p = PRW + (size_t)t * RW_COLS; const bf16_t* pa = PATT + (size_t)t * PATT_COLS;
#pragma unroll
        for (int j = 0; j < 4; ++j) { const int c = lane + 64 * j, col = 3072 + c;
            const float cur = bf2f(p[col]); const float prev = first ? 0.f : bf2f(p[col - RW_COLS]);
            const float xs = cur + mu[col] * (prev - cur);
            float v; if (c < 64) v = tanhf(xs); else if (c < 128) v = xs; else v = sigmoidf_(xs);
            LA[(size_t)t * 384 + c] = f2bf(v); }
        {
#pragma unroll
            for (int j = 0; j < 2; ++j) { const int c = lane + 64 * j; float v = 0.f;
                if (l == 1 && c < 32) { const float cur = bf2f(pa[2240 + c]); const float prev = first ? 0.f : bf2f(pa[2240 + c - PATT_COLS]); v = cur + muv[c] * (prev - cur); }
                LA[(size_t)t * 384 + 256 + c] = f2bf(v); } }
        float q[6], kv[4]; float sq = 0.f, skv = 0.f;
#pragma unroll
        for (int j = 0; j < 6; ++j) { q[j] = bf2f(pa[1536 + lane + 64 * j]); sq += q[j] * q[j]; }
#pragma unroll
        for (int j = 0; j < 4; ++j) { kv[j] = bf2f(pa[1920 + lane + 64 * j]); skv += kv[j] * kv[j]; }
        const float rq = rsqrtf(wave_sum(sq) * (1.f / 384.f) + 1e-6f), rkv = rsqrtf(wave_sum(skv) * (1.f / 256.f) + 1e-6f);
#pragma unroll
        for (int j = 0; j < 6; ++j) QN[(size_t)t * 384 + lane + 64 * j] = f2bf(q[j] * rq * qnw[lane + 64 * j]);
#pragma unroll
        for (int j = 0; j < 4; ++j) KVN[(size_t)t * 256 + lane + 64 * j] = f2bf(kv[j] * rkv * kvnw[lane + 64 * j]);
        { const float x = bf2f(pa[2176 + lane]); const float xo = __shfl_xor(x, 32); const f32x2 cs = RT[t * 32 + (lane & 31)];
          const float y = (lane < 32) ? (x * cs.x - xo * cs.y) : (x * cs.x + xo * cs.y);
          KPE[(size_t)t * 64 + lane] = f2bf(y); }
    }
}

DI void phase_ew2(const Ctx& C, int l) {
    inptr_t in = C.in; unsigned char* ws = C.ws;
    const bf16_t* PRW = (const bf16_t*)(ws + WS_PRW); const bf16_t* LO = (const bf16_t*)(ws + WS_LORAO);
    bf16_t* SR = (bf16_t*)(ws + WS_U); bf16_t* SW = SR + (size_t)NT * 1024; bf16_t* SK = SW + (size_t)NT * 1024; bf16_t* SV = SK + (size_t)NT * 1024;
    bf16_t* SA = SV + (size_t)NT * 1024; bf16_t* SB = SA + (size_t)NT * 1024; bf16_t* VF = (bf16_t*)(ws + WS_VFIRST);
    const float* mu = in[9] + (size_t)l * RW_COLS; const float* w0 = in[11] + (size_t)l * 1024; const float* a0 = in[13] + (size_t)l * 1024; const float* v0 = in[15];
    const float* kkw = in[18] + (size_t)l * 1024; const float* kaw = in[19] + (size_t)l * 1024;
    const int lane = C.lane;
#pragma unroll 1
    for (int j = 0; j < 2; ++j) {
        const int c0 = 8 * lane + 512 * j;
        float mu8[3][8], w0v[8], a0v[8], kkv[8], kav[8], v0v[8];
#pragma unroll
        for (int e = 0; e < 2; ++e) {
#pragma unroll
            for (int q = 0; q < 3; ++q) { const f32x4 m = *(const f32x4*)(mu + q * 1024 + c0 + 4 * e);
#pragma unroll
                for (int i = 0; i < 4; ++i) mu8[q][4 * e + i] = m[i]; }
            const f32x4 x0 = *(const f32x4*)(w0 + c0 + 4 * e), x1 = *(const f32x4*)(a0 + c0 + 4 * e), x2 = *(const f32x4*)(kkw + c0 + 4 * e), x3 = *(const f32x4*)(kaw + c0 + 4 * e);
            f32x4 x4 = (f32x4){0.f, 0.f, 0.f, 0.f}; if (l == 1) x4 = *(const f32x4*)(v0 + c0 + 4 * e);
#pragma unroll
            for (int i = 0; i < 4; ++i) { w0v[4 * e + i] = x0[i]; a0v[4 * e + i] = x1[i]; kkv[4 * e + i] = x2[i]; kav[4 * e + i] = x3[i]; v0v[4 * e + i] = x4[i]; } }
#pragma unroll 2
        for (int t = C.gw; t < NT; t += C.ngw) {
            const bool first = (t % SEQ) == 0;
            const bf16_t* p = PRW + (size_t)t * RW_COLS; const bf16_t* lo = LO + (size_t)t * 4096;
            float xs[3][8];
#pragma unroll
            for (int q = 0; q < 3; ++q) { const int col = q * 1024 + c0;
                const u32x4 cu = *(const u32x4*)(p + col); u32x4 pv = (u32x4){0u, 0u, 0u, 0u}; if (!first) pv = *(const u32x4*)(p + col - RW_COLS);
#pragma unroll
                for (int e = 0; e < 4; ++e) { const float c_lo = bflo(cu[e]), c_hi = bfhi(cu[e]), p_lo = bflo(pv[e]), p_hi = bfhi(pv[e]);
                    xs[q][2 * e] = c_lo + mu8[q][2 * e] * (p_lo - c_lo); xs[q][2 * e + 1] = c_hi + mu8[q][2 * e + 1] * (p_hi - c_hi); } }
            const u32x4 lw = *(const u32x4*)(lo + c0), la = *(const u32x4*)(lo + 1024 + c0);
            u32x4 lv = (u32x4){0u, 0u, 0u, 0u}, vfv = (u32x4){0u, 0u, 0u, 0u};
            if (l == 1) { lv = *(const u32x4*)(lo + 3072 + c0); vfv = *(const u32x4*)(VF + (size_t)t * 1024 + c0); }
            float omw[8], av[8], kk[8], k2[8], v2[8]; float ssq = 0.f;
#pragma unroll
            for (int e = 0; e < 8; ++e) {
                const float lwf = (e & 1) ? bfhi(lw[e >> 1]) : bflo(lw[e >> 1]), laf = (e & 1) ? bfhi(la[e >> 1]) : bflo(la[e >> 1]);
                const float wi = w0v[e] + lwf;
                omw[e] = 1.f - __expf(-0.6065306597f * sigmoidf_(wi));
                av[e] = sigmoidf_(a0v[e] + laf);
                kk[e] = xs[1][e] * kkv[e]; ssq += kk[e] * kk[e];
                k2[e] = xs[1][e] * (1.f + (av[e] - 1.f) * kav[e]);
                v2[e] = xs[2][e];
                if (l == 1) { const float lvf = (e & 1) ? bfhi(lv[e >> 1]) : bflo(lv[e >> 1]), vff = (e & 1) ? bfhi(vfv[e >> 1]) : bflo(vfv[e >> 1]);
                    v2[e] = xs[2][e] + (vff - xs[2][e]) * sigmoidf_(v0v[e] + lvf); }
            }
            ssq += DPP_F(ssq, 0xB1); ssq += DPP_F(ssq, 0x4E); ssq += DPP_F(ssq, 0x141);
            const float inv = 1.f / fmaxf(sqrtf(ssq), 1e-12f);
            u32x4 oR, oW, oK, oV, oA, oB, oF;
#pragma unroll
            for (int e = 0; e < 4; ++e) { const float ka = kk[2 * e] * inv, kb = kk[2 * e + 1] * inv;
                oR[e] = pk2(xs[0][2 * e], xs[0][2 * e + 1]); oW[e] = pk2(omw[2 * e], omw[2 * e + 1]); oK[e] = pk2(k2[2 * e], k2[2 * e + 1]); oV[e] = pk2(v2[2 * e], v2[2 * e + 1]);
                oA[e] = pk2(ka, kb); oB[e] = pk2(ka * av[2 * e], kb * av[2 * e + 1]); oF[e] = pk2(xs[2][2 * e], xs[2][2 * e + 1]); }
            const size_t o = (size_t)t * 1024 + c0;
            *(u32x4*)(SR + o) = oR; *(u32x4*)(SW + o) = oW; *(u32x4*)(SK + o) = oK; *(u32x4*)(SV + o) = oV; *(u32x4*)(SA + o) = oA; *(u32x4*)(SB + o) = oB;
            if (l == 0) *(u32x4*)(VF + o) = oF;
        }
    }
    bf16_t* QM = (bf16_t*)(ws + WS_QM); const f32x2* RT = (const f32x2*)(ws + WS_ROPE);
    const int gt = C.wg * 512 + C.tid, ngt = C.G * 512;
    for (int i = gt; i < NT * 4 * 32; i += ngt) { const int t = i >> 7, h = (i >> 5) & 3, j = i & 31;
        bf16_t* q = QM + (size_t)t * 768 + h * 192 + 128; const float x1 = bf2f(q[j]), x2 = bf2f(q[j + 32]); const f32x2 cs = RT[t * 32 + j];
        q[j] = f2bf(x1 * cs.x - x2 * cs.y); q[j + 32] = f2bf(x2 * cs.x + x1 * cs.y); }
}

DI float dot2z(h2_t a, h2_t b) { float d; asm("v_dot2_f32_f16 %0, %1, %2, 0" : "=v"(d) : "v"(a), "v"(b)); return d; }
DI float fma_s(float a, float b, float c) { float d; asm("v_fma_f32 %0, %1, %2, %3" : "=v"(d) : "v"(a), "v"(b), "v"(c)); return d; }
#define ROW_ALLREDUCE(x) do { \
    x += __builtin_bit_cast(float, __builtin_amdgcn_update_dpp(0, __builtin_bit_cast(int, x), 0x128, 0xf, 0xf, true)); \
    x += __builtin_bit_cast(float, __builtin_amdgcn_update_dpp(0, __builtin_bit_cast(int, x), 0x124, 0xf, 0xf, true)); \
    x += __builtin_bit_cast(float, __builtin_amdgcn_update_dpp(0, __builtin_bit_cast(int, x), 0x122, 0xf, 0xf, true)); \
    x += __builtin_bit_cast(float, __builtin_amdgcn_update_dpp(0, __builtin_bit_cast(int, x), 0x121, 0xf, 0xf, true)); } while (0)

DI void phase_scan(const Ctx& C, int l) {
    unsigned char* ws = C.ws; inptr_t in = C.in;
    const bf16_t* SR = (const bf16_t*)(ws + WS_U); float* Yf = (float*)(ws + WS_H);
    constexpr int CH = 32, VECB = CH * 128, BUFB = 5 * VECB + CH * 64, OB = 2 * BUFB;
    LAS unsigned char* lds = C.lds;
    const int tid = C.tid, lane = C.lane, wave = C.wave;
    for (int u = C.wg; u < 256; u += C.G) {
        const int bh = u >> 2, rg = u & 3, b = bh >> 4, h = bh & 15;
        const size_t tb = (size_t)b * SEQ; const int cb = h * 64;
        const int lt = tid - 256;
        u32x4 pre[3][6];
#define LD_CHUNK(set, c_) do { const size_t t_ = tb + (size_t)(c_) * CH + (lt >> 3); const int j_ = lt & 7; \
            _Pragma("unroll") for (int vq = 0; vq < 5; ++vq) { const int arr = (vq < 3) ? vq : vq + 1; \
                pre[set][vq] = *(const u32x4*)(SR + (size_t)arr * NT * 1024 + t_ * 1024 + cb + 8 * j_); } \
            if (lt < 64) { const size_t tv_ = tb + (size_t)(c_) * CH + (lt >> 1); \
                pre[set][5] = *(const u32x4*)(SR + (size_t)3 * NT * 1024 + tv_ * 1024 + cb + 16 * rg + 8 * (lt & 1)); } } while (0)
#define ST_CHUNK(set, buf_) do { const int step_ = lt >> 3, j_ = lt & 7; \
            _Pragma("unroll") for (int vq = 0; vq < 5; ++vq) { const u32x4 p = pre[set][vq]; f32x4 lo = {bflo(p.x), bfhi(p.x), bflo(p.y), bfhi(p.y)}, hi = {bflo(p.z), bfhi(p.z), bflo(p.w), bfhi(p.w)}; \
                if (vq == 1) { lo = 1.f - lo; hi = 1.f - hi; } \
                if (vq == 3) { lo = -lo; hi = -hi; } \
                const h4_t hl = __builtin_convertvector(lo, h4_t), hh = __builtin_convertvector(hi, h4_t); \
                LAS h4_t* d = (LAS h4_t*)(lds + (buf_) * BUFB + vq * VECB + step_ * 128 + j_ * 16); d[0] = hl; d[1] = hh; } \
            if (lt < 64) { const u32x4 p = pre[set][5]; const f32x4 lo = {bflo(p.x), bfhi(p.x), bflo(p.y), bfhi(p.y)}, hi = {bflo(p.z), bfhi(p.z), bflo(p.w), bfhi(p.w)}; \
                const h4_t hl = __builtin_convertvector(lo, h4_t), hh = __builtin_convertvector(hi, h4_t); \
                LAS h4_t* d = (LAS h4_t*)(lds + (buf_) * BUFB + 5 * VECB + (lt >> 1) * 64 + (lt & 1) * 32); \
                d[0] = (h4_t){hl[0], hl[0], hl[1], hl[1]}; d[1] = (h4_t){hl[2], hl[2], hl[3], hl[3]}; d[2] = (h4_t){hh[0], hh[0], hh[1], hh[1]}; d[3] = (h4_t){hh[2], hh[2], hh[3], hh[3]}; } } while (0)
        h2_t S01 = {(_Float16)0.f, (_Float16)0.f}, S23 = {(_Float16)0.f, (_Float16)0.f};
        const int ks = lane & 15, rowl = wave * 4 + (lane >> 4);
        constexpr int NCH = SEQ / CH;
        float tq[32]; int mo_it = (C.wg * 4 + (wave - 4)); bool mo_pending = false; TrDesc mo_d{};
        LAS float* mo_scr = (LAS float*)(lds + OB + 2 * CH * 64) + (wave - 4) * (64 * 33);
        if (wave >= 4) { LD_CHUNK(0, 0); LD_CHUNK(1, 1); LD_CHUNK(2, 2); ST_CHUNK(0, 0); LD_CHUNK(0, 3); }
        __syncthreads();
#define SCAN_ITER(c, setn) do { \
            const int buf = (c) & 1; \
            if (wave >= 4) { \
                if ((c) + 1 < NCH) { ST_CHUNK(setn, buf ^ 1); if ((c) + 4 < NCH) LD_CHUNK(setn, (c) + 4); } \
                if ((c) > 0 && lt < 128) { \
                    const int step = lt >> 2, q4 = lt & 3; const LAS float* ob_ = (const LAS float*)(lds + OB + (((c) - 1) & 1) * (CH * 64)) + (step >> 4) * 256 + (step & 15); \
                    const f32x4 o = {ob_[(4 * q4 + 0) * 16], ob_[(4 * q4 + 1) * 16], ob_[(4 * q4 + 2) * 16], ob_[(4 * q4 + 3) * 16]}; \
                    *(f32x4*)(Yf + (tb + (size_t)((c) - 1) * CH + step) * 1024 + cb + 16 * rg + 4 * q4) = o; } \
                if (((c) & 1) == 0) { if (mo_pending) { tr_store(mo_d, tq, mo_scr, lane); mo_pending = false; } \
                    if (mo_it < N_MOE_ITEMS) { mo_d = moe_tr_desc(l, mo_it, in, ws); tr_load(mo_d, tq, lane); mo_pending = true; mo_it += 1024; } } \
            } else { SCAN_BODY(buf); } \
            __syncthreads(); } while (0)
#define SC_LD(X, s_) do { const int so_ = ((s_) & (CH - 1)) * 128; X##r = *(const LAS h4_t*)(bp + 0 * VECB + so_); X##w = *(const LAS h4_t*)(bp + 1 * VECB + so_); X##k = *(const LAS h4_t*)(bp + 2 * VECB + so_); \
            X##a = *(const LAS h4_t*)(bp + 3 * VECB + so_); X##b = *(const LAS h4_t*)(bp + 4 * VECB + so_); X##v = vp[((s_) & (CH - 1)) * 16]; } while (0)
#define DPPF(x, ctl) __builtin_bit_cast(float, __builtin_amdgcn_update_dpp(0, __builtin_bit_cast(int, x), ctl, 0xf, 0xf, true))
#define H_LO(x) __builtin_shufflevector(x, x, 0, 1)
#define H_HI(x) __builtin_shufflevector(x, x, 2, 3)
#define SC_DOT(x) __builtin_amdgcn_fdot2(S01, H_LO(x), dot2z(S23, H_HI(x)), false)
#define SC_FIRST(X) do { float sa = SC_DOT(X##a); \
            const h2_t t01 = S01 * H_LO(X##w) + X##v * H_LO(X##k), t23 = S23 * H_HI(X##w) + X##v * H_HI(X##k); \
            ROW_ALLREDUCE(sa); \
            const _Float16 sh = (_Float16)sa; const h2_t sa2 = {sh, sh}; \
            S01 = sa2 * H_LO(X##b) + t01; S23 = sa2 * H_HI(X##b) + t23; } while (0)
#define SC_PAIR(X, Y, s_) do { float o = SC_DOT(X##r); float sa = SC_DOT(Y##a); \
            const h2_t t01 = S01 * H_LO(Y##w) + Y##v * H_LO(Y##k), t23 = S23 * H_HI(Y##w) + Y##v * H_HI(Y##k); \
            sa += DPPF(sa, 0x128); o += DPPF(o, 0x128); sa += DPPF(sa, 0x124); o += DPPF(o, 0x124); sa += DPPF(sa, 0x122); o += DPPF(o, 0x122); sa += DPPF(sa, 0x121); o += DPPF(o, 0x121); \
            const _Float16 sh = (_Float16)sa; const h2_t sa2 = {sh, sh}; \
            S01 = sa2 * H_LO(Y##b) + t01; S23 = sa2 * H_HI(Y##b) + t23; \
            osel = (ks == (((s_) - 1) & 15)) ? o : osel; if ((((s_) - 1) & 15) == 15) op16[(((s_) - 1) >> 4) * 256] = osel; } while (0)
#define SC_LAST(X, s_) do { float o = SC_DOT(X##r); ROW_ALLREDUCE(o); osel = (ks == ((s_) & 15)) ? o : osel; op16[((s_) >> 4) * 256] = osel; } while (0)
#define SCAN_BODY(buf_) do { \
            const LAS unsigned char* bp = lds + (buf_) * BUFB + ks * 8; \
            const LAS h2_t* vp = (const LAS h2_t*)(lds + (buf_) * BUFB + 5 * VECB) + rowl; \
            LAS float* op16 = (LAS float*)(lds + OB + (buf_) * (CH * 64)) + rowl * 16 + ks; float osel = 0.f;     \
            h4_t Ar, Aw, Ak, Aa, Ab, Br, Bw, Bk, Ba, Bb, Cr, Cw, Ck, Ca, Cb, Dr, Dw, Dk, Da, Db; h2_t Av, Bv, Cv, Dv; \
            SC_LD(A, 0); SC_LD(B, 1); SC_LD(C, 2); SC_LD(D, 3); \
            SC_FIRST(A); \
            _Pragma("unroll 2") for (int s = 0; s < CH - 4; s += 4) { \
                SC_PAIR(A, B, s + 1); SC_LD(A, s + 4); \
                SC_PAIR(B, C, s + 2); SC_LD(B, s + 5); \
                SC_PAIR(C, D, s + 3); SC_LD(C, s + 6); \
                SC_PAIR(D, A, s + 4); SC_LD(D, s + 7); } \
            SC_PAIR(A, B, CH - 3); SC_PAIR(B, C, CH - 2); SC_PAIR(C, D, CH - 1); SC_LAST(D, CH - 1); } while (0)
#pragma unroll 1
        for (int c = 0; c < NCH; c += 3) { SCAN_ITER(c, 1); if (c + 1 < NCH) SCAN_ITER(c + 1, 2); if (c + 2 < NCH) SCAN_ITER(c + 2, 0); }
#undef SC_LD
#undef SC_FIRST
#undef SC_PAIR
#undef SC_LAST
#undef DPPF
#undef H_LO
#undef H_HI
#undef SC_DOT
#undef SCAN_BODY
#undef SCAN_ITER
#undef LD_CHUNK
#undef ST_CHUNK
        if (wave >= 4) { if (mo_pending) tr_store(mo_d, tq, mo_scr, lane);
            for (; mo_it < N_MOE_ITEMS; mo_it += 1024) { const TrDesc d = moe_tr_desc(l, mo_it, in, ws); tr_load(d, tq, lane); tr_store(d, tq, mo_scr, lane); } }
        if (wave >= 4 && lt < 128) { const int c = NCH; const int step = lt >> 2, q4 = lt & 3; const LAS float* ob_ = (const LAS float*)(lds + OB + ((c - 1) & 1) * (CH * 64)) + (step >> 4) * 256 + (step & 15);
            const f32x4 o = {ob_[(4 * q4 + 0) * 16], ob_[(4 * q4 + 1) * 16], ob_[(4 * q4 + 2) * 16], ob_[(4 * q4 + 3) * 16]};
            *(f32x4*)(Yf + (tb + (size_t)(c - 1) * CH + step) * 1024 + cb + 16 * rg + 4 * q4) = o; }
        __syncthreads();
    }
}

DI void phase_post(const Ctx& C, int l) {
    inptr_t in = C.in; unsigned char* ws = C.ws;
    const float* Yf = (const float*)(ws + WS_H); const bf16_t* LO = (const bf16_t*)(ws + WS_LORAO);
    const bf16_t* SR = (const bf16_t*)(ws + WS_U); const bf16_t* SK = SR + (size_t)2 * NT * 1024; const bf16_t* SV = SR + (size_t)3 * NT * 1024;
    bf16_t* Y = (bf16_t*)(ws + WS_PRW);
    const float* rk = in[20] + (size_t)l * 1024; const float* lnw = in[21] + (size_t)l * 1024; const float* lnb = in[22] + (size_t)l * 1024;
    const int lane = C.lane;
    for (int t = C.gw; t < NT; t += C.ngw) {
#pragma unroll
        for (int j = 0; j < 2; ++j) {
            const int c0 = 8 * lane + 512 * j; const size_t o = (size_t)t * 1024 + c0;
            const f32x4 y0 = *(const f32x4*)(Yf + o), y1 = *(const f32x4*)(Yf + o + 4);
            const u32x4 rr = *(const u32x4*)(SR + o), kq = *(const u32x4*)(SK + o), vq = *(const u32x4*)(SV + o), gq = *(const u32x4*)(LO + (size_t)t * 4096 + 2048 + c0);
            float y[8], rk8[8], lw8[8], lb8[8];
#pragma unroll
            for (int e = 0; e < 2; ++e) { const f32x4 a = *(const f32x4*)(rk + c0 + 4 * e), b = *(const f32x4*)(lnw + c0 + 4 * e), c = *(const f32x4*)(lnb + c0 + 4 * e);
#pragma unroll
                for (int i = 0; i < 4; ++i) { rk8[4 * e + i] = a[i]; lw8[4 * e + i] = b[i]; lb8[4 * e + i] = c[i]; y[4 * e + i] = e ? y1[i] : y0[i]; } }
            float sm = 0.f, bs = 0.f; float r8[8], k8[8], v8[8], g8[8];
#pragma unroll
            for (int e = 0; e < 8; ++e) { r8[e] = (e & 1) ? bfhi(rr[e >> 1]) : bflo(rr[e >> 1]); k8[e] = (e & 1) ? bfhi(kq[e >> 1]) : bflo(kq[e >> 1]);
                v8[e] = (e & 1) ? bfhi(vq[e >> 1]) : bflo(vq[e >> 1]); g8[e] = (e & 1) ? bfhi(gq[e >> 1]) : bflo(gq[e >> 1]);
                sm += y[e]; bs += r8[e] * k8[e] * rk8[e]; }
            sm += DPP_F(sm, 0xB1); sm += DPP_F(sm, 0x4E); sm += DPP_F(sm, 0x141);
            bs += DPP_F(bs, 0xB1); bs += DPP_F(bs, 0x4E); bs += DPP_F(bs, 0x141);
            const float mean = sm * (1.f / 64.f); float vs = 0.f;
#pragma unroll
            for (int e = 0; e < 8; ++e) { y[e] -= mean; vs += y[e] * y[e]; }
            vs += DPP_F(vs, 0xB1); vs += DPP_F(vs, 0x4E); vs += DPP_F(vs, 0x141);
            const float rs = rsqrtf(vs * (1.f / 64.f) + 64e-5f);
            u32x4 ov;
#pragma unroll
            for (int e = 0; e < 4; ++e) { const float o0 = (y[2 * e] * rs * lw8[2 * e] + lb8[2 * e] + bs * v8[2 * e]) * g8[2 * e], o1 = (y[2 * e + 1] * rs * lw8[2 * e + 1] + lb8[2 * e + 1] + bs * v8[2 * e + 1]) * g8[2 * e + 1];
                ov[e] = pk2(o0, o1); }
            *(u32x4*)(Y + (size_t)t * 2048 + c0) = ov;
        }
    }
}

struct AttnP {
    const bf16_t* Q; int qpitch, qcol0;
    const bf16_t* K1; int k1pitch, k1col0;
    const bf16_t* K2; int k2pitch, k2col0;
    const bf16_t* V; int vpitch, vcol0;
    bf16_t* O; int opitch, ocol0;
    size_t qrow0, krow0;
    int q0;
    int nkeys;
    float c1;
    const int* pos; const float* lut;
    float lam, outscale; const float* subw;
};

template <int DQK, int DK1, int MODE, int KT, int PFD>
DI void attn_unit(LAS unsigned char* lds, const AttnP& P) {
    constexpr int DV = 128, KP = DQK * 2 + 16, VP = DV * 2 + 64;
    constexpr int NBLK = KT / 32;
    constexpr int KTILE = KT * KP, VTILE = KT * VP;
    constexpr int NVT = (MODE == 0) ? 1 : 2;
    constexpr int VSLOT = NVT * VTILE + 256;
    constexpr int OFF_V = 2 * KTILE, OFF_POS = NVT * VTILE, OFF_LUT = OFF_V + 2 * VSLOT, OFF_END = OFF_LUT + 512;
    constexpr int OFF_OST = 4 * 17408, OSTP = 272;
    static_assert(OFF_END <= LDS_MAIN && OFF_OST + 4 * 32 * OSTP <= LDS_MAIN, "attention LDS");
    constexpr int KCH = DQK / 8, K1CH = DK1 / 8;
    constexpr int NKC = 2 * KT * KCH, NVC = NVT * KT * 16, NKCH = NKC / 512, NVCH = NVC / 512, NCHK = NKCH + NVCH;
    static_assert(NKC % 512 == 0 && NVC % 512 == 0, "chunks");
    constexpr float NEG = -1e30f, THR = 8.f;
    constexpr int KSTEP = (MODE == 0) ? KT : 2 * KT;
    int tid = threadIdx.x; asm volatile("" : "+v"(tid));
    const int lane = tid & 63, wave = __builtin_amdgcn_readfirstlane(tid >> 6);
    const int qg = wave >> 1, st = wave & 1, r32 = lane & 31, h2 = lane >> 5;
    const int qw0 = P.q0 + 32 * qg;
    const int myq = qw0 + r32;
    bf16x8 qf[DQK / 16];
    {
        const bf16_t* qp = P.Q + (P.qrow0 + myq) * (size_t)P.qpitch + P.qcol0 + ((MODE == 0) ? st * 64 : 0) + 8 * h2;
#pragma unroll
        for (int ks = 0; ks < DQK / 16; ++ks) qf[ks] = *(const bf16x8*)(qp + 16 * ks);
    }
    int mypos = 0, posq0 = 0;
    if constexpr (MODE == 0) { mypos = P.pos[myq]; posq0 = P.pos[qw0]; if (tid < 128) ((LAS float*)(lds + OFF_LUT))[tid] = P.lut[tid]; }
    f32x16 o[4];
#pragma unroll
    for (int d = 0; d < 4; ++d)
#pragma unroll
        for (int i = 0; i < 16; ++i) o[d][i] = 0.f;
    float m_run = NEG, l_run = 0.f;
    const int nsteps = P.nkeys / KSTEP;
    const char* gp[NCHK]; unsigned adv[NCHK]; unsigned ldst[NCHK];
#pragma unroll
    for (int i = 0; i < NKCH; ++i) { const int c = tid + 512 * i; const int s = c / (KT * KCH), rc = c % (KT * KCH), row = rc / KCH, ch = rc % KCH;
        const int key = (MODE == 0) ? row : s * KT + row;
        if (ch < K1CH) { gp[i] = (const char*)(P.K1 + (P.krow0 + key) * (size_t)P.k1pitch + P.k1col0 + ((MODE == 0) ? s * 64 : 0) + ch * 8); adv[i] = (unsigned)(KSTEP * P.k1pitch * 2); }
        else { gp[i] = (const char*)(P.K2 + (P.krow0 + key) * (size_t)P.k2pitch + P.k2col0 + (ch - K1CH) * 8); adv[i] = (unsigned)(KSTEP * P.k2pitch * 2); }
        ldst[i] = (unsigned)(s * KTILE + row * KP + ch * 16); }
#pragma unroll
    for (int i = 0; i < NVCH; ++i) { const int c2 = tid + 512 * i; const int s = c2 / (KT * 16), rc = c2 % (KT * 16), row = rc / 16, ch = rc % 16;
        const int key = (MODE == 0) ? row : s * KT + row;
        gp[NKCH + i] = (const char*)(P.V + (P.krow0 + key) * (size_t)P.vpitch + P.vcol0 + ch * 8); adv[NKCH + i] = (unsigned)(KSTEP * P.vpitch * 2);
        ldst[NKCH + i] = (unsigned)(s * VTILE + row * VP + ch * 16); }
    u32x4 preK[PFD][NKCH], preV[PFD][NVCH]; int prepos[2] = {0, 0};
#define KSET(par) ((PFD == 2) ? ((par) ^ 1) : 0)
#define VSET(par) ((PFD == 2) ? (par) : 0)
#define ATT_PREFETCH_K(set_) do { _Pragma("unroll") for (int i = 0; i < NKCH; ++i) { preK[set_][i] = *(const u32x4*)gp[i]; gp[i] += adv[i]; } } while (0)
#define ATT_PREFETCH_V(set_, step_) do { _Pragma("unroll") for (int i = 0; i < NVCH; ++i) { preV[set_][i] = *(const u32x4*)gp[NKCH + i]; gp[NKCH + i] += adv[NKCH + i]; } \
        if constexpr (MODE == 0) { if (tid < KT) prepos[set_] = P.pos[(step_) * KT + tid]; } } while (0)
#define ATT_STAGE_K(set_) do { _Pragma("unroll") for (int i = 0; i < NKCH; ++i) *(LAS u32x4*)(lds + ldst[i]) = preK[set_][i]; } while (0)
#define ATT_STAGE_V(set_, vo_) do { _Pragma("unroll") for (int i = 0; i < NVCH; ++i) *(LAS u32x4*)(lds + (vo_) + ldst[NKCH + i]) = preV[set_][i]; \
        if constexpr (MODE == 0) { if (tid < KT) ((LAS int*)(lds + (vo_) + OFF_POS))[tid] = prepos[set_]; } } while (0)
#define ATT_QK(dst) do { const LAS unsigned char* kb_ = lds + st * KTILE + r32 * KP + 16 * h2; \
        _Pragma("unroll") for (int blk = 0; blk < NBLK; ++blk) { \
            _Pragma("unroll") for (int i = 0; i < 16; ++i) dst[blk][i] = 0.f; \
            _Pragma("unroll") for (int ks = 0; ks < DQK / 16; ++ks) { const bf16x8 kf = *(const LAS bf16x8*)(kb_ + blk * 32 * KP + ks * 32); dst[blk] = __builtin_amdgcn_mfma_f32_32x32x16_bf16(kf, qf[ks], dst[blk], 0, 0, 0); } } } while (0)
#define ATT_VLD(j_) do { const int d_ = (j_) / (2 * NBLK), r_ = (j_) % (2 * NBLK); const LAS unsigned char* vp_ = vb_ + (16 * r_) * VP + d_ * 64; \
            vlo_[(j_) & 1] = __builtin_bit_cast(s16x4, __builtin_amdgcn_ds_read_tr16_b64_v4i16((LAS v4i16_t*)vp_)); \
            vhi_[(j_) & 1] = __builtin_bit_cast(s16x4, __builtin_amdgcn_ds_read_tr16_b64_v4i16((LAS v4i16_t*)(vp_ + 8 * VP))); } while (0)
#define ATT_PV(vo_) do { const int sv_ = (MODE == 0) ? 0 : st; \
        const LAS unsigned char* vb_ = lds + (vo_) + sv_ * VTILE + (4 * h2 + ((lane & 15) >> 2)) * VP + ((lane >> 4) & 1) * 32 + (lane & 3) * 8; \
        s16x4 vlo_[2], vhi_[2]; ATT_VLD(0); \
        _Pragma("unroll") for (int j = 0; j < 8 * NBLK; ++j) { if (j + 1 < 8 * NBLK) ATT_VLD(j + 1); \
            const s16x4 lo_ = vlo_[j & 1], hi_ = vhi_[j & 1]; const bf16x8 vf_ = {lo_[0], lo_[1], lo_[2], lo_[3], hi_[0], hi_[1], hi_[2], hi_[3]}; \
            const int d_ = j / (2 * NBLK), r_ = j % (2 * NBLK); \
            o[d_] = __builtin_amdgcn_mfma_f32_32x32x16_bf16(vf_, pf[r_ >> 1][r_ & 1], o[d_], 0, 0, 0); } } while (0)
    f32x16 sc[NBLK]; bf16x8 pf[NBLK][2]; bool pv_pending = false;
    auto att_body = [&](int step, int vo_cur, int vo_prev) {
        const int k0 = step * KSTEP + ((MODE == 0) ? 0 : st * KT);
        const bool valid_next = (step + 1 < nsteps) && (MODE == 2 || k0 + KSTEP <= qw0 + 31);
        const bool valid = (MODE == 2) || (k0 <= qw0 + 31);
        if (pv_pending) ATT_PV(vo_prev);
        pv_pending = valid;
        if (valid) {
        const bool need_mask = (MODE != 2) && (k0 + KT - 1 > qw0);
        float bb = 0.f; bool near = false;
        if constexpr (MODE == 0) {
            const LAS float* lut = (const LAS float*)(lds + OFF_LUT);
            const LAS int* pk = (const LAS int*)(lds + vo_cur + OFF_POS);
            near = (posq0 - pk[KT - 1]) < 127;
            if (near) {
#pragma unroll
                for (int blk = 0; blk < NBLK; ++blk)
#pragma unroll
                    for (int i = 0; i < 16; ++i) { const int kl = 32 * blk + (i & 3) + 8 * (i >> 2) + 4 * h2; int rel = mypos - pk[kl]; rel = rel < 0 ? 0 : (rel > 127 ? 127 : rel);
                        sc[blk][i] = sc[blk][i] * P.c1 + lut[rel]; }
            } else bb = lut[127];
        }
        if (need_mask) {
#pragma unroll
            for (int blk = 0; blk < NBLK; ++blk)
#pragma unroll
                for (int i = 0; i < 16; ++i) { const int key = k0 + 32 * blk + (i & 3) + 8 * (i >> 2) + 4 * h2; if (key > myq) sc[blk][i] = NEG; }
        }
        const float cc = near ? 1.f : P.c1;
        float mx = sc[0][0];
#pragma unroll
        for (int blk = 0; blk < NBLK; ++blk)
#pragma unroll
            for (int i = 0; i < 16; ++i) mx = fmaxf(mx, sc[blk][i]);
        { const int mi = __builtin_bit_cast(int, mx); auto rr = __builtin_amdgcn_permlane32_swap(mi, mi, false, false); mx = fmaxf(__builtin_bit_cast(float, (int)rr[0]), __builtin_bit_cast(float, (int)rr[1])); }
        mx = mx * cc + bb;
        if (__any(mx > m_run + THR)) {
            const float m_new = fmaxf(m_run, mx);
            const float alpha = __builtin_amdgcn_exp2f(m_run - m_new);
            m_run = m_new; l_run *= alpha;
#pragma unroll
            for (int d = 0; d < 4; ++d)
#pragma unroll
                for (int i = 0; i < 16; ++i) o[d][i] *= alpha;
        }
        const float off = bb - m_run;
        float psum = 0.f;
#pragma unroll
        for (int blk = 0; blk < NBLK; ++blk)
#pragma unroll
            for (int i = 0; i < 16; ++i) { const float p = __builtin_amdgcn_exp2f(__builtin_fmaf(sc[blk][i], cc, off)); sc[blk][i] = p; psum += p; }
        l_run += psum;
#pragma unroll
        for (int blk = 0; blk < NBLK; ++blk)
#pragma unroll
            for (int s16 = 0; s16 < 2; ++s16) { u32x4 w; w.x = pk2(sc[blk][8 * s16 + 0], sc[blk][8 * s16 + 1]); w.y = pk2(sc[blk][8 * s16 + 2], sc[blk][8 * s16 + 3]);
                w.z = pk2(sc[blk][8 * s16 + 4], sc[blk][8 * s16 + 5]); w.w = pk2(sc[blk][8 * s16 + 6], sc[blk][8 * s16 + 7]); pf[blk][s16] = __builtin_bit_cast(bf16x8, w); }
        }
        if (valid_next) ATT_QK(sc);
        };
#define ATT_BODY(step, vc, vp) att_body(step, vc, vp)
    ATT_PREFETCH_K(0);
    __syncthreads();
    ATT_STAGE_K(0);
    if (nsteps > 1) ATT_PREFETCH_K(KSET(0));
    if (PFD == 2 && nsteps > 2) ATT_PREFETCH_K(0);
    ATT_PREFETCH_V(0, 0);
    if (PFD == 2 && nsteps > 1) ATT_PREFETCH_V(1, 1);
    __syncthreads();
    ATT_QK(sc);
#define ATT_BAR() asm volatile("s_waitcnt lgkmcnt(0)\n\ts_barrier" ::: "memory")
#define ATT_ITER(step, par) do { \
        const int vo_cur = OFF_V + (par) * VSLOT, vo_prev = OFF_V + ((par) ^ 1) * VSLOT; \
        ATT_BAR();                                                  \
        if ((step) + 1 < nsteps) ATT_STAGE_K(KSET(par)); \
        ATT_STAGE_V(VSET(par), vo_cur); \
        ATT_BAR();                                                  \
        if ((step) + 1 + PFD < nsteps) ATT_PREFETCH_K(KSET(par)); \
        if ((step) + PFD < nsteps) ATT_PREFETCH_V(VSET(par), (step) + PFD); \
        ATT_BODY(step, vo_cur, vo_prev); } while (0)
    for (int step = 0; step < nsteps; step += 2) { ATT_ITER(step, 0); if (step + 1 < nsteps) ATT_ITER(step + 1, 1); }
    if (pv_pending) ATT_PV(OFF_V + ((nsteps - 1) & 1) * VSLOT);
#undef ATT_PREFETCH_K
#undef ATT_PREFETCH_V
#undef ATT_STAGE_K
#undef ATT_STAGE_V
#undef ATT_QK
#undef ATT_PV
#undef ATT_VLD
#undef ATT_ITER
#undef ATT_BAR
#undef ATT_BODY
#undef KSET
#undef VSET
    l_run += __shfl_xor(l_run, 32);
    __syncthreads();
    LAS float* mb = (LAS float*)(lds + qg * 17408);
    if (st == 1) {
        if constexpr (MODE == 0) { const float inv = 1.f / l_run;
#pragma unroll
            for (int d = 0; d < 4; ++d)
#pragma unroll
                for (int i = 0; i < 16; ++i) mb[(d * 16 + i) * 64 + lane] = o[d][i] * inv;
        } else {
#pragma unroll
            for (int d = 0; d < 4; ++d)
#pragma unroll
                for (int i = 0; i < 16; ++i) mb[(d * 16 + i) * 64 + lane] = o[d][i];
            mb[4096 + lane] = m_run; mb[4160 + lane] = l_run;
        }
    }
    __syncthreads();
    if (st == 0) {
        if constexpr (MODE == 0) {
            const float inv = 1.f / l_run; float ss = 0.f;
#pragma unroll
            for (int d = 0; d < 4; ++d)
#pragma unroll
                for (int i = 0; i < 16; ++i) { const float v = o[d][i] * inv - P.lam * mb[(d * 16 + i) * 64 + lane]; o[d][i] = v; ss += v * v; }
            ss += __shfl_xor(ss, 32);
            const float rn = rsqrtf(ss * (1.f / 128.f) + 1e-5f) * P.outscale;
#pragma unroll
            for (int d = 0; d < 4; ++d)
#pragma unroll
                for (int i = 0; i < 16; ++i) { const int dv = 32 * d + (i & 3) + 8 * (i >> 2) + 4 * h2; o[d][i] = o[d][i] * rn * P.subw[dv]; }
        } else {
            const float m1 = mb[4096 + lane], l1 = mb[4160 + lane];
            const float mt = fmaxf(m_run, m1); const float a0 = __builtin_amdgcn_exp2f(m_run - mt), a1 = __builtin_amdgcn_exp2f(m1 - mt);
            const float inv = 1.f / (l_run * a0 + l1 * a1);
#pragma unroll
            for (int d = 0; d < 4; ++d)
#pragma unroll
                for (int i = 0; i < 16; ++i) o[d][i] = (o[d][i] * a0 + mb[(d * 16 + i) * 64 + lane] * a1) * inv;
        }
        LAS unsigned char* og = lds + OFF_OST + qg * (32 * OSTP);
#pragma unroll
        for (int d = 0; d < 4; ++d)
#pragma unroll
            for (int g4 = 0; g4 < 4; ++g4) { u32x2 w; w.x = pk2(o[d][4 * g4 + 0], o[d][4 * g4 + 1]); w.y = pk2(o[d][4 * g4 + 2], o[d][4 * g4 + 3]);
                *(LAS u32x2*)(og + r32 * OSTP + (32 * d + 8 * g4 + 4 * h2) * 2) = w; }
        asm volatile("s_waitcnt lgkmcnt(0)" ::: "memory");
        bf16_t* op = P.O + (P.qrow0 + qw0) * (size_t)P.opitch + P.ocol0;
#pragma unroll
        for (int i = 0; i < 8; ++i) { const int row = 4 * i + (lane >> 4), ch = lane & 15;
            const u32x4 v = *(const LAS u32x4*)(og + row * OSTP + ch * 16);
            *(u32x4*)(op + (size_t)row * P.opitch + ch * 8) = v; }
    }
    __syncthreads();
}

DI void phase_att(const Ctx& C, int l) {
    inptr_t in = C.in; unsigned char* ws = C.ws;
    const int ATT_SEL = C.att_sel;
    if (ATT_SEL & 1) phase_post(C, l);
    bf16_t* Y = (bf16_t*)(ws + WS_PRW); const bf16_t* PATT = (const bf16_t*)(ws + WS_PATT);
    const float lambda_init = 0.8f - 0.6f * expf(-0.3f * (float)l);
    float lam;
    { const float a = wave_sum(in[23][l * 64 + C.lane] * in[24][l * 64 + C.lane]), b = wave_sum(in[25][l * 64 + C.lane] * in[26][l * 64 + C.lane]); lam = expf(a) - expf(b) + lambda_init; }
    if (ATT_SEL & 2) for (int w = C.wg; w < 256; w += C.G) {
        const int bh = w >> 4, j = w & 15, b = bh >> 2, h = bh & 3;
#pragma unroll 1
        for (int k = 0; k < 2; ++k) { const int qb = k ? 31 - j : j;
            AttnP P; P.Q = PATT; P.qpitch = PATT_COLS; P.qcol0 = h * 128; P.K1 = PATT; P.k1pitch = PATT_COLS; P.k1col0 = 512 + h * 128; P.K2 = PATT; P.k2pitch = 0; P.k2col0 = 0;
            P.V = PATT; P.vpitch = PATT_COLS; P.vcol0 = 1024 + h * 128; P.O = Y; P.opitch = 2048; P.ocol0 = 1024 + h * 128;
            P.qrow0 = (size_t)b * SEQ; P.krow0 = (size_t)b * SEQ; P.q0 = qb * 128; P.nkeys = qb * 128 + 128; P.c1 = 0.125f * LOG2E;
            P.pos = (const int*)in[2] + b * SEQ; P.lut = (const float*)(ws + WS_LUT) + h * 128; P.lam = lam; P.outscale = 1.f - lambda_init; P.subw = in[27] + l * 128;
            attn_unit<64, 64, 0, 64, 1>(C.lds, P); }
    }
    const bf16_t* QM = (const bf16_t*)(ws + WS_QM); const bf16_t* KVM = (const bf16_t*)(ws + WS_KVM); const bf16_t* KPE = (const bf16_t*)(ws + WS_KPE);
    if (ATT_SEL & 4) for (int w = C.wg; w < 256; w += C.G) {
        const int bh = w >> 4, j = w & 15, b = bh >> 2, h = bh & 3;
#pragma unroll 1
        for (int k = 0; k < 2; ++k) { const int qb = k ? 31 - j : j;
            AttnP P; P.Q = QM; P.qpitch = 768; P.qcol0 = h * 192; P.K1 = KVM; P.k1pitch = 1024; P.k1col0 = h * 256; P.K2 = KPE; P.k2pitch = 64; P.k2col0 = 0;
            P.V = KVM; P.vpitch = 1024; P.vcol0 = h * 256 + 128; P.O = Y; P.opitch = 2048; P.ocol0 = 1536 + h * 128;
            P.qrow0 = (size_t)b * SEQ; P.krow0 = (size_t)b * SEQ; P.q0 = qb * 128; P.nkeys = qb * 128 + 128; P.c1 = 0.07216878364870322f * LOG2E;
            P.pos = nullptr; P.lut = nullptr; P.lam = 0.f; P.outscale = 0.f; P.subw = nullptr;
            attn_unit<192, 128, 1, 32, 1>(C.lds, P); }
    }
}

DI void phase_cross(const Ctx& C) {
    unsigned char* ws = C.ws;
    const bf16_t* CAQ = (const bf16_t*)(ws + WS_CAQ); const bf16_t* MKV = (const bf16_t*)(ws + WS_MEMKV); bf16_t* CAO = (bf16_t*)(ws + WS_CAO);
    for (int u = C.wg; u < 512; u += C.G) {
        const int bh = u >> 5, qb = u & 31, b = bh >> 2, h = bh & 3;
        AttnP P; P.Q = CAQ; P.qpitch = 512; P.qcol0 = h * 128; P.K1 = MKV; P.k1pitch = 1024; P.k1col0 = h * 128; P.K2 = MKV; P.k2pitch = 0; P.k2col0 = 0;
        P.V = MKV; P.vpitch = 1024; P.vcol0 = 512 + h * 128; P.O = CAO; P.opitch = 512; P.ocol0 = h * 128;
        P.qrow0 = (size_t)b * SEQ; P.krow0 = (size_t)b * MEMLEN; P.q0 = qb * 128; P.nkeys = MEMLEN; P.c1 = 0.08838834764831845f * LOG2E;
        P.pos = nullptr; P.lut = nullptr; P.lam = 0.f; P.outscale = 0.f; P.subw = nullptr;
        attn_unit<128, 128, 2, 64, 1>(C.lds, P);
    }
}

DI void phase_route(const Ctx& C, int l) {
    inptr_t in = C.in; unsigned char* ws = C.ws;
    const float* LG = (const float*)(ws + WS_LOGITS);
    const float* bg = in[39] + l * 4; const float* be = in[41] + l * 32;
    int* EID = (int*)(ws + WS_EID); float* GATE = (float*)(ws + WS_GATE); int* CNT = (int*)(ws + WS_CNT);
    LAS int* hist = (LAS int*)(C.lds);
    const int lane = C.lane;
    for (int wgt = C.wg; wgt < 256; wgt += C.G) {
        if (C.tid < 32) hist[C.tid] = 0;
        __syncthreads();
#pragma unroll 1
        for (int r = 0; r < 8; ++r) {
            const int t = wgt * 64 + C.wave * 8 + r;
            const float raw = (lane < 36) ? LG[(size_t)t * 256 + lane] : 0.f;
            const float g0 = RDL_F(raw, 32), g1 = RDL_F(raw, 33), g2 = RDL_F(raw, 34), g3 = RDL_F(raw, 35);
            int sel = 0; float best = g0 + bg[0];
            if (g1 + bg[1] > best) { best = g1 + bg[1]; sel = 1; }
            if (g2 + bg[2] > best) { best = g2 + bg[2]; sel = 2; }
            if (g3 + bg[3] > best) { best = g3 + bg[3]; sel = 3; }
            const float gm = fmaxf(fmaxf(g0, g1), fmaxf(g2, g3));
            const float e0 = __expf(g0 - gm), e1 = __expf(g1 - gm), e2 = __expf(g2 - gm), e3 = __expf(g3 - gm);
            const float es = sel == 0 ? e0 : (sel == 1 ? e1 : (sel == 2 ? e2 : e3));
            const float pgrp = es / ((e0 + e1) + (e2 + e3));
            float val = (lane < 32 && (lane >> 3) == sel) ? raw + be[lane & 31] : -INFINITY;
            const float m1 = wave_max(val); const int i1 = __ffsll((long long)__ballot(val == m1)) - 1;
            if (lane == i1) val = -INFINITY;
            const float m2 = wave_max(val); const int i2 = __ffsll((long long)__ballot(val == m2)) - 1;
            const float r1 = __shfl(raw, i1), r2 = __shfl(raw, i2);
            const float w1 = 1.f / (1.f + __expf(r2 - r1)), w2 = 1.f - w1;
            if (lane == 0) { EID[2 * t] = i1; EID[2 * t + 1] = i2; GATE[2 * t] = w1 * pgrp; GATE[2 * t + 1] = w2 * pgrp;
                atomicAdd((int*)&hist[i1], 1); atomicAdd((int*)&hist[i2], 1); }
        }
        __syncthreads();
        if (C.tid < 32) CNT[wgt * 32 + C.tid] = hist[C.tid];
        __syncthreads();
    }
}

DI void phase_dispatch(const Ctx& C) {
    unsigned char* ws = C.ws;
    const int* EID = (const int*)(ws + WS_EID); const int* CNT = (const int*)(ws + WS_CNT);
    int* ROWMAP = (int*)(ws + WS_ROWMAP); int* ROWDST = (int*)(ws + WS_ROWDST); int* TILEEXP = (int*)(ws + WS_TILEEXP);
    LAS int* tot = (LAS int*)(C.lds); LAS int* base = tot + 32; LAS int* off = base + 32; LAS int* eid = off + 40; LAS int* posl = eid + 128;
    const int tid = C.tid;
    for (int wgt = C.wg; wgt < 256; wgt += C.G) {
        { LAS int* cl = posl + 128;
#pragma unroll
          for (int i = 0; i < 16; ++i) cl[tid + 512 * i] = CNT[tid + 512 * i];
          __syncthreads();
          if (tid < 32) { int s = 0, bsum = 0; for (int w = 0; w < 256; ++w) { const int c = cl[w * 32 + tid]; if (w == wgt) bsum = s; s += c; } tot[tid] = s; base[tid] = bsum; } }
        if (tid >= 64 && tid < 192) eid[tid - 64] = EID[wgt * 128 + (tid - 64)];
        __syncthreads();
        if (tid == 0) { int o = 0; for (int e = 0; e < 32; ++e) { off[e] = o; o += (tot[e] + 255) & ~255; } off[32] = o; }
        __syncthreads();
        if (tid < 128) { const int e = eid[tid]; int rank = 0; for (int j = 0; j < tid; ++j) rank += (eid[j] == e) ? 1 : 0;
            const int pos = off[e] + base[e] + rank; ROWMAP[pos] = wgt * 64 + (tid >> 1); ROWDST[pos] = wgt * 128 + tid; }
        if (wgt < 32) { const int e = wgt; for (int p = off[e] + tot[e] + tid; p < off[e + 1]; p += 512) { ROWMAP[p] = 0; ROWDST[p] = -1; } }
        if (wgt == 0) { if (tid < 32) { for (int tl = off[tid] >> 8; tl < (off[tid + 1] >> 8); ++tl) TILEEXP[tl] = tid; } if (tid == 0) TILEEXP[200] = off[32] >> 8; }
        __syncthreads();
    }
}

#ifndef PHASE_MASK
#define PHASE_MASK 0x1ffff
#endif
#define IN(k) (lo <= (k) && (k) < hi)
#define EN(j) ((PHASE_MASK >> (j)) & 1)
#define SEAM(k) do { if (IN(k) && IN((k) + 1)) xcd_barrier(bar); } while (0)
#define PH_BEGIN() do { int t_ = threadIdx.x; asm volatile("" : "+v"(t_)); kaptr_t ka_ = (kaptr_t)__builtin_amdgcn_kernarg_segment_ptr(); asm volatile("" : "+s"(ka_)); \
        C.lds = (LAS unsigned char*)lds_raw; C.in = (inptr_t)ka_; C.X = *(float* const CAS*)(ka_ + 360); C.ws = *(unsigned char* const CAS*)(ka_ + 368); \
        C.tid = t_; C.lane = t_ & 63; C.wave = __builtin_amdgcn_readfirstlane(t_ >> 6); { int g_ = gridDim.x, b_ = blockIdx.x; asm volatile("" : "+s"(g_), "+s"(b_)); C.G = g_; C.wg = b_; } C.gw = C.wg * 8 + C.wave; C.ngw = C.G * 8; \
        ws = C.ws; in = C.in; } while (0)
constexpr int PPL = 16, NPHASE = 2 * PPL + 1;
template <int l>
DI void run_layer(unsigned char* lds_raw, const XcdBarrier& bar, int lo, int hi, int att_sel = 7) {
    Ctx C; unsigned char* ws; inptr_t in; C.att_sel = att_sel;
    constexpr int pb = l * PPL;

        if (EN(0) && IN(pb + 0)) { PH_BEGIN(); phase_convert(C, l); } SEAM(pb + 0);
        if (EN(1) && IN(pb + 1)) { PH_BEGIN();
            { pg8::Gemm g{(const bf16_t*)(ws + WS_XB), (const bf16_t*)(ws + WS_WINT), DM, DM, DM, nullptr}; pg8::StaticOrder S; S.init(NT, INP, C.G, C.wg, DM);
              pg8::EpiBf16 E{(bf16_t*)(ws + WS_PRW), RW_COLS, (bf16_t*)(ws + WS_PATT), PATT_COLS, 13, (const float*)(ws + WS_SSQM), 1};
              pg8::gemm_phase<pg8::EpiBf16, pg8::StaticOrder>(C.lds, g, S, E); }
            { pg8::Gemm g{(const bf16_t*)(ws + WS_MEMN), (const bf16_t*)(ws + WS_CAWKVT), DM, DM, DM, nullptr}; pg8::StaticOrder S; S.init(NMEM, 1024, C.G, (C.wg + C.G / 2) % C.G, DM);
              pg8::EpiBf16 E{(bf16_t*)(ws + WS_MEMKV), 1024, nullptr, 0, 1 << 30, nullptr, 1};
              pg8::gemm_phase<pg8::EpiBf16, pg8::StaticOrder>(C.lds, g, S, E); }
        } SEAM(pb + 1);
        if (EN(2) && IN(pb + 2)) { PH_BEGIN(); phase_ew1(C, l); } SEAM(pb + 2);
        if (EN(3) && IN(pb + 3)) { PH_BEGIN();
            { pg8::Gemm g{(const bf16_t*)(ws + WS_LORAA), (const bf16_t*)(ws + WS_LORABT), 384, 384, 384, nullptr}; pg8::StaticOrder S; S.init(NT, 4096, C.G, C.wg, 384);
              pg8::EpiBf16 E{(bf16_t*)(ws + WS_LORAO), 4096, nullptr, 0, 1 << 30, nullptr, 1};
              pg8::gemm_phase<pg8::EpiBf16, pg8::StaticOrder>(C.lds, g, S, E); }
            { pg8::Gemm g{(const bf16_t*)(ws + WS_QN), (const bf16_t*)(ws + WS_WQBT), 384, 384, 384, nullptr}; pg8::StaticOrder S; S.init(NT, 768, C.G, C.wg, 384);
              pg8::EpiBf16 E{(bf16_t*)(ws + WS_QM), 768, nullptr, 0, 1 << 30, nullptr, 1};
              pg8::gemm_phase<pg8::EpiBf16, pg8::StaticOrder>(C.lds, g, S, E); }
            { pg8::Gemm g{(const bf16_t*)(ws + WS_KVN), (const bf16_t*)(ws + WS_WKVBT), 256, 256, 256, nullptr}; pg8::StaticOrder S; S.init(NT, 1024, C.G, C.wg, 256);
              pg8::EpiBf16 E{(bf16_t*)(ws + WS_KVM), 1024, nullptr, 0, 1 << 30, nullptr, 1};
              pg8::gemm_phase<pg8::EpiBf16, pg8::StaticOrder>(C.lds, g, S, E); }
        } SEAM(pb + 3);
        if (EN(4) && IN(pb + 4)) { PH_BEGIN(); phase_ew2(C, l); } SEAM(pb + 4);
        if (EN(5) && IN(pb + 5)) { PH_BEGIN(); phase_scan(C, l); } SEAM(pb + 5);
        if (EN(6) && IN(pb + 6)) { PH_BEGIN(); phase_att(C, l); } SEAM(pb + 6);
        if (EN(7) && IN(pb + 7)) { PH_BEGIN();
            pg8::Gemm g{(const bf16_t*)(ws + WS_PRW), (const bf16_t*)(ws + WS_WOUTT), DM, DM, DM, nullptr}; pg8::StaticOrder S; S.init(NT, DM, C.G, C.wg, DM);
            pg8::EpiResid E{l == 0 ? in[0] : nullptr, (const bf16_t*)(ws + WS_XB), (bf16_t*)(ws + WS_XB), DM, (float*)(ws + WS_PARTC)};
            pg8::gemm_phase<pg8::EpiResid, pg8::StaticOrder>(C.lds, g, S, E);
        } SEAM(pb + 7);
        if (EN(8) && IN(pb + 8)) { PH_BEGIN();
            pg8::Gemm g{(const bf16_t*)(ws + WS_XB), (const bf16_t*)(ws + WS_CAWQT), DM, DM, DM, nullptr}; pg8::StaticOrder S; S.init(NT, 512, C.G, C.wg, DM);
            pg8::EpiBf16 E{(bf16_t*)(ws + WS_CAQ), 512, nullptr, 0, 1 << 30, (const float*)(ws + WS_PARTC), 32};
            pg8::gemm_phase<pg8::EpiBf16, pg8::StaticOrder>(C.lds, g, S, E);
        } SEAM(pb + 8);
        if (EN(9) && IN(pb + 9)) { PH_BEGIN(); phase_cross(C); } SEAM(pb + 9);
        if (EN(10) && IN(pb + 10)) { PH_BEGIN();
            pg8::Gemm g{(const bf16_t*)(ws + WS_CAO), (const bf16_t*)(ws + WS_CAWOT), 512, 512, 512, nullptr}; pg8::StaticOrder S; S.init(NT, DM, C.G, C.wg, 512);
            pg8::EpiResid E{nullptr, (const bf16_t*)(ws + WS_XB), (bf16_t*)(ws + WS_XB), DM, (float*)(ws + WS_PARTF)};
            pg8::gemm_phase<pg8::EpiResid, pg8::StaticOrder>(C.lds, g, S, E);
        } SEAM(pb + 10);
        if (EN(11) && IN(pb + 11)) { PH_BEGIN();
            pg8::Gemm g{(const bf16_t*)(ws + WS_XB), (const bf16_t*)(ws + WS_WRB), DM, DM, DM, nullptr}; pg8::StaticOrder S; S.init(NT, 256, C.G, C.wg, DM);
            pg8::EpiF32 E{(float*)(ws + WS_LOGITS), 256, (const float*)(ws + WS_PARTF), 32, (float*)(ws + WS_SSQF)};
            pg8::gemm_phase<pg8::EpiF32, pg8::StaticOrder>(C.lds, g, S, E);
        } SEAM(pb + 11);
        if (EN(12) && IN(pb + 12)) { PH_BEGIN(); phase_route(C, l); } SEAM(pb + 12);
        if (EN(13) && IN(pb + 13)) { PH_BEGIN(); phase_dispatch(C); } SEAM(pb + 13);
        if (EN(14) && IN(pb + 14)) { PH_BEGIN();
            const int* TE = (const int*)(ws + WS_TILEEXP);
            pg8::Gemm g{(const bf16_t*)(ws + WS_XB), (const bf16_t*)(ws + WS_WGU), DM, DM, DM, (const int*)(ws + WS_ROWMAP)};
            pg8::MoeOrder S{TE, TE[200], 4, C.G, C.wg, DM, (long)1024 * DM};
            pg8::EpiSiluMul E{(bf16_t*)(ws + WS_HID), DEXP, (const float*)(ws + WS_SSQF), (const int*)(ws + WS_ROWMAP)};
            pg8::gemm_phase<pg8::EpiSiluMul, pg8::MoeOrder, true>(C.lds, g, S, E);
        } SEAM(pb + 14);
        if (EN(15) && IN(pb + 15)) { PH_BEGIN();
            const int* TE = (const int*)(ws + WS_TILEEXP);
            pg8::Gemm g{(const bf16_t*)(ws + WS_HID), (const bf16_t*)(ws + WS_WD), DEXP, DEXP, DEXP, nullptr};
            pg8::MoeOrder S{TE, TE[200], 8, C.G, C.wg, DEXP, (long)DM * DEXP};
            pg8::EpiScatter E{(bf16_t*)(ws + WS_C2), DM, (const int*)(ws + WS_ROWDST)};
            pg8::gemm_phase<pg8::EpiScatter, pg8::MoeOrder>(C.lds, g, S, E);
        } SEAM(pb + 15);
    }

__global__ void __launch_bounds__(512, 2) mk_fwd(Args args) {
    extern __shared__ __attribute__((aligned(16))) unsigned char lds_raw[];
    Ctx C;
    unsigned char* ws; inptr_t in;
    PH_BEGIN();
    volatile LAS unsigned* MISC = (volatile LAS unsigned*)(C.lds + LDS_MISC);
    if (C.tid < 64) MISC[C.tid] = 0u;
    __syncthreads();
    const int lo = args.ph_lo, hi = args.ph_hi;
    XcdBarrier bar; bar.bar = (unsigned*)(args.ws + WS_CTL) + CW_BAR; bar.x = 0; bar.st = MISC + 8;
    if (hi - lo > 1) bar = xcd_barrier_post((unsigned*)(args.ws + WS_CTL) + CW_BAR, MISC + 8);
#ifndef PROBE_MASK
#define PROBE_MASK 0
#endif
#if PROBE_MASK
#ifndef PROBE_ATT
#define PROBE_ATT 7
#endif
#define RUNP(k) do { run_layer<0>(lds_raw, bar, (k), (k) + 1); xcd_barrier(bar); if ((PROBE_MASK >> (k)) & 1) { run_layer<0>(lds_raw, bar, (k), (k) + 1, PROBE_ATT); xcd_barrier(bar); } } while (0)
    RUNP(0); RUNP(1); RUNP(2); RUNP(3); RUNP(4); RUNP(5); RUNP(6); RUNP(7); RUNP(8); RUNP(9); RUNP(10); RUNP(11); RUNP(12); RUNP(13); RUNP(14); RUNP(15);
    run_layer<1>(lds_raw, bar, PPL, 2 * PPL); xcd_barrier(bar);
#else
    run_layer<0>(lds_raw, bar, lo, hi);
    run_layer<1>(lds_raw, bar, lo, hi);
#endif
    if (EN(16) && IN(2 * PPL)) { PH_BEGIN();
        const bf16_t* C2 = (const bf16_t*)(ws + WS_C2); const float* gate = (const float*)(ws + WS_GATE);
        for (int m = C.gw; m < NT; m += C.ngw)
            norm_row(nullptr, (const bf16_t*)(ws + WS_XB) + (size_t)m * DM, nullptr, C2 + (size_t)(2 * m) * DM, C2 + (size_t)(2 * m + 1) * DM, gate[2 * m], gate[2 * m + 1], in[4], nullptr, C.X + (size_t)m * DM, C.lane);
    }
#undef IN
#undef SEAM
}

extern "C" void kernel_launch(void* const* d_in, const int* in_sizes, int n_in, void* d_out, int out_size, void* d_ws, size_t ws_size, hipStream_t stream) {
    static int grid = 0;
    if (grid == 0) {
        if (n_in != 45 || out_size != NT * DM || ws_size < WS_END) { grid = -1; return; }
        int dev = 0, cus = 0;
        if (hipGetDevice(&dev) != hipSuccess || hipDeviceGetAttribute(&cus, hipDeviceAttributeMultiprocessorCount, dev) != hipSuccess) { grid = -1; return; }
        if (hipFuncSetAttribute((const void*)mk_fwd, hipFuncAttributeMaxDynamicSharedMemorySize, LDS_BYTES) != hipSuccess) { grid = -1; return; }
        int per_cu = 0;
        (void)hipOccupancyMaxActiveBlocksPerMultiprocessor(&per_cu, (const void*)mk_fwd, 512, LDS_BYTES);
        (void)hipGetLastError();
        grid = cus;
    }
    if (grid < 0) return;
    (void)hipMemsetAsync((char*)d_ws + WS_CTL, 0, 1 * MiB, stream);
    Args a{};
    for (int i = 0; i < 45; ++i) a.in[i] = d_in[i];
    a.out = (float*)d_out; a.ws = (unsigned char*)d_ws;
#if MK_ONE_LAUNCH
    a.ph_lo = 0; a.ph_hi = NPHASE;
    hipLaunchKernelGGL(mk_fwd, dim3(grid), dim3(512), LDS_BYTES, stream, a);
#else
    for (int p = 0; p < NPHASE; ++p) { a.ph_lo = p; a.ph_hi = p + 1; hipLaunchKernelGGL(mk_fwd, dim3(grid), dim3(512), LDS_BYTES, stream, a); }
#endif
}
```

```cpp
#include <hip/hip_runtime.h>
#include <stdint.h>
#include <math.h>

#ifndef MK_ONE_LAUNCH
#define MK_ONE_LAUNCH 1
#endif

#define DI __device__ __forceinline__
#define LAS __attribute__((address_space(3)))
#define GAS __attribute__((address_space(1)))

typedef unsigned short bf16_t;
typedef short bf16x8 __attribute__((ext_vector_type(8)));
typedef short s16x4 __attribute__((ext_vector_type(4)));
typedef float f32x2 __attribute__((ext_vector_type(2)));
typedef float f32x4 __attribute__((ext_vector_type(4)));
typedef float f32x16 __attribute__((ext_vector_type(16)));
typedef unsigned u32x2 __attribute__((ext_vector_type(2)));
typedef unsigned u32x4 __attribute__((ext_vector_type(4)));
typedef __bf16 bf16x2_t __attribute__((ext_vector_type(2)));
typedef short v4i16_t __attribute__((ext_vector_type(4)));
typedef _Float16 h2_t __attribute__((ext_vector_type(2)));
typedef _Float16 h4_t __attribute__((ext_vector_type(4)));

constexpr int NB = 4, SEQ = 4096, DM = 2048, NT = NB * SEQ;
constexpr int MEMLEN = 256, NMEM = NB * MEMLEN;
constexpr int RW_DIM = 1024, RW_COLS = 3328, IN_COLS = 5568, INP = 5632;
constexpr int PATT_COLS = 2304;
constexpr int NEXP = 32, DEXP = 512;
constexpr int MOE_ROWS = 40960;
constexpr float LOG2E = 1.4426950408889634f;

constexpr size_t MiB = 1u << 20, KiB = 1024;
constexpr size_t WS_CTL = 0;
constexpr size_t WS_ROPE = 1 * MiB;
constexpr size_t WS_EID = 5 * MiB;
constexpr size_t WS_GATE = 5 * MiB + 128 * KiB;
constexpr size_t WS_CNT = 5 * MiB + 256 * KiB;
constexpr size_t WS_ROWMAP = 5 * MiB + 320 * KiB;
constexpr size_t WS_ROWDST = 5 * MiB + 512 * KiB;
constexpr size_t WS_TILEEXP = 5 * MiB + 704 * KiB;
constexpr size_t WS_WRB = 7 * MiB;
constexpr size_t WS_LOGITS = 852 * MiB;
constexpr size_t WS_SSQM = 6 * MiB;
constexpr size_t WS_SSQC = 6 * MiB + 64 * KiB;
constexpr size_t WS_SSQF = 6 * MiB + 128 * KiB;
constexpr size_t WS_LUT = 6 * MiB + 512 * KiB;
constexpr size_t WS_WINT = 8 * MiB;
constexpr size_t WS_WOUTT = 30 * MiB;
constexpr size_t WS_CAWQT = 38 * MiB;
constexpr size_t WS_CAWKVT = 40 * MiB;
constexpr size_t WS_CAWOT = 44 * MiB;
constexpr size_t WS_WQBT = 46 * MiB;
constexpr size_t WS_WKVBT = 47 * MiB;
constexpr size_t WS_LORABT = 48 * MiB;
constexpr size_t WS_WGU = 52 * MiB;
constexpr size_t WS_WD = 180 * MiB;
constexpr size_t WS_H = 248 * MiB;
constexpr size_t WS_PRW = 312 * MiB;
constexpr size_t WS_PATT = 416 * MiB;
constexpr size_t WS_U = 488 * MiB;
constexpr size_t WS_HID = 488 * MiB, WS_C2 = 528 * MiB;
constexpr size_t WS_APERM = 312 * MiB;
constexpr size_t WS_LORAA = 680 * MiB;
constexpr size_t WS_LORAO = 692 * MiB;
constexpr size_t WS_VFIRST = 820 * MiB;
constexpr size_t WS_QN = 852 * MiB, WS_KVN = 864 * MiB, WS_QM = 872 * MiB, WS_KVM = 896 * MiB, WS_KPE = 928 * MiB;
constexpr size_t WS_CAQ = 852 * MiB, WS_CAO = 868 * MiB;
constexpr size_t WS_MEMN = 932 * MiB, WS_MEMKV = 936 * MiB;
constexpr size_t WS_XB = 940 * MiB;
constexpr size_t WS_PARTC = 1004 * MiB;
constexpr size_t WS_PARTF = 1006 * MiB;
constexpr size_t WS_L1OFF = 1000 * MiB;
constexpr size_t WS_WRB1 = 1052 * MiB;
constexpr size_t WS_END = 1053 * MiB;
constexpr int CW_BAR = 4096;

constexpr int LDS_MAIN = 131072;
constexpr int LDS_MISC = LDS_MAIN;
constexpr int LDS_BYTES = 147456;

DI unsigned pk2(float lo, float hi) { f32x2 v = {lo, hi}; bf16x2_t b = __builtin_convertvector(v, bf16x2_t); return __builtin_bit_cast(unsigned, b); }
DI bf16_t f2bf(float f) { return (bf16_t)(pk2(f, 0.f) & 0xffffu); }
DI float bf2f(bf16_t b) { return __uint_as_float(((unsigned)b) << 16); }
DI float bflo(unsigned u) { return __uint_as_float(u << 16); }
DI float bfhi(unsigned u) { return __uint_as_float(u & 0xffff0000u); }
#define DPP_F(x, ctl) __builtin_bit_cast(float, __builtin_amdgcn_update_dpp(0, __builtin_bit_cast(int, x), ctl, 0xf, 0xf, true))
#define RDL_F(x, l) __builtin_bit_cast(float, __builtin_amdgcn_readlane(__builtin_bit_cast(int, x), l))
DI float wave_sum(float v) {
    v += DPP_F(v, 0xB1);
    v += DPP_F(v, 0x4E);
    v += DPP_F(v, 0x141);
    v += DPP_F(v, 0x140);
    const float r0 = RDL_F(v, 0), r1 = RDL_F(v, 16), r2 = RDL_F(v, 32), r3 = RDL_F(v, 48);
    return (r0 + r1) + (r2 + r3);
}
DI float wave_max(float v) {
    v = fmaxf(v, DPP_F(v, 0xB1)); v = fmaxf(v, DPP_F(v, 0x4E)); v = fmaxf(v, DPP_F(v, 0x141)); v = fmaxf(v, DPP_F(v, 0x140));
    const float r0 = RDL_F(v, 0), r1 = RDL_F(v, 16), r2 = RDL_F(v, 32), r3 = RDL_F(v, 48);
    return fmaxf(fmaxf(r0, r1), fmaxf(r2, r3));
}
DI float sigmoidf_(float x) { return 1.f / (1.f + __expf(-x)); }

#define XB_TMO      128
#define XB_XCNT(j)  (256  + 64 * (j))
#define XB_XSUB(j)  (1280 + 64 * (j))
#define XB_XGEN(j)  (2304 + 64 * (j))
#define XB_TOP      3328
#define XB_TOPGEN   3392
#define XCD_BAR_WORDS 3456
#define XB_SPIN_CAP (1u << 24)

DI unsigned xb_ld(unsigned* p)              { return __hip_atomic_load(p, __ATOMIC_RELAXED, __HIP_MEMORY_SCOPE_AGENT); }
DI unsigned xb_add(unsigned* p, unsigned v) { return __hip_atomic_fetch_add(p, v, __ATOMIC_RELAXED, __HIP_MEMORY_SCOPE_AGENT); }
DI unsigned xb_xcc_id() { return (unsigned)__builtin_amdgcn_s_getreg((3 << 11) | 20) & 0xFu; }
#define XB_SPIN(cond, bar) do { unsigned _sp = 0; while (cond) { __builtin_amdgcn_s_sleep(1); \
    if ((++_sp & 255u) == 0u) { if (xb_ld(&(bar)[XB_TMO])) break; if (_sp > XB_SPIN_CAP) { atomicAdd(&(bar)[XB_TMO], 1u); break; } } } } while (0)

struct XcdBarrier { unsigned* bar; unsigned x; volatile LAS unsigned* st; };

DI XcdBarrier xcd_barrier_post(unsigned* bar, volatile LAS unsigned* st) {
    XcdBarrier b; b.bar = bar; b.x = xb_xcc_id(); b.st = st;
    if (threadIdx.x == 0) (void)xb_add(&bar[XB_XCNT(b.x)], 1u);
    return b;
}
DI void xcd_barrier_complete(unsigned* bar, unsigned x, unsigned& nloc, unsigned& nx) {
    const unsigned G = gridDim.x * gridDim.y * gridDim.z;
    unsigned sum, cnt, mine, sp = 0u;
    for (;;) {
        sum = 0u; cnt = 0u; mine = 0u;
#pragma unroll
        for (unsigned j = 0; j < 16; ++j) { const unsigned c = xb_ld(&bar[XB_XCNT(j)]); sum += c; cnt += (c > 0u) ? 1u : 0u; mine = (j == x) ? c : mine; }
        if (sum == G) break;
        __builtin_amdgcn_s_sleep(1);
        if ((++sp & 255u) == 0u) { if (xb_ld(&bar[XB_TMO])) break; if (sp > XB_SPIN_CAP) { atomicAdd(&bar[XB_TMO], 1u); break; } }
    }
    nloc = mine > 0u ? mine : 1u; nx = cnt > 0u ? cnt : 1u;
}
DI void xcd_barrier(const XcdBarrier& b) {
    asm volatile("s_waitcnt vmcnt(0)" ::: "memory");
    __syncthreads();
    if (threadIdx.x == 0) {
        unsigned* bar = b.bar;
        __builtin_amdgcn_s_waitcnt(0);
        unsigned nloc = b.st[0], nx = b.st[1];
        if (nloc == 0u) { xcd_barrier_complete(bar, b.x, nloc, nx); b.st[0] = nloc; b.st[1] = nx; }
        const unsigned old = xb_add(&bar[XB_XSUB(b.x)], 1u);
        const unsigned gen = old / nloc;
        if (old + 1u == (gen + 1u) * nloc) {
            __builtin_amdgcn_fence(__ATOMIC_RELEASE, "agent");
            asm volatile("s_waitcnt vmcnt(0)" ::: "memory");
            const unsigned og = xb_add(&bar[XB_TOP], 1u);
            const unsigned tg = og / nx;
            if (og + 1u == (tg + 1u) * nx) xb_add(&bar[XB_TOPGEN], 1u);
            else XB_SPIN(xb_ld(&bar[XB_TOPGEN]) == tg, bar);
            __builtin_amdgcn_fence(__ATOMIC_ACQUIRE, "agent");
            xb_add(&bar[XB_XGEN(b.x)], 1u);
            asm volatile("s_waitcnt vmcnt(0)" ::: "memory");
        } else {
            XB_SPIN(xb_ld(&bar[XB_XGEN(b.x)]) == gen, bar);
            __builtin_amdgcn_fence(__ATOMIC_ACQUIRE, "agent");
            asm volatile("s_waitcnt vmcnt(0)" ::: "memory");
        }
    }
    __syncthreads();
}

namespace pg8 {
constexpr int BM = 256, BK = 64, HALF = 128, HTB = HALF * BK * 2, STAGE_BYTES = 8 * HTB, NXCD = 8, WGM = 8;
__host__ __device__ __forceinline__ int lds_byte(int r, int c) { const int st = (r >> 4) * 2 + (c >> 5), rr = r & 15, cc = c & 31, ob = rr * 64 + cc * 2; return st * 1024 + (ob ^ (((ob >> 9) & 1) << 5)); }
__host__ __device__ __forceinline__ void stage_rc(int b, int& R, int& C) { const int st = b / 1024, sb = b % 1024, swz = sb ^ (((sb >> 9) & 1) << 5); R = (st >> 1) * 16 + swz / 64; C = (st & 1) * 32 + (swz % 64) / 2; }
__host__ __device__ __forceinline__ int perm32(int rho) { const int n = rho >> 4, i = rho & 15; return 8 * (i >> 2) + 4 * n + (i & 3); }

struct Unit { int pm, pn; long bbase; };
struct Gemm { const bf16_t* A; const bf16_t* Bt; int lda, ldb, K; const int* rowmap; };

struct StaticOrder {
    int nM, nN, nwg, G, c, ldb;
    DI void init(int M, int N, int G_, int c_, int ldb_) { nM = M / BM; nN = N / BM; nwg = nM * nN; G = G_; c = c_; ldb = ldb_; }
    DI bool next(int i, Unit& u) const {
        const long L = (long)i * G + c; if (L >= nwg) return false;
        int wgid = (int)L; { const int q = nwg / NXCD, r = nwg % NXCD, xcd = wgid % NXCD, off = wgid / NXCD; wgid = (xcd < r ? xcd * (q + 1) : r * (q + 1) + (xcd - r) * q) + off; }
        const int nig = WGM * nN, gid = wgid / nig, fm = gid * WGM, gsz = (nM - fm) < WGM ? (nM - fm) : WGM;
        u.pm = fm + ((wgid % nig) % gsz); u.pn = (wgid % nig) / gsz; u.bbase = (long)u.pn * BM * ldb; return true;
    }
};
struct MoeOrder {
    const int* tileexp; int ntiles, nN, G, c, ldb; long estride;
    DI bool next(int i, Unit& u) const {
        const long L = (long)i * G + c; if (L >= (long)ntiles * nN) return false;
        const int tile = (int)(L / nN), pn = (int)(L % nN); const int e = tileexp[tile];
        u.pm = tile; u.pn = pn; u.bbase = (long)e * estride + (long)pn * BM * ldb; return true;
    }
};

template <class Epi, class Sched, bool GATHER = false>
DI void gemm_phase(LAS unsigned char* lds, const Gemm g, const Sched& S, const Epi& E) {
    int tid = threadIdx.x; asm volatile("" : "+v"(tid));
    const int wid = __builtin_amdgcn_readfirstlane(tid >> 6), lane = tid & 63, wr = wid >> 2, wc = wid & 3, fr = lane & 15, fq = lane >> 4;
    const int K = g.K, nt = K / BK;
    unsigned voffA[2], voffB[2]; int RA[2], CA[2];
#pragma unroll
    for (int i = 0; i < 2; ++i) { int R, C; stage_rc(tid * 16 + i * 8192, R, C); const int Rb = Epi::PERM ? ((R & ~31) + perm32(R & 31)) : R;
        RA[i] = R; CA[i] = C; voffA[i] = (unsigned)(R * g.lda + C) * 2u; voffB[i] = (unsigned)(Rb * g.ldb + C) * 2u; }
    const size_t kstep = (size_t)(BK * 2);
    const size_t hstepA = (size_t)HALF * g.lda * 2, hstepB = (size_t)HALF * g.ldb * 2;
    const unsigned ldsw = (unsigned)wid * 1024u;
    const int aoff = lds_byte(wr * 64 + fr, fq * 8), boff = lds_byte(wc * 32 + fr, fq * 8);
#define PG8_SA(b, h) (((b) * 2 + (h)) * HTB)
#define PG8_SB(b, h) ((4 + (b) * 2 + (h)) * HTB)
#define PG8_STAGE(bufoff, gbase, voff) do { _Pragma("unroll") for (int _i = 0; _i < 2; ++_i) \
        __builtin_amdgcn_global_load_lds((const unsigned*)((const char*)(gbase) + (voff)[_i]), (LAS unsigned*)(lds + (bufoff) + ldsw + _i * 8192), 16, 0, 0); } while (0)
    unsigned gA[2][2], ngA[2][2];
#define PG8_STAGE_A(b, h, ptr, isnext) do { if constexpr (GATHER) { if (isnext) PG8_STAGE(PG8_SA(b, h), ptr, ngA[h]); else PG8_STAGE(PG8_SA(b, h), ptr, gA[h]); } \
        else PG8_STAGE(PG8_SA(b, h), (ptr) + (h) * hstepA, voffA); } while (0)
#define PG8_GATHER_OFFS(dst, un) do { _Pragma("unroll") for (int h_ = 0; h_ < 2; ++h_) _Pragma("unroll") for (int i_ = 0; i_ < 2; ++i_) \
        dst[h_][i_] = (unsigned)(g.rowmap[(un).pm * BM + h_ * HALF + RA[i_]] * g.lda + CA[i_]) * 2u; } while (0)
#define PG8_LDA(dst, b, h) do { _Pragma("unroll") for (int m = 0; m < 4; ++m) _Pragma("unroll") for (int k = 0; k < 2; ++k) dst[m][k] = *(const LAS bf16x8*)(lds + PG8_SA(b, h) + aoff + m * 2048 + k * 1024); } while (0)
#define PG8_LDB(dst, b, h) do { _Pragma("unroll") for (int n = 0; n < 2; ++n) _Pragma("unroll") for (int k = 0; k < 2; ++k) dst[n][k] = *(const LAS bf16x8*)(lds + PG8_SB(b, h) + boff + n * 2048 + k * 1024); } while (0)
#define PG8_MMA(ai, bj, At, Bt) do { __builtin_amdgcn_s_setprio(1); _Pragma("unroll") for (int m = 0; m < 4; ++m) _Pragma("unroll") for (int n = 0; n < 2; ++n) _Pragma("unroll") for (int k = 0; k < 2; ++k) \
        acc[ai][bj][m][n] = __builtin_amdgcn_mfma_f32_16x16x32_bf16(Bt[n][k], At[m][k], acc[ai][bj][m][n], 0, 0, 0); __builtin_amdgcn_s_setprio(0); } while (0)
#define PG8_WAIT_V(n) asm volatile("s_waitcnt vmcnt(" #n ")" ::: "memory")
#define PG8_WAIT_L(n) asm volatile("s_waitcnt lgkmcnt(" #n ")" ::: "memory")
#define PG8_BAR __builtin_amdgcn_s_barrier()
#define PG8_SCHED __builtin_amdgcn_sched_barrier(0)
    Unit cur, nxt; int ui = 0;
    if (!S.next(0, cur)) return;
    f32x4 acc[2][2][4][2];
#pragma unroll
    for (int a = 0; a < 2; ++a)
#pragma unroll
        for (int b = 0; b < 2; ++b)
#pragma unroll
            for (int m = 0; m < 4; ++m)
#pragma unroll
                for (int n = 0; n < 2; ++n) acc[a][b][m][n] = (f32x4){0.f, 0.f, 0.f, 0.f};
    bf16x8 At[4][2], B0[2][2], B1[2][2];
    const char* cA; const char* cB = (const char*)g.Bt + cur.bbase * 2;
    if constexpr (GATHER) { cA = (const char*)g.A; PG8_GATHER_OFFS(gA, cur); PG8_GATHER_OFFS(ngA, cur); }
    else cA = (const char*)g.A + (size_t)cur.pm * BM * g.lda * 2;
    PG8_STAGE(PG8_SB(0, 0), cB, voffB); PG8_STAGE(PG8_SB(0, 1), cB + hstepB, voffB); PG8_STAGE_A(0, 0, cA, false); PG8_STAGE_A(0, 1, cA, false);
    if (wr == 1) PG8_BAR;
    PG8_WAIT_V(2); PG8_BAR;
    PG8_STAGE(PG8_SB(1, 0), cB + kstep, voffB); PG8_STAGE_A(1, 0, cA + kstep, false); PG8_STAGE(PG8_SB(1, 1), cB + hstepB + kstep, voffB);
    PG8_WAIT_V(6); PG8_BAR;
    for (;;) {
        const bool has_next = S.next(ui + 1, nxt);
        const char* nA; const char* nB = has_next ? (const char*)g.Bt + nxt.bbase * 2 : cB;
        if constexpr (GATHER) { nA = cA; if (has_next) PG8_GATHER_OFFS(ngA, nxt); }
        else nA = has_next ? (const char*)g.A + (size_t)nxt.pm * BM * g.lda * 2 : cA;
        for (int t = 0; t < nt; t += 2) {
            const bool last = (t == nt - 2);
            const char* a1 = cA + (size_t)(t + 1) * kstep;
            const char* a2 = last ? nA : cA + (size_t)(t + 2) * kstep; const char* b2 = last ? nB : cB + (size_t)(t + 2) * kstep;
            const char* a3 = a2 + kstep; const char* b3 = b2 + kstep;
            PG8_LDB(B0, 0, 0); PG8_LDB(B1, 0, 1); PG8_SCHED; PG8_LDA(At, 0, 0); PG8_STAGE_A(1, 1, a1, false);
            PG8_WAIT_V(8); PG8_WAIT_L(0); PG8_BAR; PG8_MMA(0, 0, At, B0); PG8_MMA(0, 1, At, B1); PG8_BAR; PG8_SCHED;
            PG8_LDA(At, 0, 1); PG8_STAGE(PG8_SB(0, 0), b2, voffB); PG8_STAGE(PG8_SB(0, 1), b2 + hstepB, voffB); PG8_STAGE_A(0, 0, a2, last);
            PG8_WAIT_V(8); PG8_WAIT_L(0); PG8_BAR; PG8_MMA(1, 0, At, B0); PG8_MMA(1, 1, At, B1); PG8_BAR; PG8_SCHED;
            PG8_LDB(B0, 1, 0); PG8_LDB(B1, 1, 1); PG8_SCHED; PG8_LDA(At, 1, 0); PG8_STAGE_A(0, 1, a2, last);
            PG8_WAIT_V(8); PG8_WAIT_L(0); PG8_BAR; PG8_MMA(0, 0, At, B0); PG8_MMA(0, 1, At, B1); PG8_BAR; PG8_SCHED;
            PG8_LDA(At, 1, 1); PG8_STAGE(PG8_SB(1, 0), b3, voffB); PG8_STAGE(PG8_SB(1, 1), b3 + hstepB, voffB); PG8_STAGE_A(1, 0, a3, last);
            PG8_WAIT_V(8); PG8_WAIT_L(0); PG8_BAR; PG8_MMA(1, 0, At, B0); PG8_MMA(1, 1, At, B1); PG8_BAR; PG8_SCHED;
        }
        if (wr == 0) PG8_BAR;
        E(acc, cur, wr, wc, fr, fq);
        if (!has_next) break;
#pragma unroll
        for (int a = 0; a < 2; ++a)
#pragma unroll
            for (int b = 0; b < 2; ++b)
#pragma unroll
                for (int m = 0; m < 4; ++m)
#pragma unroll
                    for (int n = 0; n < 2; ++n) acc[a][b][m][n] = (f32x4){0.f, 0.f, 0.f, 0.f};
        cur = nxt; cA = nA; cB = nB; ++ui;
        if constexpr (GATHER) {
#pragma unroll
            for (int h_ = 0; h_ < 2; ++h_)
#pragma unroll
                for (int i_ = 0; i_ < 2; ++i_) gA[h_][i_] = ngA[h_][i_]; }
        if (wr == 1) PG8_BAR;
    }
    PG8_WAIT_V(0);
    PG8_BAR;
#undef PG8_SA
#undef PG8_SB
#undef PG8_STAGE
#undef PG8_STAGE_A
#undef PG8_LDA
#undef PG8_LDB
#undef PG8_MMA
#undef PG8_WAIT_V
#undef PG8_WAIT_L
#undef PG8_BAR
#undef PG8_SCHED
#undef PG8_GATHER_OFFS
}

DI float row_ssq32(const float* part, int row) { const f32x4* p = (const f32x4*)(part + (size_t)row * 32); float t = 0.f;
#pragma unroll
    for (int i = 0; i < 8; ++i) { const f32x4 v = p[i]; t += (v[0] + v[1]) + (v[2] + v[3]); }
    return t; }
DI float row_rstd(const float* ssq, int np, int row) {
    float t;
    if (np == 1) t = ssq[row];
    else { const f32x4* p = (const f32x4*)(ssq + (size_t)row * 32); t = 0.f;
#pragma unroll
        for (int i = 0; i < 8; ++i) { const f32x4 v = p[i]; t += (v[0] + v[1]) + (v[2] + v[3]); } }
    return rsqrtf(t * (1.f / 2048.f) + 1e-6f);
}
struct EpiBf16 {
    static constexpr bool PERM = true;
    bf16_t* O; int ldc; bf16_t* O2; int ldc2; int split_tile; const float* ssq; int np;
    DI void operator()(const f32x4 (&acc)[2][2][4][2], const Unit& u, int wr, int wc, int fr, int fq) const {
        bf16_t* base = O; int ld = ldc; int colt = u.pn * BM;
        if (u.pn >= split_tile) { base = O2; ld = ldc2; colt = (u.pn - split_tile) * BM; }
        const int row0 = u.pm * BM + wr * 64 + fr, col0 = colt + wc * 32 + 8 * fq;
#pragma unroll
        for (int ai = 0; ai < 2; ++ai)
#pragma unroll
            for (int m = 0; m < 4; ++m) { const int row = row0 + ai * HALF + m * 16; bf16_t* rowp = base + (size_t)row * ld + col0;
                const float rs = ssq ? row_rstd(ssq, np, row) : 1.f;
#pragma unroll
                for (int bj = 0; bj < 2; ++bj) { const f32x4 v0 = acc[ai][bj][m][0] * rs, v1 = acc[ai][bj][m][1] * rs;
                    u32x4 w; w.x = pk2(v0[0], v0[1]); w.y = pk2(v0[2], v0[3]); w.z = pk2(v1[0], v1[1]); w.w = pk2(v1[2], v1[3]);
                    *(u32x4*)(rowp + bj * HALF) = w; } }
    }
};
struct EpiResid {
    static constexpr bool PERM = true;
    const float* basef; const bf16_t* baseb; bf16_t* out; int ldc; float* part_out;
    DI void operator()(const f32x4 (&acc)[2][2][4][2], const Unit& u, int wr, int wc, int fr, int fq) const {
        const int row0 = u.pm * BM + wr * 64 + fr, col0 = u.pn * BM + wc * 32 + 8 * fq;
#pragma unroll
        for (int ai = 0; ai < 2; ++ai)
#pragma unroll
            for (int m = 0; m < 4; ++m) { const int row = row0 + ai * HALF + m * 16; const size_t off = (size_t)row * ldc + col0; float sq = 0.f;
#pragma unroll
                for (int bj = 0; bj < 2; ++bj) { f32x4 v0 = acc[ai][bj][m][0], v1 = acc[ai][bj][m][1];
                    if (basef) { v0 += *(const f32x4*)(basef + off + bj * HALF); v1 += *(const f32x4*)(basef + off + bj * HALF + 4); }
                    else { const u32x4 b = *(const u32x4*)(baseb + off + bj * HALF);
                        v0 += (f32x4){bflo(b.x), bfhi(b.x), bflo(b.y), bfhi(b.y)}; v1 += (f32x4){bflo(b.z), bfhi(b.z), bflo(b.w), bfhi(b.w)}; }
                    u32x4 w; w.x = pk2(v0[0], v0[1]); w.y = pk2(v0[2], v0[3]); w.z = pk2(v1[0], v1[1]); w.w = pk2(v1[2], v1[3]);
                    *(u32x4*)(out + off + bj * HALF) = w;
                    const float a0 = bflo(w.x), a1 = bfhi(w.x), a2 = bflo(w.y), a3 = bfhi(w.y), a4 = bflo(w.z), a5 = bfhi(w.z), a6 = bflo(w.w), a7 = bfhi(w.w);
                    sq += ((a0 * a0 + a1 * a1) + (a2 * a2 + a3 * a3)) + ((a4 * a4 + a5 * a5) + (a6 * a6 + a7 * a7)); }
                sq += __shfl_xor(sq, 16); sq += __shfl_xor(sq, 32);
                if (fq == 0) part_out[(size_t)row * 32 + u.pn * 4 + wc] = sq; }
    }
};
struct EpiF32 {
    static constexpr bool PERM = false;
    float* out; int ldc; const float* ssq; int np; float* ssq_pub;
    DI void operator()(const f32x4 (&acc)[2][2][4][2], const Unit& u, int wr, int wc, int fr, int fq) const {
        const int row0 = u.pm * BM + wr * 64 + fr, col0 = u.pn * BM + wc * 32 + 4 * fq;
#pragma unroll
        for (int ai = 0; ai < 2; ++ai)
#pragma unroll
            for (int m = 0; m < 4; ++m) { const int row = row0 + ai * HALF + m * 16; const size_t off = (size_t)row * ldc + col0;
                float rs = 1.f;
                if (ssq) { const float t = (np == 1) ? ssq[row] : row_ssq32(ssq, row); rs = rsqrtf(t * (1.f / 2048.f) + 1e-6f); if (ssq_pub && u.pn == 0 && wc == 0 && fq == 0) ssq_pub[row] = t; }
#pragma unroll
                for (int bj = 0; bj < 2; ++bj)
#pragma unroll
                    for (int n = 0; n < 2; ++n) *(f32x4*)(out + off + bj * HALF + n * 16) = acc[ai][bj][m][n] * rs; }
    }
};
struct EpiSiluMul {
    static constexpr bool PERM = true;
    bf16_t* O; int ldc; const float* ssq; const int* rowmap;
    DI void operator()(const f32x4 (&acc)[2][2][4][2], const Unit& u, int wr, int wc, int fr, int fq) const {
        const int row0 = u.pm * BM + wr * 64 + fr, col0 = (u.pn * BM + wc * 32 + 8 * fq) >> 1;
#pragma unroll
        for (int ai = 0; ai < 2; ++ai)
#pragma unroll
            for (int m = 0; m < 4; ++m) { const int row = row0 + ai * HALF + m * 16; bf16_t* rowp = O + (size_t)row * ldc + col0;
                const float rs = row_rstd(ssq, 1, rowmap[row]);
#pragma unroll
                for (int bj = 0; bj < 2; ++bj) { const f32x4 v0 = acc[ai][bj][m][0] * rs, v1 = acc[ai][bj][m][1] * rs;
                    const float h0 = v0[0] / (1.f + __expf(-v0[0])) * v0[1], h1 = v0[2] / (1.f + __expf(-v0[2])) * v0[3];
                    const float h2 = v1[0] / (1.f + __expf(-v1[0])) * v1[1], h3 = v1[2] / (1.f + __expf(-v1[2])) * v1[3];
                    u32x2 w; w.x = pk2(h0, h1); w.y = pk2(h2, h3);
                    *(u32x2*)(rowp + bj * (HALF / 2)) = w; } }
    }
};
struct EpiScatter {
    static constexpr bool PERM = true;
    bf16_t* O; int ldc; const int* dst;
    DI void operator()(const f32x4 (&acc)[2][2][4][2], const Unit& u, int wr, int wc, int fr, int fq) const {
        const int row0 = u.pm * BM + wr * 64 + fr, col0 = u.pn * BM + wc * 32 + 8 * fq;
#pragma unroll
        for (int ai = 0; ai < 2; ++ai)
#pragma unroll
            for (int m = 0; m < 4; ++m) { const int d = dst[row0 + ai * HALF + m * 16];
                if (d >= 0) { bf16_t* rowp = O + (size_t)d * ldc + col0;
#pragma unroll
                    for (int bj = 0; bj < 2; ++bj) { const f32x4 v0 = acc[ai][bj][m][0], v1 = acc[ai][bj][m][1];
                        u32x4 w; w.x = pk2(v0[0], v0[1]); w.y = pk2(v0[2], v0[3]); w.z = pk2(v1[0], v1[1]); w.w = pk2(v1[2], v1[3]);
                        *(u32x4*)(rowp + bj * HALF) = w; } } }
    }
};
}

struct Args { const void* in[45]; float* out; unsigned char* ws; int ph_lo, ph_hi; };
static_assert(sizeof(void*) == 8 && sizeof(Args) == 384, "Args layout");

#define CAS __attribute__((address_space(4)))
typedef const CAS char* kaptr_t;
typedef const float* const CAS* inptr_t;
struct Ctx {
    LAS unsigned char* lds; unsigned char* ws; inptr_t in; float* X;
    int tid, lane, wave, G, wg, gw, ngw, att_sel, vcu;
};

DI size_t wofs(int l) { return l ? WS_L1OFF : 0; }
struct TrDesc { const float* W; bf16_t* WT; int N, ldk, row_off, row_mul, nblk, item; const float* ks; };
DI void tr_load(const TrDesc& d, float (&tv)[32], int lane) {
    const int kb = d.item / d.nblk, nb = d.item % d.nblk, k0 = 64 * kb, n0 = 32 * nb;
#pragma unroll
    for (int i = 0; i < 32; ++i) { const int kk = 2 * i + (lane >> 5); tv[i] = d.W[(size_t)(k0 + kk) * d.N + n0 + (lane & 31)]; }
}
DI void tr_store(const TrDesc& d, const float (&tv)[32], LAS float* scr, int lane) {
    const int kb = d.item / d.nblk, nb = d.item % d.nblk, k0 = 64 * kb, n0 = 32 * nb;
#pragma unroll
    for (int i = 0; i < 32; ++i) { const int kk = 2 * i + (lane >> 5); scr[kk * 33 + (lane & 31)] = d.ks ? tv[i] * d.ks[k0 + kk] : tv[i]; }
    asm volatile("s_waitcnt lgkmcnt(0)" ::: "memory");
    const int c = lane & 7;
#pragma unroll
    for (int j = 0; j < 4; ++j) { const int n = (lane >> 3) + 8 * j; const LAS float* s = scr + (8 * c) * 33 + n;
        u32x4 o; o.x = pk2(s[0 * 33], s[1 * 33]); o.y = pk2(s[2 * 33], s[3 * 33]); o.z = pk2(s[4 * 33], s[5 * 33]); o.w = pk2(s[6 * 33], s[7 * 33]);
        *(u32x4*)(d.WT + (size_t)(d.row_off + (n0 + n) * d.row_mul) * d.ldk + k0 + 8 * c) = o; }
    asm volatile("s_waitcnt lgkmcnt(0)" ::: "memory");
}

DI void norm_row(const float* xin, const bf16_t* xinb, bf16_t* xout, const bf16_t* c0, const bf16_t* c1, float g0, float g1, const float* w, bf16_t* hout, float* fout, int lane, float* ssq_w = nullptr) {
    f32x4 v[8]; float ss = 0.f;
    if (xin) {
#pragma unroll
        for (int j = 0; j < 8; ++j) { v[j] = ((const f32x4*)xin)[lane + 64 * j]; }
    } else {
#pragma unroll
        for (int j = 0; j < 8; ++j) { const u32x2 a = ((const u32x2*)xinb)[lane + 64 * j]; v[j] = (f32x4){bflo(a.x), bfhi(a.x), bflo(a.y), bfhi(a.y)}; }
    }
    if (c0) {
#pragma unroll
        for (int j = 0; j < 8; ++j) { const u32x2 a = ((const u32x2*)c0)[lane + 64 * j], b = ((const u32x2*)c1)[lane + 64 * j];
            v[j][0] += g0 * bflo(a.x) + g1 * bflo(b.x); v[j][1] += g0 * bfhi(a.x) + g1 * bfhi(b.x);
            v[j][2] += g0 * bflo(a.y) + g1 * bflo(b.y); v[j][3] += g0 * bfhi(a.y) + g1 * bfhi(b.y); }
    }
#pragma unroll
    for (int j = 0; j < 8; ++j) ss += (v[j][0] * v[j][0] + v[j][1] * v[j][1]) + (v[j][2] * v[j][2] + v[j][3] * v[j][3]);
    if (xout) {
#pragma unroll
        for (int j = 0; j < 8; ++j) { u32x2 o; o.x = pk2(v[j][0], v[j][1]); o.y = pk2(v[j][2], v[j][3]); ((u32x2*)xout)[lane + 64 * j] = o; }
    }
    const float sst = wave_sum(ss);
    if (ssq_w) { if (lane == 0) *ssq_w = sst; }
    if (!w) return;
    const float rstd = rsqrtf(sst * (1.f / DM) + 1e-6f);
#pragma unroll
    for (int j = 0; j < 8; ++j) { const f32x4 ww = ((const f32x4*)w)[lane + 64 * j]; const f32x4 y = v[j] * rstd * ww;
        if (hout) { u32x2 o; o.x = pk2(y[0], y[1]); o.y = pk2(y[2], y[3]); ((u32x2*)hout)[lane + 64 * j] = o; }
        if (fout) ((f32x4*)fout)[lane + 64 * j] = y; }
}

constexpr int I_WIN = 32 * 174, I_VR = 32, I_WOUT = 32 * 64, I_CAQ = 32 * 16, I_CAKV = 32 * 32, I_CAO = 8 * 64, I_WQB = 6 * 24, I_WKVB = 4 * 32;
constexpr int N_SMALL_ITEMS = I_WIN + I_VR + I_WOUT + I_CAQ + I_CAKV + I_CAO + I_WQB + I_WKVB;
DI TrDesc small_tr_desc(int l, int r, inptr_t in, unsigned char* wsl) {
    bf16_t* WINT = (bf16_t*)(wsl + WS_WINT);
    if (r < I_WIN) return TrDesc{in[6] + (size_t)l * DM * IN_COLS, WINT, IN_COLS, DM, 0, 1, 174, r, in[5] + (size_t)l * DM}; r -= I_WIN;
    if (r < I_VR) return TrDesc{in[7], WINT, 32, DM, IN_COLS, 1, 1, r, in[5] + DM}; r -= I_VR;
    if (r < I_WOUT) return TrDesc{in[8] + (size_t)l * DM * DM, (bf16_t*)(wsl + WS_WOUTT), DM, DM, 0, 1, 64, r, nullptr}; r -= I_WOUT;
    if (r < I_CAQ) return TrDesc{in[34] + (size_t)l * DM * 512, (bf16_t*)(wsl + WS_CAWQT), 512, DM, 0, 1, 16, r, in[32] + (size_t)l * DM}; r -= I_CAQ;
    if (r < I_CAKV) return TrDesc{in[35] + (size_t)l * DM * 1024, (bf16_t*)(wsl + WS_CAWKVT), 1024, DM, 0, 1, 32, r, nullptr}; r -= I_CAKV;
    if (r < I_CAO) return TrDesc{in[36] + (size_t)l * 512 * DM, (bf16_t*)(wsl + WS_CAWOT), DM, 512, 0, 1, 64, r, nullptr}; r -= I_CAO;
    if (r < I_WQB) return TrDesc{in[29] + (size_t)l * 384 * 768, (bf16_t*)(wsl + WS_WQBT), 768, 384, 0, 1, 24, r, nullptr}; r -= I_WQB;
    return TrDesc{in[31] + (size_t)l * 256 * 1024, (bf16_t*)(wsl + WS_WKVBT), 1024, 256, 0, 1, 32, r, nullptr};
}
constexpr int I_EXP = 512;
constexpr int N_MOE_ITEMS = 3 * NEXP * I_EXP;
DI TrDesc moe_tr_desc(int l, int r, inptr_t in, unsigned char* ws) {
    const int e = r / (3 * I_EXP), q = r % (3 * I_EXP), mat = q / I_EXP, ii = q % I_EXP;
    const size_t eo = ((size_t)l * NEXP + e);
    if (mat == 0) return TrDesc{in[42] + eo * DM * DEXP, (bf16_t*)(ws + WS_WGU) + (size_t)e * 1024 * DM, DEXP, DM, 0, 2, 16, ii, in[37] + (size_t)l * DM};
    if (mat == 1) return TrDesc{in[43] + eo * DM * DEXP, (bf16_t*)(ws + WS_WGU) + (size_t)e * 1024 * DM, DEXP, DM, 1, 2, 16, ii, in[37] + (size_t)l * DM};
    return TrDesc{in[44] + eo * DEXP * DM, (bf16_t*)(ws + WS_WD) + (size_t)e * DM * DEXP, DM, DEXP, 0, 1, 64, ii, nullptr};
}
DI void phase_convert(const Ctx& C, int l) {
    inptr_t in = C.in;
    unsigned char* ws = C.ws;
    LAS float* scr = (LAS float*)(C.lds + C.wave * 16384);
    bf16_t* WINT = (bf16_t*)(ws + WS_WINT);
    const int n_items = (l == 0) ? N_SMALL_ITEMS : 0;
    auto decode = [&](int it) -> TrDesc { return small_tr_desc(0, it, in, ws); };
    {
        const int first = (l == 0 && C.gw >= I_WIN && C.gw < I_WIN + I_VR) ? C.gw + C.ngw : C.gw;
        float ta[32], tb[32];
        int it = first;
        if (it < n_items) { TrDesc d0 = decode(it); tr_load(d0, ta, C.lane);
            for (;;) {
                int it2 = it + C.ngw; if (l == 0 && it2 >= I_WIN && it2 < I_WIN + I_VR) it2 += C.ngw;
                const bool has2 = it2 < n_items; TrDesc d1 = d0;
                if (has2) { d1 = decode(it2); tr_load(d1, tb, C.lane); }
                tr_store(d0, ta, scr, C.lane);
                if (!has2) break;
                int it3 = it2 + C.ngw; if (l == 0 && it3 >= I_WIN && it3 < I_WIN + I_VR) it3 += C.ngw;
                const bool has3 = it3 < n_items;
                if (has3) { d0 = decode(it3); tr_load(d0, ta, C.lane); }
                tr_store(d1, tb, scr, C.lane);
                if (!has3) break;
                it = it3;
            }
        }
    }
    const int gt = C.wg * 512 + C.tid, ngt = C.G * 512;
    if (l == 0) {
        for (int i = gt; i < 64 * DM / 8; i += ngt) ((u32x4*)(WINT + (size_t)IN_COLS * DM))[i] = (u32x4){0u, 0u, 0u, 0u};
        for (int i = gt; i < 32 * DM / 8; i += ngt) ((u32x4*)((bf16_t*)(ws + WS_L1OFF + WS_WINT) + (size_t)(IN_COLS + 32) * DM))[i] = (u32x4){0u, 0u, 0u, 0u};
#pragma unroll 1
        for (int lw = 0; lw < 2; ++lw) {
            bf16_t* LB = (bf16_t*)(ws + wofs(lw) + WS_LORABT);
            const float* w2 = in[12] + (size_t)lw * 64 * 1024; const float* a2 = in[14] + (size_t)lw * 64 * 1024; const float* g2 = in[17] + (size_t)lw * 128 * 1024; const float* v2 = in[16];
            for (int i = gt; i < 4096 * 384; i += ngt) {
                const int n = i / 384, k = i % 384, blk = n >> 10, c = n & 1023; float v = 0.f;
                if (blk == 0) { if (k < 64) v = w2[k * 1024 + c]; }
                else if (blk == 1) { if (k >= 64 && k < 128) v = a2[(k - 64) * 1024 + c]; }
                else if (blk == 2) { if (k >= 128 && k < 256) v = g2[(k - 128) * 1024 + c]; }
                else { if (lw == 1 && k >= 256 && k < 288) v = v2[(k - 256) * 1024 + c]; }
                LB[i] = f2bf(v);
            }
            bf16_t* WRB = (bf16_t*)(ws + (lw ? WS_WRB1 : WS_WRB)); const float* nf = in[37] + (size_t)lw * DM; const float* wg = in[38] + (size_t)lw * DM * 4; const float* we = in[40] + (size_t)lw * DM * 32;
            for (int i = gt; i < 256 * DM; i += ngt) { const int o = i / DM, k = i % DM; const float v = (o < 32) ? we[k * 32 + o] : ((o < 36) ? wg[k * 4 + (o - 32)] : 0.f); WRB[i] = f2bf(v * nf[k]); }
        }
    }
    if (l == 0) {
        float* LUT = (float*)(ws + WS_LUT); const float* rb = in[3];
        for (int i = gt; i < 4 * 128; i += ngt) { const int h = i >> 7, n = i & 127; int bk;
            if (n < 16) bk = n; else { bk = 16 + (int)(log2f((float)n * 0.0625f) * (16.f / 3.f)); if (bk > 31) bk = 31; }
            LUT[i] = rb[bk * 4 + h] * LOG2E; }
        f32x2* RT = (f32x2*)(ws + WS_ROPE); const int* pos = (const int*)in[2];
        for (int i = gt; i < NT * 32; i += ngt) { const int t = i >> 5, j = i & 31; const float invf = powf(10000.f, -(float)j / 32.f); const float ang = (float)pos[t] * invf; float s, c; sincosf(ang, &s, &c); RT[i] = (f32x2){c, s}; }
    }
    for (int m = C.gw; m < NMEM; m += C.ngw) norm_row(in[1] + (size_t)m * DM, nullptr, nullptr, nullptr, nullptr, 0.f, 0.f, in[33] + (size_t)l * DM, (bf16_t*)(ws + WS_MEMN) + (size_t)m * DM, nullptr, C.lane);
    {
        const bf16_t* C2 = (const bf16_t*)(ws + WS_C2); const float* gate = (const float*)(ws + WS_GATE); bf16_t* XB = (bf16_t*)(ws + WS_XB); float* SSQM = (float*)(ws + WS_SSQM);
        for (int m = C.gw; m < NT; m += C.ngw) {
            if (l == 0) norm_row(in[0] + (size_t)m * DM, nullptr, XB + (size_t)m * DM, nullptr, nullptr, 0.f, 0.f, nullptr, nullptr, nullptr, C.lane, SSQM + m);
            else norm_row(nullptr, XB + (size_t)m * DM, XB + (size_t)m * DM, C2 + (size_t)(2 * m) * DM, C2 + (size_t)(2 * m + 1) * DM, gate[2 * m], gate[2 * m + 1], nullptr, nullptr, nullptr, C.lane, SSQM + m);
        }
    }
}

DI void phase_ew1(const Ctx& C, int l) {
    inptr_t in = C.in; unsigned char* ws = C.ws;
    const bf16_t* PRW = (const bf16_t*)(ws + WS_PRW); const bf16_t* PATT = (const bf16_t*)(ws + WS_PATT);
    bf16_t* LA = (bf16_t*)(ws + WS_LORAA); bf16_t* QN = (bf16_t*)(ws + WS_QN); bf16_t* KVN = (bf16_t*)(ws + WS_KVN); bf16_t* KPE = (bf16_t*)(ws + WS_KPE);
    const float* mu = in[9] + (size_t)l * RW_COLS; const float* muv = in[10];
    const float* qnw = in[28] + (size_t)l * 384; const float* kvnw = in[30] + (size_t)l * 256;
    const f32x2* RT = (const f32x2*)(ws + WS_ROPE);
    const int lane = C.lane;
#pragma unroll 4
    for (int t = C.gw; t < NT; t += C.ngw) {
        const bool first = (t % SEQ) == 0;
        const bf16_t* p = PRW + (size_t)t * RW_COLS; const bf16_t* pa = PATT + (size_t)t * PATT_COLS;
#pragma unroll
        for (int j = 0; j < 4; ++j) { const int c = lane + 64 * j, col = 3072 + c;
            const float cur = bf2f(p[col]); const float prev = first ? 0.f : bf2f(p[col - RW_COLS]);
            const float xs = cur + mu[col] * (prev - cur);
            float v; if (c < 64) v = tanhf(xs); else if (c < 128) v = xs; else v = sigmoidf_(xs);
            LA[(size_t)t * 384 + c] = f2bf(v); }
        {
#pragma unroll
            for (int j = 0; j < 2; ++j) { const int c = lane + 64 * j; float v = 0.f;
                if (l == 1 && c < 32) { const float cur = bf2f(pa[2240 + c]); const float prev = first ? 0.f : bf2f(pa[2240 + c - PATT_COLS]); v = cur + muv[c] * (prev - cur); }
                LA[(size_t)t * 384 + 256 + c] = f2bf(v); } }
        float q[6], kv[4]; float sq = 0.f, skv = 0.f;
#pragma unroll
        for (int j = 0; j < 6; ++j) { q[j] = bf2f(pa[1536 + lane + 64 * j]); sq += q[j] * q[j]; }
#pragma unroll
        for (int j = 0; j < 4; ++j) { kv[j] = bf2f(pa[1920 + lane + 64 * j]); skv += kv[j] * kv[j]; }
        const float rq = rsqrtf(wave_sum(sq) * (1.f / 384.f) + 1e-6f), rkv = rsqrtf(wave_sum(skv) * (1.f / 256.f) + 1e-6f);
#pragma unroll
        for (int j = 0; j < 6; ++j) QN[(size_t)t * 384 + lane + 64 * j] = f2bf(q[j] * rq * qnw[lane + 64 * j]);
#pragma unroll
        for (int j = 0; j < 4; ++j) KVN[(size_t)t * 256 + lane + 64 * j] = f2bf(kv[j] * rkv * kvnw[lane + 64 * j]);
        { const float x = bf2f(pa[2176 + lane]); const float xo = __shfl_xor(x, 32); const f32x2 cs = RT[t * 32 + (lane & 31)];
          const float y = (lane < 32) ? (x * cs.x - xo * cs.y) : (x * cs.x + xo * cs.y);
          KPE[(size_t)t * 64 + lane] = f2bf(y); }
    }
}

DI void phase_ew2(const Ctx& C, int l) {
    inptr_t in = C.in; unsigned char* ws = C.ws;
    const bf16_t* PRW = (const bf16_t*)(ws + WS_PRW); const bf16_t* LO = (const bf16_t*)(ws + WS_LORAO);
    bf16_t* SR = (bf16_t*)(ws + WS_U); bf16_t* SW = SR + (size_t)NT * 1024; bf16_t* SK = SW + (size_t)NT * 1024; bf16_t* SV = SK + (size_t)NT * 1024;
    bf16_t* SA = SV + (size_t)NT * 1024; bf16_t* SB = SA + (size_t)NT * 1024; bf16_t* VF = (bf16_t*)(ws + WS_VFIRST);
    const float* mu = in[9] + (size_t)l * RW_COLS; const float* w0 = in[11] + (size_t)l * 1024; const float* a0 = in[13] + (size_t)l * 1024; const float* v0 = in[15];
    const float* kkw = in[18] + (size_t)l * 1024; const float* kaw = in[19] + (size_t)l * 1024;
    const int lane = C.lane;
#pragma unroll 1
    for (int j = 0; j < 2; ++j) {
        const int c0 = 8 * lane + 512 * j;
        float mu8[3][8], w0v[8], a0v[8], kkv[8], kav[8], v0v[8];
#pragma unroll
        for (int e = 0; e < 2; ++e) {
#pragma unroll
            for (int q = 0; q < 3; ++q) { const f32x4 m = *(const f32x4*)(mu + q * 1024 + c0 + 4 * e);
#pragma unroll
                for (int i = 0; i < 4; ++i) mu8[q][4 * e + i] = m[i]; }
            const f32x4 x0 = *(const f32x4*)(w0 + c0 + 4 * e), x1 = *(const f32x4*)(a0 + c0 + 4 * e), x2 = *(const f32x4*)(kkw + c0 + 4 * e), x3 = *(const f32x4*)(kaw + c0 + 4 * e);
            f32x4 x4 = (f32x4){0.f, 0.f, 0.f, 0.f}; if (l == 1) x4 = *(const f32x4*)(v0 + c0 + 4 * e);
#pragma unroll
            for (int i = 0; i < 4; ++i) { w0v[4 * e + i] = x0[i]; a0v[4 * e + i] = x1[i]; kkv[4 * e + i] = x2[i]; kav[4 * e + i] = x3[i]; v0v[4 * e + i] = x4[i]; } }
#pragma unroll 2
        for (int t = C.gw; t < NT; t += C.ngw) {
            const bool first = (t % SEQ) == 0;
            const bf16_t* p = PRW + (size_t)t * RW_COLS; const bf16_t* lo = LO + (size_t)t * 4096;
            float xs[3][8];
#pragma unroll
            for (int q = 0; q < 3; ++q) { const int col = q * 1024 + c0;
                const u32x4 cu = *(const u32x4*)(p + col); u32x4 pv = (u32x4){0u, 0u, 0u, 0u}; if (!first) pv = *(const u32x4*)(p + col - RW_COLS);
#pragma unroll
                for (int e = 0; e < 4; ++e) { const float c_lo = bflo(cu[e]), c_hi = bfhi(cu[e]), p_lo = bflo(pv[e]), p_hi = bfhi(pv[e]);
                    xs[q][2 * e] = c_lo + mu8[q][2 * e] * (p_lo - c_lo); xs[q][2 * e + 1] = c_hi + mu8[q][2 * e + 1] * (p_hi - c_hi); } }
            const u32x4 lw = *(const u32x4*)(lo + c0), la = *(const u32x4*)(lo + 1024 + c0);
            u32x4 lv = (u32x4){0u, 0u, 0u, 0u}, vfv = (u32x4){0u, 0u, 0u, 0u};
            if (l == 1) { lv = *(const u32x4*)(lo + 3072 + c0); vfv = *(const u32x4*)(VF + (size_t)t * 1024 + c0); }
            float omw[8], av[8], kk[8], k2[8], v2[8]; float ssq = 0.f;
#pragma unroll
            for (int e = 0; e < 8; ++e) {
                const float lwf = (e & 1) ? bfhi(lw[e >> 1]) : bflo(lw[e >> 1]), laf = (e & 1) ? bfhi(la[e >> 1]) : bflo(la[e >> 1]);
                const float wi = w0v[e] + lwf;
                omw[e] = 1.f - __expf(-0.6065306597f * sigmoidf_(wi));
                av[e] = sigmoidf_(a0v[e] + laf);
                kk[e] = xs[1][e] * kkv[e]; ssq += kk[e] * kk[e];
                k2[e] = xs[1][e] * (1.f + (av[e] - 1.f) * kav[e]);
                v2[e] = xs[2][e];
                if (l == 1) { const float lvf = (e & 1) ? bfhi(lv[e >> 1]) : bflo(lv[e >> 1]), vff = (e & 1) ? bfhi(vfv[e >> 1]) : bflo(vfv[e >> 1]);
                    v2[e] = xs[2][e] + (vff - xs[2][e]) * sigmoidf_(v0v[e] + lvf); }
            }
            ssq += DPP_F(ssq, 0xB1); ssq += DPP_F(ssq, 0x4E); ssq += DPP_F(ssq, 0x141);
            const float inv = 1.f / fmaxf(sqrtf(ssq), 1e-12f);
            u32x4 oR, oW, oK, oV, oA, oB, oF;
#pragma unroll
            for (int e = 0; e < 4; ++e) { const float ka = kk[2 * e] * inv, kb = kk[2 * e + 1] * inv;
                oR[e] = pk2(xs[0][2 * e], xs[0][2 * e + 1]); oW[e] = pk2(omw[2 * e], omw[2 * e + 1]); oK[e] = pk2(k2[2 * e], k2[2 * e + 1]); oV[e] = pk2(v2[2 * e], v2[2 * e + 1]);
                oA[e] = pk2(ka, kb); oB[e] = pk2(ka * av[2 * e], kb * av[2 * e + 1]); oF[e] = pk2(xs[2][2 * e], xs[2][2 * e + 1]); }
            const size_t o = (size_t)t * 1024 + c0;
            *(u32x4*)(SR + o) = oR; *(u32x4*)(SW + o) = oW; *(u32x4*)(SK + o) = oK; *(u32x4*)(SV + o) = oV; *(u32x4*)(SA + o) = oA; *(u32x4*)(SB + o) = oB;
            if (l == 0) *(u32x4*)(VF + o) = oF;
        }
    }
    bf16_t* QM = (bf16_t*)(ws + WS_QM); const f32x2* RT = (const f32x2*)(ws + WS_ROPE);
    const int gt = C.wg * 512 + C.tid, ngt = C.G * 512;
    for (int i = gt; i < NT * 4 * 32; i += ngt) { const int t = i >> 7, h = (i >> 5) & 3, j = i & 31;
        bf16_t* q = QM + (size_t)t * 768 + h * 192 + 128; const float x1 = bf2f(q[j]), x2 = bf2f(q[j + 32]); const f32x2 cs = RT[t * 32 + j];
        q[j] = f2bf(x1 * cs.x - x2 * cs.y); q[j + 32] = f2bf(x2 * cs.x + x1 * cs.y); }
}

DI float dot2z(h2_t a, h2_t b) { float d; asm("v_dot2_f32_f16 %0, %1, %2, 0" : "=v"(d) : "v"(a), "v"(b)); return d; }
DI float fma_s(float a, float b, float c) { float d; asm("v_fma_f32 %0, %1, %2, %3" : "=v"(d) : "v"(a), "v"(b), "v"(c)); return d; }
#define ROW_ALLREDUCE(x) do { \
    x += __builtin_bit_cast(float, __builtin_amdgcn_update_dpp(0, __builtin_bit_cast(int, x), 0x128, 0xf, 0xf, true)); \
    x += __builtin_bit_cast(float, __builtin_amdgcn_update_dpp(0, __builtin_bit_cast(int, x), 0x124, 0xf, 0xf, true)); \
    x += __builtin_bit_cast(float, __builtin_amdgcn_update_dpp(0, __builtin_bit_cast(int, x), 0x122, 0xf, 0xf, true)); \
    x += __builtin_bit_cast(float, __builtin_amdgcn_update_dpp(0, __builtin_bit_cast(int, x), 0x121, 0xf, 0xf, true)); } while (0)

DI void phase_scan(const Ctx& C, int l) {
    unsigned char* ws = C.ws; inptr_t in = C.in;
    const bf16_t* SR = (const bf16_t*)(ws + WS_U); float* Yf = (float*)(ws + WS_H);
    constexpr int CH = 32, VECB = CH * 128, BUFB = 5 * VECB + CH * 64, OB = 2 * BUFB;
    LAS unsigned char* lds = C.lds;
    const int tid = C.tid, lane = C.lane, wave = C.wave;
    for (int u = C.vcu; u < 256; u += C.G) {
        const int bh = u >> 2, rg = u & 3, b = bh >> 4, h = bh & 15;
        const size_t tb = (size_t)b * SEQ; const int cb = h * 64;
        const int lt = tid - 256;
        u32x4 pre[3][6];
#define LD_CHUNK(set, c_) do { const size_t t_ = tb + (size_t)(c_) * CH + (lt >> 3); const int j_ = lt & 7; \
            _Pragma("unroll") for (int vq = 0; vq < 5; ++vq) { const int arr = (vq < 3) ? vq : vq + 1; \
                pre[set][vq] = *(const u32x4*)(SR + (size_t)arr * NT * 1024 + t_ * 1024 + cb + 8 * j_); } \
            if (lt < 64) { const size_t tv_ = tb + (size_t)(c_) * CH + (lt >> 1); \
                pre[set][5] = *(const u32x4*)(SR + (size_t)3 * NT * 1024 + tv_ * 1024 + cb + 16 * rg + 8 * (lt & 1)); } } while (0)
#define ST_CHUNK(set, buf_) do { const int step_ = lt >> 3, j_ = lt & 7; \
            _Pragma("unroll") for (int vq = 0; vq < 5; ++vq) { const u32x4 p = pre[set][vq]; f32x4 lo = {bflo(p.x), bfhi(p.x), bflo(p.y), bfhi(p.y)}, hi = {bflo(p.z), bfhi(p.z), bflo(p.w), bfhi(p.w)}; \
                if (vq == 1) { lo = 1.f - lo; hi = 1.f - hi; } \
                if (vq == 3) { lo = -lo; hi = -hi; } \
                const h4_t hl = __builtin_convertvector(lo, h4_t), hh = __builtin_convertvector(hi, h4_t); \
                LAS h4_t* d = (LAS h4_t*)(lds + (buf_) * BUFB + vq * VECB + step_ * 128 + j_ * 16); d[0] = hl; d[1] = hh; } \
            if (lt < 64) { const u32x4 p = pre[set][5]; const f32x4 lo = {bflo(p.x), bfhi(p.x), bflo(p.y), bfhi(p.y)}, hi = {bflo(p.z), bfhi(p.z), bflo(p.w), bfhi(p.w)}; \
                const h4_t hl = __builtin_convertvector(lo, h4_t), hh = __builtin_convertvector(hi, h4_t); \
                LAS h4_t* d = (LAS h4_t*)(lds + (buf_) * BUFB + 5 * VECB + (lt >> 1) * 64 + (lt & 1) * 32); \
                d[0] = (h4_t){hl[0], hl[0], hl[1], hl[1]}; d[1] = (h4_t){hl[2], hl[2], hl[3], hl[3]}; d[2] = (h4_t){hh[0], hh[0], hh[1], hh[1]}; d[3] = (h4_t){hh[2], hh[2], hh[3], hh[3]}; } } while (0)
        h2_t S01 = {(_Float16)0.f, (_Float16)0.f}, S23 = {(_Float16)0.f, (_Float16)0.f};
        const int ks = lane & 15, rowl = wave * 4 + (lane >> 4);
        constexpr int NCH = SEQ / CH;
        const int n_bg = N_MOE_ITEMS + (l == 0 ? N_SMALL_ITEMS : 0);
#define BG_DESC(it_) (((it_) < N_MOE_ITEMS) ? moe_tr_desc(l, (it_), in, ws) : small_tr_desc(1, (it_) - N_MOE_ITEMS, in, ws + WS_L1OFF))
        float tq[32]; int mo_it = (C.wg * 4 + (wave - 4)); bool mo_pending = false; TrDesc mo_d{};
        LAS float* mo_scr = (LAS float*)(lds + OB + 2 * CH * 64) + (wave - 4) * (64 * 33);
        if (wave >= 4) { LD_CHUNK(0, 0); LD_CHUNK(1, 1); LD_CHUNK(2, 2); ST_CHUNK(0, 0); LD_CHUNK(0, 3); }
        __syncthreads();
#define SCAN_ITER(c, setn) do { \
            const int buf = (c) & 1; \
            if (wave >= 4) { \
                if ((c) + 1 < NCH) { ST_CHUNK(setn, buf ^ 1); if ((c) + 4 < NCH) LD_CHUNK(setn, (c) + 4); } \
                if ((c) > 0 && lt < 128) { \
                    const int step = lt >> 2, q4 = lt & 3; const LAS float* ob_ = (const LAS float*)(lds + OB + (((c) - 1) & 1) * (CH * 64)) + (step >> 4) * 256 + (step & 15); \
                    const f32x4 o = {ob_[(4 * q4 + 0) * 16], ob_[(4 * q4 + 1) * 16], ob_[(4 * q4 + 2) * 16], ob_[(4 * q4 + 3) * 16]}; \
                    *(f32x4*)(Yf + (tb + (size_t)((c) - 1) * CH + step) * 1024 + cb + 16 * rg + 4 * q4) = o; } \
                if (((c) & 1) == 0) { if (mo_pending) { tr_store(mo_d, tq, mo_scr, lane); mo_pending = false; } \
                    if (mo_it < n_bg) { mo_d = BG_DESC(mo_it); tr_load(mo_d, tq, lane); mo_pending = true; mo_it += 1024; } } \
            } else { SCAN_BODY(buf); } \
            __syncthreads(); } while (0)
#define SC_LD(X, s_) do { const int so_ = ((s_) & (CH - 1)) * 128; X##r = *(const LAS h4_t*)(bp + 0 * VECB + so_); X##w = *(const LAS h4_t*)(bp + 1 * VECB + so_); X##k = *(const LAS h4_t*)(bp + 2 * VECB + so_); \
            X##a = *(const LAS h4_t*)(bp + 3 * VECB + so_); X##b = *(const LAS h4_t*)(bp + 4 * VECB + so_); X##v = vp[((s_) & (CH - 1)) * 16]; } while (0)
#define DPPF(x, ctl) __builtin_bit_cast(float, __builtin_amdgcn_update_dpp(0, __builtin_bit_cast(int, x), ctl, 0xf, 0xf, true))
#define H_LO(x) __builtin_shufflevector(x, x, 0, 1)
#define H_HI(x) __builtin_shufflevector(x, x, 2, 3)
#define SC_DOT(x) __builtin_amdgcn_fdot2(S01, H_LO(x), dot2z(S23, H_HI(x)), false)
#define SC_FIRST(X) do { float sa = SC_DOT(X##a); \
            const h2_t t01 = S01 * H_LO(X##w) + X##v * H_LO(X##k), t23 = S23 * H_HI(X##w) + X##v * H_HI(X##k); \
            ROW_ALLREDUCE(sa); \
            const _Float16 sh = (_Float16)sa; const h2_t sa2 = {sh, sh}; \
            S01 = sa2 * H_LO(X##b) + t01; S23 = sa2 * H_HI(X##b) + t23; } while (0)
#define SC_PAIR(X, Y, s_) do { float o = SC_DOT(X##r); float sa = SC_DOT(Y##a); \
            const h2_t t01 = S01 * H_LO(Y##w) + Y##v * H_LO(Y##k), t23 = S23 * H_HI(Y##w) + Y##v * H_HI(Y##k); \
            sa += DPPF(sa, 0x128); o += DPPF(o, 0x128); sa += DPPF(sa, 0x124); o += DPPF(o, 0x124); sa += DPPF(sa, 0x122); o += DPPF(o, 0x122); sa += DPPF(sa, 0x121); o += DPPF(o, 0x121); \
            const _Float16 sh = (_Float16)sa; const h2_t sa2 = {sh, sh}; \
            S01 = sa2 * H_LO(Y##b) + t01; S23 = sa2 * H_HI(Y##b) + t23; \
            osel = (ks == (((s_) - 1) & 15)) ? o : osel; if ((((s_) - 1) & 15) == 15) op16[(((s_) - 1) >> 4) * 256] = osel; } while (0)
#define SC_LAST(X, s_) do { float o = SC_DOT(X##r); ROW_ALLREDUCE(o); osel = (ks == ((s_) & 15)) ? o : osel; op16[((s_) >> 4) * 256] = osel; } while (0)
#define SCAN_BODY(buf_) do { \
            const LAS unsigned char* bp = lds + (buf_) * BUFB + ks * 8; \
            const LAS h2_t* vp = (const LAS h2_t*)(lds + (buf_) * BUFB + 5 * VECB) + rowl; \
            LAS float* op16 = (LAS float*)(lds + OB + (buf_) * (CH * 64)) + rowl * 16 + ks; float osel = 0.f;     \
            h4_t Ar, Aw, Ak, Aa, Ab, Br, Bw, Bk, Ba, Bb, Cr, Cw, Ck, Ca, Cb, Dr, Dw, Dk, Da, Db; h2_t Av, Bv, Cv, Dv; \
            SC_LD(A, 0); SC_LD(B, 1); SC_LD(C, 2); SC_LD(D, 3); \
            SC_FIRST(A); \
            _Pragma("unroll 2") for (int s = 0; s < CH - 4; s += 4) { \
                SC_PAIR(A, B, s + 1); SC_LD(A, s + 4); \
                SC_PAIR(B, C, s + 2); SC_LD(B, s + 5); \
                SC_PAIR(C, D, s + 3); SC_LD(C, s + 6); \
                SC_PAIR(D, A, s + 4); SC_LD(D, s + 7); } \
            SC_PAIR(A, B, CH - 3); SC_PAIR(B, C, CH - 2); SC_PAIR(C, D, CH - 1); SC_LAST(D, CH - 1); } while (0)
#pragma unroll 1
        for (int c = 0; c < NCH; c += 3) { SCAN_ITER(c, 1); if (c + 1 < NCH) SCAN_ITER(c + 1, 2); if (c + 2 < NCH) SCAN_ITER(c + 2, 0); }
#undef SC_LD
#undef SC_FIRST
#undef SC_PAIR
#undef SC_LAST
#undef DPPF
#undef H_LO
#undef H_HI
#undef SC_DOT
#undef SCAN_BODY
#undef SCAN_ITER
#undef LD_CHUNK
#undef ST_CHUNK
        if (wave >= 4) { if (mo_pending) tr_store(mo_d, tq, mo_scr, lane);
            for (; mo_it < n_bg; mo_it += 1024) { const TrDesc d = BG_DESC(mo_it); tr_load(d, tq, lane); tr_store(d, tq, mo_scr, lane); } }
#undef BG_DESC
        if (wave >= 4 && lt < 128) { const int c = NCH; const int step = lt >> 2, q4 = lt & 3; const LAS float* ob_ = (const LAS float*)(lds + OB + ((c - 1) & 1) * (CH * 64)) + (step >> 4) * 256 + (step & 15);
            const f32x4 o = {ob_[(4 * q4 + 0) * 16], ob_[(4 * q4 + 1) * 16], ob_[(4 * q4 + 2) * 16], ob_[(4 * q4 + 3) * 16]};
            *(f32x4*)(Yf + (tb + (size_t)(c - 1) * CH + step) * 1024 + cb + 16 * rg + 4 * q4) = o; }
        __syncthreads();
    }
}

DI void phase_post(const Ctx& C, int l) {
    inptr_t in = C.in; unsigned char* ws = C.ws;
    const float* Yf = (const float*)(ws + WS_H); const bf16_t* LO = (const bf16_t*)(ws + WS_LORAO);
    const bf16_t* SR = (const bf16_t*)(ws + WS_U); const bf16_t* SK = SR + (size_t)2 * NT * 1024; const bf16_t* SV = SR + (size_t)3 * NT * 1024;
    bf16_t* Y = (bf16_t*)(ws + WS_PRW);
    const float* rk = in[20] + (size_t)l * 1024; const float* lnw = in[21] + (size_t)l * 1024; const float* lnb = in[22] + (size_t)l * 1024;
    const int lane = C.lane;
    for (int t = C.gw; t < NT; t += C.ngw) {
#pragma unroll
        for (int j = 0; j < 2; ++j) {
            const int c0 = 8 * lane + 512 * j; const size_t o = (size_t)t * 1024 + c0;
            const f32x4 y0 = *(const f32x4*)(Yf + o), y1 = *(const f32x4*)(Yf + o + 4);
            const u32x4 rr = *(const u32x4*)(SR + o), kq = *(const u32x4*)(SK + o), vq = *(const u32x4*)(SV + o), gq = *(const u32x4*)(LO + (size_t)t * 4096 + 2048 + c0);
            float y[8], rk8[8], lw8[8], lb8[8];
#pragma unroll
            for (int e = 0; e < 2; ++e) { const f32x4 a = *(const f32x4*)(rk + c0 + 4 * e), b = *(const f32x4*)(lnw + c0 + 4 * e), c = *(const f32x4*)(lnb + c0 + 4 * e);
#pragma unroll
                for (int i = 0; i < 4; ++i) { rk8[4 * e + i] = a[i]; lw8[4 * e + i] = b[i]; lb8[4 * e + i] = c[i]; y[4 * e + i] = e ? y1[i] : y0[i]; } }
            float sm = 0.f, bs = 0.f; float r8[8], k8[8], v8[8], g8[8];
#pragma unroll
            for (int e = 0; e < 8; ++e) { r8[e] = (e & 1) ? bfhi(rr[e >> 1]) : bflo(rr[e >> 1]); k8[e] = (e & 1) ? bfhi(kq[e >> 1]) : bflo(kq[e >> 1]);
                v8[e] = (e & 1) ? bfhi(vq[e >> 1]) : bflo(vq[e >> 1]); g8[e] = (e & 1) ? bfhi(gq[e >> 1]) : bflo(gq[e >> 1]);
                sm += y[e]; bs += r8[e] * k8[e] * rk8[e]; }
            sm += DPP_F(sm, 0xB1); sm += DPP_F(sm, 0x4E); sm += DPP_F(sm, 0x141);
            bs += DPP_F(bs, 0xB1); bs += DPP_F(bs, 0x4E); bs += DPP_F(bs, 0x141);
            const float mean = sm * (1.f / 64.f); float vs = 0.f;
#pragma unroll
            for (int e = 0; e < 8; ++e) { y[e] -= mean; vs += y[e] * y[e]; }
            vs += DPP_F(vs, 0xB1); vs += DPP_F(vs, 0x4E); vs += DPP_F(vs, 0x141);
            const float rs = rsqrtf(vs * (1.f / 64.f) + 64e-5f);
            u32x4 ov;
#pragma unroll
            for (int e = 0; e < 4; ++e) { const float o0 = (y[2 * e] * rs * lw8[2 * e] + lb8[2 * e] + bs * v8[2 * e]) * g8[2 * e], o1 = (y[2 * e + 1] * rs * lw8[2 * e + 1] + lb8[2 * e + 1] + bs * v8[2 * e + 1]) * g8[2 * e + 1];
                ov[e] = pk2(o0, o1); }
            *(u32x4*)(Y + (size_t)t * 2048 + c0) = ov;
        }
    }
}

struct AttnP {
    const bf16_t* Q; int qpitch, qcol0;
    const bf16_t* K1; int k1pitch, k1col0;
    const bf16_t* K2; int k2pitch, k2col0;
    const bf16_t* V; int vpitch, vcol0;
    bf16_t* O; int opitch, ocol0;
    size_t qrow0, krow0;
    int q0;
    int nkeys;
    float c1;
    const int* pos; const float* lut;
    float lam, outscale; const float* subw;
    int dbg;
};

template <int DQK, int DK1, int MODE, int KT, int PFD>
DI void attn_unit(LAS unsigned char* lds, const AttnP& P) {
    constexpr int DV = 128, KP = DQK * 2 + 16, VP = DV * 2 + 64;
    constexpr int NBLK = KT / 32;
    constexpr int KTILE = KT * KP, VTILE = KT * VP;
    constexpr int NVT = (MODE == 0) ? 1 : 2;
    constexpr int VSLOT = NVT * VTILE + 256;
    constexpr int OFF_V = 2 * KTILE, OFF_POS = NVT * VTILE, OFF_LUT = OFF_V + 2 * VSLOT, OFF_END = OFF_LUT + 512;
    constexpr int OFF_OST = 4 * 17408, OSTP = 272;
    static_assert(OFF_END <= LDS_MAIN && OFF_OST + 4 * 32 * OSTP <= LDS_MAIN, "attention LDS");
    constexpr int KCH = DQK / 8, K1CH = DK1 / 8;
    constexpr int NKC = 2 * KT * KCH, NVC = NVT * KT * 16, NKCH = NKC / 512, NVCH = NVC / 512, NCHK = NKCH + NVCH;
    static_assert(NKC % 512 == 0 && NVC % 512 == 0, "chunks");
    constexpr float NEG = -1e30f, THR = 8.f;
    constexpr int KSTEP = (MODE == 0) ? KT : 2 * KT;
    int tid = threadIdx.x; asm volatile("" : "+v"(tid));
    const int lane = tid & 63, wave = __builtin_amdgcn_readfirstlane(tid >> 6);
    const int qg = wave >> 1, st = wave & 1, r32 = lane & 31, h2 = lane >> 5;
    const int qw0 = P.q0 + 32 * qg;
    const int myq = qw0 + r32;
    bf16x8 qf[DQK / 16];
    {
        const bf16_t* qp = P.Q + (P.qrow0 + myq) * (size_t)P.qpitch + P.qcol0 + ((MODE == 0) ? st * 64 : 0) + 8 * h2;
#pragma unroll
        for (int ks = 0; ks < DQK / 16; ++ks) qf[ks] = *(const bf16x8*)(qp + 16 * ks);
    }
    int mypos = 0, posq0 = 0;
    if constexpr (MODE == 0) { mypos = P.pos[myq]; posq0 = P.pos[qw0]; if (tid < 128) ((LAS float*)(lds + OFF_LUT))[tid] = P.lut[tid]; }
    f32x16 o[4];
#pragma unroll
    for (int d = 0; d < 4; ++d)
#pragma unroll
        for (int i = 0; i < 16; ++i) o[d][i] = 0.f;
    float m_run = NEG, l_run = 0.f;
    const int nsteps = P.nkeys / KSTEP;
    const char* gp[NCHK]; unsigned adv[NCHK]; unsigned ldst[NCHK];
#pragma unroll
    for (int i = 0; i < NKCH; ++i) { const int c = tid + 512 * i; const int s = c / (KT * KCH), rc = c % (KT * KCH), row = rc / KCH, ch = rc % KCH;
        const int key = (MODE == 0) ? row : s * KT + row;
        if (ch < K1CH) { gp[i] = (const char*)(P.K1 + (P.krow0 + key) * (size_t)P.k1pitch + P.k1col0 + ((MODE == 0) ? s * 64 : 0) + ch * 8); adv[i] = (unsigned)(KSTEP * P.k1pitch * 2); }
        else { gp[i] = (const char*)(P.K2 + (P.krow0 + key) * (size_t)P.k2pitch + P.k2col0 + (ch - K1CH) * 8); adv[i] = (unsigned)(KSTEP * P.k2pitch * 2); }
        ldst[i] = (unsigned)(s * KTILE + row * KP + ch * 16); }
#pragma unroll
    for (int i = 0; i < NVCH; ++i) { const int c2 = tid + 512 * i; const int s = c2 / (KT * 16), rc = c2 % (KT * 16), row = rc / 16, ch = rc % 16;
        const int key = (MODE == 0) ? row : s * KT + row;
        gp[NKCH + i] = (const char*)(P.V + (P.krow0 + key) * (size_t)P.vpitch + P.vcol0 + ch * 8); adv[NKCH + i] = (unsigned)(KSTEP * P.vpitch * 2);
        ldst[NKCH + i] = (unsigned)(s * VTILE + row * VP + ch * 16); }
    u32x4 preK[PFD][NKCH], preV[PFD][NVCH]; int prepos[2] = {0, 0};
#define KSET(par) ((PFD == 2) ? ((par) ^ 1) : 0)
#define VSET(par) ((PFD == 2) ? (par) : 0)
#define ATT_PREFETCH_K(set_) do { _Pragma("unroll") for (int i = 0; i < NKCH; ++i) { preK[set_][i] = *(const u32x4*)gp[i]; gp[i] += adv[i]; } } while (0)
#define ATT_PREFETCH_V(set_, step_) do { _Pragma("unroll") for (int i = 0; i < NVCH; ++i) { preV[set_][i] = *(const u32x4*)gp[NKCH + i]; gp[NKCH + i] += adv[NKCH + i]; } \
        if constexpr (MODE == 0) { if (tid < KT) prepos[set_] = P.pos[(step_) * KT + tid]; } } while (0)
#define ATT_STAGE_K(set_) do { _Pragma("unroll") for (int i = 0; i < NKCH; ++i) *(LAS u32x4*)(lds + ldst[i]) = preK[set_][i]; } while (0)
#define ATT_STAGE_V(set_, vo_) do { _Pragma("unroll") for (int i = 0; i < NVCH; ++i) *(LAS u32x4*)(lds + (vo_) + ldst[NKCH + i]) = preV[set_][i]; \
        if constexpr (MODE == 0) { if (tid < KT) ((LAS int*)(lds + (vo_) + OFF_POS))[tid] = prepos[set_]; } } while (0)
#define ATT_QK(dst) do { const LAS unsigned char* kb_ = lds + st * KTILE + r32 * KP + 16 * h2; \
        _Pragma("unroll") for (int blk = 0; blk < NBLK; ++blk) { \
            _Pragma("unroll") for (int i = 0; i < 16; ++i) dst[blk][i] = 0.f; \
            _Pragma("unroll") for (int ks = 0; ks < DQK / 16; ++ks) { const bf16x8 kf = *(const LAS bf16x8*)(kb_ + blk * 32 * KP + ks * 32); dst[blk] = __builtin_amdgcn_mfma_f32_32x32x16_bf16(kf, qf[ks], dst[blk], 0, 0, 0); } } } while (0)
#define ATT_VLD(j_) do { const int d_ = (j_) / (2 * NBLK), r_ = (j_) % (2 * NBLK); const LAS unsigned char* vp_ = vb_ + (16 * r_) * VP + d_ * 64; \
            vlo_[(j_) & 1] = __builtin_bit_cast(s16x4, __builtin_amdgcn_ds_read_tr16_b64_v4i16((LAS v4i16_t*)vp_)); \
            vhi_[(j_) & 1] = __builtin_bit_cast(s16x4, __builtin_amdgcn_ds_read_tr16_b64_v4i16((LAS v4i16_t*)(vp_ + 8 * VP))); } while (0)
#define ATT_PV(vo_) do { const int sv_ = (MODE == 0) ? 0 : st; \
        const LAS unsigned char* vb_ = lds + (vo_) + sv_ * VTILE + (4 * h2 + ((lane & 15) >> 2)) * VP + ((lane >> 4) & 1) * 32 + (lane & 3) * 8; \
        s16x4 vlo_[2], vhi_[2]; ATT_VLD(0); \
        _Pragma("unroll") for (int j = 0; j < 8 * NBLK; ++j) { if (j + 1 < 8 * NBLK) ATT_VLD(j + 1); \
            const s16x4 lo_ = vlo_[j & 1], hi_ = vhi_[j & 1]; const bf16x8 vf_ = {lo_[0], lo_[1], lo_[2], lo_[3], hi_[0], hi_[1], hi_[2], hi_[3]}; \
            const int d_ = j / (2 * NBLK), r_ = j % (2 * NBLK); \
            o[d_] = __builtin_amdgcn_mfma_f32_32x32x16_bf16(vf_, pf[r_ >> 1][r_ & 1], o[d_], 0, 0, 0); } } while (0)
    f32x16 sc[NBLK]; bf16x8 pf[NBLK][2]; bool pv_pending = false;
    const bool order_b = (wave & 1) != 0;
    auto att_body = [&](int step, int vo_cur, int vo_prev) {
        const int k0 = step * KSTEP + ((MODE == 0) ? 0 : st * KT);
        const bool valid_next = (step + 1 < nsteps) && (MODE == 2 || k0 + KSTEP <= qw0 + 31);
        const bool valid = (MODE == 2) || (k0 <= qw0 + 31);
        if (!order_b && pv_pending && !(P.dbg & 1)) ATT_PV(vo_prev);
        pv_pending = valid && !order_b;
        if (valid && !(P.dbg & 2)) {
        const bool need_mask = (MODE != 2) && (k0 + KT - 1 > qw0);
        float bb = 0.f; bool near = false;
        if constexpr (MODE == 0) {
            const LAS float* lut = (const LAS float*)(lds + OFF_LUT);
            const LAS int* pk = (const LAS int*)(lds + vo_cur + OFF_POS);
            near = (posq0 - pk[KT - 1]) < 127;
            if (near) {
#pragma unroll
                for (int blk = 0; blk < NBLK; ++blk)
#pragma unroll
                    for (int i = 0; i < 16; ++i) { const int kl = 32 * blk + (i & 3) + 8 * (i >> 2) + 4 * h2; int rel = mypos - pk[kl]; rel = rel < 0 ? 0 : (rel > 127 ? 127 : rel);
                        sc[blk][i] = sc[blk][i] * P.c1 + lut[rel]; }
            } else bb = lut[127];
        }
        if (need_mask) {
#pragma unroll
            for (int blk = 0; blk < NBLK; ++blk)
#pragma unroll
                for (int i = 0; i < 16; ++i) { const int key = k0 + 32 * blk + (i & 3) + 8 * (i >> 2) + 4 * h2; if (key > myq) sc[blk][i] = NEG; }
        }
        const float cc = near ? 1.f : P.c1;
        float mx = sc[0][0];
#pragma unroll
        for (int blk = 0; blk < NBLK; ++blk)
#pragma unroll
            for (int i = 0; i < 16; ++i) mx = fmaxf(mx, sc[blk][i]);
        { const int mi = __builtin_bit_cast(int, mx); auto rr = __builtin_amdgcn_permlane32_swap(mi, mi, false, false); mx = fmaxf(__builtin_bit_cast(float, (int)rr[0]), __builtin_bit_cast(float, (int)rr[1])); }
        mx = mx * cc + bb;
        if (__any(mx > m_run + THR)) {
            const float m_new = fmaxf(m_run, mx);
            const float alpha = __builtin_amdgcn_exp2f(m_run - m_new);
            m_run = m_new; l_run *= alpha;
#pragma unroll
            for (int d = 0; d < 4; ++d)
#pragma unroll
                for (int i = 0; i < 16; ++i) o[d][i] *= alpha;
        }
        const float off = bb - m_run;
        float psum = 0.f;
#pragma unroll
        for (int blk = 0; blk < NBLK; ++blk)
#pragma unroll
            for (int i = 0; i < 16; ++i) { const float p = __builtin_amdgcn_exp2f(__builtin_fmaf(sc[blk][i], cc, off)); sc[blk][i] = p; psum += p; }
        l_run += psum;
#pragma unroll
        for (int blk = 0; blk < NBLK; ++blk)
#pragma unroll
            for (int s16 = 0; s16 < 2; ++s16) { u32x4 w; w.x = pk2(sc[blk][8 * s16 + 0], sc[blk][8 * s16 + 1]); w.y = pk2(sc[blk][8 * s16 + 2], sc[blk][8 * s16 + 3]);
                w.z = pk2(sc[blk][8 * s16 + 4], sc[blk][8 * s16 + 5]); w.w = pk2(sc[blk][8 * s16 + 6], sc[blk][8 * s16 + 7]); pf[blk][s16] = __builtin_bit_cast(bf16x8, w); }
        }
        if (order_b && valid && !(P.dbg & 1)) ATT_PV(vo_cur);
        if (valid_next && !(P.dbg & 4)) ATT_QK(sc);
        };
#define ATT_BODY(step, vc, vp) att_body(step, vc, vp)
    ATT_PREFETCH_K(0);
    __syncthreads();
    ATT_STAGE_K(0);
    if (nsteps > 1) ATT_PREFETCH_K(KSET(0));
    if (PFD == 2 && nsteps > 2) ATT_PREFETCH_K(0);
    ATT_PREFETCH_V(0, 0);
    if (PFD == 2 && nsteps > 1) ATT_PREFETCH_V(1, 1);
    __syncthreads();
    ATT_QK(sc);
#define ATT_BAR() asm volatile("s_waitcnt lgkmcnt(0)\n\ts_barrier" ::: "memory")
#define ATT_ITER(step, par) do { \
        const int vo_cur = OFF_V + (par) * VSLOT, vo_prev = OFF_V + ((par) ^ 1) * VSLOT; \
        ATT_BAR();                                                  \
        if (!(P.dbg & 8)) { if ((step) + 1 < nsteps) ATT_STAGE_K(KSET(par)); \
        ATT_STAGE_V(VSET(par), vo_cur); } \
        ATT_BAR();                                                  \
        if (!(P.dbg & 8)) { if ((step) + 1 + PFD < nsteps) ATT_PREFETCH_K(KSET(par)); \
        if ((step) + PFD < nsteps) ATT_PREFETCH_V(VSET(par), (step) + PFD); } \
        ATT_BODY(step, vo_cur, vo_prev); } while (0)
    for (int step = 0; step < nsteps; step += 2) { ATT_ITER(step, 0); if (step + 1 < nsteps) ATT_ITER(step + 1, 1); }
    if (pv_pending) ATT_PV(OFF_V + ((nsteps - 1) & 1) * VSLOT);
#undef ATT_PREFETCH_K
#undef ATT_PREFETCH_V
#undef ATT_STAGE_K
#undef ATT_STAGE_V
#undef ATT_QK
#undef ATT_PV
#undef ATT_VLD
#undef ATT_ITER
#undef ATT_BAR
#undef ATT_BODY
#undef KSET
#undef VSET
    l_run += __shfl_xor(l_run, 32);
    __syncthreads();
    LAS float* mb = (LAS float*)(lds + qg * 17408);
    if (st == 1) {
        if constexpr (MODE == 0) { const float inv = 1.f / l_run;
#pragma unroll
            for (int d = 0; d < 4; ++d)
#pragma unroll
                for (int i = 0; i < 16; ++i) mb[(d * 16 + i) * 64 + lane] = o[d][i] * inv;
        } else {
#pragma unroll
            for (int d = 0; d < 4; ++d)
#pragma unroll
                for (int i = 0; i < 16; ++i) mb[(d * 16 + i) * 64 + lane] = o[d][i];
            mb[4096 + lane] = m_run; mb[4160 + lane] = l_run;
        }
    }
    __syncthreads();
    if (st == 0) {
        if constexpr (MODE == 0) {
            const float inv = 1.f / l_run; float ss = 0.f;
#pragma unroll
            for (int d = 0; d < 4; ++d)
#pragma unroll
                for (int i = 0; i < 16; ++i) { const float v = o[d][i] * inv - P.lam * mb[(d * 16 + i) * 64 + lane]; o[d][i] = v; ss += v * v; }
            ss += __shfl_xor(ss, 32);
            const float rn = rsqrtf(ss * (1.f / 128.f) + 1e-5f) * P.outscale;
#pragma unroll
            for (int d = 0; d < 4; ++d)
#pragma unroll
                for (int i = 0; i < 16; ++i) { const int dv = 32 * d + (i & 3) + 8 * (i >> 2) + 4 * h2; o[d][i] = o[d][i] * rn * P.subw[dv]; }
        } else {
            const float m1 = mb[4096 + lane], l1 = mb[4160 + lane];
            const float mt = fmaxf(m_run, m1); const float a0 = __builtin_amdgcn_exp2f(m_run - mt), a1 = __builtin_amdgcn_exp2f(m1 - mt);
            const float inv = 1.f / (l_run * a0 + l1 * a1);
#pragma unroll
            for (int d = 0; d < 4; ++d)
#pragma unroll
                for (int i = 0; i < 16; ++i) o[d][i] = (o[d][i] * a0 + mb[(d * 16 + i) * 64 + lane] * a1) * inv;
        }
        LAS unsigned char* og = lds + OFF_OST + qg * (32 * OSTP);
#pragma unroll
        for (int d = 0; d < 4; ++d)
#pragma unroll
            for (int g4 = 0; g4 < 4; ++g4) { u32x2 w; w.x = pk2(o[d][4 * g4 + 0], o[d][4 * g4 + 1]); w.y = pk2(o[d][4 * g4 + 2], o[d][4 * g4 + 3]);
                *(LAS u32x2*)(og + r32 * OSTP + (32 * d + 8 * g4 + 4 * h2) * 2) = w; }
        asm volatile("s_waitcnt lgkmcnt(0)" ::: "memory");
        bf16_t* op = P.O + (P.qrow0 + qw0) * (size_t)P.opitch + P.ocol0;
#pragma unroll
        for (int i = 0; i < 8; ++i) { const int row = 4 * i + (lane >> 4), ch = lane & 15;
            const u32x4 v = *(const LAS u32x4*)(og + row * OSTP + ch * 16);
            *(u32x4*)(op + (size_t)row * P.opitch + ch * 8) = v; }
    }
    __syncthreads();
}

DI void phase_att(const Ctx& C, int l) {
    inptr_t in = C.in; unsigned char* ws = C.ws;
    const int ATT_SEL = C.att_sel & 0xff; const int dbg = C.att_sel >> 8;
    if (ATT_SEL & 1) phase_post(C, l);
    bf16_t* Y = dbg ? (bf16_t*)(ws + WS_H) : (bf16_t*)(ws + WS_PRW); const bf16_t* PATT = (const bf16_t*)(ws + WS_PATT);
    const float lambda_init = 0.8f - 0.6f * expf(-0.3f * (float)l);
    float lam;
    { const float a = wave_sum(in[23][l * 64 + C.lane] * in[24][l * 64 + C.lane]), b = wave_sum(in[25][l * 64 + C.lane] * in[26][l * 64 + C.lane]); lam = expf(a) - expf(b) + lambda_init; }
    if (ATT_SEL & 2) for (int w = C.vcu; w < 256; w += C.G) {
        const int bh = w >> 4, j = w & 15, b = bh >> 2, h = bh & 3;
#pragma unroll 1
        for (int k = 0; k < 2; ++k) { const int qb = k ? 31 - j : j;
            AttnP P; P.Q = PATT; P.qpitch = PATT_COLS; P.qcol0 = h * 128; P.K1 = PATT; P.k1pitch = PATT_COLS; P.k1col0 = 512 + h * 128; P.K2 = PATT; P.k2pitch = 0; P.k2col0 = 0;
            P.V = PATT; P.vpitch = PATT_COLS; P.vcol0 = 1024 + h * 128; P.O = Y; P.opitch = 2048; P.ocol0 = 1024 + h * 128;
            P.qrow0 = (size_t)b * SEQ; P.krow0 = (size_t)b * SEQ; P.q0 = qb * 128; P.nkeys = qb * 128 + 128; P.c1 = 0.125f * LOG2E;
            P.pos = (const int*)in[2] + b * SEQ; P.lut = (const float*)(ws + WS_LUT) + h * 128; P.lam = lam; P.outscale = 1.f - lambda_init; P.subw = in[27] + l * 128; P.dbg = dbg;
            attn_unit<64, 64, 0, 64, 1>(C.lds, P); }
    }
    const bf16_t* QM = (const bf16_t*)(ws + WS_QM); const bf16_t* KVM = (const bf16_t*)(ws + WS_KVM); const bf16_t* KPE = (const bf16_t*)(ws + WS_KPE);
    if (ATT_SEL & 4) for (int w = C.vcu; w < 256; w += C.G) {
        const int bh = w >> 4, j = w & 15, b = bh >> 2, h = bh & 3;
#pragma unroll 1
        for (int k = 0; k < 2; ++k) { const int qb = k ? 31 - j : j;
            AttnP P; P.Q = QM; P.qpitch = 768; P.qcol0 = h * 192; P.K1 = KVM; P.k1pitch = 1024; P.k1col0 = h * 256; P.K2 = KPE; P.k2pitch = 64; P.k2col0 = 0;
            P.V = KVM; P.vpitch = 1024; P.vcol0 = h * 256 + 128; P.O = Y; P.opitch = 2048; P.ocol0 = 1536 + h * 128;
            P.qrow0 = (size_t)b * SEQ; P.krow0 = (size_t)b * SEQ; P.q0 = qb * 128; P.nkeys = qb * 128 + 128; P.c1 = 0.07216878364870322f * LOG2E;
            P.pos = nullptr; P.lut = nullptr; P.lam = 0.f; P.outscale = 0.f; P.subw = nullptr; P.dbg = dbg;
            attn_unit<192, 128, 1, 32, 1>(C.lds, P); }
    }
}

DI void phase_cross(const Ctx& C) {
    unsigned char* ws = C.ws; const int dbg = 0;
    const bf16_t* CAQ = (const bf16_t*)(ws + WS_CAQ); const bf16_t* MKV = (const bf16_t*)(ws + WS_MEMKV); bf16_t* CAO = (bf16_t*)(ws + WS_CAO);
    for (int u = C.vcu; u < 512; u += C.G) {
        const int bh = u >> 5, qb = u & 31, b = bh >> 2, h = bh & 3;
        AttnP P; P.Q = CAQ; P.qpitch = 512; P.qcol0 = h * 128; P.K1 = MKV; P.k1pitch = 1024; P.k1col0 = h * 128; P.K2 = MKV; P.k2pitch = 0; P.k2col0 = 0;
        P.V = MKV; P.vpitch = 1024; P.vcol0 = 512 + h * 128; P.O = CAO; P.opitch = 512; P.ocol0 = h * 128;
        P.qrow0 = (size_t)b * SEQ; P.krow0 = (size_t)b * MEMLEN; P.q0 = qb * 128; P.nkeys = MEMLEN; P.c1 = 0.08838834764831845f * LOG2E;
        P.pos = nullptr; P.lut = nullptr; P.lam = 0.f; P.outscale = 0.f; P.subw = nullptr; P.dbg = dbg;
        attn_unit<128, 128, 2, 64, 1>(C.lds, P);
    }
}

DI void phase_route(const Ctx& C, int l) {
    inptr_t in = C.in; unsigned char* ws = C.ws;
    const float* LG = (const float*)(ws + WS_LOGITS);
    const float* bg = in[39] + l * 4; const float* be = in[41] + l * 32;
    int* EID = (int*)(ws + WS_EID); float* GATE = (float*)(ws + WS_GATE); int* CNT = (int*)(ws + WS_CNT);
    LAS int* hist = (LAS int*)(C.lds);
    const int lane = C.lane;
    for (int wgt = C.wg; wgt < 256; wgt += C.G) {
        if (C.tid < 32) hist[C.tid] = 0;
        __syncthreads();
#pragma unroll 1
        for (int r = 0; r < 8; ++r) {
            const int t = wgt * 64 + C.wave * 8 + r;
            const float raw = (lane < 36) ? LG[(size_t)t * 256 + lane] : 0.f;
            const float g0 = RDL_F(raw, 32), g1 = RDL_F(raw, 33), g2 = RDL_F(raw, 34), g3 = RDL_F(raw, 35);
            int sel = 0; float best = g0 + bg[0];
            if (g1 + bg[1] > best) { best = g1 + bg[1]; sel = 1; }
            if (g2 + bg[2] > best) { best = g2 + bg[2]; sel = 2; }
            if (g3 + bg[3] > best) { best = g3 + bg[3]; sel = 3; }
            const float gm = fmaxf(fmaxf(g0, g1), fmaxf(g2, g3));
            const float e0 = __expf(g0 - gm), e1 = __expf(g1 - gm), e2 = __expf(g2 - gm), e3 = __expf(g3 - gm);
            const float es = sel == 0 ? e0 : (sel == 1 ? e1 : (sel == 2 ? e2 : e3));
            const float pgrp = es / ((e0 + e1) + (e2 + e3));
            float val = (lane < 32 && (lane >> 3) == sel) ? raw + be[lane & 31] : -INFINITY;
            const float m1 = wave_max(val); const int i1 = __ffsll((long long)__ballot(val == m1)) - 1;
            if (lane == i1) val = -INFINITY;
            const float m2 = wave_max(val); const int i2 = __ffsll((long long)__ballot(val == m2)) - 1;
            const float r1 = __shfl(raw, i1), r2 = __shfl(raw, i2);
            const float w1 = 1.f / (1.f + __expf(r2 - r1)), w2 = 1.f - w1;
            if (lane == 0) { EID[2 * t] = i1; EID[2 * t + 1] = i2; GATE[2 * t] = w1 * pgrp; GATE[2 * t + 1] = w2 * pgrp;
                atomicAdd((int*)&hist[i1], 1); atomicAdd((int*)&hist[i2], 1); }
        }
        __syncthreads();
        if (C.tid < 32) CNT[wgt * 32 + C.tid] = hist[C.tid];
        __syncthreads();
    }
}

DI void phase_dispatch(const Ctx& C) {
    unsigned char* ws = C.ws;
    const int* EID = (const int*)(ws + WS_EID); const int* CNT = (const int*)(ws + WS_CNT);
    int* ROWMAP = (int*)(ws + WS_ROWMAP); int* ROWDST = (int*)(ws + WS_ROWDST); int* TILEEXP = (int*)(ws + WS_TILEEXP);
    LAS int* tot = (LAS int*)(C.lds); LAS int* base = tot + 32; LAS int* off = base + 32; LAS int* eid = off + 40; LAS int* posl = eid + 128;
    const int tid = C.tid;
    for (int wgt = C.wg; wgt < 256; wgt += C.G) {
        { LAS int* cl = posl + 128;
#pragma unroll
          for (int i = 0; i < 16; ++i) cl[tid + 512 * i] = CNT[tid + 512 * i];
          __syncthreads();
          if (tid < 32) { int s = 0, bsum = 0; for (int w = 0; w < 256; ++w) { const int c = cl[w * 32 + tid]; if (w == wgt) bsum = s; s += c; } tot[tid] = s; base[tid] = bsum; } }
        if (tid >= 64 && tid < 192) eid[tid - 64] = EID[wgt * 128 + (tid - 64)];
        __syncthreads();
        if (tid == 0) { int o = 0; for (int e = 0; e < 32; ++e) { off[e] = o; o += (tot[e] + 255) & ~255; } off[32] = o; }
        __syncthreads();
        if (tid < 128) { const int e = eid[tid]; int rank = 0; for (int j = 0; j < tid; ++j) rank += (eid[j] == e) ? 1 : 0;
            const int pos = off[e] + base[e] + rank; ROWMAP[pos] = wgt * 64 + (tid >> 1); ROWDST[pos] = wgt * 128 + tid; }
        if (wgt < 32) { const int e = wgt; for (int p = off[e] + tot[e] + tid; p < off[e + 1]; p += 512) { ROWMAP[p] = 0; ROWDST[p] = -1; } }
        if (wgt == 0) { if (tid < 32) { for (int tl = off[tid] >> 8; tl < (off[tid + 1] >> 8); ++tl) TILEEXP[tl] = tid; } if (tid == 0) TILEEXP[200] = off[32] >> 8; }
        __syncthreads();
    }
}

#ifndef PHASE_MASK
#define PHASE_MASK 0x1ffff
#endif
#define IN(k) (lo <= (k) && (k) < hi)
#define EN(j) ((PHASE_MASK >> (j)) & 1)
#define SEAM(k) do { if (IN(k) && IN((k) + 1)) xcd_barrier(bar); } while (0)
#define PH_BEGIN() do { int t_ = threadIdx.x; asm volatile("" : "+v"(t_)); kaptr_t ka_ = (kaptr_t)__builtin_amdgcn_kernarg_segment_ptr(); asm volatile("" : "+s"(ka_)); \
        C.lds = (LAS unsigned char*)lds_raw; C.in = (inptr_t)ka_; C.X = *(float* const CAS*)(ka_ + 360); C.ws = *(unsigned char* const CAS*)(ka_ + 368); \
        C.tid = t_; C.lane = t_ & 63; C.wave = __builtin_amdgcn_readfirstlane(t_ >> 6); { int g_ = gridDim.x, b_ = blockIdx.x; asm volatile("" : "+s"(g_), "+s"(b_)); C.G = g_; C.wg = b_; } C.gw = C.wg * 8 + C.wave; C.ngw = C.G * 8; C.vcu = (C.G % 8 == 0) ? (C.wg % 8) * (C.G / 8) + C.wg / 8 : C.wg; \
        ws = C.ws; in = C.in; } while (0)
constexpr int PPL = 16, NPHASE = 2 * PPL + 1;
template <int l>
DI void run_layer(unsigned char* lds_raw, const XcdBarrier& bar, int lo, int hi, int att_sel = 7) {
    Ctx C; unsigned char* ws; inptr_t in; C.att_sel = att_sel;
    constexpr int pb = l * PPL;

        if (EN(0) && IN(pb + 0)) { PH_BEGIN(); phase_convert(C, l); } SEAM(pb + 0);
        if (EN(1) && IN(pb + 1)) { PH_BEGIN();
            { pg8::Gemm g{(const bf16_t*)(ws + WS_XB), (const bf16_t*)(ws + wofs(l) + WS_WINT), DM, DM, DM, nullptr}; pg8::StaticOrder S; S.init(NT, INP, C.G, C.wg, DM);
              pg8::EpiBf16 E{(bf16_t*)(ws + WS_PRW), RW_COLS, (bf16_t*)(ws + WS_PATT), PATT_COLS, 13, (const float*)(ws + WS_SSQM), 1};
              pg8::gemm_phase<pg8::EpiBf16, pg8::StaticOrder>(C.lds, g, S, E); }
            { pg8::Gemm g{(const bf16_t*)(ws + WS_MEMN), (const bf16_t*)(ws + wofs(l) + WS_CAWKVT), DM, DM, DM, nullptr}; pg8::StaticOrder S; S.init(NMEM, 1024, C.G, (C.wg + C.G / 2) % C.G, DM);
              pg8::EpiBf16 E{(bf16_t*)(ws + WS_MEMKV), 1024, nullptr, 0, 1 << 30, nullptr, 1};
              pg8::gemm_phase<pg8::EpiBf16, pg8::StaticOrder>(C.lds, g, S, E); }
        } SEAM(pb + 1);
        if (EN(2) && IN(pb + 2)) { PH_BEGIN(); phase_ew1(C, l); } SEAM(pb + 2);
        if (EN(3) && IN(pb + 3)) { PH_BEGIN();
            { pg8::Gemm g{(const bf16_t*)(ws + WS_LORAA), (const bf16_t*)(ws + wofs(l) + WS_LORABT), 384, 384, 384, nullptr}; pg8::StaticOrder S; S.init(NT, 4096, C.G, C.wg, 384);
              pg8::EpiBf16 E{(bf16_t*)(ws + WS_LORAO), 4096, nullptr, 0, 1 << 30, nullptr, 1};
              pg8::gemm_phase<pg8::EpiBf16, pg8::StaticOrder>(C.lds, g, S, E); }
            { pg8::Gemm g{(const bf16_t*)(ws + WS_QN), (const bf16_t*)(ws + wofs(l) + WS_WQBT), 384, 384, 384, nullptr}; pg8::StaticOrder S; S.init(NT, 768, C.G, C.wg, 384);
              pg8::EpiBf16 E{(bf16_t*)(ws + WS_QM), 768, nullptr, 0, 1 << 30, nullptr, 1};
              pg8::gemm_phase<pg8::EpiBf16, pg8::StaticOrder>(C.lds, g, S, E); }
            { pg8::Gemm g{(const bf16_t*)(ws + WS_KVN), (const bf16_t*)(ws + wofs(l) + WS_WKVBT), 256, 256, 256, nullptr}; pg8::StaticOrder S; S.init(NT, 1024, C.G, C.wg, 256);
              pg8::EpiBf16 E{(bf16_t*)(ws + WS_KVM), 1024, nullptr, 0, 1 << 30, nullptr, 1};
              pg8::gemm_phase<pg8::EpiBf16, pg8::StaticOrder>(C.lds, g, S, E); }
        } SEAM(pb + 3);
        if (EN(4) && IN(pb + 4)) { PH_BEGIN(); phase_ew2(C, l); } SEAM(pb + 4);
        if (EN(5) && IN(pb + 5)) { PH_BEGIN(); phase_scan(C, l); } SEAM(pb + 5);
        if (EN(6) && IN(pb + 6)) { PH_BEGIN(); phase_att(C, l); } SEAM(pb + 6);
        if (EN(7) && IN(pb + 7)) { PH_BEGIN();
            pg8::Gemm g{(const bf16_t*)(ws + WS_PRW), (const bf16_t*)(ws + wofs(l) + WS_WOUTT), DM, DM, DM, nullptr}; pg8::StaticOrder S; S.init(NT, DM, C.G, C.wg, DM);
            pg8::EpiResid E{l == 0 ? in[0] : nullptr, (const bf16_t*)(ws + WS_XB), (bf16_t*)(ws + WS_XB), DM, (float*)(ws + WS_PARTC)};
            pg8::gemm_phase<pg8::EpiResid, pg8::StaticOrder>(C.lds, g, S, E);
        } SEAM(pb + 7);
        if (EN(8) && IN(pb + 8)) { PH_BEGIN();
            pg8::Gemm g{(const bf16_t*)(ws + WS_XB), (const bf16_t*)(ws + wofs(l) + WS_CAWQT), DM, DM, DM, nullptr}; pg8::StaticOrder S; S.init(NT, 512, C.G, C.wg, DM);
            pg8::EpiBf16 E{(bf16_t*)(ws + WS_CAQ), 512, nullptr, 0, 1 << 30, (const float*)(ws + WS_PARTC), 32};
            pg8::gemm_phase<pg8::EpiBf16, pg8::StaticOrder>(C.lds, g, S, E);
        } SEAM(pb + 8);
        if (EN(9) && IN(pb + 9)) { PH_BEGIN(); phase_cross(C); } SEAM(pb + 9);
        if (EN(10) && IN(pb + 10)) { PH_BEGIN();
            pg8::Gemm g{(const bf16_t*)(ws + WS_CAO), (const bf16_t*)(ws + wofs(l) + WS_CAWOT), 512, 512, 512, nullptr}; pg8::StaticOrder S; S.init(NT, DM, C.G, C.wg, 512);
            pg8::EpiResid E{nullptr, (const bf16_t*)(ws + WS_XB), (bf16_t*)(ws + WS_XB), DM, (float*)(ws + WS_PARTF)};
            pg8::gemm_phase<pg8::EpiResid, pg8::StaticOrder>(C.lds, g, S, E);
        } SEAM(pb + 10);
        if (EN(11) && IN(pb + 11)) { PH_BEGIN();
            pg8::Gemm g{(const bf16_t*)(ws + WS_XB), (const bf16_t*)(ws + (l ? WS_WRB1 : WS_WRB)), DM, DM, DM, nullptr}; pg8::StaticOrder S; S.init(NT, 256, C.G, C.wg, DM);
            pg8::EpiF32 E{(float*)(ws + WS_LOGITS), 256, (const float*)(ws + WS_PARTF), 32, (float*)(ws + WS_SSQF)};
            pg8::gemm_phase<pg8::EpiF32, pg8::StaticOrder>(C.lds, g, S, E);
        } SEAM(pb + 11);
        if (EN(12) && IN(pb + 12)) { PH_BEGIN(); phase_route(C, l); } SEAM(pb + 12);
        if (EN(13) && IN(pb + 13)) { PH_BEGIN(); phase_dispatch(C); } SEAM(pb + 13);
        if (EN(14) && IN(pb + 14)) { PH_BEGIN();
            const int* TE = (const int*)(ws + WS_TILEEXP);
            pg8::Gemm g{(const bf16_t*)(ws + WS_XB), (const bf16_t*)(ws + WS_WGU), DM, DM, DM, (const int*)(ws + WS_ROWMAP)};
            pg8::MoeOrder S{TE, TE[200], 4, C.G, C.wg, DM, (long)1024 * DM};
            pg8::EpiSiluMul E{(bf16_t*)(ws + WS_HID), DEXP, (const float*)(ws + WS_SSQF), (const int*)(ws + WS_ROWMAP)};
            pg8::gemm_phase<pg8::EpiSiluMul, pg8::MoeOrder, true>(C.lds, g, S, E);
        } SEAM(pb + 14);
        if (EN(15) && IN(pb + 15)) { PH_BEGIN();
            const int* TE = (const int*)(ws + WS_TILEEXP);
            pg8::Gemm g{(const bf16_t*)(ws + WS_HID), (const bf16_t*)(ws + WS_WD), DEXP, DEXP, DEXP, nullptr};
            pg8::MoeOrder S{TE, TE[200], 8, C.G, C.wg, DEXP, (long)DM * DEXP};
            pg8::EpiScatter E{(bf16_t*)(ws + WS_C2), DM, (const int*)(ws + WS_ROWDST)};
            pg8::gemm_phase<pg8::EpiScatter, pg8::MoeOrder>(C.lds, g, S, E);
        } SEAM(pb + 15);
    }

__global__ void __launch_bounds__(512, 2) mk_fwd(Args args) {
    extern __shared__ __attribute__((aligned(16))) unsigned char lds_raw[];
    Ctx C;
    unsigned char* ws; inptr_t in;
    PH_BEGIN();
    volatile LAS unsigned* MISC = (volatile LAS unsigned*)(C.lds + LDS_MISC);
    if (C.tid < 64) MISC[C.tid] = 0u;
    __syncthreads();
    const int lo = args.ph_lo, hi = args.ph_hi;
    XcdBarrier bar; bar.bar = (unsigned*)(args.ws + WS_CTL) + CW_BAR; bar.x = 0; bar.st = MISC + 8;
    if (hi - lo > 1) bar = xcd_barrier_post((unsigned*)(args.ws + WS_CTL) + CW_BAR, MISC + 8);
#ifndef PROBE_MASK
#define PROBE_MASK 0
#endif
#if PROBE_MASK
#ifndef PROBE_ATT
#define PROBE_ATT 7
#endif
#define RUNP(k) do { run_layer<0>(lds_raw, bar, (k), (k) + 1); xcd_barrier(bar); if ((PROBE_MASK >> (k)) & 1) { run_layer<0>(lds_raw, bar, (k), (k) + 1, PROBE_ATT); xcd_barrier(bar); } } while (0)
    RUNP(0); RUNP(1); RUNP(2); RUNP(3); RUNP(4); RUNP(5); RUNP(6); RUNP(7); RUNP(8); RUNP(9); RUNP(10); RUNP(11); RUNP(12); RUNP(13); RUNP(14); RUNP(15);
    run_layer<1>(lds_raw, bar, PPL, 2 * PPL); xcd_barrier(bar);
#else
    run_layer<0>(lds_raw, bar, lo, hi);
    run_layer<1>(lds_raw, bar, lo, hi);
#endif
    if (EN(16) && IN(2 * PPL)) { PH_BEGIN();
        const bf16_t* C2 = (const bf16_t*)(ws + WS_C2); const float* gate = (const float*)(ws + WS_GATE);
        for (int m = C.gw; m < NT; m += C.ngw)
            norm_row(nullptr, (const bf16_t*)(ws + WS_XB) + (size_t)m * DM, nullptr, C2 + (size_t)(2 * m) * DM, C2 + (size_t)(2 * m + 1) * DM, gate[2 * m], gate[2 * m + 1], in[4], nullptr, C.X + (size_t)m * DM, C.lane);
    }
#undef IN
#undef SEAM
}

extern "C" void kernel_launch(void* const* d_in, const int* in_sizes, int n_in, void* d_out, int out_size, void* d_ws, size_t ws_size, hipStream_t stream) {
    static int grid = 0;
    if (grid == 0) {
        if (n_in != 45 || out_size != NT * DM || ws_size < WS_END) { grid = -1; return; }
        int dev = 0, cus = 0;
        if (hipGetDevice(&dev) != hipSuccess || hipDeviceGetAttribute(&cus, hipDeviceAttributeMultiprocessorCount, dev) != hipSuccess) { grid = -1; return; }
        if (hipFuncSetAttribute((const void*)mk_fwd, hipFuncAttributeMaxDynamicSharedMemorySize, LDS_BYTES) != hipSuccess) { grid = -1; return; }
        int per_cu = 0;
        (void)hipOccupancyMaxActiveBlocksPerMultiprocessor(&per_cu, (const void*)mk_fwd, 512, LDS_BYTES);
        (void)hipGetLastError();
        grid = cus;
    }
    if (grid < 0) return;
    (void)hipMemsetAsync((char*)d_ws + WS_CTL, 0, 1 * MiB, stream);
    Args a{};
    for (int i = 0; i < 45; ++i) a.in[i] = d_in[i];
    a.out = (float*)d_out; a.ws = (unsigned char*)d_ws;
#if MK_ONE_LAUNCH
    a.ph_lo = 0; a.ph_hi = NPHASE;
    hipLaunchKernelGGL(mk_fwd, dim3(grid), dim3(512), LDS_BYTES, stream, a);
#else
    for (int p = 0; p < NPHASE; ++p) { a.ph_lo = p; a.ph_hi = p + 1; hipLaunchKernelGGL(mk_fwd, dim3(grid), dim3(512), LDS_BYTES, stream, a); }
#endif
}
```

```cpp
#include <hip/hip_runtime.h>
#include <stdint.h>
#include <math.h>

#ifndef MK_ONE_LAUNCH
#define MK_ONE_LAUNCH 1
#endif

#define DI __device__ __forceinline__
#define LAS __attribute__((address_space(3)))
#define GAS __attribute__((address_space(1)))

typedef unsigned short bf16_t;
typedef short bf16x8 __attribute__((ext_vector_type(8)));
typedef short s16x4 __attribute__((ext_vector_type(4)));
typedef float f32x2 __attribute__((ext_vector_type(2)));
typedef float f32x4 __attribute__((ext_vector_type(4)));
typedef float f32x16 __attribute__((ext_vector_type(16)));
typedef unsigned u32x2 __attribute__((ext_vector_type(2)));
typedef unsigned u32x4 __attribute__((ext_vector_type(4)));
typedef __bf16 bf16x2_t __attribute__((ext_vector_type(2)));
typedef short v4i16_t __attribute__((ext_vector_type(4)));
typedef _Float16 h2_t __attribute__((ext_vector_type(2)));
typedef _Float16 h4_t __attribute__((ext_vector_type(4)));

constexpr int NB = 4, SEQ = 4096, DM = 2048, NT = NB * SEQ;
constexpr int MEMLEN = 256, NMEM = NB * MEMLEN;
constexpr int RW_DIM = 1024, RW_COLS = 3328, IN_COLS = 5568, INP = 5632;
constexpr int PATT_COLS = 2304;
constexpr int NEXP = 32, DEXP = 512;
constexpr int MOE_ROWS = 40960;
constexpr float LOG2E = 1.4426950408889634f;

constexpr size_t MiB = 1u << 20, KiB = 1024;
constexpr size_t WS_CTL = 0;
constexpr size_t WS_ROPE = 1 * MiB;
constexpr size_t WS_EID = 5 * MiB;
constexpr size_t WS_GATE = 5 * MiB + 128 * KiB;
constexpr size_t WS_CNT = 5 * MiB + 256 * KiB;
constexpr size_t WS_ROWMAP = 5 * MiB + 320 * KiB;
constexpr size_t WS_ROWDST = 5 * MiB + 512 * KiB;
constexpr size_t WS_TILEEXP = 5 * MiB + 704 * KiB;
constexpr size_t WS_WRB = 7 * MiB;
constexpr size_t WS_LOGITS = 852 * MiB;
constexpr size_t WS_SSQM = 6 * MiB;
constexpr size_t WS_SSQC = 6 * MiB + 64 * KiB;
constexpr size_t WS_SSQF = 6 * MiB + 128 * KiB;
constexpr size_t WS_LUT = 6 * MiB + 512 * KiB;
constexpr size_t WS_WINT = 8 * MiB;
constexpr size_t WS_WOUTT = 30 * MiB;
constexpr size_t WS_CAWQT = 38 * MiB;
constexpr size_t WS_CAWKVT = 40 * MiB;
constexpr size_t WS_CAWOT = 44 * MiB;
constexpr size_t WS_WQBT = 46 * MiB;
constexpr size_t WS_WKVBT = 47 * MiB;
constexpr size_t WS_LORABT = 48 * MiB;
constexpr size_t WS_WGU = 52 * MiB;
constexpr size_t WS_WD = 180 * MiB;
constexpr size_t WS_H = 248 * MiB;
constexpr size_t WS_PRW = 312 * MiB;
constexpr size_t WS_PATT = 416 * MiB;
constexpr size_t WS_U = 488 * MiB;
constexpr size_t WS_HID = 488 * MiB, WS_C2 = 528 * MiB;
constexpr size_t WS_APERM = 312 * MiB;
constexpr size_t WS_LORAA = 680 * MiB;
constexpr size_t WS_LORAO = 692 * MiB;
constexpr size_t WS_VFIRST = 820 * MiB;
constexpr size_t WS_QN = 852 * MiB, WS_KVN = 864 * MiB, WS_QM = 872 * MiB, WS_KVM = 896 * MiB, WS_KPE = 928 * MiB;
constexpr size_t WS_CAQ = 852 * MiB, WS_CAO = 868 * MiB;
constexpr size_t WS_MEMN = 932 * MiB, WS_MEMKV = 936 * MiB;
constexpr size_t WS_XB = 940 * MiB;
constexpr size_t WS_PARTC = 1004 * MiB;
constexpr size_t WS_PARTF = 1006 * MiB;
constexpr size_t WS_L1OFF = 1000 * MiB;
constexpr size_t WS_WRB1 = 1052 * MiB;
constexpr size_t WS_END = 1053 * MiB;
constexpr int CW_BAR = 4096;

constexpr int LDS_MAIN = 131072;
constexpr int LDS_MISC = LDS_MAIN;
constexpr int LDS_BYTES = 147456;

DI unsigned pk2(float lo, float hi) { f32x2 v = {lo, hi}; bf16x2_t b = __builtin_convertvector(v, bf16x2_t); return __builtin_bit_cast(unsigned, b); }
DI bf16_t f2bf(float f) { return (bf16_t)(pk2(f, 0.f) & 0xffffu); }
DI float bf2f(bf16_t b) { return __uint_as_float(((unsigned)b) << 16); }
DI float bflo(unsigned u) { return __uint_as_float(u << 16); }
DI float bfhi(unsigned u) { return __uint_as_float(u & 0xffff0000u); }
#define DPP_F(x, ctl) __builtin_bit_cast(float, __builtin_amdgcn_update_dpp(0, __builtin_bit_cast(int, x), ctl, 0xf, 0xf, true))
#define RDL_F(x, l) __builtin_bit_cast(float, __builtin_amdgcn_readlane(__builtin_bit_cast(int, x), l))
DI float wave_sum(float v) {
    v += DPP_F(v, 0xB1);
    v += DPP_F(v, 0x4E);
    v += DPP_F(v, 0x141);
    v += DPP_F(v, 0x140);
    const float r0 = RDL_F(v, 0), r1 = RDL_F(v, 16), r2 = RDL_F(v, 32), r3 = RDL_F(v, 48);
    return (r0 + r1) + (r2 + r3);
}
DI float wave_max(float v) {
    v = fmaxf(v, DPP_F(v, 0xB1)); v = fmaxf(v, DPP_F(v, 0x4E)); v = fmaxf(v, DPP_F(v, 0x141)); v = fmaxf(v, DPP_F(v, 0x140));
    const float r0 = RDL_F(v, 0), r1 = RDL_F(v, 16), r2 = RDL_F(v, 32), r3 = RDL_F(v, 48);
    return fmaxf(fmaxf(r0, r1), fmaxf(r2, r3));
}
DI float sigmoidf_(float x) { return 1.f / (1.f + __expf(-x)); }

#define XB_TMO      128
#define XB_XCNT(j)  (256  + 64 * (j))
#define XB_XSUB(j)  (1280 + 64 * (j))
#define XB_XGEN(j)  (2304 + 64 * (j))
#define XB_TOP      3328
#define XB_TOPGEN   3392
#define XCD_BAR_WORDS 3456
#define XB_SPIN_CAP (1u << 24)

DI unsigned xb_ld(unsigned* p)              { return __hip_atomic_load(p, __ATOMIC_RELAXED, __HIP_MEMORY_SCOPE_AGENT); }
DI unsigned xb_add(unsigned* p, unsigned v) { return __hip_atomic_fetch_add(p, v, __ATOMIC_RELAXED, __HIP_MEMORY_SCOPE_AGENT); }
DI unsigned xb_xcc_id() { return (unsigned)__builtin_amdgcn_s_getreg((3 << 11) | 20) & 0xFu; }
#define XB_SPIN(cond, bar) do { unsigned _sp = 0; while (cond) { __builtin_amdgcn_s_sleep(1); \
    if ((++_sp & 255u) == 0u) { if (xb_ld(&(bar)[XB_TMO])) break; if (_sp > XB_SPIN_CAP) { atomicAdd(&(bar)[XB_TMO], 1u); break; } } } } while (0)

struct XcdBarrier { unsigned* bar; unsigned x; volatile LAS unsigned* st; };

DI XcdBarrier xcd_barrier_post(unsigned* bar, volatile LAS unsigned* st) {
    XcdBarrier b; b.bar = bar; b.x = xb_xcc_id(); b.st = st;
    if (threadIdx.x == 0) (void)xb_add(&bar[XB_XCNT(b.x)], 1u);
    return b;
}
DI void xcd_barrier_complete(unsigned* bar, unsigned x, unsigned& nloc, unsigned& nx) {
    const unsigned G = gridDim.x * gridDim.y * gridDim.z;
    unsigned sum, cnt, mine, sp = 0u;
    for (;;) {
        sum = 0u; cnt = 0u; mine = 0u;
#pragma unroll
        for (unsigned j = 0; j < 16; ++j) { const unsigned c = xb_ld(&bar[XB_XCNT(j)]); sum += c; cnt += (c > 0u) ? 1u : 0u; mine = (j == x) ? c : mine; }
        if (sum == G) break;
        __builtin_amdgcn_s_sleep(1);
        if ((++sp & 255u) == 0u) { if (xb_ld(&bar[XB_TMO])) break; if (sp > XB_SPIN_CAP) { atomicAdd(&bar[XB_TMO], 1u); break; } }
    }
    nloc = mine > 0u ? mine : 1u; nx = cnt > 0u ? cnt : 1u;
}
DI void xcd_barrier(const XcdBarrier& b) {
    asm volatile("s_waitcnt vmcnt(0)" ::: "memory");
    __syncthreads();
    if (threadIdx.x == 0) {
        unsigned* bar = b.bar;
        __builtin_amdgcn_s_waitcnt(0);
        unsigned nloc = b.st[0], nx = b.st[1];
        if (nloc == 0u) { xcd_barrier_complete(bar, b.x, nloc, nx); b.st[0] = nloc; b.st[1] = nx; }
        const unsigned old = xb_add(&bar[XB_XSUB(b.x)], 1u);
        const unsigned gen = old / nloc;
        if (old + 1u == (gen + 1u) * nloc) {
            __builtin_amdgcn_fence(__ATOMIC_RELEASE, "agent");
            asm volatile("s_waitcnt vmcnt(0)" ::: "memory");
            const unsigned og = xb_add(&bar[XB_TOP], 1u);
            const unsigned tg = og / nx;
            if (og + 1u == (tg + 1u) * nx) xb_add(&bar[XB_TOPGEN], 1u);
            else XB_SPIN(xb_ld(&bar[XB_TOPGEN]) == tg, bar);
            __builtin_amdgcn_fence(__ATOMIC_ACQUIRE, "agent");
            xb_add(&bar[XB_XGEN(b.x)], 1u);
            asm volatile("s_waitcnt vmcnt(0)" ::: "memory");
        } else {
            XB_SPIN(xb_ld(&bar[XB_XGEN(b.x)]) == gen, bar);
            __builtin_amdgcn_fence(__ATOMIC_ACQUIRE, "agent");
            asm volatile("s_waitcnt vmcnt(0)" ::: "memory");
        }
    }
    __syncthreads();
}

namespace pg8 {
constexpr int BM = 256, BK = 64, HALF = 128, HTB = HALF * BK * 2, STAGE_BYTES = 8 * HTB, NXCD = 8, WGM = 8;
__host__ __device__ __forceinline__ int lds_byte(int r, int c) { const int st = (r >> 4) * 2 + (c >> 5), rr = r & 15, cc = c & 31, ob = rr * 64 + cc * 2; return st * 1024 + (ob ^ (((ob >> 9) & 1) << 5)); }
__host__ __device__ __forceinline__ void stage_rc(int b, int& R, int& C) { const int st = b / 1024, sb = b % 1024, swz = sb ^ (((sb >> 9) & 1) << 5); R = (st >> 1) * 16 + swz / 64; C = (st & 1) * 32 + (swz % 64) / 2; }
__host__ __device__ __forceinline__ int perm32(int rho) { const int n = rho >> 4, i = rho & 15; return 8 * (i >> 2) + 4 * n + (i & 3); }

struct Unit { int pm, pn; long bbase; };
struct Gemm { const bf16_t* A; const bf16_t* Bt; int lda, ldb, K; const int* rowmap; };

struct StaticOrder {
    int nM, nN, nwg, G, c, ldb;
    DI void init(int M, int N, int G_, int c_, int ldb_) { nM = M / BM; nN = N / BM; nwg = nM * nN; G = G_; c = c_; ldb = ldb_; }
    DI bool next(int i, Unit& u) const {
        const long L = (long)i * G + c; if (L >= nwg) return false;
        int wgid = (int)L; { const int q = nwg / NXCD, r = nwg % NXCD, xcd = wgid % NXCD, off = wgid / NXCD; wgid = (xcd < r ? xcd * (q + 1) : r * (q + 1) + (xcd - r) * q) + off; }
        const int nig = WGM * nN, gid = wgid / nig, fm = gid * WGM, gsz = (nM - fm) < WGM ? (nM - fm) : WGM;
        u.pm = fm + ((wgid % nig) % gsz); u.pn = (wgid % nig) / gsz; u.bbase = (long)u.pn * BM * ldb; return true;
    }
};
struct MoeOrder {
    const int* tileexp; int ntiles, nN, G, c, ldb; long estride;
    DI bool next(int i, Unit& u) const {
        const long L = (long)i * G + c; if (L >= (long)ntiles * nN) return false;
        const int tile = (int)(L / nN), pn = (int)(L % nN); const int e = tileexp[tile];
        u.pm = tile; u.pn = pn; u.bbase = (long)e * estride + (long)pn * BM * ldb; return true;
    }
};

template <class Epi, class Sched, bool GATHER = false>
DI void gemm_phase(LAS unsigned char* lds, const Gemm g, const Sched& S, const Epi& E) {
    int tid = threadIdx.x; asm volatile("" : "+v"(tid));
    const int wid = __builtin_amdgcn_readfirstlane(tid >> 6), lane = tid & 63, wr = wid >> 2, wc = wid & 3, fr = lane & 15, fq = lane >> 4;
    const int K = g.K, nt = K / BK;
    unsigned voffA[2], voffB[2]; int RA[2], CA[2];
#pragma unroll
    for (int i = 0; i < 2; ++i) { int R, C; stage_rc(tid * 16 + i * 8192, R, C); const int Rb = Epi::PERM ? ((R & ~31) + perm32(R & 31)) : R;
        RA[i] = R; CA[i] = C; voffA[i] = (unsigned)(R * g.lda + C) * 2u; voffB[i] = (unsigned)(Rb * g.ldb + C) * 2u; }
    const size_t kstep = (size_t)(BK * 2);
    const size_t hstepA = (size_t)HALF * g.lda * 2, hstepB = (size_t)HALF * g.ldb * 2;
    const unsigned ldsw = (unsigned)wid * 1024u;
    const int aoff = lds_byte(wr * 64 + fr, fq * 8), boff = lds_byte(wc * 32 + fr, fq * 8);
#define PG8_SA(b, h) (((b) * 2 + (h)) * HTB)
#define PG8_SB(b, h) ((4 + (b) * 2 + (h)) * HTB)
#define PG8_STAGE(bufoff, gbase, voff) do { _Pragma("unroll") for (int _i = 0; _i < 2; ++_i) \
        __builtin_amdgcn_global_load_lds((const unsigned*)((const char*)(gbase) + (voff)[_i]), (LAS unsigned*)(lds + (bufoff) + ldsw + _i * 8192), 16, 0, 0); } while (0)
    unsigned gA[2][2], ngA[2][2];
#define PG8_STAGE_A(b, h, ptr, isnext) do { if constexpr (GATHER) { if (isnext) PG8_STAGE(PG8_SA(b, h), ptr, ngA[h]); else PG8_STAGE(PG8_SA(b, h), ptr, gA[h]); } \
        else PG8_STAGE(PG8_SA(b, h), (ptr) + (h) * hstepA, voffA); } while (0)
#define PG8_GATHER_OFFS(dst, un) do { _Pragma("unroll") for (int h_ = 0; h_ < 2; ++h_) _Pragma("unroll") for (int i_ = 0; i_ < 2; ++i_) \
        dst[h_][i_] = (unsigned)(g.rowmap[(un).pm * BM + h_ * HALF + RA[i_]] * g.lda + CA[i_]) * 2u; } while (0)
#define PG8_LDA(dst, b, h) do { _Pragma("unroll") for (int m = 0; m < 4; ++m) _Pragma("unroll") for (int k = 0; k < 2; ++k) dst[m][k] = *(const LAS bf16x8*)(lds + PG8_SA(b, h) + aoff + m * 2048 + k * 1024); } while (0)
#define PG8_LDB(dst, b, h) do { _Pragma("unroll") for (int n = 0; n < 2; ++n) _Pragma("unroll") for (int k = 0; k < 2; ++k) dst[n][k] = *(const LAS bf16x8*)(lds + PG8_SB(b, h) + boff + n * 2048 + k * 1024); } while (0)
#define PG8_MMA(ai, bj, At, Bt) do { __builtin_amdgcn_s_setprio(1); _Pragma("unroll") for (int m = 0; m < 4; ++m) _Pragma("unroll") for (int n = 0; n < 2; ++n) _Pragma("unroll") for (int k = 0; k < 2; ++k) \
        acc[ai][bj][m][n] = __builtin_amdgcn_mfma_f32_16x16x32_bf16(Bt[n][k], At[m][k], acc[ai][bj][m][n], 0, 0, 0); __builtin_amdgcn_s_setprio(0); } while (0)
#define PG8_WAIT_V(n) asm volatile("s_waitcnt vmcnt(" #n ")" ::: "memory")
#define PG8_WAIT_L(n) asm volatile("s_waitcnt lgkmcnt(" #n ")" ::: "memory")
#define PG8_BAR __builtin_amdgcn_s_barrier()
#define PG8_SCHED __builtin_amdgcn_sched_barrier(0)
    Unit cur, nxt; int ui = 0;
    if (!S.next(0, cur)) return;
    f32x4 acc[2][2][4][2];
#pragma unroll
    for (int a = 0; a < 2; ++a)
#pragma unroll
        for (int b = 0; b < 2; ++b)
#pragma unroll
            for (int m = 0; m < 4; ++m)
#pragma unroll
                for (int n = 0; n < 2; ++n) acc[a][b][m][n] = (f32x4){0.f, 0.f, 0.f, 0.f};
    bf16x8 At[4][2], B0[2][2], B1[2][2];
    const char* cA; const char* cB = (const char*)g.Bt + cur.bbase * 2;
    if constexpr (GATHER) { cA = (const char*)g.A; PG8_GATHER_OFFS(gA, cur); PG8_GATHER_OFFS(ngA, cur); }
    else cA = (const char*)g.A + (size_t)cur.pm * BM * g.lda * 2;
    PG8_STAGE(PG8_SB(0, 0), cB, voffB); PG8_STAGE(PG8_SB(0, 1), cB + hstepB, voffB); PG8_STAGE_A(0, 0, cA, false); PG8_STAGE_A(0, 1, cA, false);
    if (wr == 1) PG8_BAR;
    PG8_WAIT_V(2); PG8_BAR;
    PG8_STAGE(PG8_SB(1, 0), cB + kstep, voffB); PG8_STAGE_A(1, 0, cA + kstep, false); PG8_STAGE(PG8_SB(1, 1), cB + hstepB + kstep, voffB);
    PG8_WAIT_V(6); PG8_BAR;
    for (;;) {
        const bool has_next = S.next(ui + 1, nxt);
        const char* nA; const char* nB = has_next ? (const char*)g.Bt + nxt.bbase * 2 : cB;
        if constexpr (GATHER) { nA = cA; if (has_next) PG8_GATHER_OFFS(ngA, nxt); }
        else nA = has_next ? (const char*)g.A + (size_t)nxt.pm * BM * g.lda * 2 : cA;
        for (int t = 0; t < nt; t += 2) {
            const bool last = (t == nt - 2);
            const char* a1 = cA + (size_t)(t + 1) * kstep;
            const char* a2 = last ? nA : cA + (size_t)(t + 2) * kstep; const char* b2 = last ? nB : cB + (size_t)(t + 2) * kstep;
            const char* a3 = a2 + kstep; const char* b3 = b2 + kstep;
            PG8_LDB(B0, 0, 0); PG8_LDB(B1, 0, 1); PG8_SCHED; PG8_LDA(At, 0, 0); PG8_STAGE_A(1, 1, a1, false);
            PG8_WAIT_V(8); PG8_WAIT_L(0); PG8_BAR; PG8_MMA(0, 0, At, B0); PG8_MMA(0, 1, At, B1); PG8_BAR; PG8_SCHED;
            PG8_LDA(At, 0, 1); PG8_STAGE(PG8_SB(0, 0), b2, voffB); PG8_STAGE(PG8_SB(0, 1), b2 + hstepB, voffB); PG8_STAGE_A(0, 0, a2, last);
            PG8_WAIT_V(8); PG8_WAIT_L(0); PG8_BAR; PG8_MMA(1, 0, At, B0); PG8_MMA(1, 1, At, B1); PG8_BAR; PG8_SCHED;
            PG8_LDB(B0, 1, 0); PG8_LDB(B1, 1, 1); PG8_SCHED; PG8_LDA(At, 1, 0); PG8_STAGE_A(0, 1, a2, last);
            PG8_WAIT_V(8); PG8_WAIT_L(0); PG8_BAR; PG8_MMA(0, 0, At, B0); PG8_MMA(0, 1, At, B1); PG8_BAR; PG8_SCHED;
            PG8_LDA(At, 1, 1); PG8_STAGE(PG8_SB(1, 0), b3, voffB); PG8_STAGE(PG8_SB(1, 1), b3 + hstepB, voffB); PG8_STAGE_A(1, 0, a3, last);
            PG8_WAIT_V(8); PG8_WAIT_L(0); PG8_BAR; PG8_MMA(1, 0, At, B0); PG8_MMA(1, 1, At, B1); PG8_BAR; PG8_SCHED;
        }
        if (wr == 0) PG8_BAR;
        E(acc, cur, wr, wc, fr, fq);
        if (!has_next) break;
#pragma unroll
        for (int a = 0; a < 2; ++a)
#pragma unroll
            for (int b = 0; b < 2; ++b)
#pragma unroll
                for (int m = 0; m < 4; ++m)
#pragma unroll
                    for (int n = 0; n < 2; ++n) acc[a][b][m][n] = (f32x4){0.f, 0.f, 0.f, 0.f};
        cur = nxt; cA = nA; cB = nB; ++ui;
        if constexpr (GATHER) {
#pragma unroll
            for (int h_ = 0; h_ < 2; ++h_)
#pragma unroll
                for (int i_ = 0; i_ < 2; ++i_) gA[h_][i_] = ngA[h_][i_]; }
        if (wr == 1) PG8_BAR;
    }
    PG8_WAIT_V(0);
    PG8_BAR;
#undef PG8_SA
#undef PG8_SB
#undef PG8_STAGE
#undef PG8_STAGE_A
#undef PG8_LDA
#undef PG8_LDB
#undef PG8_MMA
#undef PG8_WAIT_V
#undef PG8_WAIT_L
#undef PG8_BAR
#undef PG8_SCHED
#undef PG8_GATHER_OFFS
}

DI float row_ssq32(const float* part, int row) { const f32x4* p = (const f32x4*)(part + (size_t)row * 32); float t = 0.f;
#pragma unroll
    for (int i = 0; i < 8; ++i) { const f32x4 v = p[i]; t += (v[0] + v[1]) + (v[2] + v[3]); }
    return t; }
DI float row_rstd(const float* ssq, int np, int row) {
    float t;
    if (np == 1) t = ssq[row];
    else { const f32x4* p = (const f32x4*)(ssq + (size_t)row * 32); t = 0.f;
#pragma unroll
        for (int i = 0; i < 8; ++i) { const f32x4 v = p[i]; t += (v[0] + v[1]) + (v[2] + v[3]); } }
    return rsqrtf(t * (1.f / 2048.f) + 1e-6f);
}
struct EpiBf16 {
    static constexpr bool PERM = true;
    bf16_t* O; int ldc; bf16_t* O2; int ldc2; int split_tile; const float* ssq; int np;
    DI void operator()(const f32x4 (&acc)[2][2][4][2], const Unit& u, int wr, int wc, int fr, int fq) const {
        bf16_t* base = O; int ld = ldc; int colt = u.pn * BM;
        if (u.pn >= split_tile) { base = O2; ld = ldc2; colt = (u.pn - split_tile) * BM; }
        const int row0 = u.pm * BM + wr * 64 + fr, col0 = colt + wc * 32 + 8 * fq;
#pragma unroll
        for (int ai = 0; ai < 2; ++ai)
#pragma unroll
            for (int m = 0; m < 4; ++m) { const int row = row0 + ai * HALF + m * 16; bf16_t* rowp = base + (size_t)row * ld + col0;
                const float rs = ssq ? row_rstd(ssq, np, row) : 1.f;
#pragma unroll
                for (int bj = 0; bj < 2; ++bj) { const f32x4 v0 = acc[ai][bj][m][0] * rs, v1 = acc[ai][bj][m][1] * rs;
                    u32x4 w; w.x = pk2(v0[0], v0[1]); w.y = pk2(v0[2], v0[3]); w.z = pk2(v1[0], v1[1]); w.w = pk2(v1[2], v1[3]);
                    *(u32x4*)(rowp + bj * HALF) = w; } }
    }
};
struct EpiResid {
    static constexpr bool PERM = true;
    const float* basef; const bf16_t* baseb; bf16_t* out; int ldc; float* part_out;
    DI void operator()(const f32x4 (&acc)[2][2][4][2], const Unit& u, int wr, int wc, int fr, int fq) const {
        const int row0 = u.pm * BM + wr * 64 + fr, col0 = u.pn * BM + wc * 32 + 8 * fq;
#pragma unroll
        for (int ai = 0; ai < 2; ++ai)
#pragma unroll
            for (int m = 0; m < 4; ++m) { const int row = row0 + ai * HALF + m * 16; const size_t off = (size_t)row * ldc + col0; float sq = 0.f;
#pragma unroll
                for (int bj = 0; bj < 2; ++bj) { f32x4 v0 = acc[ai][bj][m][0], v1 = acc[ai][bj][m][1];
                    if (basef) { v0 += *(const f32x4*)(basef + off + bj * HALF); v1 += *(const f32x4*)(basef + off + bj * HALF + 4); }
                    else { const u32x4 b = *(const u32x4*)(baseb + off + bj * HALF);
                        v0 += (f32x4){bflo(b.x), bfhi(b.x), bflo(b.y), bfhi(b.y)}; v1 += (f32x4){bflo(b.z), bfhi(b.z), bflo(b.w), bfhi(b.w)}; }
                    u32x4 w; w.x = pk2(v0[0], v0[1]); w.y = pk2(v0[2], v0[3]); w.z = pk2(v1[0], v1[1]); w.w = pk2(v1[2], v1[3]);
                    *(u32x4*)(out + off + bj * HALF) = w;
                    const float a0 = bflo(w.x), a1 = bfhi(w.x), a2 = bflo(w.y), a3 = bfhi(w.y), a4 = bflo(w.z), a5 = bfhi(w.z), a6 = bflo(w.w), a7 = bfhi(w.w);
                    sq += ((a0 * a0 + a1 * a1) + (a2 * a2 + a3 * a3)) + ((a4 * a4 + a5 * a5) + (a6 * a6 + a7 * a7)); }
                sq += __shfl_xor(sq, 16); sq += __shfl_xor(sq, 32);
                if (fq == 0) part_out[(size_t)row * 32 + u.pn * 4 + wc] = sq; }
    }
};
struct EpiF32 {
    static constexpr bool PERM = false;
    float* out; int ldc; const float* ssq; int np; float* ssq_pub;
    DI void operator()(const f32x4 (&acc)[2][2][4][2], const Unit& u, int wr, int wc, int fr, int fq) const {
        const int row0 = u.pm * BM + wr * 64 + fr, col0 = u.pn * BM + wc * 32 + 4 * fq;
#pragma unroll
        for (int ai = 0; ai < 2; ++ai)
#pragma unroll
            for (int m = 0; m < 4; ++m) { const int row = row0 + ai * HALF + m * 16; const size_t off = (size_t)row * ldc + col0;
                float rs = 1.f;
                if (ssq) { const float t = (np == 1) ? ssq[row] : row_ssq32(ssq, row); rs = rsqrtf(t * (1.f / 2048.f) + 1e-6f); if (ssq_pub && u.pn == 0 && wc == 0 && fq == 0) ssq_pub[row] = t; }
#pragma unroll
                for (int bj = 0; bj < 2; ++bj)
#pragma unroll
                    for (int n = 0; n < 2; ++n) *(f32x4*)(out + off + bj * HALF + n * 16) = acc[ai][bj][m][n] * rs; }
    }
};
struct EpiSiluMul {
    static constexpr bool PERM = true;
    bf16_t* O; int ldc; const float* ssq; const int* rowmap;
    DI void operator()(const f32x4 (&acc)[2][2][4][2], const Unit& u, int wr, int wc, int fr, int fq) const {
        const int row0 = u.pm * BM + wr * 64 + fr, col0 = (u.pn * BM + wc * 32 + 8 * fq) >> 1;
#pragma unroll
        for (int ai = 0; ai < 2; ++ai)
#pragma unroll
            for (int m = 0; m < 4; ++m) { const int row = row0 + ai * HALF + m * 16; bf16_t* rowp = O + (size_t)row * ldc + col0;
                const float rs = row_rstd(ssq, 1, rowmap[row]);
#pragma unroll
                for (int bj = 0; bj < 2; ++bj) { const f32x4 v0 = acc[ai][bj][m][0] * rs, v1 = acc[ai][bj][m][1] * rs;
                    const float h0 = v0[0] / (1.f + __expf(-v0[0])) * v0[1], h1 = v0[2] / (1.f + __expf(-v0[2])) * v0[3];
                    const float h2 = v1[0] / (1.f + __expf(-v1[0])) * v1[1], h3 = v1[2] / (1.f + __expf(-v1[2])) * v1[3];
                    u32x2 w; w.x = pk2(h0, h1); w.y = pk2(h2, h3);
                    *(u32x2*)(rowp + bj * (HALF / 2)) = w; } }
    }
};
struct EpiScatter {
    static constexpr bool PERM = true;
    bf16_t* O; int ldc; const int* dst;
    DI void operator()(const f32x4 (&acc)[2][2][4][2], const Unit& u, int wr, int wc, int fr, int fq) const {
        const int row0 = u.pm * BM + wr * 64 + fr, col0 = u.pn * BM + wc * 32 + 8 * fq;
#pragma unroll
        for (int ai = 0; ai < 2; ++ai)
#pragma unroll
            for (int m = 0; m < 4; ++m) { const int d = dst[row0 + ai * HALF + m * 16];
                if (d >= 0) { bf16_t* rowp = O + (size_t)d * ldc + col0;
#pragma unroll
                    for (int bj = 0; bj < 2; ++bj) { const f32x4 v0 = acc[ai][bj][m][0], v1 = acc[ai][bj][m][1];
                        u32x4 w; w.x = pk2(v0[0], v0[1]); w.y = pk2(v0[2], v0[3]); w.z = pk2(v1[0], v1[1]); w.w = pk2(v1[2], v1[3]);
                        *(u32x4*)(rowp + bj * HALF) = w; } } }
    }
};
}

struct Args { const void* in[45]; float* out; unsigned char* ws; int ph_lo, ph_hi; };
static_assert(sizeof(void*) == 8 && sizeof(Args) == 384, "Args layout");

#define CAS __attribute__((address_space(4)))
typedef const CAS char* kaptr_t;
typedef const float* const CAS* inptr_t;
struct Ctx {
    LAS unsigned char* lds; unsigned char* ws; inptr_t in; float* X;
    int tid, lane, wave, G, wg, gw, ngw, att_sel, vcu;
};

DI size_t wofs(int l) { return l ? WS_L1OFF : 0; }
struct TrDesc { const float* W; bf16_t* WT; int N, ldk, row_off, row_mul, nblk, item; const float* ks; };
DI void tr_load(const TrDesc& d, float (&tv)[32], int lane) {
    const int kb = d.item / d.nblk, nb = d.item % d.nblk, k0 = 64 * kb, n0 = 32 * nb;
#pragma unroll
    for (int i = 0; i < 32; ++i) { const int kk = 2 * i + (lane >> 5); tv[i] = d.W[(size_t)(k0 + kk) * d.N + n0 + (lane & 31)]; }
}
DI void tr_store(const TrDesc& d, const float (&tv)[32], LAS float* scr, int lane) {
    const int kb = d.item / d.nblk, nb = d.item % d.nblk, k0 = 64 * kb, n0 = 32 * nb;
#pragma unroll
    for (int i = 0; i < 32; ++i) { const int kk = 2 * i + (lane >> 5); scr[kk * 33 + (lane & 31)] = d.ks ? tv[i] * d.ks[k0 + kk] : tv[i]; }
    asm volatile("s_waitcnt lgkmcnt(0)" ::: "memory");
    const int c = lane & 7;
#pragma unroll
    for (int j = 0; j < 4; ++j) { const int n = (lane >> 3) + 8 * j; const LAS float* s = scr + (8 * c) * 33 + n;
        u32x4 o; o.x = pk2(s[0 * 33], s[1 * 33]); o.y = pk2(s[2 * 33], s[3 * 33]); o.z = pk2(s[4 * 33], s[5 * 33]); o.w = pk2(s[6 * 33], s[7 * 33]);
        *(u32x4*)(d.WT + (size_t)(d.row_off + (n0 + n) * d.row_mul) * d.ldk + k0 + 8 * c) = o; }
    asm volatile("s_waitcnt lgkmcnt(0)" ::: "memory");
}

DI void norm_row(const float* xin, const bf16_t* xinb, bf16_t* xout, const bf16_t* c0, const bf16_t* c1, float g0, float g1, const float* w, bf16_t* hout, float* fout, int lane, float* ssq_w = nullptr) {
    f32x4 v[8]; float ss = 0.f;
    if (xin) {
#pragma unroll
        for (int j = 0; j < 8; ++j) { v[j] = ((const f32x4*)xin)[lane + 64 * j]; }
    } else {
#pragma unroll
        for (int j = 0; j < 8; ++j) { const u32x2 a = ((const u32x2*)xinb)[lane + 64 * j]; v[j] = (f32x4){bflo(a.x), bfhi(a.x), bflo(a.y), bfhi(a.y)}; }
    }
    if (c0) {
#pragma unroll
        for (int j = 0; j < 8; ++j) { const u32x2 a = ((const u32x2*)c0)[lane + 64 * j], b = ((const u32x2*)c1)[lane + 64 * j];
            v[j][0] += g0 * bflo(a.x) + g1 * bflo(b.x); v[j][1] += g0 * bfhi(a.x) + g1 * bfhi(b.x);
            v[j][2] += g0 * bflo(a.y) + g1 * bflo(b.y); v[j][3] += g0 * bfhi(a.y) + g1 * bfhi(b.y); }
    }
#pragma unroll
    for (int j = 0; j < 8; ++j) ss += (v[j][0] * v[j][0] + v[j][1] * v[j][1]) + (v[j][2] * v[j][2] + v[j][3] * v[j][3]);
    if (xout) {
#pragma unroll
        for (int j = 0; j < 8; ++j) { u32x2 o; o.x = pk2(v[j][0], v[j][1]); o.y = pk2(v[j][2], v[j][3]); ((u32x2*)xout)[lane + 64 * j] = o; }
    }
    const float sst = wave_sum(ss);
    if (ssq_w) { if (lane == 0) *ssq_w = sst; }
    if (!w) return;
    const float rstd = rsqrtf(sst * (1.f / DM) + 1e-6f);
#pragma unroll
    for (int j = 0; j < 8; ++j) { const f32x4 ww = ((const f32x4*)w)[lane + 64 * j]; const f32x4 y = v[j] * rstd * ww;
        if (hout) { u32x2 o; o.x = pk2(y[0], y[1]); o.y = pk2(y[2], y[3]); ((u32x2*)hout)[lane + 64 * j] = o; }
        if (fout) ((f32x4*)fout)[lane + 64 * j] = y; }
}

constexpr int I_WIN = 32 * 174, I_VR = 32, I_WOUT = 32 * 64, I_CAQ = 32 * 16, I_CAKV = 32 * 32, I_CAO = 8 * 64, I_WQB = 6 * 24, I_WKVB = 4 * 32;
constexpr int N_SMALL_ITEMS = I_WIN + I_VR + I_WOUT + I_CAQ + I_CAKV + I_CAO + I_WQB + I_WKVB;
DI TrDesc small_tr_desc(int l, int r, inptr_t in, unsigned char* wsl) {
    bf16_t* WINT = (bf16_t*)(wsl + WS_WINT);
    if (r < I_WIN) return TrDesc{in[6] + (size_t)l * DM * IN_COLS, WINT, IN_COLS, DM, 0, 1, 174, r, in[5] + (size_t)l * DM}; r -= I_WIN;
    if (r < I_VR) return TrDesc{in[7], WINT, 32, DM, IN_COLS, 1, 1, r, in[5] + DM}; r -= I_VR;
    if (r < I_WOUT) return TrDesc{in[8] + (size_t)l * DM * DM, (bf16_t*)(wsl + WS_WOUTT), DM, DM, 0, 1, 64, r, nullptr}; r -= I_WOUT;
    if (r < I_CAQ) return TrDesc{in[34] + (size_t)l * DM * 512, (bf16_t*)(wsl + WS_CAWQT), 512, DM, 0, 1, 16, r, in[32] + (size_t)l * DM}; r -= I_CAQ;
    if (r < I_CAKV) return TrDesc{in[35] + (size_t)l * DM * 1024, (bf16_t*)(wsl + WS_CAWKVT), 1024, DM, 0, 1, 32, r, nullptr}; r -= I_CAKV;
    if (r < I_CAO) return TrDesc{in[36] + (size_t)l * 512 * DM, (bf16_t*)(wsl + WS_CAWOT), DM, 512, 0, 1, 64, r, nullptr}; r -= I_CAO;
    if (r < I_WQB) return TrDesc{in[29] + (size_t)l * 384 * 768, (bf16_t*)(wsl + WS_WQBT), 768, 384, 0, 1, 24, r, nullptr}; r -= I_WQB;
    return TrDesc{in[31] + (size_t)l * 256 * 1024, (bf16_t*)(wsl + WS_WKVBT), 1024, 256, 0, 1, 32, r, nullptr};
}
constexpr int I_EXP = 512;
constexpr int N_MOE_ITEMS = 3 * NEXP * I_EXP;
DI TrDesc moe_tr_desc(int l, int r, inptr_t in, unsigned char* ws) {
    const int e = r / (3 * I_EXP), q = r % (3 * I_EXP), mat = q / I_EXP, ii = q % I_EXP;
    const size_t eo = ((size_t)l * NEXP + e);
    if (mat == 0) return TrDesc{in[42] + eo * DM * DEXP, (bf16_t*)(ws + WS_WGU) + (size_t)e * 1024 * DM, DEXP, DM, 0, 2, 16, ii, in[37] + (size_t)l * DM};
    if (mat == 1) return TrDesc{in[43] + eo * DM * DEXP, (bf16_t*)(ws + WS_WGU) + (size_t)e * 1024 * DM, DEXP, DM, 1, 2, 16, ii, in[37] + (size_t)l * DM};
    return TrDesc{in[44] + eo * DEXP * DM, (bf16_t*)(ws + WS_WD) + (size_t)e * DM * DEXP, DM, DEXP, 0, 1, 64, ii, nullptr};
}
DI void phase_convert(const Ctx& C, int l) {
    inptr_t in = C.in;
    unsigned char* ws = C.ws;
    LAS float* scr = (LAS float*)(C.lds + C.wave * 16384);
    bf16_t* WINT = (bf16_t*)(ws + WS_WINT);
    const int n_items = (l == 0) ? N_SMALL_ITEMS : 0;
    auto decode = [&](int it) -> TrDesc { return small_tr_desc(0, it, in, ws); };
    {
        const int first = (l == 0 && C.gw >= I_WIN && C.gw < I_WIN + I_VR) ? C.gw + C.ngw : C.gw;
        float ta[32], tb[32];
        int it = first;
        if (it < n_items) { TrDesc d0 = decode(it); tr_load(d0, ta, C.lane);
            for (;;) {
                int it2 = it + C.ngw; if (l == 0 && it2 >= I_WIN && it2 < I_WIN + I_VR) it2 += C.ngw;
                const bool has2 = it2 < n_items; TrDesc d1 = d0;
                if (has2) { d1 = decode(it2); tr_load(d1, tb, C.lane); }
                tr_store(d0, ta, scr, C.lane);
                if (!has2) break;
                int it3 = it2 + C.ngw; if (l == 0 && it3 >= I_WIN && it3 < I_WIN + I_VR) it3 += C.ngw;
                const bool has3 = it3 < n_items;
                if (has3) { d0 = decode(it3); tr_load(d0, ta, C.lane); }
                tr_store(d1, tb, scr, C.lane);
                if (!has3) break;
                it = it3;
            }
        }
    }
    const int gt = C.wg * 512 + C.tid, ngt = C.G * 512;
    if (l == 0) {
        for (int i = gt; i < 64 * DM / 8; i += ngt) ((u32x4*)(WINT + (size_t)IN_COLS * DM))[i] = (u32x4){0u, 0u, 0u, 0u};
        for (int i = gt; i < 32 * DM / 8; i += ngt) ((u32x4*)((bf16_t*)(ws + WS_L1OFF + WS_WINT) + (size_t)(IN_COLS + 32) * DM))[i] = (u32x4){0u, 0u, 0u, 0u};
#pragma unroll 1
        for (int lw = 0; lw < 2; ++lw) {
            bf16_t* LB = (bf16_t*)(ws + wofs(lw) + WS_LORABT);
            const float* w2 = in[12] + (size_t)lw * 64 * 1024; const float* a2 = in[14] + (size_t)lw * 64 * 1024; const float* g2 = in[17] + (size_t)lw * 128 * 1024; const float* v2 = in[16];
            for (int i = gt; i < 4096 * 384; i += ngt) {
                const int n = i / 384, k = i % 384, blk = n >> 10, c = n & 1023; float v = 0.f;
                if (blk == 0) { if (k < 64) v = w2[k * 1024 + c]; }
                else if (blk == 1) { if (k >= 64 && k < 128) v = a2[(k - 64) * 1024 + c]; }
                else if (blk == 2) { if (k >= 128 && k < 256) v = g2[(k - 128) * 1024 + c]; }
                else { if (lw == 1 && k >= 256 && k < 288) v = v2[(k - 256) * 1024 + c]; }
                LB[i] = f2bf(v);
            }
            bf16_t* WRB = (bf16_t*)(ws + (lw ? WS_WRB1 : WS_WRB)); const float* nf = in[37] + (size_t)lw * DM; const float* wg = in[38] + (size_t)lw * DM * 4; const float* we = in[40] + (size_t)lw * DM * 32;
            for (int i = gt; i < 256 * DM; i += ngt) { const int o = i / DM, k = i % DM; const float v = (o < 32) ? we[k * 32 + o] : ((o < 36) ? wg[k * 4 + (o - 32)] : 0.f); WRB[i] = f2bf(v * nf[k]); }
        }
    }
    if (l == 0) {
        float* LUT = (float*)(ws + WS_LUT); const float* rb = in[3];
        for (int i = gt; i < 4 * 128; i += ngt) { const int h = i >> 7, n = i & 127; int bk;
            if (n < 16) bk = n; else { bk = 16 + (int)(log2f((float)n * 0.0625f) * (16.f / 3.f)); if (bk > 31) bk = 31; }
            LUT[i] = rb[bk * 4 + h] * LOG2E; }
        f32x2* RT = (f32x2*)(ws + WS_ROPE); const int* pos = (const int*)in[2];
        for (int i = gt; i < NT * 32; i += ngt) { const int t = i >> 5, j = i & 31; const float invf = powf(10000.f, -(float)j / 32.f); const float ang = (float)pos[t] * invf; float s, c; sincosf(ang, &s, &c); RT[i] = (f32x2){c, s}; }
    }
    for (int m = C.gw; m < NMEM; m += C.ngw) norm_row(in[1] + (size_t)m * DM, nullptr, nullptr, nullptr, nullptr, 0.f, 0.f, in[33] + (size_t)l * DM, (bf16_t*)(ws + WS_MEMN) + (size_t)m * DM, nullptr, C.lane);
    {
        const bf16_t* C2 = (const bf16_t*)(ws + WS_C2); const float* gate = (const float*)(ws + WS_GATE); bf16_t* XB = (bf16_t*)(ws + WS_XB); float* SSQM = (float*)(ws + WS_SSQM);
        for (int m = C.gw; m < NT; m += C.ngw) {
            if (l == 0) norm_row(in[0] + (size_t)m * DM, nullptr, XB + (size_t)m * DM, nullptr, nullptr, 0.f, 0.f, nullptr, nullptr, nullptr, C.lane, SSQM + m);
            else norm_row(nullptr, XB + (size_t)m * DM, XB + (size_t)m * DM, C2 + (size_t)(2 * m) * DM, C2 + (size_t)(2 * m + 1) * DM, gate[2 * m], gate[2 * m + 1], nullptr, nullptr, nullptr, C.lane, SSQM + m);
        }
    }
}

DI void phase_ew1(const Ctx& C, int l) {
    inptr_t in = C.in; unsigned char* ws = C.ws;
    const bf16_t* PRW = (const bf16_t*)(ws + WS_PRW); const bf16_t* PATT = (const bf16_t*)(ws + WS_PATT);
    bf16_t* LA = (bf16_t*)(ws + WS_LORAA); bf16_t* QN = (bf16_t*)(ws + WS_QN); bf16_t* KVN = (bf16_t*)(ws + WS_KVN); bf16_t* KPE = (bf16_t*)(ws + WS_KPE);
    const float* mu = in[9] + (size_t)l * RW_COLS; const float* muv = in[10];
    const float* qnw = in[28] + (size_t)l * 384; const float* kvnw = in[30] + (size_t)l * 256;
    const f32x2* RT = (const f32x2*)(ws + WS_ROPE);
    const int lane = C.lane;
#pragma unroll 4
    for (int t = C.gw; t < NT; t += C.ngw) {
        const bool first = (t % SEQ) == 0;
        const bf16_t* p = PRW + (size_t)t * RW_COLS; const bf16_t* pa = PATT + (size_t)t * PATT_COLS;
#pragma unroll
        for (int j = 0; j < 4; ++j) { const int c = lane + 64 * j, col = 3072 + c;
            const float cur = bf2f(p[col]); const float prev = first ? 0.f : bf2f(p[col - RW_COLS]);
            const float xs = cur + mu[col] * (prev - cur);
            float v; if (c < 64) v = tanhf(xs); else if (c < 128) v = xs; else v = sigmoidf_(xs);
            LA[(size_t)t * 384 + c] = f2bf(v); }
        {
#pragma unroll
            for (int j = 0; j < 2; ++j) { const int c = lane + 64 * j; float v = 0.f;
                if (l == 1 && c < 32) { const float cur = bf2f(pa[2240 + c]); const float prev = first ? 0.f : bf2f(pa[2240 + c - PATT_COLS]); v = cur + muv[c] * (prev - cur); }
                LA[(size_t)t * 384 + 256 + c] = f2bf(v); } }
        float q[6], kv[4]; float sq = 0.f, skv = 0.f;
#pragma unroll
        for (int j = 0; j < 6; ++j) { q[j] = bf2f(pa[1536 + lane + 64 * j]); sq += q[j] * q[j]; }
#pragma unroll
        for (int j = 0; j < 4; ++j) { kv[j] = bf2f(pa[1920 + lane + 64 * j]); skv += kv[j] * kv[j]; }
        const float rq = rsqrtf(wave_sum(sq) * (1.f / 384.f) + 1e-6f), rkv = rsqrtf(wave_sum(skv) * (1.f / 256.f) + 1e-6f);
#pragma unroll
        for (int j = 0; j < 6; ++j) QN[(size_t)t * 384 + lane + 64 * j] = f2bf(q[j] * rq * qnw[lane + 64 * j]);
#pragma unroll
        for (int j = 0; j < 4; ++j) KVN[(size_t)t * 256 + lane + 64 * j] = f2bf(kv[j] * rkv * kvnw[lane + 64 * j]);
        { const float x = bf2f(pa[2176 + lane]); const float xo = __shfl_xor(x, 32); const f32x2 cs = RT[t * 32 + (lane & 31)];
          const float y = (lane < 32) ? (x * cs.x - xo * cs.y) : (x * cs.x + xo * cs.y);
          KPE[(size_t)t * 64 + lane] = f2bf(y); }
    }
}

DI void phase_ew2(const Ctx& C, int l) {
    inptr_t in = C.in; unsigned char* ws = C.ws;
    const bf16_t* PRW = (const bf16_t*)(ws + WS_PRW); const bf16_t* LO = (const bf16_t*)(ws + WS_LORAO);
    bf16_t* SR = (bf16_t*)(ws + WS_U); bf16_t* SW = SR + (size_t)NT * 1024; bf16_t* SK = SW + (size_t)NT * 1024; bf16_t* SV = SK + (size_t)NT * 1024;
    bf16_t* SA = SV + (size_t)NT * 1024; bf16_t* SB = SA + (size_t)NT * 1024; bf16_t* VF = (bf16_t*)(ws + WS_VFIRST);
    const float* mu = in[9] + (size_t)l * RW_COLS; const float* w0 = in[11] + (size_t)l * 1024; const float* a0 = in[13] + (size_t)l * 1024; const float* v0 = in[15];
    const float* kkw = in[18] + (size_t)l * 1024; const float* kaw = in[19] + (size_t)l * 1024;
    const int lane = C.lane;
#pragma unroll 1
    for (int j = 0; j < 2; ++j) {
        const int c0 = 8 * lane + 512 * j;
        float mu8[3][8], w0v[8], a0v[8], kkv[8], kav[8], v0v[8];
#pragma unroll
        for (int e = 0; e < 2; ++e) {
#pragma unroll
            for (int q = 0; q < 3; ++q) { const f32x4 m = *(const f32x4*)(mu + q * 1024 + c0 + 4 * e);
#pragma unroll
                for (int i = 0; i < 4; ++i) mu8[q][4 * e + i] = m[i]; }
            const f32x4 x0 = *(const f32x4*)(w0 + c0 + 4 * e), x1 = *(const f32x4*)(a0 + c0 + 4 * e), x2 = *(const f32x4*)(kkw + c0 + 4 * e), x3 = *(const f32x4*)(kaw + c0 + 4 * e);
            f32x4 x4 = (f32x4){0.f, 0.f, 0.f, 0.f}; if (l == 1) x4 = *(const f32x4*)(v0 + c0 + 4 * e);
#pragma unroll
            for (int i = 0; i < 4; ++i) { w0v[4 * e + i] = x0[i]; a0v[4 * e + i] = x1[i]; kkv[4 * e + i] = x2[i]; kav[4 * e + i] = x3[i]; v0v[4 * e + i] = x4[i]; } }
#pragma unroll 2
        for (int t = C.gw; t < NT; t += C.ngw) {
            const bool first = (t % SEQ) == 0;
            const bf16_t* p = PRW + (size_t)t * RW_COLS; const bf16_t* lo = LO + (size_t)t * 4096;
            float xs[3][8];
#pragma unroll
            for (int q = 0; q < 3; ++q) { const int col = q * 1024 + c0;
                const u32x4 cu = *(const u32x4*)(p + col); u32x4 pv = (u32x4){0u, 0u, 0u, 0u}; if (!first) pv = *(const u32x4*)(p + col - RW_COLS);
#pragma unroll
                for (int e = 0; e < 4; ++e) { const float c_lo = bflo(cu[e]), c_hi = bfhi(cu[e]), p_lo = bflo(pv[e]), p_hi = bfhi(pv[e]);
                    xs[q][2 * e] = c_lo + mu8[q][2 * e] * (p_lo - c_lo); xs[q][2 * e + 1] = c_hi + mu8[q][2 * e + 1] * (p_hi - c_hi); } }
            const u32x4 lw = *(const u32x4*)(lo + c0), la = *(const u32x4*)(lo + 1024 + c0);
            u32x4 lv = (u32x4){0u, 0u, 0u, 0u}, vfv = (u32x4){0u, 0u, 0u, 0u};
            if (l == 1) { lv = *(const u32x4*)(lo + 3072 + c0); vfv = *(const u32x4*)(VF + (size_t)t * 1024 + c0); }
            float omw[8], av[8], kk[8], k2[8], v2[8]; float ssq = 0.f;
#pragma unroll
            for (int e = 0; e < 8; ++e) {
                const float lwf = (e & 1) ? bfhi(lw[e >> 1]) : bflo(lw[e >> 1]), laf = (e & 1) ? bfhi(la[e >> 1]) : bflo(la[e >> 1]);
                const float wi = w0v[e] + lwf;
                omw[e] = 1.f - __expf(-0.6065306597f * sigmoidf_(wi));
                av[e] = sigmoidf_(a0v[e] + laf);
                kk[e] = xs[1][e] * kkv[e]; ssq += kk[e] * kk[e];
                k2[e] = xs[1][e] * (1.f + (av[e] - 1.f) * kav[e]);
                v2[e] = xs[2][e];
                if (l == 1) { const float lvf = (e & 1) ? bfhi(lv[e >> 1]) : bflo(lv[e >> 1]), vff = (e & 1) ? bfhi(vfv[e >> 1]) : bflo(vfv[e >> 1]);
                    v2[e] = xs[2][e] + (vff - xs[2][e]) * sigmoidf_(v0v[e] + lvf); }
            }
            ssq += DPP_F(ssq, 0xB1); ssq += DPP_F(ssq, 0x4E); ssq += DPP_F(ssq, 0x141);
            const float inv = 1.f / fmaxf(sqrtf(ssq), 1e-12f);
            u32x4 oR, oW, oK, oV, oA, oB, oF;
#pragma unroll
            for (int e = 0; e < 4; ++e) { const float ka = kk[2 * e] * inv, kb = kk[2 * e + 1] * inv;
                oR[e] = pk2(xs[0][2 * e], xs[0][2 * e + 1]); oW[e] = pk2(omw[2 * e], omw[2 * e + 1]); oK[e] = pk2(k2[2 * e], k2[2 * e + 1]); oV[e] = pk2(v2[2 * e], v2[2 * e + 1]);
                oA[e] = pk2(ka, kb); oB[e] = pk2(ka * av[2 * e], kb * av[2 * e + 1]); oF[e] = pk2(xs[2][2 * e], xs[2][2 * e + 1]); }
            const size_t o = (size_t)t * 1024 + c0;
            *(u32x4*)(SR + o) = oR; *(u32x4*)(SW + o) = oW; *(u32x4*)(SK + o) = oK; *(u32x4*)(SV + o) = oV; *(u32x4*)(SA + o) = oA; *(u32x4*)(SB + o) = oB;
            if (l == 0) *(u32x4*)(VF + o) = oF;
        }
    }
    bf16_t* QM = (bf16_t*)(ws + WS_QM); const f32x2* RT = (const f32x2*)(ws + WS_ROPE);
    const int gt = C.wg * 512 + C.tid, ngt = C.G * 512;
    for (int i = gt; i < NT * 4 * 32; i += ngt) { const int t = i >> 7, h = (i >> 5) & 3, j = i & 31;
        bf16_t* q = QM + (size_t)t * 768 + h * 192 + 128; const float x1 = bf2f(q[j]), x2 = bf2f(q[j + 32]); const f32x2 cs = RT[t * 32 + j];
        q[j] = f2bf(x1 * cs.x - x2 * cs.y); q[j + 32] = f2bf(x2 * cs.x + x1 * cs.y); }
}

DI float dot2z(h2_t a, h2_t b) { float d; asm("v_dot2_f32_f16 %0, %1, %2, 0" : "=v"(d) : "v"(a), "v"(b)); return d; }
DI float fma_s(float a, float b, float c) { float d; asm("v_fma_f32 %0, %1, %2, %3" : "=v"(d) : "v"(a), "v"(b), "v"(c)); return d; }
#define ROW_ALLREDUCE(x) do { \
    x += __builtin_bit_cast(float, __builtin_amdgcn_update_dpp(0, __builtin_bit_cast(int, x), 0x128, 0xf, 0xf, true)); \
    x += __builtin_bit_cast(float, __builtin_amdgcn_update_dpp(0, __builtin_bit_cast(int, x), 0x124, 0xf, 0xf, true)); \
    x += __builtin_bit_cast(float, __builtin_amdgcn_update_dpp(0, __builtin_bit_cast(int, x), 0x122, 0xf, 0xf, true)); \
    x += __builtin_bit_cast(float, __builtin_amdgcn_update_dpp(0, __builtin_bit_cast(int, x), 0x121, 0xf, 0xf, true)); } while (0)

DI void phase_scan(const Ctx& C, int l) {
    unsigned char* ws = C.ws; inptr_t in = C.in;
    const bf16_t* SR = (const bf16_t*)(ws + WS_U); float* Yf = (float*)(ws + WS_H);
    constexpr int CH = 32, VECB = CH * 128, BUFB = 5 * VECB + CH * 64, OB = 2 * BUFB;
    LAS unsigned char* lds = C.lds;
    const int tid = C.tid, lane = C.lane, wave = C.wave;
    for (int u = C.vcu; u < 256; u += C.G) {
        const int bh = u >> 2, rg = u & 3, b = bh >> 4, h = bh & 15;
        const size_t tb = (size_t)b * SEQ; const int cb = h * 64;
        const int lt = tid - 256;
        u32x4 pre[3][6];
#define LD_CHUNK(set, c_) do { const size_t t_ = tb + (size_t)(c_) * CH + (lt >> 3); const int j_ = lt & 7; \
            _Pragma("unroll") for (int vq = 0; vq < 5; ++vq) { const int arr = (vq < 3) ? vq : vq + 1; \
                pre[set][vq] = *(const u32x4*)(SR + (size_t)arr * NT * 1024 + t_ * 1024 + cb + 8 * j_); } \
            if (lt < 64) { const size_t tv_ = tb + (size_t)(c_) * CH + (lt >> 1); \
                pre[set][5] = *(const u32x4*)(SR + (size_t)3 * NT * 1024 + tv_ * 1024 + cb + 16 * rg + 8 * (lt & 1)); } } while (0)
#define ST_CHUNK(set, buf_) do { const int step_ = lt >> 3, j_ = lt & 7; \
            _Pragma("unroll") for (int vq = 0; vq < 5; ++vq) { const u32x4 p = pre[set][vq]; f32x4 lo = {bflo(p.x), bfhi(p.x), bflo(p.y), bfhi(p.y)}, hi = {bflo(p.z), bfhi(p.z), bflo(p.w), bfhi(p.w)}; \
                if (vq == 1) { lo = 1.f - lo; hi = 1.f - hi; } \
                if (vq == 3) { lo = -lo; hi = -hi; } \
                const h4_t hl = __builtin_convertvector(lo, h4_t), hh = __builtin_convertvector(hi, h4_t); \
                LAS h4_t* d = (LAS h4_t*)(lds + (buf_) * BUFB + vq * VECB + step_ * 128 + j_ * 16); d[0] = hl; d[1] = hh; } \
            if (lt < 64) { const u32x4 p = pre[set][5]; const f32x4 lo = {bflo(p.x), bfhi(p.x), bflo(p.y), bfhi(p.y)}, hi = {bflo(p.z), bfhi(p.z), bflo(p.w), bfhi(p.w)}; \
                const h4_t hl = __builtin_convertvector(lo, h4_t), hh = __builtin_convertvector(hi, h4_t); \
                LAS h4_t* d = (LAS h4_t*)(lds + (buf_) * BUFB + 5 * VECB + (lt >> 1) * 64 + (lt & 1) * 32); \
                d[0] = (h4_t){hl[0], hl[0], hl[1], hl[1]}; d[1] = (h4_t){hl[2], hl[2], hl[3], hl[3]}; d[2] = (h4_t){hh[0], hh[0], hh[1], hh[1]}; d[3] = (h4_t){hh[2], hh[2], hh[3], hh[3]}; } } while (0)
        h2_t S01 = {(_Float16)0.f, (_Float16)0.f}, S23 = {(_Float16)0.f, (_Float16)0.f};
        const int ks = lane & 15, rowl = wave * 4 + (lane >> 4);
        constexpr int NCH = SEQ / CH;
        const int n_bg = N_MOE_ITEMS + (l == 0 ? N_SMALL_ITEMS : 0);
#define BG_DESC(it_) (((it_) < N_MOE_ITEMS) ? moe_tr_desc(l, (it_), in, ws) : small_tr_desc(1, (it_) - N_MOE_ITEMS, in, ws + WS_L1OFF))
        float tq[32]; int mo_it = (C.wg * 4 + (wave - 4)); bool mo_pending = false; TrDesc mo_d{};
        LAS float* mo_scr = (LAS float*)(lds + OB + 2 * CH * 64) + (wave - 4) * (64 * 33);
        if (wave >= 4) { LD_CHUNK(0, 0); LD_CHUNK(1, 1); LD_CHUNK(2, 2); ST_CHUNK(0, 0); LD_CHUNK(0, 3); }
        __syncthreads();
#define SCAN_ITER(c, setn) do { \
            const int buf = (c) & 1; \
            if (wave >= 4) { \
                if ((c) + 1 < NCH) { ST_CHUNK(setn, buf ^ 1); if ((c) + 4 < NCH) LD_CHUNK(setn, (c) + 4); } \
                if ((c) > 0 && lt < 128) { \
                    const int step = lt >> 2, q4 = lt & 3; const LAS float* ob_ = (const LAS float*)(lds + OB + (((c) - 1) & 1) * (CH * 64)) + (step >> 4) * 256 + (step & 15); \
                    const f32x4 o = {ob_[(4 * q4 + 0) * 16], ob_[(4 * q4 + 1) * 16], ob_[(4 * q4 + 2) * 16], ob_[(4 * q4 + 3) * 16]}; \
                    *(f32x4*)(Yf + (tb + (size_t)((c) - 1) * CH + step) * 1024 + cb + 16 * rg + 4 * q4) = o; } \
                if (((c) & 1) == 0) { if (mo_pending) { tr_store(mo_d, tq, mo_scr, lane); mo_pending = false; } \
                    if (mo_it < n_bg) { mo_d = BG_DESC(mo_it); tr_load(mo_d, tq, lane); mo_pending = true; mo_it += 1024; } } \
            } else { SCAN_BODY(buf); } \
            __syncthreads(); } while (0)
#define SC_LD(X, s_) do { const int so_ = ((s_) & (CH - 1)) * 128; X##r = *(const LAS h4_t*)(bp + 0 * VECB + so_); X##w = *(const LAS h4_t*)(bp + 1 * VECB + so_); X##k = *(const LAS h4_t*)(bp + 2 * VECB + so_); \
            X##a = *(const LAS h4_t*)(bp + 3 * VECB + so_); X##b = *(const LAS h4_t*)(bp + 4 * VECB + so_); X##v = vp[((s_) & (CH - 1)) * 16]; } while (0)
#define DPPF(x, ctl) __builtin_bit_cast(float, __builtin_amdgcn_update_dpp(0, __builtin_bit_cast(int, x), ctl, 0xf, 0xf, true))
#define H_LO(x) __builtin_shufflevector(x, x, 0, 1)
#define H_HI(x) __builtin_shufflevector(x, x, 2, 3)
#define SC_DOT(x) __builtin_amdgcn_fdot2(S01, H_LO(x), dot2z(S23, H_HI(x)), false)
#define SC_FIRST(X) do { float sa = SC_DOT(X##a); \
            const h2_t t01 = S01 * H_LO(X##w) + X##v * H_LO(X##k), t23 = S23 * H_HI(X##w) + X##v * H_HI(X##k); \
            ROW_ALLREDUCE(sa); \
            const _Float16 sh = (_Float16)sa; const h2_t sa2 = {sh, sh}; \
            S01 = sa2 * H_LO(X##b) + t01; S23 = sa2 * H_HI(X##b) + t23; } while (0)
#define SC_PAIR(X, Y, s_) do { float o = SC_DOT(X##r); float sa = SC_DOT(Y##a); \
            const h2_t t01 = S01 * H_LO(Y##w) + Y##v * H_LO(Y##k), t23 = S23 * H_HI(Y##w) + Y##v * H_HI(Y##k); \
            sa += DPPF(sa, 0x128); o += DPPF(o, 0x128); sa += DPPF(sa, 0x124); o += DPPF(o, 0x124); sa += DPPF(sa, 0x122); o += DPPF(o, 0x122); sa += DPPF(sa, 0x121); o += DPPF(o, 0x121); \
            const _Float16 sh = (_Float16)sa; const h2_t sa2 = {sh, sh}; \
            S01 = sa2 * H_LO(Y##b) + t01; S23 = sa2 * H_HI(Y##b) + t23; \
            osel = (ks == (((s_) - 1) & 15)) ? o : osel; if ((((s_) - 1) & 15) == 15) op16[(((s_) - 1) >> 4) * 256] = osel; } while (0)
#define SC_LAST(X, s_) do { float o = SC_DOT(X##r); ROW_ALLREDUCE(o); osel = (ks == ((s_) & 15)) ? o : osel; op16[((s_) >> 4) * 256] = osel; } while (0)
#define SCAN_BODY(buf_) do { \
            const LAS unsigned char* bp = lds + (buf_) * BUFB + ks * 8; \
            const LAS h2_t* vp = (const LAS h2_t*)(lds + (buf_) * BUFB + 5 * VECB) + rowl; \
            LAS float* op16 = (LAS float*)(lds + OB + (buf_) * (CH * 64)) + rowl * 16 + ks; float osel = 0.f;     \
            h4_t Ar, Aw, Ak, Aa, Ab, Br, Bw, Bk, Ba, Bb, Cr, Cw, Ck, Ca, Cb, Dr, Dw, Dk, Da, Db; h2_t Av, Bv, Cv, Dv; \
            SC_LD(A, 0); SC_LD(B, 1); SC_LD(C, 2); SC_LD(D, 3); \
            SC_FIRST(A); \
            _Pragma("unroll 2") for (int s = 0; s < CH - 4; s += 4) { \
                SC_PAIR(A, B, s + 1); SC_LD(A, s + 4); \
                SC_PAIR(B, C, s + 2); SC_LD(B, s + 5); \
                SC_PAIR(C, D, s + 3); SC_LD(C, s + 6); \
                SC_PAIR(D, A, s + 4); SC_LD(D, s + 7); } \
            SC_PAIR(A, B, CH - 3); SC_PAIR(B, C, CH - 2); SC_PAIR(C, D, CH - 1); SC_LAST(D, CH - 1); } while (0)
#pragma unroll 1
        for (int c = 0; c < NCH; c += 3) { SCAN_ITER(c, 1); if (c + 1 < NCH) SCAN_ITER(c + 1, 2); if (c + 2 < NCH) SCAN_ITER(c + 2, 0); }
#undef SC_LD
#undef SC_FIRST
#undef SC_PAIR
#undef SC_LAST
#undef DPPF
#undef H_LO
#undef H_HI
#undef SC_DOT
#undef SCAN_BODY
#undef SCAN_ITER
#undef LD_CHUNK
#undef ST_CHUNK
        if (wave >= 4) { if (mo_pending) tr_store(mo_d, tq, mo_scr, lane);
            for (; mo_it < n_bg; mo_it += 1024) { const TrDesc d = BG_DESC(mo_it); tr_load(d, tq, lane); tr_store(d, tq, mo_scr, lane); } }
#undef BG_DESC
        if (wave >= 4 && lt < 128) { const int c = NCH; const int step = lt >> 2, q4 = lt & 3; const LAS float* ob_ = (const LAS float*)(lds + OB + ((c - 1) & 1) * (CH * 64)) + (step >> 4) * 256 + (step & 15);
            const f32x4 o = {ob_[(4 * q4 + 0) * 16], ob_[(4 * q4 + 1) * 16], ob_[(4 * q4 + 2) * 16], ob_[(4 * q4 + 3) * 16]};
            *(f32x4*)(Yf + (tb + (size_t)(c - 1) * CH + step) * 1024 + cb + 16 * rg + 4 * q4) = o; }
        __syncthreads();
    }
}

DI void phase_post(const Ctx& C, int l) {
    inptr_t in = C.in; unsigned char* ws = C.ws;
    const float* Yf = (const float*)(ws + WS_H); const bf16_t* LO = (const bf16_t*)(ws + WS_LORAO);
    const bf16_t* SR = (const bf16_t*)(ws + WS_U); const bf16_t* SK = SR + (size_t)2 * NT * 1024; const bf16_t* SV = SR + (size_t)3 * NT * 1024;
    bf16_t* Y = (bf16_t*)(ws + WS_PRW);
    const float* rk = in[20] + (size_t)l * 1024; const float* lnw = in[21] + (size_t)l * 1024; const float* lnb = in[22] + (size_t)l * 1024;
    const int lane = C.lane;
    for (int t = C.gw; t < NT; t += C.ngw) {
#pragma unroll
        for (int j = 0; j < 2; ++j) {
            const int c0 = 8 * lane + 512 * j; const size_t o = (size_t)t * 1024 + c0;
            const f32x4 y0 = *(const f32x4*)(Yf + o), y1 = *(const f32x4*)(Yf + o + 4);
            const u32x4 rr = *(const u32x4*)(SR + o), kq = *(const u32x4*)(SK + o), vq = *(const u32x4*)(SV + o), gq = *(const u32x4*)(LO + (size_t)t * 4096 + 2048 + c0);
            float y[8], rk8[8], lw8[8], lb8[8];
#pragma unroll
            for (int e = 0; e < 2; ++e) { const f32x4 a = *(const f32x4*)(rk + c0 + 4 * e), b = *(const f32x4*)(lnw + c0 + 4 * e), c = *(const f32x4*)(lnb + c0 + 4 * e);
#pragma unroll
                for (int i = 0; i < 4; ++i) { rk8[4 * e + i] = a[i]; lw8[4 * e + i] = b[i]; lb8[4 * e + i] = c[i]; y[4 * e + i] = e ? y1[i] : y0[i]; } }
            float sm = 0.f, bs = 0.f; float r8[8], k8[8], v8[8], g8[8];
#pragma unroll
            for (int e = 0; e < 8; ++e) { r8[e] = (e & 1) ? bfhi(rr[e >> 1]) : bflo(rr[e >> 1]); k8[e] = (e & 1) ? bfhi(kq[e >> 1]) : bflo(kq[e >> 1]);
                v8[e] = (e & 1) ? bfhi(vq[e >> 1]) : bflo(vq[e >> 1]); g8[e] = (e & 1) ? bfhi(gq[e >> 1]) : bflo(gq[e >> 1]);
                sm += y[e]; bs += r8[e] * k8[e] * rk8[e]; }
            sm += DPP_F(sm, 0xB1); sm += DPP_F(sm, 0x4E); sm += DPP_F(sm, 0x141);
            bs += DPP_F(bs, 0xB1); bs += DPP_F(bs, 0x4E); bs += DPP_F(bs, 0x141);
            const float mean = sm * (1.f / 64.f); float vs = 0.f;
#pragma unroll
            for (int e = 0; e < 8; ++e) { y[e] -= mean; vs += y[e] * y[e]; }
            vs += DPP_F(vs, 0xB1); vs += DPP_F(vs, 0x4E); vs += DPP_F(vs, 0x141);
            const float rs = rsqrtf(vs * (1.f / 64.f) + 64e-5f);
            u32x4 ov;
#pragma unroll
            for (int e = 0; e < 4; ++e) { const float o0 = (y[2 * e] * rs * lw8[2 * e] + lb8[2 * e] + bs * v8[2 * e]) * g8[2 * e], o1 = (y[2 * e + 1] * rs * lw8[2 * e + 1] + lb8[2 * e + 1] + bs * v8[2 * e + 1]) * g8[2 * e + 1];
                ov[e] = pk2(o0, o1); }
            *(u32x4*)(Y + (size_t)t * 2048 + c0) = ov;
        }
    }
}

struct AttnP {
    const bf16_t* Q; int qpitch, qcol0;
    const bf16_t* K1; int k1pitch, k1col0;
    const bf16_t* K2; int k2pitch, k2col0;
    const bf16_t* V; int vpitch, vcol0;
    bf16_t* O; int opitch, ocol0;
    size_t qrow0, krow0;
    int q0;
    int nkeys;
    float c1;
    const int* pos; const float* lut;
    float lam, outscale; const float* subw;
    int dbg;
};

template <int DQK, int DK1, int MODE, int KT, int PFD>
DI void attn_unit(LAS unsigned char* lds, const AttnP& P) {
    constexpr int DV = 128, KP = DQK * 2 + 16, VP = DV * 2 + 64;
    constexpr int NBLK = KT / 32;
    constexpr int KTILE = KT * KP, VTILE = KT * VP;
    constexpr int NVT = (MODE == 0) ? 1 : 2;
    constexpr int VSLOT = NVT * VTILE + 256;
    constexpr bool ONEB = (MODE != 2);
    constexpr int KSLOT = 2 * KTILE, NKS = ONEB ? 2 : 1, NVS = ONEB ? 3 : 2;
    constexpr int OFF_V = NKS * KSLOT, OFF_POS = NVT * VTILE, OFF_LUT = OFF_V + NVS * VSLOT, OFF_END = OFF_LUT + 512;
    static_assert(!ONEB || PFD == 1, "one-barrier loop uses a single prefetch set");
    constexpr int OFF_OST = 4 * 17408, OSTP = 272;
    static_assert(OFF_END <= LDS_MAIN && OFF_OST + 4 * 32 * OSTP <= LDS_MAIN, "attention LDS");
    constexpr int KCH = DQK / 8, K1CH = DK1 / 8;
    constexpr int NKC = 2 * KT * KCH, NVC = NVT * KT * 16, NKCH = NKC / 512, NVCH = NVC / 512, NCHK = NKCH + NVCH;
    static_assert(NKC % 512 == 0 && NVC % 512 == 0, "chunks");
    constexpr float NEG = -1e30f, THR = 8.f;
    constexpr int KSTEP = (MODE == 0) ? KT : 2 * KT;
    int tid = threadIdx.x; asm volatile("" : "+v"(tid));
    const int lane = tid & 63, wave = __builtin_amdgcn_readfirstlane(tid >> 6);
    const int qg = wave >> 1, st = wave & 1, r32 = lane & 31, h2 = lane >> 5;
    const int qw0 = P.q0 + 32 * qg;
    const int myq = qw0 + r32;
    bf16x8 qf[DQK / 16];
    {
        const bf16_t* qp = P.Q + (P.qrow0 + myq) * (size_t)P.qpitch + P.qcol0 + ((MODE == 0) ? st * 64 : 0) + 8 * h2;
#pragma unroll
        for (int ks = 0; ks < DQK / 16; ++ks) qf[ks] = *(const bf16x8*)(qp + 16 * ks);
    }
    int mypos = 0, posq0 = 0;
    if constexpr (MODE == 0) { mypos = P.pos[myq]; posq0 = P.pos[qw0]; if (tid < 128) ((LAS float*)(lds + OFF_LUT))[tid] = P.lut[tid]; }
    f32x16 o[4];
#pragma unroll
    for (int d = 0; d < 4; ++d)
#pragma unroll
        for (int i = 0; i < 16; ++i) o[d][i] = 0.f;
    float m_run = NEG, l_run = 0.f;
    const int nsteps = P.nkeys / KSTEP;
    const char* gp[NCHK]; unsigned adv[NCHK]; unsigned ldst[NCHK];
#pragma unroll
    for (int i = 0; i < NKCH; ++i) { const int c = tid + 512 * i; const int s = c / (KT * KCH), rc = c % (KT * KCH), row = rc / KCH, ch = rc % KCH;
        const int key = (MODE == 0) ? row : s * KT + row;
        if (ch < K1CH) { gp[i] = (const char*)(P.K1 + (P.krow0 + key) * (size_t)P.k1pitch + P.k1col0 + ((MODE == 0) ? s * 64 : 0) + ch * 8); adv[i] = (unsigned)(KSTEP * P.k1pitch * 2); }
        else { gp[i] = (const char*)(P.K2 + (P.krow0 + key) * (size_t)P.k2pitch + P.k2col0 + (ch - K1CH) * 8); adv[i] = (unsigned)(KSTEP * P.k2pitch * 2); }
        ldst[i] = (unsigned)(s * KTILE + row * KP + ch * 16); }
#pragma unroll
    for (int i = 0; i < NVCH; ++i) { const int c2 = tid + 512 * i; const int s = c2 / (KT * 16), rc = c2 % (KT * 16), row = rc / 16, ch = rc % 16;
        const int key = (MODE == 0) ? row : s * KT + row;
        gp[NKCH + i] = (const char*)(P.V + (P.krow0 + key) * (size_t)P.vpitch + P.vcol0 + ch * 8); adv[NKCH + i] = (unsigned)(KSTEP * P.vpitch * 2);
        ldst[NKCH + i] = (unsigned)(s * VTILE + row * VP + ch * 16); }
    u32x4 preK[PFD][NKCH], preV[PFD][NVCH]; int prepos[2] = {0, 0};
#define KSET(par) ((PFD == 2) ? ((par) ^ 1) : 0)
#define VSET(par) ((PFD == 2) ? (par) : 0)
#define ATT_PREFETCH_K(set_) do { _Pragma("unroll") for (int i = 0; i < NKCH; ++i) { preK[set_][i] = *(const u32x4*)gp[i]; gp[i] += adv[i]; } } while (0)
#define ATT_PREFETCH_V(set_, step_) do { _Pragma("unroll") for (int i = 0; i < NVCH; ++i) { preV[set_][i] = *(const u32x4*)gp[NKCH + i]; gp[NKCH + i] += adv[NKCH + i]; } \
        if constexpr (MODE == 0) { if (tid < KT) prepos[set_] = P.pos[(step_) * KT + tid]; } } while (0)
#define ATT_STAGE_K(set_, ko_) do { _Pragma("unroll") for (int i = 0; i < NKCH; ++i) *(LAS u32x4*)(lds + (ko_) + ldst[i]) = preK[set_][i]; } while (0)
#define ATT_STAGE_V(set_, vo_) do { _Pragma("unroll") for (int i = 0; i < NVCH; ++i) *(LAS u32x4*)(lds + (vo_) + ldst[NKCH + i]) = preV[set_][i]; \
        if constexpr (MODE == 0) { if (tid < KT) ((LAS int*)(lds + (vo_) + OFF_POS))[tid] = prepos[set_]; } } while (0)
#define ATT_QK(dst, ko_) do { const LAS unsigned char* kb_ = lds + (ko_) + st * KTILE + r32 * KP + 16 * h2; \
        _Pragma("unroll") for (int blk = 0; blk < NBLK; ++blk) { \
            _Pragma("unroll") for (int i = 0; i < 16; ++i) dst[blk][i] = 0.f; \
            _Pragma("unroll") for (int ks = 0; ks < DQK / 16; ++ks) { const bf16x8 kf = *(const LAS bf16x8*)(kb_ + blk * 32 * KP + ks * 32); dst[blk] = __builtin_amdgcn_mfma_f32_32x32x16_bf16(kf, qf[ks], dst[blk], 0, 0, 0); } } } while (0)
#define ATT_VLD(j_) do { const int d_ = (j_) / (2 * NBLK), r_ = (j_) % (2 * NBLK); const LAS unsigned char* vp_ = vb_ + (16 * r_) * VP + d_ * 64; \
            vlo_[(j_) & 1] = __builtin_bit_cast(s16x4, __builtin_amdgcn_ds_read_tr16_b64_v4i16((LAS v4i16_t*)vp_)); \
            vhi_[(j_) & 1] = __builtin_bit_cast(s16x4, __builtin_amdgcn_ds_read_tr16_b64_v4i16((LAS v4i16_t*)(vp_ + 8 * VP))); } while (0)
#define ATT_PV(vo_) do { const int sv_ = (MODE == 0) ? 0 : st; \
        const LAS unsigned char* vb_ = lds + (vo_) + sv_ * VTILE + (4 * h2 + ((lane & 15) >> 2)) * VP + ((lane >> 4) & 1) * 32 + (lane & 3) * 8; \
        s16x4 vlo_[2], vhi_[2]; ATT_VLD(0); \
        _Pragma("unroll") for (int j = 0; j < 8 * NBLK; ++j) { if (j + 1 < 8 * NBLK) ATT_VLD(j + 1); \
            const s16x4 lo_ = vlo_[j & 1], hi_ = vhi_[j & 1]; const bf16x8 vf_ = {lo_[0], lo_[1], lo_[2], lo_[3], hi_[0], hi_[1], hi_[2], hi_[3]}; \
            const int d_ = j / (2 * NBLK), r_ = j % (2 * NBLK); \
            o[d_] = __builtin_amdgcn_mfma_f32_32x32x16_bf16(vf_, pf[r_ >> 1][r_ & 1], o[d_], 0, 0, 0); } } while (0)
    f32x16 sc[NBLK]; bf16x8 pf[NBLK][2]; bool pv_pending = false;
    const bool order_b = (wave & 1) != 0;
    auto att_body = [&](int step, int vo_cur, int vo_prev, int ko_next) {
        const int k0 = step * KSTEP + ((MODE == 0) ? 0 : st * KT);
        const bool valid_next = (step + 1 < nsteps) && (MODE == 2 || k0 + KSTEP <= qw0 + 31);
        const bool valid = (MODE == 2) || (k0 <= qw0 + 31);
        if (!order_b && pv_pending && !(P.dbg & 1)) ATT_PV(vo_prev);
        pv_pending = valid && !order_b;
        if (valid && !(P.dbg & 2)) {
        const bool need_mask = (MODE != 2) && (k0 + KT - 1 > qw0);
        float bb = 0.f; bool near = false;
        if constexpr (MODE == 0) {
            const LAS float* lut = (const LAS float*)(lds + OFF_LUT);
            const LAS int* pk = (const LAS int*)(lds + vo_cur + OFF_POS);
            near = (posq0 - pk[KT - 1]) < 127;
            if (near) {
#pragma unroll
                for (int blk = 0; blk < NBLK; ++blk)
#pragma unroll
                    for (int i = 0; i < 16; ++i) { const int kl = 32 * blk + (i & 3) + 8 * (i >> 2) + 4 * h2; int rel = mypos - pk[kl]; rel = rel < 0 ? 0 : (rel > 127 ? 127 : rel);
                        sc[blk][i] = sc[blk][i] * P.c1 + lut[rel]; }
            } else bb = lut[127];
        }
        if (need_mask) {
#pragma unroll
            for (int blk = 0; blk < NBLK; ++blk)
#pragma unroll
                for (int i = 0; i < 16; ++i) { const int key = k0 + 32 * blk + (i & 3) + 8 * (i >> 2) + 4 * h2; if (key > myq) sc[blk][i] = NEG; }
        }
        const float cc = near ? 1.f : P.c1;
        float mx = sc[0][0];
#pragma unroll
        for (int blk = 0; blk < NBLK; ++blk)
#pragma unroll
            for (int i = 0; i < 16; ++i) mx = fmaxf(mx, sc[blk][i]);
        { const int mi = __builtin_bit_cast(int, mx); auto rr = __builtin_amdgcn_permlane32_swap(mi, mi, false, false); mx = fmaxf(__builtin_bit_cast(float, (int)rr[0]), __builtin_bit_cast(float, (int)rr[1])); }
        mx = mx * cc + bb;
        if (__any(mx > m_run + THR)) {
            const float m_new = fmaxf(m_run, mx);
            const float alpha = __builtin_amdgcn_exp2f(m_run - m_new);
            m_run = m_new; l_run *= alpha;
#pragma unroll
            for (int d = 0; d < 4; ++d)
#pragma unroll
                for (int i = 0; i < 16; ++i) o[d][i] *= alpha;
        }
        const float off = bb - m_run;
        float psum = 0.f;
#pragma unroll
        for (int blk = 0; blk < NBLK; ++blk)
#pragma unroll
            for (int i = 0; i < 16; ++i) { const float p = __builtin_amdgcn_exp2f(__builtin_fmaf(sc[blk][i], cc, off)); sc[blk][i] = p; psum += p; }
        l_run += psum;
#pragma unroll
        for (int blk = 0; blk < NBLK; ++blk)
#pragma unroll
            for (int s16 = 0; s16 < 2; ++s16) { u32x4 w; w.x = pk2(sc[blk][8 * s16 + 0], sc[blk][8 * s16 + 1]); w.y = pk2(sc[blk][8 * s16 + 2], sc[blk][8 * s16 + 3]);
                w.z = pk2(sc[blk][8 * s16 + 4], sc[blk][8 * s16 + 5]); w.w = pk2(sc[blk][8 * s16 + 6], sc[blk][8 * s16 + 7]); pf[blk][s16] = __builtin_bit_cast(bf16x8, w); }
        }
        if (order_b && valid && !(P.dbg & 1)) ATT_PV(vo_cur);
        if (valid_next && !(P.dbg & 4)) ATT_QK(sc, ko_next);
        };
#define ATT_BODY(step, vc, vp) att_body(step, vc, vp, 0)
#define ATT_BAR() asm volatile("s_waitcnt lgkmcnt(0)\n\ts_barrier" ::: "memory")
    if constexpr (ONEB) {
        ATT_PREFETCH_K(0);
        __syncthreads();
        ATT_STAGE_K(0, 0);
        if (nsteps > 1) ATT_PREFETCH_K(0);
        ATT_PREFETCH_V(0, 0);
        if (nsteps > 1) ATT_STAGE_K(0, KSLOT);
        ATT_STAGE_V(0, OFF_V);
        if (nsteps > 2) ATT_PREFETCH_K(0);
        if (nsteps > 1) ATT_PREFETCH_V(0, 1);
        __syncthreads();
        ATT_QK(sc, 0);
        int vo_prev = OFF_V + 2 * VSLOT, vo_cur = OFF_V, vo_next = OFF_V + VSLOT;
        for (int step = 0; step < nsteps; ++step) {
            ATT_BAR();
            const int ko_next = ((step + 1) & 1) * KSLOT, ko_free = (step & 1) * KSLOT;
            if (!(P.dbg & 8)) {
                if (step + 2 < nsteps) ATT_STAGE_K(0, ko_free);
                if (step + 1 < nsteps) ATT_STAGE_V(0, vo_next);
                if (step + 3 < nsteps) ATT_PREFETCH_K(0);
                if (step + 2 < nsteps) ATT_PREFETCH_V(0, step + 2); }
            att_body(step, vo_cur, vo_prev, ko_next);
            const int tmp_ = vo_prev; vo_prev = vo_cur; vo_cur = vo_next; vo_next = tmp_;
        }
        if (pv_pending) ATT_PV(vo_prev);
    } else {
    ATT_PREFETCH_K(0);
    __syncthreads();
    ATT_STAGE_K(0, 0);
    if (nsteps > 1) ATT_PREFETCH_K(KSET(0));
    if (PFD == 2 && nsteps > 2) ATT_PREFETCH_K(0);
    ATT_PREFETCH_V(0, 0);
    if (PFD == 2 && nsteps > 1) ATT_PREFETCH_V(1, 1);
    __syncthreads();
    ATT_QK(sc, 0);
#define ATT_ITER(step, par) do { \
        const int vo_cur = OFF_V + (par) * VSLOT, vo_prev = OFF_V + ((par) ^ 1) * VSLOT; \
        ATT_BAR();                                                  \
        if (!(P.dbg & 8)) { if ((step) + 1 < nsteps) ATT_STAGE_K(KSET(par), 0); \
        ATT_STAGE_V(VSET(par), vo_cur); } \
        ATT_BAR();                                                  \
        if (!(P.dbg & 8)) { if ((step) + 1 + PFD < nsteps) ATT_PREFETCH_K(KSET(par)); \
        if ((step) + PFD < nsteps) ATT_PREFETCH_V(VSET(par), (step) + PFD); } \
        ATT_BODY(step, vo_cur, vo_prev); } while (0)
    for (int step = 0; step < nsteps; step += 2) { ATT_ITER(step, 0); if (step + 1 < nsteps) ATT_ITER(step + 1, 1); }
    if (pv_pending) ATT_PV(OFF_V + ((nsteps - 1) & 1) * VSLOT);
    }
#undef ATT_PREFETCH_K
#undef ATT_PREFETCH_V
#undef ATT_STAGE_K
#undef ATT_STAGE_V
#undef ATT_QK
#undef ATT_PV
#undef ATT_VLD
#undef ATT_ITER
#undef ATT_BAR
#undef ATT_BODY
#undef KSET
#undef VSET
    l_run += __shfl_xor(l_run, 32);
    __syncthreads();
    LAS float* mb = (LAS float*)(lds + qg * 17408);
    if (st == 1) {
        if constexpr (MODE == 0) { const float inv = 1.f / l_run;
#pragma unroll
            for (int d = 0; d < 4; ++d)
#pragma unroll
                for (int i = 0; i < 16; ++i) mb[(d * 16 + i) * 64 + lane] = o[d][i] * inv;
        } else {
#pragma unroll
            for (int d = 0; d < 4; ++d)
#pragma unroll
                for (int i = 0; i < 16; ++i) mb[(d * 16 + i) * 64 + lane] = o[d][i];
            mb[4096 + lane] = m_run; mb[4160 + lane] = l_run;
        }
    }
    __syncthreads();
    if (st == 0) {
        if constexpr (MODE == 0) {
            const float inv = 1.f / l_run; float ss = 0.f;
#pragma unroll
            for (int d = 0; d < 4; ++d)
#pragma unroll
                for (int i = 0; i < 16; ++i) { const float v = o[d][i] * inv - P.lam * mb[(d * 16 + i) * 64 + lane]; o[d][i] = v; ss += v * v; }
            ss += __shfl_xor(ss, 32);
            const float rn = rsqrtf(ss * (1.f / 128.f) + 1e-5f) * P.outscale;
#pragma unroll
            for (int d = 0; d < 4; ++d)
#pragma unroll
                for (int i = 0; i < 16; ++i) { const int dv = 32 * d + (i & 3) + 8 * (i >> 2) + 4 * h2; o[d][i] = o[d][i] * rn * P.subw[dv]; }
        } else {
            const float m1 = mb[4096 + lane], l1 = mb[4160 + lane];
            const float mt = fmaxf(m_run, m1); const float a0 = __builtin_amdgcn_exp2f(m_run - mt), a1 = __builtin_amdgcn_exp2f(m1 - mt);
            const float inv = 1.f / (l_run * a0 + l1 * a1);
#pragma unroll
            for (int d = 0; d < 4; ++d)
#pragma unroll
                for (int i = 0; i < 16; ++i) o[d][i] = (o[d][i] * a0 + mb[(d * 16 + i) * 64 + lane] * a1) * inv;
        }
        LAS unsigned char* og = lds + OFF_OST + qg * (32 * OSTP);
#pragma unroll
        for (int d = 0; d < 4; ++d)
#pragma unroll
            for (int g4 = 0; g4 < 4; ++g4) { u32x2 w; w.x = pk2(o[d][4 * g4 + 0], o[d][4 * g4 + 1]); w.y = pk2(o[d][4 * g4 + 2], o[d][4 * g4 + 3]);
                *(LAS u32x2*)(og + r32 * OSTP + (32 * d + 8 * g4 + 4 * h2) * 2) = w; }
        asm volatile("s_waitcnt lgkmcnt(0)" ::: "memory");
        bf16_t* op = P.O + (P.qrow0 + qw0) * (size_t)P.opitch + P.ocol0;
#pragma unroll
        for (int i = 0; i < 8; ++i) { const int row = 4 * i + (lane >> 4), ch = lane & 15;
            const u32x4 v = *(const LAS u32x4*)(og + row * OSTP + ch * 16);
            *(u32x4*)(op + (size_t)row * P.opitch + ch * 8) = v; }
    }
    __syncthreads();
}

DI void phase_att(const Ctx& C, int l) {
    inptr_t in = C.in; unsigned char* ws = C.ws;
    const int ATT_SEL = C.att_sel & 0xff; const int dbg = C.att_sel >> 8;
    if (ATT_SEL & 1) phase_post(C, l);
    bf16_t* Y = dbg ? (bf16_t*)(ws + WS_H) : (bf16_t*)(ws + WS_PRW); const bf16_t* PATT = (const bf16_t*)(ws + WS_PATT);
    const float lambda_init = 0.8f - 0.6f * expf(-0.3f * (float)l);
    float lam;
    { const float a = wave_sum(in[23][l * 64 + C.lane] * in[24][l * 64 + C.lane]), b = wave_sum(in[25][l * 64 + C.lane] * in[26][l * 64 + C.lane]); lam = expf(a) - expf(b) + lambda_init; }
    if (ATT_SEL & 2) for (int w = C.vcu; w < 256; w += C.G) {
        const int bh = w >> 4, j = w & 15, b = bh >> 2, h = bh & 3;
#pragma unroll 1
        for (int k = 0; k < 2; ++k) { const int qb = k ? 31 - j : j;
            AttnP P; P.Q = PATT; P.qpitch = PATT_COLS; P.qcol0 = h * 128; P.K1 = PATT; P.k1pitch = PATT_COLS; P.k1col0 = 512 + h * 128; P.K2 = PATT; P.k2pitch = 0; P.k2col0 = 0;
            P.V = PATT; P.vpitch = PATT_COLS; P.vcol0 = 1024 + h * 128; P.O = Y; P.opitch = 2048; P.ocol0 = 1024 + h * 128;
            P.qrow0 = (size_t)b * SEQ; P.krow0 = (size_t)b * SEQ; P.q0 = qb * 128; P.nkeys = qb * 128 + 128; P.c1 = 0.125f * LOG2E;
            P.pos = (const int*)in[2] + b * SEQ; P.lut = (const float*)(ws + WS_LUT) + h * 128; P.lam = lam; P.outscale = 1.f - lambda_init; P.subw = in[27] + l * 128; P.dbg = dbg;
            attn_unit<64, 64, 0, 64, 1>(C.lds, P); }
    }
    const bf16_t* QM = (const bf16_t*)(ws + WS_QM); const bf16_t* KVM = (const bf16_t*)(ws + WS_KVM); const bf16_t* KPE = (const bf16_t*)(ws + WS_KPE);
    if (ATT_SEL & 4) for (int w = C.vcu; w < 256; w += C.G) {
        const int bh = w >> 4, j = w & 15, b = bh >> 2, h = bh & 3;
#pragma unroll 1
        for (int k = 0; k < 2; ++k) { const int qb = k ? 31 - j : j;
            AttnP P; P.Q = QM; P.qpitch = 768; P.qcol0 = h * 192; P.K1 = KVM; P.k1pitch = 1024; P.k1col0 = h * 256; P.K2 = KPE; P.k2pitch = 64; P.k2col0 = 0;
            P.V = KVM; P.vpitch = 1024; P.vcol0 = h * 256 + 128; P.O = Y; P.opitch = 2048; P.ocol0 = 1536 + h * 128;
            P.qrow0 = (size_t)b * SEQ; P.krow0 = (size_t)b * SEQ; P.q0 = qb * 128; P.nkeys = qb * 128 + 128; P.c1 = 0.07216878364870322f * LOG2E;
            P.pos = nullptr; P.lut = nullptr; P.lam = 0.f; P.outscale = 0.f; P.subw = nullptr; P.dbg = dbg;
            attn_unit<192, 128, 1, 32, 1>(C.lds, P); }
    }
}

DI void phase_cross(const Ctx& C) {
    unsigned char* ws = C.ws; const int dbg = 0;
    const bf16_t* CAQ = (const bf16_t*)(ws + WS_CAQ); const bf16_t* MKV = (const bf16_t*)(ws + WS_MEMKV); bf16_t* CAO = (bf16_t*)(ws + WS_CAO);
    for (int u = C.vcu; u < 512; u += C.G) {
        const int bh = u >> 5, qb = u & 31, b = bh >> 2, h = bh & 3;
        AttnP P; P.Q = CAQ; P.qpitch = 512; P.qcol0 = h * 128; P.K1 = MKV; P.k1pitch = 1024; P.k1col0 = h * 128; P.K2 = MKV; P.k2pitch = 0; P.k2col0 = 0;
        P.V = MKV; P.vpitch = 1024; P.vcol0 = 512 + h * 128; P.O = CAO; P.opitch = 512; P.ocol0 = h * 128;
        P.qrow0 = (size_t)b * SEQ; P.krow0 = (size_t)b * MEMLEN; P.q0 = qb * 128; P.nkeys = MEMLEN; P.c1 = 0.08838834764831845f * LOG2E;
        P.pos = nullptr; P.lut = nullptr; P.lam = 0.f; P.outscale = 0.f; P.subw = nullptr; P.dbg = dbg;
        attn_unit<128, 128, 2, 64, 1>(C.lds, P);
    }
}

DI void phase_route(const Ctx& C, int l) {
    inptr_t in = C.in; unsigned char* ws = C.ws;
    const float* LG = (const float*)(ws + WS_LOGITS);
    const float* bg = in[39] + l * 4; const float* be = in[41] + l * 32;
    int* EID = (int*)(ws + WS_EID); float* GATE = (float*)(ws + WS_GATE); int* CNT = (int*)(ws + WS_CNT);
    LAS int* hist = (LAS int*)(C.lds);
    const int lane = C.lane;
    for (int wgt = C.wg; wgt < 256; wgt += C.G) {
        if (C.tid < 32) hist[C.tid] = 0;
        __syncthreads();
#pragma unroll 1
        for (int r = 0; r < 8; ++r) {
            const int t = wgt * 64 + C.wave * 8 + r;
            const float raw = (lane < 36) ? LG[(size_t)t * 256 + lane] : 0.f;
            const float g0 = RDL_F(raw, 32), g1 = RDL_F(raw, 33), g2 = RDL_F(raw, 34), g3 = RDL_F(raw, 35);
            int sel = 0; float best = g0 + bg[0];
            if (g1 + bg[1] > best) { best = g1 + bg[1]; sel = 1; }
            if (g2 + bg[2] > best) { best = g2 + bg[2]; sel = 2; }
            if (g3 + bg[3] > best) { best = g3 + bg[3]; sel = 3; }
            const float gm = fmaxf(fmaxf(g0, g1), fmaxf(g2, g3));
            const float e0 = __expf(g0 - gm), e1 = __expf(g1 - gm), e2 = __expf(g2 - gm), e3 = __expf(g3 - gm);
            const float es = sel == 0 ? e0 : (sel == 1 ? e1 : (sel == 2 ? e2 : e3));
            const float pgrp = es / ((e0 + e1) + (e2 + e3));
            float val = (lane < 32 && (lane >> 3) == sel) ? raw + be[lane & 31] : -INFINITY;
            const float m1 = wave_max(val); const int i1 = __ffsll((long long)__ballot(val == m1)) - 1;
            if (lane == i1) val = -INFINITY;
            const float m2 = wave_max(val); const int i2 = __ffsll((long long)__ballot(val == m2)) - 1;
            const float r1 = __shfl(raw, i1), r2 = __shfl(raw, i2);
            const float w1 = 1.f / (1.f + __expf(r2 - r1)), w2 = 1.f - w1;
            if (lane == 0) { EID[2 * t] = i1; EID[2 * t + 1] = i2; GATE[2 * t] = w1 * pgrp; GATE[2 * t + 1] = w2 * pgrp;
                atomicAdd((int*)&hist[i1], 1); atomicAdd((int*)&hist[i2], 1); }
        }
        __syncthreads();
        if (C.tid < 32) CNT[wgt * 32 + C.tid] = hist[C.tid];
        __syncthreads();
    }
}

DI void phase_dispatch(const Ctx& C) {
    unsigned char* ws = C.ws;
    const int* EID = (const int*)(ws + WS_EID); const int* CNT = (const int*)(ws + WS_CNT);
    int* ROWMAP = (int*)(ws + WS_ROWMAP); int* ROWDST = (int*)(ws + WS_ROWDST); int* TILEEXP = (int*)(ws + WS_TILEEXP);
    LAS int* tot = (LAS int*)(C.lds); LAS int* base = tot + 32; LAS int* off = base + 32; LAS int* eid = off + 40; LAS int* posl = eid + 128;
    const int tid = C.tid;
    for (int wgt = C.wg; wgt < 256; wgt += C.G) {
        { LAS int* cl = posl + 128;
#pragma unroll
          for (int i = 0; i < 16; ++i) cl[tid + 512 * i] = CNT[tid + 512 * i];
          __syncthreads();
          if (tid < 32) { int s = 0, bsum = 0; for (int w = 0; w < 256; ++w) { const int c = cl[w * 32 + tid]; if (w == wgt) bsum = s; s += c; } tot[tid] = s; base[tid] = bsum; } }
        if (tid >= 64 && tid < 192) eid[tid - 64] = EID[wgt * 128 + (tid - 64)];
        __syncthreads();
        if (tid == 0) { int o = 0; for (int e = 0; e < 32; ++e) { off[e] = o; o += (tot[e] + 255) & ~255; } off[32] = o; }
        __syncthreads();
        if (tid < 128) { const int e = eid[tid]; int rank = 0; for (int j = 0; j < tid; ++j) rank += (eid[j] == e) ? 1 : 0;
            const int pos = off[e] + base[e] + rank; ROWMAP[pos] = wgt * 64 + (tid >> 1); ROWDST[pos] = wgt * 128 + tid; }
        if (wgt < 32) { const int e = wgt; for (int p = off[e] + tot[e] + tid; p < off[e + 1]; p += 512) { ROWMAP[p] = 0; ROWDST[p] = -1; } }
        if (wgt == 0) { if (tid < 32) { for (int tl = off[tid] >> 8; tl < (off[tid + 1] >> 8); ++tl) TILEEXP[tl] = tid; } if (tid == 0) TILEEXP[200] = off[32] >> 8; }
        __syncthreads();
    }
}

#ifndef PHASE_MASK
#define PHASE_MASK 0x1ffff
#endif
#define IN(k) (lo <= (k) && (k) < hi)
#define EN(j) ((PHASE_MASK >> (j)) & 1)
#define SEAM(k) do { if (IN(k) && IN((k) + 1)) xcd_barrier(bar); } while (0)
#define PH_BEGIN() do { int t_ = threadIdx.x; asm volatile("" : "+v"(t_)); kaptr_t ka_ = (kaptr_t)__builtin_amdgcn_kernarg_segment_ptr(); asm volatile("" : "+s"(ka_)); \
        C.lds = (LAS unsigned char*)lds_raw; C.in = (inptr_t)ka_; C.X = *(float* const CAS*)(ka_ + 360); C.ws = *(unsigned char* const CAS*)(ka_ + 368); \
        C.tid = t_; C.lane = t_ & 63; C.wave = __builtin_amdgcn_readfirstlane(t_ >> 6); { int g_ = gridDim.x, b_ = blockIdx.x; asm volatile("" : "+s"(g_), "+s"(b_)); C.G = g_; C.wg = b_; } C.gw = C.wg * 8 + C.wave; C.ngw = C.G * 8; C.vcu = (C.G % 8 == 0) ? (C.wg % 8) * (C.G / 8) + C.wg / 8 : C.wg; \
        ws = C.ws; in = C.in; } while (0)
constexpr int PPL = 16, NPHASE = 2 * PPL + 1;
template <int l>
DI void run_layer(unsigned char* lds_raw, const XcdBarrier& bar, int lo, int hi, int att_sel = 7) {
    Ctx C; unsigned char* ws; inptr_t in; C.att_sel = att_sel;
    constexpr int pb = l * PPL;

        if (EN(0) && IN(pb + 0)) { PH_BEGIN(); phase_convert(C, l); } SEAM(pb + 0);
        if (EN(1) && IN(pb + 1)) { PH_BEGIN();
            { pg8::Gemm g{(const bf16_t*)(ws + WS_XB), (const bf16_t*)(ws + wofs(l) + WS_WINT), DM, DM, DM, nullptr}; pg8::StaticOrder S; S.init(NT, INP, C.G, C.wg, DM);
              pg8::EpiBf16 E{(bf16_t*)(ws + WS_PRW), RW_COLS, (bf16_t*)(ws + WS_PATT), PATT_COLS, 13, (const float*)(ws + WS_SSQM), 1};
              pg8::gemm_phase<pg8::EpiBf16, pg8::StaticOrder>(C.lds, g, S, E); }
            { pg8::Gemm g{(const bf16_t*)(ws + WS_MEMN), (const bf16_t*)(ws + wofs(l) + WS_CAWKVT), DM, DM, DM, nullptr}; pg8::StaticOrder S; S.init(NMEM, 1024, C.G, (C.wg + C.G / 2) % C.G, DM);
              pg8::EpiBf16 E{(bf16_t*)(ws + WS_MEMKV), 1024, nullptr, 0, 1 << 30, nullptr, 1};
              pg8::gemm_phase<pg8::EpiBf16, pg8::StaticOrder>(C.lds, g, S, E); }
        } SEAM(pb + 1);
        if (EN(2) && IN(pb + 2)) { PH_BEGIN(); phase_ew1(C, l); } SEAM(pb + 2);
        if (EN(3) && IN(pb + 3)) { PH_BEGIN();
            { pg8::Gemm g{(const bf16_t*)(ws + WS_LORAA), (const bf16_t*)(ws + wofs(l) + WS_LORABT), 384, 384, 384, nullptr}; pg8::StaticOrder S; S.init(NT, 4096, C.G, C.wg, 384);
              pg8::EpiBf16 E{(bf16_t*)(ws + WS_LORAO), 4096, nullptr, 0, 1 << 30, nullptr, 1};
              pg8::gemm_phase<pg8::EpiBf16, pg8::StaticOrder>(C.lds, g, S, E); }
            { pg8::Gemm g{(const bf16_t*)(ws + WS_QN), (const bf16_t*)(ws + wofs(l) + WS_WQBT), 384, 384, 384, nullptr}; pg8::StaticOrder S; S.init(NT, 768, C.G, C.wg, 384);
              pg8::EpiBf16 E{(bf16_t*)(ws + WS_QM), 768, nullptr, 0, 1 << 30, nullptr, 1};
              pg8::gemm_phase<pg8::EpiBf16, pg8::StaticOrder>(C.lds, g, S, E); }
            { pg8::Gemm g{(const bf16_t*)(ws + WS_KVN), (const bf16_t*)(ws + wofs(l) + WS_WKVBT), 256, 256, 256, nullptr}; pg8::StaticOrder S; S.init(NT, 1024, C.G, C.wg, 256);
              pg8::EpiBf16 E{(bf16_t*)(ws + WS_KVM), 1024, nullptr, 0, 1 << 30, nullptr, 1};
              pg8::gemm_phase<pg8::EpiBf16, pg8::StaticOrder>(C.lds, g, S, E); }
        } SEAM(pb + 3);
        if (EN(4) && IN(pb + 4)) { PH_BEGIN(); phase_ew2(C, l); } SEAM(pb + 4);
        if (EN(5) && IN(pb + 5)) { PH_BEGIN(); phase_scan(C, l); } SEAM(pb + 5);
        if (EN(6) && IN(pb + 6)) { PH_BEGIN(); phase_att(C, l); } SEAM(pb + 6);
        if (EN(7) && IN(pb + 7)) { PH_BEGIN();
            pg8::Gemm g{(const bf16_t*)(ws + WS_PRW), (const bf16_t*)(ws + wofs(l) + WS_WOUTT), DM, DM, DM, nullptr}; pg8::StaticOrder S; S.init(NT, DM, C.G, C.wg, DM);
            pg8::EpiResid E{l == 0 ? in[0] : nullptr, (const bf16_t*)(ws + WS_XB), (bf16_t*)(ws + WS_XB), DM, (float*)(ws + WS_PARTC)};
            pg8::gemm_phase<pg8::EpiResid, pg8::StaticOrder>(C.lds, g, S, E);
        } SEAM(pb + 7);
        if (EN(8) && IN(pb + 8)) { PH_BEGIN();
            pg8::Gemm g{(const bf16_t*)(ws + WS_XB), (const bf16_t*)(ws + wofs(l) + WS_CAWQT), DM, DM, DM, nullptr}; pg8::StaticOrder S; S.init(NT, 512, C.G, C.wg, DM);
            pg8::EpiBf16 E{(bf16_t*)(ws + WS_CAQ), 512, nullptr, 0, 1 << 30, (const float*)(ws + WS_PARTC), 32};
            pg8::gemm_phase<pg8::EpiBf16, pg8::StaticOrder>(C.lds, g, S, E);
        } SEAM(pb + 8);
        if (EN(9) && IN(pb + 9)) { PH_BEGIN(); phase_cross(C); } SEAM(pb + 9);
        if (EN(10) && IN(pb + 10)) { PH_BEGIN();
            pg8::Gemm g{(const bf16_t*)(ws + WS_CAO), (const bf16_t*)(ws + wofs(l) + WS_CAWOT), 512, 512, 512, nullptr}; pg8::StaticOrder S; S.init(NT, DM, C.G, C.wg, 512);
            pg8::EpiResid E{nullptr, (const bf16_t*)(ws + WS_XB), (bf16_t*)(ws + WS_XB), DM, (float*)(ws + WS_PARTF)};
            pg8::gemm_phase<pg8::EpiResid, pg8::StaticOrder>(C.lds, g, S, E);
        } SEAM(pb + 10);
        if (EN(11) && IN(pb + 11)) { PH_BEGIN();
            pg8::Gemm g{(const bf16_t*)(ws + WS_XB), (const bf16_t*)(ws + (l ? WS_WRB1 : WS_WRB)), DM, DM, DM, nullptr}; pg8::StaticOrder S; S.init(NT, 256, C.G, C.wg, DM);
            pg8::EpiF32 E{(float*)(ws + WS_LOGITS), 256, (const float*)(ws + WS_PARTF), 32, (float*)(ws + WS_SSQF)};
            pg8::gemm_phase<pg8::EpiF32, pg8::StaticOrder>(C.lds, g, S, E);
        } SEAM(pb + 11);
        if (EN(12) && IN(pb + 12)) { PH_BEGIN(); phase_route(C, l); } SEAM(pb + 12);
        if (EN(13) && IN(pb + 13)) { PH_BEGIN(); phase_dispatch(C); } SEAM(pb + 13);
        if (EN(14) && IN(pb + 14)) { PH_BEGIN();
            const int* TE = (const int*)(ws + WS_TILEEXP);
            pg8::Gemm g{(const bf16_t*)(ws + WS_XB), (const bf16_t*)(ws + WS_WGU), DM, DM, DM, (const int*)(ws + WS_ROWMAP)};
            pg8::MoeOrder S{TE, TE[200], 4, C.G, C.wg, DM, (long)1024 * DM};
            pg8::EpiSiluMul E{(bf16_t*)(ws + WS_HID), DEXP, (const float*)(ws + WS_SSQF), (const int*)(ws + WS_ROWMAP)};
            pg8::gemm_phase<pg8::EpiSiluMul, pg8::MoeOrder, true>(C.lds, g, S, E);
        } SEAM(pb + 14);
        if (EN(15) && IN(pb + 15)) { PH_BEGIN();
            const int* TE = (const int*)(ws + WS_TILEEXP);
            pg8::Gemm g{(const bf16_t*)(ws + WS_HID), (const bf16_t*)(ws + WS_WD), DEXP, DEXP, DEXP, nullptr};
            pg8::MoeOrder S{TE, TE[200], 8, C.G, C.wg, DEXP, (long)DM * DEXP};
            pg8::EpiScatter E{(bf16_t*)(ws + WS_C2), DM, (const int*)(ws + WS_ROWDST)};
            pg8::gemm_phase<pg8::EpiScatter, pg8::MoeOrder>(C.lds, g, S, E);
        } SEAM(pb + 15);
    }

__global__ void __launch_bounds__(512, 2) mk_fwd(Args args) {
    extern __shared__ __attribute__((aligned(16))) unsigned char lds_raw[];
    Ctx C;
    unsigned char* ws; inptr_t in;
    PH_BEGIN();
    volatile LAS unsigned* MISC = (volatile LAS unsigned*)(C.lds + LDS_MISC);
    if (C.tid < 64) MISC[C.tid] = 0u;
    __syncthreads();
    const int lo = args.ph_lo, hi = args.ph_hi;
    XcdBarrier bar; bar.bar = (unsigned*)(args.ws + WS_CTL) + CW_BAR; bar.x = 0; bar.st = MISC + 8;
    if (hi - lo > 1) bar = xcd_barrier_post((unsigned*)(args.ws + WS_CTL) + CW_BAR, MISC + 8);
#ifndef PROBE_MASK
#define PROBE_MASK 0
#endif
#if PROBE_MASK
#ifndef PROBE_ATT
#define PROBE_ATT 7
#endif
#define RUNP(k) do { run_layer<0>(lds_raw, bar, (k), (k) + 1); xcd_barrier(bar); if ((PROBE_MASK >> (k)) & 1) { run_layer<0>(lds_raw, bar, (k), (k) + 1, PROBE_ATT); xcd_barrier(bar); } } while (0)
    RUNP(0); RUNP(1); RUNP(2); RUNP(3); RUNP(4); RUNP(5); RUNP(6); RUNP(7); RUNP(8); RUNP(9); RUNP(10); RUNP(11); RUNP(12); RUNP(13); RUNP(14); RUNP(15);
    run_layer<1>(lds_raw, bar, PPL, 2 * PPL); xcd_barrier(bar);
#else
    run_layer<0>(lds_raw, bar, lo, hi);
    run_layer<1>(lds_raw, bar, lo, hi);
#endif
    if (EN(16) && IN(2 * PPL)) { PH_BEGIN();
        const bf16_t* C2 = (const bf16_t*)(ws + WS_C2); const float* gate = (const float*)(ws + WS_GATE);
        for (int m = C.gw; m < NT; m += C.ngw)
            norm_row(nullptr, (const bf16_t*)(ws + WS_XB) + (size_t)m * DM, nullptr, C2 + (size_t)(2 * m) * DM, C2 + (size_t)(2 * m + 1) * DM, gate[2 * m], gate[2 * m + 1], in[4], nullptr, C.X + (size_t)m * DM, C.lane);
    }
#undef IN
#undef SEAM
}

extern "C" void kernel_launch(void* const* d_in, const int* in_sizes, int n_in, void* d_out, int out_size, void* d_ws, size_t ws_size, hipStream_t stream) {
    static int grid = 0;
    if (grid == 0) {
        if (n_in != 45 || out_size != NT * DM || ws_size < WS_END) { grid = -1; return; }
        int dev = 0, cus = 0;
        if (hipGetDevice(&dev) != hipSuccess || hipDeviceGetAttribute(&cus, hipDeviceAttributeMultiprocessorCount, dev) != hipSuccess) { grid = -1; return; }
        if (hipFuncSetAttribute((const void*)mk_fwd, hipFuncAttributeMaxDynamicSharedMemorySize, LDS_BYTES) != hipSuccess) { grid = -1; return; }
        int per_cu = 0;
        (void)hipOccupancyMaxActiveBlocksPerMultiprocessor(&per_cu, (const void*)mk_fwd, 512, LDS_BYTES);
        (void)hipGetLastError();
        grid = cus;
    }
    if (grid < 0) return;
    (void)hipMemsetAsync((char*)d_ws + WS_CTL, 0, 1 * MiB, stream);
    Args a{};
    for (int i = 0; i < 45; ++i) a.in[i] = d_in[i];
    a.out = (float*)d_out; a.ws = (unsigned char*)d_ws;
#if MK_ONE_LAUNCH
    a.ph_lo = 0; a.ph_hi = NPHASE;
    hipLaunchKernelGGL(mk_fwd, dim3(grid), dim3(512), LDS_BYTES, stream, a);
#else
    for (int p = 0; p < NPHASE; ++p) { a.ph_lo = p; a.ph_hi = p + 1; hipLaunchKernelGGL(mk_fwd, dim3(grid), dim3(512), LDS_BYTES, stream, a); }
#endif
}
```

```cpp
#include <hip/hip_runtime.h>
#include <stdint.h>
#include <math.h>

#ifndef MK_ONE_LAUNCH
#define MK_ONE_LAUNCH 1
#endif

#define DI __device__ __forceinline__
#define LAS __attribute__((address_space(3)))
#define GAS __attribute__((address_space(1)))

typedef unsigned short bf16_t;
typedef short bf16x8 __attribute__((ext_vector_type(8)));
typedef short s16x4 __attribute__((ext_vector_type(4)));
typedef float f32x2 __attribute__((ext_vector_type(2)));
typedef float f32x4 __attribute__((ext_vector_type(4)));
typedef float f32x16 __attribute__((ext_vector_type(16)));
typedef unsigned u32x2 __attribute__((ext_vector_type(2)));
typedef unsigned u32x4 __attribute__((ext_vector_type(4)));
typedef __bf16 bf16x2_t __attribute__((ext_vector_type(2)));
typedef short v4i16_t __attribute__((ext_vector_type(4)));
typedef _Float16 h2_t __attribute__((ext_vector_type(2)));
typedef _Float16 h4_t __attribute__((ext_vector_type(4)));

constexpr int NB = 4, SEQ = 4096, DM = 2048, NT = NB * SEQ;
constexpr int MEMLEN = 256, NMEM = NB * MEMLEN;
constexpr int RW_DIM = 1024, RW_COLS = 3328, IN_COLS = 5568, INP = 5632;
constexpr int PATT_COLS = 2304;
constexpr int NEXP = 32, DEXP = 512;
constexpr int MOE_ROWS = 40960;
constexpr float LOG2E = 1.4426950408889634f;

constexpr size_t MiB = 1u << 20, KiB = 1024;
constexpr size_t WS_CTL = 0;
constexpr size_t WS_ROPE = 1 * MiB;
constexpr size_t WS_EID = 5 * MiB;
constexpr size_t WS_GATE = 5 * MiB + 128 * KiB;
constexpr size_t WS_CNT = 5 * MiB + 256 * KiB;
constexpr size_t WS_ROWMAP = 5 * MiB + 320 * KiB;
constexpr size_t WS_ROWDST = 5 * MiB + 512 * KiB;
constexpr size_t WS_TILEEXP = 5 * MiB + 704 * KiB;
constexpr size_t WS_WRB = 7 * MiB;
constexpr size_t WS_LOGITS = 852 * MiB;
constexpr size_t WS_SSQM = 6 * MiB;
constexpr size_t WS_SSQC = 6 * MiB + 64 * KiB;
constexpr size_t WS_SSQF = 6 * MiB + 128 * KiB;
constexpr size_t WS_LUT = 6 * MiB + 512 * KiB;
constexpr size_t WS_WINT = 8 * MiB;
constexpr size_t WS_WOUTT = 30 * MiB;
constexpr size_t WS_CAWQT = 38 * MiB;
constexpr size_t WS_CAWKVT = 40 * MiB;
constexpr size_t WS_CAWOT = 44 * MiB;
constexpr size_t WS_WQBT = 46 * MiB;
constexpr size_t WS_WKVBT = 47 * MiB;
constexpr size_t WS_LORABT = 48 * MiB;
constexpr size_t WS_WGU = 52 * MiB;
constexpr size_t WS_WD = 180 * MiB;
constexpr size_t WS_H = 248 * MiB;
constexpr size_t WS_PRW = 312 * MiB;
constexpr size_t WS_PATT = 416 * MiB;
constexpr size_t WS_U = 488 * MiB;
constexpr size_t WS_HID = 488 * MiB, WS_C2 = 528 * MiB;
constexpr size_t WS_APERM = 312 * MiB;
constexpr size_t WS_LORAA = 680 * MiB;
constexpr size_t WS_LORAO = 692 * MiB;
constexpr size_t WS_VFIRST = 820 * MiB;
constexpr size_t WS_QN = 852 * MiB, WS_KVN = 864 * MiB, WS_QM = 872 * MiB, WS_KVM = 896 * MiB, WS_KPE = 928 * MiB;
constexpr size_t WS_CAQ = 852 * MiB, WS_CAO = 868 * MiB;
constexpr size_t WS_MEMN = 932 * MiB, WS_MEMKV = 936 * MiB;
constexpr size_t WS_XB = 940 * MiB;
constexpr size_t WS_PARTC = 1004 * MiB;
constexpr size_t WS_PARTF = 1006 * MiB;
constexpr size_t WS_L1OFF = 1000 * MiB;
constexpr size_t WS_WRB1 = 1052 * MiB;
constexpr size_t WS_END = 1053 * MiB;
constexpr int CW_BAR = 4096;

constexpr int LDS_MAIN = 131072;
constexpr int LDS_MISC = LDS_MAIN;
constexpr int LDS_BYTES = 147456;

DI unsigned pk2(float lo, float hi) { f32x2 v = {lo, hi}; bf16x2_t b = __builtin_convertvector(v, bf16x2_t); return __builtin_bit_cast(unsigned, b); }
DI bf16_t f2bf(float f) { return (bf16_t)(pk2(f, 0.f) & 0xffffu); }
DI unsigned pkh2(float lo, float hi) { const h2_t v = {(_Float16)lo, (_Float16)hi}; return __builtin_bit_cast(unsigned, v); }
DI float hflo(unsigned u) { return (float)__builtin_bit_cast(h2_t, u)[0]; }
DI float hfhi(unsigned u) { return (float)__builtin_bit_cast(h2_t, u)[1]; }
DI float bf2f(bf16_t b) { return __uint_as_float(((unsigned)b) << 16); }
DI float bflo(unsigned u) { return __uint_as_float(u << 16); }
DI float bfhi(unsigned u) { return __uint_as_float(u & 0xffff0000u); }
#define DPP_F(x, ctl) __builtin_bit_cast(float, __builtin_amdgcn_update_dpp(0, __builtin_bit_cast(int, x), ctl, 0xf, 0xf, true))
#define RDL_F(x, l) __builtin_bit_cast(float, __builtin_amdgcn_readlane(__builtin_bit_cast(int, x), l))
DI float wave_sum(float v) {
    v += DPP_F(v, 0xB1);
    v += DPP_F(v, 0x4E);
    v += DPP_F(v, 0x141);
    v += DPP_F(v, 0x140);
    const float r0 = RDL_F(v, 0), r1 = RDL_F(v, 16), r2 = RDL_F(v, 32), r3 = RDL_F(v, 48);
    return (r0 + r1) + (r2 + r3);
}
DI float wave_max(float v) {
    v = fmaxf(v, DPP_F(v, 0xB1)); v = fmaxf(v, DPP_F(v, 0x4E)); v = fmaxf(v, DPP_F(v, 0x141)); v = fmaxf(v, DPP_F(v, 0x140));
    const float r0 = RDL_F(v, 0), r1 = RDL_F(v, 16), r2 = RDL_F(v, 32), r3 = RDL_F(v, 48);
    return fmaxf(fmaxf(r0, r1), fmaxf(r2, r3));
}
DI float sigmoidf_(float x) { return 1.f / (1.f + __expf(-x)); }

#define XB_TMO      128
#define XB_XCNT(j)  (256  + 64 * (j))
#define XB_XSUB(j)  (1280 + 64 * (j))
#define XB_XGEN(j)  (2304 + 64 * (j))
#define XB_TOP      3328
#define XB_TOPGEN   3392
#define XCD_BAR_WORDS 3456
#define XB_SPIN_CAP (1u << 24)

DI unsigned xb_ld(unsigned* p)              { return __hip_atomic_load(p, __ATOMIC_RELAXED, __HIP_MEMORY_SCOPE_AGENT); }
DI unsigned xb_add(unsigned* p, unsigned v) { return __hip_atomic_fetch_add(p, v, __ATOMIC_RELAXED, __HIP_MEMORY_SCOPE_AGENT); }
DI unsigned xb_xcc_id() { return (unsigned)__builtin_amdgcn_s_getreg((3 << 11) | 20) & 0xFu; }
#define XB_SPIN(cond, bar) do { unsigned _sp = 0; while (cond) { __builtin_amdgcn_s_sleep(1); \
    if ((++_sp & 255u) == 0u) { if (xb_ld(&(bar)[XB_TMO])) break; if (_sp > XB_SPIN_CAP) { atomicAdd(&(bar)[XB_TMO], 1u); break; } } } } while (0)

struct XcdBarrier { unsigned* bar; unsigned x; volatile LAS unsigned* st; };

DI XcdBarrier xcd_barrier_post(unsigned* bar, volatile LAS unsigned* st) {
    XcdBarrier b; b.bar = bar; b.x = xb_xcc_id(); b.st = st;
    if (threadIdx.x == 0) (void)xb_add(&bar[XB_XCNT(b.x)], 1u);
    return b;
}
DI void xcd_barrier_complete(unsigned* bar, unsigned x, unsigned& nloc, unsigned& nx) {
    const unsigned G = gridDim.x * gridDim.y * gridDim.z;
    unsigned sum, cnt, mine, sp = 0u;
    for (;;) {
        sum = 0u; cnt = 0u; mine = 0u;
#pragma unroll
        for (unsigned j = 0; j < 16; ++j) { const unsigned c = xb_ld(&bar[XB_XCNT(j)]); sum += c; cnt += (c > 0u) ? 1u : 0u; mine = (j == x) ? c : mine; }
        if (sum == G) break;
        __builtin_amdgcn_s_sleep(1);
        if ((++sp & 255u) == 0u) { if (xb_ld(&bar[XB_TMO])) break; if (sp > XB_SPIN_CAP) { atomicAdd(&bar[XB_TMO], 1u); break; } }
    }
    nloc = mine > 0u ? mine : 1u; nx = cnt > 0u ? cnt : 1u;
}
DI void xcd_barrier(const XcdBarrier& b) {
    asm volatile("s_waitcnt vmcnt(0)" ::: "memory");
    __syncthreads();
    if (threadIdx.x == 0) {
        unsigned* bar = b.bar;
        __builtin_amdgcn_s_waitcnt(0);
        unsigned nloc = b.st[0], nx = b.st[1];
        if (nloc == 0u) { xcd_barrier_complete(bar, b.x, nloc, nx); b.st[0] = nloc; b.st[1] = nx; }
        const unsigned old = xb_add(&bar[XB_XSUB(b.x)], 1u);
        const unsigned gen = old / nloc;
        if (old + 1u == (gen + 1u) * nloc) {
            __builtin_amdgcn_fence(__ATOMIC_RELEASE, "agent");
            asm volatile("s_waitcnt vmcnt(0)" ::: "memory");
            const unsigned og = xb_add(&bar[XB_TOP], 1u);
            const unsigned tg = og / nx;
            if (og + 1u == (tg + 1u) * nx) xb_add(&bar[XB_TOPGEN], 1u);
            else XB_SPIN(xb_ld(&bar[XB_TOPGEN]) == tg, bar);
            __builtin_amdgcn_fence(__ATOMIC_ACQUIRE, "agent");
            xb_add(&bar[XB_XGEN(b.x)], 1u);
            asm volatile("s_waitcnt vmcnt(0)" ::: "memory");
        } else {
            XB_SPIN(xb_ld(&bar[XB_XGEN(b.x)]) == gen, bar);
            __builtin_amdgcn_fence(__ATOMIC_ACQUIRE, "agent");
            asm volatile("s_waitcnt vmcnt(0)" ::: "memory");
        }
    }
    __syncthreads();
}

namespace pg8 {
constexpr int BM = 256, BK = 64, HALF = 128, HTB = HALF * BK * 2, STAGE_BYTES = 8 * HTB, NXCD = 8, WGM = 8;
__host__ __device__ __forceinline__ int lds_byte(int r, int c) { const int st = (r >> 4) * 2 + (c >> 5), rr = r & 15, cc = c & 31, ob = rr * 64 + cc * 2; return st * 1024 + (ob ^ (((ob >> 9) & 1) << 5)); }
__host__ __device__ __forceinline__ void stage_rc(int b, int& R, int& C) { const int st = b / 1024, sb = b % 1024, swz = sb ^ (((sb >> 9) & 1) << 5); R = (st >> 1) * 16 + swz / 64; C = (st & 1) * 32 + (swz % 64) / 2; }
__host__ __device__ __forceinline__ int perm32(int rho) { const int n = rho >> 4, i = rho & 15; return 8 * (i >> 2) + 4 * n + (i & 3); }

struct Unit { int pm, pn; long bbase; };
struct Gemm { const bf16_t* A; const bf16_t* Bt; int lda, ldb, K; const int* rowmap; };

struct StaticOrder {
    int nM, nN, nwg, G, c, ldb;
    DI void init(int M, int N, int G_, int c_, int ldb_) { nM = M / BM; nN = N / BM; nwg = nM * nN; G = G_; c = c_; ldb = ldb_; }
    DI bool next(int i, Unit& u) const {
        const long L = (long)i * G + c; if (L >= nwg) return false;
        int wgid = (int)L; { const int q = nwg / NXCD, r = nwg % NXCD, xcd = wgid % NXCD, off = wgid / NXCD; wgid = (xcd < r ? xcd * (q + 1) : r * (q + 1) + (xcd - r) * q) + off; }
        const int nig = WGM * nN, gid = wgid / nig, fm = gid * WGM, gsz = (nM - fm) < WGM ? (nM - fm) : WGM;
        u.pm = fm + ((wgid % nig) % gsz); u.pn = (wgid % nig) / gsz; u.bbase = (long)u.pn * BM * ldb; return true;
    }
};
struct MoeOrder {
    const int* tileexp; int ntiles, nN, G, c, ldb; long estride;
    DI bool next(int i, Unit& u) const {
        const long L = (long)i * G + c; if (L >= (long)ntiles * nN) return false;
        const int tile = (int)(L / nN), pn = (int)(L % nN); const int e = tileexp[tile];
        u.pm = tile; u.pn = pn; u.bbase = (long)e * estride + (long)pn * BM * ldb; return true;
    }
};

template <class Epi, class Sched, bool GATHER = false>
DI void gemm_phase(LAS unsigned char* lds, const Gemm g, const Sched& S, const Epi& E) {
    int tid = threadIdx.x; asm volatile("" : "+v"(tid));
    const int wid = __builtin_amdgcn_readfirstlane(tid >> 6), lane = tid & 63, wr = wid >> 2, wc = wid & 3, fr = lane & 15, fq = lane >> 4;
    const int K = g.K, nt = K / BK;
    unsigned voffA[2], voffB[2]; int RA[2], CA[2];
#pragma unroll
    for (int i = 0; i < 2; ++i) { int R, C; stage_rc(tid * 16 + i * 8192, R, C); const int Rb = Epi::PERM ? ((R & ~31) + perm32(R & 31)) : R;
        RA[i] = R; CA[i] = C; voffA[i] = (unsigned)(R * g.lda + C) * 2u; voffB[i] = (unsigned)(Rb * g.ldb + C) * 2u; }
    const size_t kstep = (size_t)(BK * 2);
    const size_t hstepA = (size_t)HALF * g.lda * 2, hstepB = (size_t)HALF * g.ldb * 2;
    const unsigned ldsw = (unsigned)wid * 1024u;
    const int aoff = lds_byte(wr * 64 + fr, fq * 8), boff = lds_byte(wc * 32 + fr, fq * 8);
#define PG8_SA(b, h) (((b) * 2 + (h)) * HTB)
#define PG8_SB(b, h) ((4 + (b) * 2 + (h)) * HTB)
#define PG8_STAGE(bufoff, gbase, voff) do { _Pragma("unroll") for (int _i = 0; _i < 2; ++_i) \
        __builtin_amdgcn_global_load_lds((const unsigned*)((const char*)(gbase) + (voff)[_i]), (LAS unsigned*)(lds + (bufoff) + ldsw + _i * 8192), 16, 0, 0); } while (0)
    unsigned gA[2][2], ngA[2][2];
#define PG8_STAGE_A(b, h, ptr, isnext) do { if constexpr (GATHER) { if (isnext) PG8_STAGE(PG8_SA(b, h), ptr, ngA[h]); else PG8_STAGE(PG8_SA(b, h), ptr, gA[h]); } \
        else PG8_STAGE(PG8_SA(b, h), (ptr) + (h) * hstepA, voffA); } while (0)
#define PG8_GATHER_OFFS(dst, un) do { _Pragma("unroll") for (int h_ = 0; h_ < 2; ++h_) _Pragma("unroll") for (int i_ = 0; i_ < 2; ++i_) \
        dst[h_][i_] = (unsigned)(g.rowmap[(un).pm * BM + h_ * HALF + RA[i_]] * g.lda + CA[i_]) * 2u; } while (0)
#define PG8_LDA(dst, b, h) do { _Pragma("unroll") for (int m = 0; m < 4; ++m) _Pragma("unroll") for (int k = 0; k < 2; ++k) dst[m][k] = *(const LAS bf16x8*)(lds + PG8_SA(b, h) + aoff + m * 2048 + k * 1024); } while (0)
#define PG8_LDB(dst, b, h) do { _Pragma("unroll") for (int n = 0; n < 2; ++n) _Pragma("unroll") for (int k = 0; k < 2; ++k) dst[n][k] = *(const LAS bf16x8*)(lds + PG8_SB(b, h) + boff + n * 2048 + k * 1024); } while (0)
#define PG8_MMA(ai, bj, At, Bt) do { __builtin_amdgcn_s_setprio(1); _Pragma("unroll") for (int m = 0; m < 4; ++m) _Pragma("unroll") for (int n = 0; n < 2; ++n) _Pragma("unroll") for (int k = 0; k < 2; ++k) \
        acc[ai][bj][m][n] = __builtin_amdgcn_mfma_f32_16x16x32_bf16(Bt[n][k], At[m][k], acc[ai][bj][m][n], 0, 0, 0); __builtin_amdgcn_s_setprio(0); } while (0)
#define PG8_WAIT_V(n) asm volatile("s_waitcnt vmcnt(" #n ")" ::: "memory")
#define PG8_WAIT_L(n) asm volatile("s_waitcnt lgkmcnt(" #n ")" ::: "memory")
#define PG8_BAR __builtin_amdgcn_s_barrier()
#define PG8_SCHED __builtin_amdgcn_sched_barrier(0)
    Unit cur, nxt; int ui = 0;
    if (!S.next(0, cur)) return;
    f32x4 acc[2][2][4][2];
#pragma unroll
    for (int a = 0; a < 2; ++a)
#pragma unroll
        for (int b = 0; b < 2; ++b)
#pragma unroll
            for (int m = 0; m < 4; ++m)
#pragma unroll
                for (int n = 0; n < 2; ++n) acc[a][b][m][n] = (f32x4){0.f, 0.f, 0.f, 0.f};
    bf16x8 At[4][2], B0[2][2], B1[2][2];
    const char* cA; const char* cB = (const char*)g.Bt + cur.bbase * 2;
    if constexpr (GATHER) { cA = (const char*)g.A; PG8_GATHER_OFFS(gA, cur); PG8_GATHER_OFFS(ngA, cur); }
    else cA = (const char*)g.A + (size_t)cur.pm * BM * g.lda * 2;
    PG8_STAGE(PG8_SB(0, 0), cB, voffB); PG8_STAGE(PG8_SB(0, 1), cB + hstepB, voffB); PG8_STAGE_A(0, 0, cA, false); PG8_STAGE_A(0, 1, cA, false);
    if (wr == 1) PG8_BAR;
    PG8_WAIT_V(2); PG8_BAR;
    PG8_STAGE(PG8_SB(1, 0), cB + kstep, voffB); PG8_STAGE_A(1, 0, cA + kstep, false); PG8_STAGE(PG8_SB(1, 1), cB + hstepB + kstep, voffB);
    PG8_WAIT_V(6); PG8_BAR;
    for (;;) {
        const bool has_next = S.next(ui + 1, nxt);
        const char* nA; const char* nB = has_next ? (const char*)g.Bt + nxt.bbase * 2 : cB;
        if constexpr (GATHER) { nA = cA; if (has_next) PG8_GATHER_OFFS(ngA, nxt); }
        else nA = has_next ? (const char*)g.A + (size_t)nxt.pm * BM * g.lda * 2 : cA;
        for (int t = 0; t < nt; t += 2) {
            const bool last = (t == nt - 2);
            const char* a1 = cA + (size_t)(t + 1) * kstep;
            const char* a2 = last ? nA : cA + (size_t)(t + 2) * kstep; const char* b2 = last ? nB : cB + (size_t)(t + 2) * kstep;
            const char* a3 = a2 + kstep; const char* b3 = b2 + kstep;
            PG8_LDB(B0, 0, 0); PG8_LDB(B1, 0, 1); PG8_SCHED; PG8_LDA(At, 0, 0); PG8_STAGE_A(1, 1, a1, false);
            PG8_WAIT_V(8); PG8_WAIT_L(0); PG8_BAR; PG8_MMA(0, 0, At, B0); PG8_MMA(0, 1, At, B1); PG8_BAR; PG8_SCHED;
            PG8_LDA(At, 0, 1); PG8_STAGE(PG8_SB(0, 0), b2, voffB); PG8_STAGE(PG8_SB(0, 1), b2 + hstepB, voffB); PG8_STAGE_A(0, 0, a2, last);
            PG8_WAIT_V(8); PG8_WAIT_L(0); PG8_BAR; PG8_MMA(1, 0, At, B0); PG8_MMA(1, 1, At, B1); PG8_BAR; PG8_SCHED;
            PG8_LDB(B0, 1, 0); PG8_LDB(B1, 1, 1); PG8_SCHED; PG8_LDA(At, 1, 0); PG8_STAGE_A(0, 1, a2, last);
            PG8_WAIT_V(8); PG8_WAIT_L(0); PG8_BAR; PG8_MMA(0, 0, At, B0); PG8_MMA(0, 1, At, B1); PG8_BAR; PG8_SCHED;
            PG8_LDA(At, 1, 1); PG8_STAGE(PG8_SB(1, 0), b3, voffB); PG8_STAGE(PG8_SB(1, 1), b3 + hstepB, voffB); PG8_STAGE_A(1, 0, a3, last);
            PG8_WAIT_V(8); PG8_WAIT_L(0); PG8_BAR; PG8_MMA(1, 0, At, B0); PG8_MMA(1, 1, At, B1); PG8_BAR; PG8_SCHED;
        }
        if (wr == 0) PG8_BAR;
        E(acc, cur, wr, wc, fr, fq);
        if (!has_next) break;
#pragma unroll
        for (int a = 0; a < 2; ++a)
#pragma unroll
            for (int b = 0; b < 2; ++b)
#pragma unroll
                for (int m = 0; m < 4; ++m)
#pragma unroll
                    for (int n = 0; n < 2; ++n) acc[a][b][m][n] = (f32x4){0.f, 0.f, 0.f, 0.f};
        cur = nxt; cA = nA; cB = nB; ++ui;
        if constexpr (GATHER) {
#pragma unroll
            for (int h_ = 0; h_ < 2; ++h_)
#pragma unroll
                for (int i_ = 0; i_ < 2; ++i_) gA[h_][i_] = ngA[h_][i_]; }
        if (wr == 1) PG8_BAR;
    }
    PG8_WAIT_V(0);
    PG8_BAR;
#undef PG8_SA
#undef PG8_SB
#undef PG8_STAGE
#undef PG8_STAGE_A
#undef PG8_LDA
#undef PG8_LDB
#undef PG8_MMA
#undef PG8_WAIT_V
#undef PG8_WAIT_L
#undef PG8_BAR
#undef PG8_SCHED
#undef PG8_GATHER_OFFS
}

DI float row_ssq32(const float* part, int row) { const f32x4* p = (const f32x4*)(part + (size_t)row * 32); float t = 0.f;
#pragma unroll
    for (int i = 0; i < 8; ++i) { const f32x4 v = p[i]; t += (v[0] + v[1]) + (v[2] + v[3]); }
    return t; }
DI float row_rstd(const float* ssq, int np, int row) {
    float t;
    if (np == 1) t = ssq[row];
    else { const f32x4* p = (const f32x4*)(ssq + (size_t)row * 32); t = 0.f;
#pragma unroll
        for (int i = 0; i < 8; ++i) { const f32x4 v = p[i]; t += (v[0] + v[1]) + (v[2] + v[3]); } }
    return rsqrtf(t * (1.f / 2048.f) + 1e-6f);
}
struct EpiBf16 {
    static constexpr bool PERM = true;
    bf16_t* O; int ldc; bf16_t* O2; int ldc2; int split_tile; const float* ssq; int np;
    DI void operator()(const f32x4 (&acc)[2][2][4][2], const Unit& u, int wr, int wc, int fr, int fq) const {
        bf16_t* base = O; int ld = ldc; int colt = u.pn * BM;
        if (u.pn >= split_tile) { base = O2; ld = ldc2; colt = (u.pn - split_tile) * BM; }
        const int row0 = u.pm * BM + wr * 64 + fr, col0 = colt + wc * 32 + 8 * fq;
#pragma unroll
        for (int ai = 0; ai < 2; ++ai)
#pragma unroll
            for (int m = 0; m < 4; ++m) { const int row = row0 + ai * HALF + m * 16; bf16_t* rowp = base + (size_t)row * ld + col0;
                const float rs = ssq ? row_rstd(ssq, np, row) : 1.f;
#pragma unroll
                for (int bj = 0; bj < 2; ++bj) { const f32x4 v0 = acc[ai][bj][m][0] * rs, v1 = acc[ai][bj][m][1] * rs;
                    u32x4 w; w.x = pk2(v0[0], v0[1]); w.y = pk2(v0[2], v0[3]); w.z = pk2(v1[0], v1[1]); w.w = pk2(v1[2], v1[3]);
                    *(u32x4*)(rowp + bj * HALF) = w; } }
    }
};
struct EpiResid {
    static constexpr bool PERM = true;
    const float* basef; const bf16_t* baseb; bf16_t* out; int ldc; float* part_out;
    DI void operator()(const f32x4 (&acc)[2][2][4][2], const Unit& u, int wr, int wc, int fr, int fq) const {
        const int row0 = u.pm * BM + wr * 64 + fr, col0 = u.pn * BM + wc * 32 + 8 * fq;
#pragma unroll
        for (int ai = 0; ai < 2; ++ai)
#pragma unroll
            for (int m = 0; m < 4; ++m) { const int row = row0 + ai * HALF + m * 16; const size_t off = (size_t)row * ldc + col0; float sq = 0.f;
#pragma unroll
                for (int bj = 0; bj < 2; ++bj) { f32x4 v0 = acc[ai][bj][m][0], v1 = acc[ai][bj][m][1];
                    if (basef) { v0 += *(const f32x4*)(basef + off + bj * HALF); v1 += *(const f32x4*)(basef + off + bj * HALF + 4); }
                    else { const u32x4 b = *(const u32x4*)(baseb + off + bj * HALF);
                        v0 += (f32x4){bflo(b.x), bfhi(b.x), bflo(b.y), bfhi(b.y)}; v1 += (f32x4){bflo(b.z), bfhi(b.z), bflo(b.w), bfhi(b.w)}; }
                    u32x4 w; w.x = pk2(v0[0], v0[1]); w.y = pk2(v0[2], v0[3]); w.z = pk2(v1[0], v1[1]); w.w = pk2(v1[2], v1[3]);
                    *(u32x4*)(out + off + bj * HALF) = w;
                    const float a0 = bflo(w.x), a1 = bfhi(w.x), a2 = bflo(w.y), a3 = bfhi(w.y), a4 = bflo(w.z), a5 = bfhi(w.z), a6 = bflo(w.w), a7 = bfhi(w.w);
                    sq += ((a0 * a0 + a1 * a1) + (a2 * a2 + a3 * a3)) + ((a4 * a4 + a5 * a5) + (a6 * a6 + a7 * a7)); }
                sq += __shfl_xor(sq, 16); sq += __shfl_xor(sq, 32);
                if (fq == 0) part_out[(size_t)row * 32 + u.pn * 4 + wc] = sq; }
    }
};
struct EpiF32 {
    static constexpr bool PERM = false;
    float* out; int ldc; const float* ssq; int np; float* ssq_pub;
    DI void operator()(const f32x4 (&acc)[2][2][4][2], const Unit& u, int wr, int wc, int fr, int fq) const {
        const int row0 = u.pm * BM + wr * 64 + fr, col0 = u.pn * BM + wc * 32 + 4 * fq;
#pragma unroll
        for (int ai = 0; ai < 2; ++ai)
#pragma unroll
            for (int m = 0; m < 4; ++m) { const int row = row0 + ai * HALF + m * 16; const size_t off = (size_t)row * ldc + col0;
                float rs = 1.f;
                if (ssq) { const float t = (np == 1) ? ssq[row] : row_ssq32(ssq, row); rs = rsqrtf(t * (1.f / 2048.f) + 1e-6f); if (ssq_pub && u.pn == 0 && wc == 0 && fq == 0) ssq_pub[row] = t; }
#pragma unroll
                for (int bj = 0; bj < 2; ++bj)
#pragma unroll
                    for (int n = 0; n < 2; ++n) *(f32x4*)(out + off + bj * HALF + n * 16) = acc[ai][bj][m][n] * rs; }
    }
};
struct EpiSiluMul {
    static constexpr bool PERM = true;
    bf16_t* O; int ldc; const float* ssq; const int* rowmap;
    DI void operator()(const f32x4 (&acc)[2][2][4][2], const Unit& u, int wr, int wc, int fr, int fq) const {
        const int row0 = u.pm * BM + wr * 64 + fr, col0 = (u.pn * BM + wc * 32 + 8 * fq) >> 1;
#pragma unroll
        for (int ai = 0; ai < 2; ++ai)
#pragma unroll
            for (int m = 0; m < 4; ++m) { const int row = row0 + ai * HALF + m * 16; bf16_t* rowp = O + (size_t)row * ldc + col0;
                const float rs = row_rstd(ssq, 1, rowmap[row]);
#pragma unroll
                for (int bj = 0; bj < 2; ++bj) { const f32x4 v0 = acc[ai][bj][m][0] * rs, v1 = acc[ai][bj][m][1] * rs;
                    const float h0 = v0[0] / (1.f + __expf(-v0[0])) * v0[1], h1 = v0[2] / (1.f + __expf(-v0[2])) * v0[3];
                    const float h2 = v1[0] / (1.f + __expf(-v1[0])) * v1[1], h3 = v1[2] / (1.f + __expf(-v1[2])) * v1[3];
                    u32x2 w; w.x = pk2(h0, h1); w.y = pk2(h2, h3);
                    *(u32x2*)(rowp + bj * (HALF / 2)) = w; } }
    }
};
struct EpiScatter {
    static constexpr bool PERM = true;
    bf16_t* O; int ldc; const int* dst;
    DI void operator()(const f32x4 (&acc)[2][2][4][2], const Unit& u, int wr, int wc, int fr, int fq) const {
        const int row0 = u.pm * BM + wr * 64 + fr, col0 = u.pn * BM + wc * 32 + 8 * fq;
#pragma unroll
        for (int ai = 0; ai < 2; ++ai)
#pragma unroll
            for (int m = 0; m < 4; ++m) { const int d = dst[row0 + ai * HALF + m * 16];
                if (d >= 0) { bf16_t* rowp = O + (size_t)d * ldc + col0;
#pragma unroll
                    for (int bj = 0; bj < 2; ++bj) { const f32x4 v0 = acc[ai][bj][m][0], v1 = acc[ai][bj][m][1];
                        u32x4 w; w.x = pk2(v0[0], v0[1]); w.y = pk2(v0[2], v0[3]); w.z = pk2(v1[0], v1[1]); w.w = pk2(v1[2], v1[3]);
                        *(u32x4*)(rowp + bj * HALF) = w; } } }
    }
};
}

struct Args { const void* in[45]; float* out; unsigned char* ws; int ph_lo, ph_hi; };
static_assert(sizeof(void*) == 8 && sizeof(Args) == 384, "Args layout");

#define CAS __attribute__((address_space(4)))
typedef const CAS char* kaptr_t;
typedef const float* const CAS* inptr_t;
struct Ctx {
    LAS unsigned char* lds; unsigned char* ws; inptr_t in; float* X;
    int tid, lane, wave, G, wg, gw, ngw, att_sel, vcu;
};

DI size_t wofs(int l) { return l ? WS_L1OFF : 0; }
struct TrDesc { const float* W; bf16_t* WT; int N, ldk, row_off, row_mul, nblk, item; const float* ks; };
DI void tr_load(const TrDesc& d, float (&tv)[32], int lane) {
    const int kb = d.item / d.nblk, nb = d.item % d.nblk, k0 = 64 * kb, n0 = 32 * nb;
#pragma unroll
    for (int i = 0; i < 32; ++i) { const int kk = 2 * i + (lane >> 5); tv[i] = d.W[(size_t)(k0 + kk) * d.N + n0 + (lane & 31)]; }
}
DI void tr_store(const TrDesc& d, const float (&tv)[32], LAS float* scr, int lane) {
    const int kb = d.item / d.nblk, nb = d.item % d.nblk, k0 = 64 * kb, n0 = 32 * nb;
#pragma unroll
    for (int i = 0; i < 32; ++i) { const int kk = 2 * i + (lane >> 5); scr[kk * 33 + (lane & 31)] = d.ks ? tv[i] * d.ks[k0 + kk] : tv[i]; }
    asm volatile("s_waitcnt lgkmcnt(0)" ::: "memory");
    const int c = lane & 7;
#pragma unroll
    for (int j = 0; j < 4; ++j) { const int n = (lane >> 3) + 8 * j; const LAS float* s = scr + (8 * c) * 33 + n;
        u32x4 o; o.x = pk2(s[0 * 33], s[1 * 33]); o.y = pk2(s[2 * 33], s[3 * 33]); o.z = pk2(s[4 * 33], s[5 * 33]); o.w = pk2(s[6 * 33], s[7 * 33]);
        *(u32x4*)(d.WT + (size_t)(d.row_off + (n0 + n) * d.row_mul) * d.ldk + k0 + 8 * c) = o; }
    asm volatile("s_waitcnt lgkmcnt(0)" ::: "memory");
}

DI void norm_row(const float* xin, const bf16_t* xinb, bf16_t* xout, const bf16_t* c0, const bf16_t* c1, float g0, float g1, const float* w, bf16_t* hout, float* fout, int lane, float* ssq_w = nullptr) {
    f32x4 v[8]; float ss = 0.f;
    if (xin) {
#pragma unroll
        for (int j = 0; j < 8; ++j) { v[j] = ((const f32x4*)xin)[lane + 64 * j]; }
    } else {
#pragma unroll
        for (int j = 0; j < 8; ++j) { const u32x2 a = ((const u32x2*)xinb)[lane + 64 * j]; v[j] = (f32x4){bflo(a.x), bfhi(a.x), bflo(a.y), bfhi(a.y)}; }
    }
    if (c0) {
#pragma unroll
        for (int j = 0; j < 8; ++j) { const u32x2 a = ((const u32x2*)c0)[lane + 64 * j], b = ((const u32x2*)c1)[lane + 64 * j];
            v[j][0] += g0 * bflo(a.x) + g1 * bflo(b.x); v[j][1] += g0 * bfhi(a.x) + g1 * bfhi(b.x);
            v[j][2] += g0 * bflo(a.y) + g1 * bflo(b.y); v[j][3] += g0 * bfhi(a.y) + g1 * bfhi(b.y); }
    }
#pragma unroll
    for (int j = 0; j < 8; ++j) ss += (v[j][0] * v[j][0] + v[j][1] * v[j][1]) + (v[j][2] * v[j][2] + v[j][3] * v[j][3]);
    if (xout) {
#pragma unroll
        for (int j = 0; j < 8; ++j) { u32x2 o; o.x = pk2(v[j][0], v[j][1]); o.y = pk2(v[j][2], v[j][3]); ((u32x2*)xout)[lane + 64 * j] = o; }
    }
    const float sst = wave_sum(ss);
    if (ssq_w) { if (lane == 0) *ssq_w = sst; }
    if (!w) return;
    const float rstd = rsqrtf(sst * (1.f / DM) + 1e-6f);
#pragma unroll
    for (int j = 0; j < 8; ++j) { const f32x4 ww = ((const f32x4*)w)[lane + 64 * j]; const f32x4 y = v[j] * rstd * ww;
        if (hout) { u32x2 o; o.x = pk2(y[0], y[1]); o.y = pk2(y[2], y[3]); ((u32x2*)hout)[lane + 64 * j] = o; }
        if (fout) ((f32x4*)fout)[lane + 64 * j] = y; }
}

constexpr int I_WIN = 32 * 174, I_VR = 32, I_WOUT = 32 * 64, I_CAQ = 32 * 16, I_CAKV = 32 * 32, I_CAO = 8 * 64, I_WQB = 6 * 24, I_WKVB = 4 * 32;
constexpr int N_SMALL_ITEMS = I_WIN + I_VR + I_WOUT + I_CAQ + I_CAKV + I_CAO + I_WQB + I_WKVB;
DI TrDesc small_tr_desc(int l, int r, inptr_t in, unsigned char* wsl) {
    bf16_t* WINT = (bf16_t*)(wsl + WS_WINT);
    if (r < I_WIN) return TrDesc{in[6] + (size_t)l * DM * IN_COLS, WINT, IN_COLS, DM, 0, 1, 174, r, in[5] + (size_t)l * DM}; r -= I_WIN;
    if (r < I_VR) return TrDesc{in[7], WINT, 32, DM, IN_COLS, 1, 1, r, in[5] + DM}; r -= I_VR;
    if (r < I_WOUT) return TrDesc{in[8] + (size_t)l * DM * DM, (bf16_t*)(wsl + WS_WOUTT), DM, DM, 0, 1, 64, r, nullptr}; r -= I_WOUT;
    if (r < I_CAQ) return TrDesc{in[34] + (size_t)l * DM * 512, (bf16_t*)(wsl + WS_CAWQT), 512, DM, 0, 1, 16, r, in[32] + (size_t)l * DM}; r -= I_CAQ;
    if (r < I_CAKV) return TrDesc{in[35] + (size_t)l * DM * 1024, (bf16_t*)(wsl + WS_CAWKVT), 1024, DM, 0, 1, 32, r, nullptr}; r -= I_CAKV;
    if (r < I_CAO) return TrDesc{in[36] + (size_t)l * 512 * DM, (bf16_t*)(wsl + WS_CAWOT), DM, 512, 0, 1, 64, r, nullptr}; r -= I_CAO;
    if (r < I_WQB) return TrDesc{in[29] + (size_t)l * 384 * 768, (bf16_t*)(wsl + WS_WQBT), 768, 384, 0, 1, 24, r, nullptr}; r -= I_WQB;
    return TrDesc{in[31] + (size_t)l * 256 * 1024, (bf16_t*)(wsl + WS_WKVBT), 1024, 256, 0, 1, 32, r, nullptr};
}
constexpr int I_EXP = 512;
constexpr int N_MOE_ITEMS = 3 * NEXP * I_EXP;
DI TrDesc moe_tr_desc(int l, int r, inptr_t in, unsigned char* ws) {
    const int e = r / (3 * I_EXP), q = r % (3 * I_EXP), mat = q / I_EXP, ii = q % I_EXP;
    const size_t eo = ((size_t)l * NEXP + e);
    if (mat == 0) return TrDesc{in[42] + eo * DM * DEXP, (bf16_t*)(ws + WS_WGU) + (size_t)e * 1024 * DM, DEXP, DM, 0, 2, 16, ii, in[37] + (size_t)l * DM};
    if (mat == 1) return TrDesc{in[43] + eo * DM * DEXP, (bf16_t*)(ws + WS_WGU) + (size_t)e * 1024 * DM, DEXP, DM, 1, 2, 16, ii, in[37] + (size_t)l * DM};
    return TrDesc{in[44] + eo * DEXP * DM, (bf16_t*)(ws + WS_WD) + (size_t)e * DM * DEXP, DM, DEXP, 0, 1, 64, ii, nullptr};
}
DI void phase_convert(const Ctx& C, int l) {
    inptr_t in = C.in;
    unsigned char* ws = C.ws;
    LAS float* scr = (LAS float*)(C.lds + C.wave * 16384);
    bf16_t* WINT = (bf16_t*)(ws + WS_WINT);
    const int n_items = (l == 0) ? N_SMALL_ITEMS : 0;
    auto decode = [&](int it) -> TrDesc { return small_tr_desc(0, it, in, ws); };
    {
        const int first = (l == 0 && C.gw >= I_WIN && C.gw < I_WIN + I_VR) ? C.gw + C.ngw : C.gw;
        float ta[32], tb[32];
        int it = first;
        if (it < n_items) { TrDesc d0 = decode(it); tr_load(d0, ta, C.lane);
            for (;;) {
                int it2 = it + C.ngw; if (l == 0 && it2 >= I_WIN && it2 < I_WIN + I_VR) it2 += C.ngw;
                const bool has2 = it2 < n_items; TrDesc d1 = d0;
                if (has2) { d1 = decode(it2); tr_load(d1, tb, C.lane); }
                tr_store(d0, ta, scr, C.lane);
                if (!has2) break;
                int it3 = it2 + C.ngw; if (l == 0 && it3 >= I_WIN && it3 < I_WIN + I_VR) it3 += C.ngw;
                const bool has3 = it3 < n_items;
                if (has3) { d0 = decode(it3); tr_load(d0, ta, C.lane); }
                tr_store(d1, tb, scr, C.lane);
                if (!has3) break;
                it = it3;
            }
        }
    }
    const int gt = C.wg * 512 + C.tid, ngt = C.G * 512;
    if (l == 0) {
        for (int i = gt; i < 64 * DM / 8; i += ngt) ((u32x4*)(WINT + (size_t)IN_COLS * DM))[i] = (u32x4){0u, 0u, 0u, 0u};
        for (int i = gt; i < 32 * DM / 8; i += ngt) ((u32x4*)((bf16_t*)(ws + WS_L1OFF + WS_WINT) + (size_t)(IN_COLS + 32) * DM))[i] = (u32x4){0u, 0u, 0u, 0u};
#pragma unroll 1
        for (int lw = 0; lw < 2; ++lw) {
            bf16_t* LB = (bf16_t*)(ws + wofs(lw) + WS_LORABT);
            const float* w2 = in[12] + (size_t)lw * 64 * 1024; const float* a2 = in[14] + (size_t)lw * 64 * 1024; const float* g2 = in[17] + (size_t)lw * 128 * 1024; const float* v2 = in[16];
            for (int i = gt; i < 4096 * 384; i += ngt) {
                const int n = i / 384, k = i % 384, blk = n >> 10, c = n & 1023; float v = 0.f;
                if (blk == 0) { if (k < 64) v = w2[k * 1024 + c]; }
                else if (blk == 1) { if (k >= 64 && k < 128) v = a2[(k - 64) * 1024 + c]; }
                else if (blk == 2) { if (k >= 128 && k < 256) v = g2[(k - 128) * 1024 + c]; }
                else { if (lw == 1 && k >= 256 && k < 288) v = v2[(k - 256) * 1024 + c]; }
                LB[i] = f2bf(v);
            }
            bf16_t* WRB = (bf16_t*)(ws + (lw ? WS_WRB1 : WS_WRB)); const float* nf = in[37] + (size_t)lw * DM; const float* wg = in[38] + (size_t)lw * DM * 4; const float* we = in[40] + (size_t)lw * DM * 32;
            for (int i = gt; i < 256 * DM; i += ngt) { const int o = i / DM, k = i % DM; const float v = (o < 32) ? we[k * 32 + o] : ((o < 36) ? wg[k * 4 + (o - 32)] : 0.f); WRB[i] = f2bf(v * nf[k]); }
        }
    }
    if (l == 0) {
        float* LUT = (float*)(ws + WS_LUT); const float* rb = in[3];
        for (int i = gt; i < 4 * 128; i += ngt) { const int h = i >> 7, n = i & 127; int bk;
            if (n < 16) bk = n; else { bk = 16 + (int)(log2f((float)n * 0.0625f) * (16.f / 3.f)); if (bk > 31) bk = 31; }
            LUT[i] = rb[bk * 4 + h] * LOG2E; }
        f32x2* RT = (f32x2*)(ws + WS_ROPE); const int* pos = (const int*)in[2];
        for (int i = gt; i < NT * 32; i += ngt) { const int t = i >> 5, j = i & 31; const float invf = powf(10000.f, -(float)j / 32.f); const float ang = (float)pos[t] * invf; float s, c; sincosf(ang, &s, &c); RT[i] = (f32x2){c, s}; }
    }
    for (int m = C.gw; m < NMEM; m += C.ngw) norm_row(in[1] + (size_t)m * DM, nullptr, nullptr, nullptr, nullptr, 0.f, 0.f, in[33] + (size_t)l * DM, (bf16_t*)(ws + WS_MEMN) + (size_t)m * DM, nullptr, C.lane);
    {
        const bf16_t* C2 = (const bf16_t*)(ws + WS_C2); const float* gate = (const float*)(ws + WS_GATE); bf16_t* XB = (bf16_t*)(ws + WS_XB); float* SSQM = (float*)(ws + WS_SSQM);
        for (int m = C.gw; m < NT; m += C.ngw) {
            if (l == 0) norm_row(in[0] + (size_t)m * DM, nullptr, XB + (size_t)m * DM, nullptr, nullptr, 0.f, 0.f, nullptr, nullptr, nullptr, C.lane, SSQM + m);
            else norm_row(nullptr, XB + (size_t)m * DM, XB + (size_t)m * DM, C2 + (size_t)(2 * m) * DM, C2 + (size_t)(2 * m + 1) * DM, gate[2 * m], gate[2 * m + 1], nullptr, nullptr, nullptr, C.lane, SSQM + m);
        }
    }
}

DI void phase_ew1(const Ctx& C, int l) {
    inptr_t in = C.in; unsigned char* ws = C.ws;
    const bf16_t* PRW = (const bf16_t*)(ws + WS_PRW); const bf16_t* PATT = (const bf16_t*)(ws + WS_PATT);
    bf16_t* LA = (bf16_t*)(ws + WS_LORAA); bf16_t* QN = (bf16_t*)(ws + WS_QN); bf16_t* KVN = (bf16_t*)(ws + WS_KVN); bf16_t* KPE = (bf16_t*)(ws + WS_KPE);
    const float* mu = in[9] + (size_t)l * RW_COLS; const float* muv = in[10];
    const float* qnw = in[28] + (size_t)l * 384; const float* kvnw = in[30] + (size_t)l * 256;
    const f32x2* RT = (const f32x2*)(ws + WS_ROPE);
    const int lane = C.lane;
#pragma unroll 4
    for (int t = C.gw; t < NT; t += C.ngw) {
        const bool first = (t % SEQ) == 0;
        const bf16_t* p = PRW + (size_t)t * RW_COLS; const bf16_t* pa = PATT + (size_t)t * PATT_COLS;
#pragma unroll
        for (int j = 0; j < 4; ++j) { const int c = lane + 64 * j, col = 3072 + c;
            const float cur = bf2f(p[col]); const float prev = first ? 0.f : bf2f(p[col - RW_COLS]);
            const float xs = cur + mu[col] * (prev - cur);
            float v; if (c < 64) v = tanhf(xs); else if (c < 128) v = xs; else v = sigmoidf_(xs);
            LA[(size_t)t * 384 + c] = f2bf(v); }
        {
#pragma unroll
            for (int j = 0; j < 2; ++j) { const int c = lane + 64 * j; float v = 0.f;
                if (l == 1 && c < 32) { const float cur = bf2f(pa[2240 + c]); const float prev = first ? 0.f : bf2f(pa[2240 + c - PATT_COLS]); v = cur + muv[c] * (prev - cur); }
                LA[(size_t)t * 384 + 256 + c] = f2bf(v); } }
        float q[6], kv[4]; float sq = 0.f, skv = 0.f;
#pragma unroll
        for (int j = 0; j < 6; ++j) { q[j] = bf2f(pa[1536 + lane + 64 * j]); sq += q[j] * q[j]; }
#pragma unroll
        for (int j = 0; j < 4; ++j) { kv[j] = bf2f(pa[1920 + lane + 64 * j]); skv += kv[j] * kv[j]; }
        const float rq = rsqrtf(wave_sum(sq) * (1.f / 384.f) + 1e-6f), rkv = rsqrtf(wave_sum(skv) * (1.f / 256.f) + 1e-6f);
#pragma unroll
        for (int j = 0; j < 6; ++j) QN[(size_t)t * 384 + lane + 64 * j] = f2bf(q[j] * rq * qnw[lane + 64 * j]);
#pragma unroll
        for (int j = 0; j < 4; ++j) KVN[(size_t)t * 256 + lane + 64 * j] = f2bf(kv[j] * rkv * kvnw[lane + 64 * j]);
        { const float x = bf2f(pa[2176 + lane]); const float xo = __shfl_xor(x, 32); const f32x2 cs = RT[t * 32 + (lane & 31)];
          const float y = (lane < 32) ? (x * cs.x - xo * cs.y) : (x * cs.x + xo * cs.y);
          KPE[(size_t)t * 64 + lane] = f2bf(y); }
    }
}

DI void phase_ew2(const Ctx& C, int l) {
    inptr_t in = C.in; unsigned char* ws = C.ws;
    const bf16_t* PRW = (const bf16_t*)(ws + WS_PRW); const bf16_t* LO = (const bf16_t*)(ws + WS_LORAO);
    bf16_t* SR = (bf16_t*)(ws + WS_U); bf16_t* SW = SR + (size_t)NT * 1024; bf16_t* SK = SW + (size_t)NT * 1024; bf16_t* SV = SK + (size_t)NT * 1024;
    bf16_t* SA = SV + (size_t)NT * 1024; bf16_t* SB = SA + (size_t)NT * 1024; bf16_t* VF = (bf16_t*)(ws + WS_VFIRST);
    const float* mu = in[9] + (size_t)l * RW_COLS; const float* w0 = in[11] + (size_t)l * 1024; const float* a0 = in[13] + (size_t)l * 1024; const float* v0 = in[15];
    const float* kkw = in[18] + (size_t)l * 1024; const float* kaw = in[19] + (size_t)l * 1024;
    const int lane = C.lane;
#pragma unroll 1
    for (int j = 0; j < 2; ++j) {
        const int c0 = 8 * lane + 512 * j;
        float mu8[3][8], w0v[8], a0v[8], kkv[8], kav[8], v0v[8];
#pragma unroll
        for (int e = 0; e < 2; ++e) {
#pragma unroll
            for (int q = 0; q < 3; ++q) { const f32x4 m = *(const f32x4*)(mu + q * 1024 + c0 + 4 * e);
#pragma unroll
                for (int i = 0; i < 4; ++i) mu8[q][4 * e + i] = m[i]; }
            const f32x4 x0 = *(const f32x4*)(w0 + c0 + 4 * e), x1 = *(const f32x4*)(a0 + c0 + 4 * e), x2 = *(const f32x4*)(kkw + c0 + 4 * e), x3 = *(const f32x4*)(kaw + c0 + 4 * e);
            f32x4 x4 = (f32x4){0.f, 0.f, 0.f, 0.f}; if (l == 1) x4 = *(const f32x4*)(v0 + c0 + 4 * e);
#pragma unroll
            for (int i = 0; i < 4; ++i) { w0v[4 * e + i] = x0[i]; a0v[4 * e + i] = x1[i]; kkv[4 * e + i] = x2[i]; kav[4 * e + i] = x3[i]; v0v[4 * e + i] = x4[i]; } }
#pragma unroll 2
        for (int t = C.gw; t < NT; t += C.ngw) {
            const bool first = (t % SEQ) == 0;
            const bf16_t* p = PRW + (size_t)t * RW_COLS; const bf16_t* lo = LO + (size_t)t * 4096;
            float xs[3][8];
#pragma unroll
            for (int q = 0; q < 3; ++q) { const int col = q * 1024 + c0;
                const u32x4 cu = *(const u32x4*)(p + col); u32x4 pv = (u32x4){0u, 0u, 0u, 0u}; if (!first) pv = *(const u32x4*)(p + col - RW_COLS);
#pragma unroll
                for (int e = 0; e < 4; ++e) { const float c_lo = bflo(cu[e]), c_hi = bfhi(cu[e]), p_lo = bflo(pv[e]), p_hi = bfhi(pv[e]);
                    xs[q][2 * e] = c_lo + mu8[q][2 * e] * (p_lo - c_lo); xs[q][2 * e + 1] = c_hi + mu8[q][2 * e + 1] * (p_hi - c_hi); } }
            const u32x4 lw = *(const u32x4*)(lo + c0), la = *(const u32x4*)(lo + 1024 + c0);
            u32x4 lv = (u32x4){0u, 0u, 0u, 0u}, vfv = (u32x4){0u, 0u, 0u, 0u};
            if (l == 1) { lv = *(const u32x4*)(lo + 3072 + c0); vfv = *(const u32x4*)(VF + (size_t)t * 1024 + c0); }
            float omw[8], av[8], kk[8], k2[8], v2[8]; float ssq = 0.f;
#pragma unroll
            for (int e = 0; e < 8; ++e) {
                const float lwf = (e & 1) ? bfhi(lw[e >> 1]) : bflo(lw[e >> 1]), laf = (e & 1) ? bfhi(la[e >> 1]) : bflo(la[e >> 1]);
                const float wi = w0v[e] + lwf;
                omw[e] = 1.f - __expf(-0.6065306597f * sigmoidf_(wi));
                av[e] = sigmoidf_(a0v[e] + laf);
                kk[e] = xs[1][e] * kkv[e]; ssq += kk[e] * kk[e];
                k2[e] = xs[1][e] * (1.f + (av[e] - 1.f) * kav[e]);
                v2[e] = xs[2][e];
                if (l == 1) { const float lvf = (e & 1) ? bfhi(lv[e >> 1]) : bflo(lv[e >> 1]), vff = (e & 1) ? bfhi(vfv[e >> 1]) : bflo(vfv[e >> 1]);
                    v2[e] = xs[2][e] + (vff - xs[2][e]) * sigmoidf_(v0v[e] + lvf); }
            }
            ssq += DPP_F(ssq, 0xB1); ssq += DPP_F(ssq, 0x4E); ssq += DPP_F(ssq, 0x141);
            const float inv = 1.f / fmaxf(sqrtf(ssq), 1e-12f);
            u32x4 oR, oW, oK, oV, oA, oB, oF;
#pragma unroll
            for (int e = 0; e < 4; ++e) { const float ka = kk[2 * e] * inv, kb = kk[2 * e + 1] * inv;
                oR[e] = pkh2(xs[0][2 * e], xs[0][2 * e + 1]); oW[e] = pkh2(1.f - omw[2 * e], 1.f - omw[2 * e + 1]); oK[e] = pkh2(k2[2 * e], k2[2 * e + 1]); oV[e] = pkh2(v2[2 * e], v2[2 * e + 1]);
                oA[e] = pkh2(-ka, -kb); oB[e] = pkh2(ka * av[2 * e], kb * av[2 * e + 1]);     oF[e] = pk2(xs[2][2 * e], xs[2][2 * e + 1]); }
            const size_t o = (size_t)t * 1024 + c0;
            *(u32x4*)(SR + o) = oR; *(u32x4*)(SW + o) = oW; *(u32x4*)(SK + o) = oK; *(u32x4*)(SV + o) = oV; *(u32x4*)(SA + o) = oA; *(u32x4*)(SB + o) = oB;
            if (l == 0) *(u32x4*)(VF + o) = oF;
        }
    }
    bf16_t* QM = (bf16_t*)(ws + WS_QM); const f32x2* RT = (const f32x2*)(ws + WS_ROPE);
    const int gt = C.wg * 512 + C.tid, ngt = C.G * 512;
    for (int i = gt; i < NT * 4 * 32; i += ngt) { const int t = i >> 7, h = (i >> 5) & 3, j = i & 31;
        bf16_t* q = QM + (size_t)t * 768 + h * 192 + 128; const float x1 = bf2f(q[j]), x2 = bf2f(q[j + 32]); const f32x2 cs = RT[t * 32 + j];
        q[j] = f2bf(x1 * cs.x - x2 * cs.y); q[j + 32] = f2bf(x2 * cs.x + x1 * cs.y); }
}

DI float dot2z(h2_t a, h2_t b) { float d; asm("v_dot2_f32_f16 %0, %1, %2, 0" : "=v"(d) : "v"(a), "v"(b)); return d; }
DI float fma_s(float a, float b, float c) { float d; asm("v_fma_f32 %0, %1, %2, %3" : "=v"(d) : "v"(a), "v"(b), "v"(c)); return d; }
#define ROW_ALLREDUCE(x) do { \
    x += __builtin_bit_cast(float, __builtin_amdgcn_update_dpp(0, __builtin_bit_cast(int, x), 0x128, 0xf, 0xf, true)); \
    x += __builtin_bit_cast(float, __builtin_amdgcn_update_dpp(0, __builtin_bit_cast(int, x), 0x124, 0xf, 0xf, true)); \
    x += __builtin_bit_cast(float, __builtin_amdgcn_update_dpp(0, __builtin_bit_cast(int, x), 0x122, 0xf, 0xf, true)); \
    x += __builtin_bit_cast(float, __builtin_amdgcn_update_dpp(0, __builtin_bit_cast(int, x), 0x121, 0xf, 0xf, true)); } while (0)

DI void phase_scan(const Ctx& C, int l) {
    unsigned char* ws = C.ws; inptr_t in = C.in;
    const bf16_t* SR = (const bf16_t*)(ws + WS_U); float* Yf = (float*)(ws + WS_H);
    constexpr int CH = 32, VECB = CH * 128, BUFB = 5 * VECB + CH * 64, OB = 2 * BUFB;
    LAS unsigned char* lds = C.lds;
    const int tid = C.tid, lane = C.lane, wave = C.wave;
    for (int u = C.vcu; u < 256; u += C.G) {
        const int bh = u >> 2, rg = u & 3, b = bh >> 4, h = bh & 15;
        const size_t tb = (size_t)b * SEQ; const int cb = h * 64;
        const int lt = tid - 256;
        u32x4 pre[3][6];
#define LD_CHUNK(set, c_) do { const size_t t_ = tb + (size_t)(c_) * CH + (lt >> 3); const int j_ = lt & 7; \
            _Pragma("unroll") for (int vq = 0; vq < 5; ++vq) { const int arr = (vq < 3) ? vq : vq + 1; \
                pre[set][vq] = *(const u32x4*)(SR + (size_t)arr * NT * 1024 + t_ * 1024 + cb + 8 * j_); } \
            if (lt < 64) { const size_t tv_ = tb + (size_t)(c_) * CH + (lt >> 1); \
                pre[set][5] = *(const u32x4*)(SR + (size_t)3 * NT * 1024 + tv_ * 1024 + cb + 16 * rg + 8 * (lt & 1)); } } while (0)
#define ST_CHUNK(set, buf_) do { const int step_ = lt >> 3, j_ = lt & 7;     \
            _Pragma("unroll") for (int vq = 0; vq < 5; ++vq) *(LAS u32x4*)(lds + (buf_) * BUFB + vq * VECB + step_ * 128 + j_ * 16) = pre[set][vq]; \
            if (lt < 64) { const u32x4 p = pre[set][5]; LAS u32x4* d = (LAS u32x4*)(lds + (buf_) * BUFB + 5 * VECB + (lt >> 1) * 64 + (lt & 1) * 32);     \
                d[0] = (u32x4){(p.x & 0xffffu) | (p.x << 16), (p.x >> 16) | (p.x & 0xffff0000u), (p.y & 0xffffu) | (p.y << 16), (p.y >> 16) | (p.y & 0xffff0000u)}; \
                d[1] = (u32x4){(p.z & 0xffffu) | (p.z << 16), (p.z >> 16) | (p.z & 0xffff0000u), (p.w & 0xffffu) | (p.w << 16), (p.w >> 16) | (p.w & 0xffff0000u)}; } } while (0)
        h2_t S01 = {(_Float16)0.f, (_Float16)0.f}, S23 = {(_Float16)0.f, (_Float16)0.f};
        const int ks = lane & 15, rowl = wave * 4 + (lane >> 4);
        constexpr int NCH = SEQ / CH;
        const int n_bg = N_MOE_ITEMS + (l == 0 ? N_SMALL_ITEMS : 0);
#define BG_DESC(it_) (((it_) < N_MOE_ITEMS) ? moe_tr_desc(l, (it_), in, ws) : small_tr_desc(1, (it_) - N_MOE_ITEMS, in, ws + WS_L1OFF))
        float tq[32]; int mo_it = (C.wg * 4 + (wave - 4)); bool mo_pending = false; TrDesc mo_d{};
        LAS float* mo_scr = (LAS float*)(lds + OB + 2 * CH * 64) + (wave - 4) * (64 * 33);
        if (wave >= 4) { LD_CHUNK(0, 0); LD_CHUNK(1, 1); LD_CHUNK(2, 2); ST_CHUNK(0, 0); LD_CHUNK(0, 3); }
        __syncthreads();
#define SCAN_ITER(c, setn) do { \
            const int buf = (c) & 1; \
            if (wave >= 4) { \
                if ((c) + 1 < NCH) { ST_CHUNK(setn, buf ^ 1); if ((c) + 4 < NCH) LD_CHUNK(setn, (c) + 4); } \
                if ((c) > 0 && lt < 128) { \
                    const int step = lt >> 2, q4 = lt & 3; const LAS float* ob_ = (const LAS float*)(lds + OB + (((c) - 1) & 1) * (CH * 64)) + (step >> 4) * 256 + (step & 15); \
                    const f32x4 o = {ob_[(4 * q4 + 0) * 16], ob_[(4 * q4 + 1) * 16], ob_[(4 * q4 + 2) * 16], ob_[(4 * q4 + 3) * 16]}; \
                    *(f32x4*)(Yf + (tb + (size_t)((c) - 1) * CH + step) * 1024 + cb + 16 * rg + 4 * q4) = o; } \
                if (((c) & 1) == 0) { if (mo_pending) { tr_store(mo_d, tq, mo_scr, lane); mo_pending = false; } \
                    if (mo_it < n_bg) { mo_d = BG_DESC(mo_it); tr_load(mo_d, tq, lane); mo_pending = true; mo_it += C.G * 4; } } \
            } else { SCAN_BODY(buf); } \
            __syncthreads(); } while (0)
#define SC_LD(X, s_) do { const int so_ = ((s_) & (CH - 1)) * 128; X##r = *(const LAS h4_t*)(bp + 0 * VECB + so_); X##w = *(const LAS h4_t*)(bp + 1 * VECB + so_); X##k = *(const LAS h4_t*)(bp + 2 * VECB + so_); \
            X##a = *(const LAS h4_t*)(bp + 3 * VECB + so_); X##b = *(const LAS h4_t*)(bp + 4 * VECB + so_); X##v = vp[((s_) & (CH - 1)) * 16]; } while (0)
#define DPPF(x, ctl) __builtin_bit_cast(float, __builtin_amdgcn_update_dpp(0, __builtin_bit_cast(int, x), ctl, 0xf, 0xf, true))
#define H_LO(x) __builtin_shufflevector(x, x, 0, 1)
#define H_HI(x) __builtin_shufflevector(x, x, 2, 3)
#define SC_DOT(x) __builtin_amdgcn_fdot2(S01, H_LO(x), dot2z(S23, H_HI(x)), false)
#define SC_FIRST(X) do { float sa = SC_DOT(X##a); \
            const h2_t t01 = S01 * H_LO(X##w) + X##v * H_LO(X##k), t23 = S23 * H_HI(X##w) + X##v * H_HI(X##k); \
            ROW_ALLREDUCE(sa); \
            const _Float16 sh = (_Float16)sa; const h2_t sa2 = {sh, sh}; \
            S01 = sa2 * H_LO(X##b) + t01; S23 = sa2 * H_HI(X##b) + t23; } while (0)
#define SC_PAIR(X, Y, s_) do { float o = SC_DOT(X##r); float sa = SC_DOT(Y##a); \
            const h2_t t01 = S01 * H_LO(Y##w) + Y##v * H_LO(Y##k), t23 = S23 * H_HI(Y##w) + Y##v * H_HI(Y##k); \
            sa += DPPF(sa, 0x128); o += DPPF(o, 0x128); sa += DPPF(sa, 0x124); o += DPPF(o, 0x124); sa += DPPF(sa, 0x122); o += DPPF(o, 0x122); sa += DPPF(sa, 0x121); o += DPPF(o, 0x121); \
            const _Float16 sh = (_Float16)sa; const h2_t sa2 = {sh, sh}; \
            S01 = sa2 * H_LO(Y##b) + t01; S23 = sa2 * H_HI(Y##b) + t23; \
            osel = (ks == (((s_) - 1) & 15)) ? o : osel; if ((((s_) - 1) & 15) == 15) op16[(((s_) - 1) >> 4) * 256] = osel; } while (0)
#define SC_LAST(X, s_) do { float o = SC_DOT(X##r); ROW_ALLREDUCE(o); osel = (ks == ((s_) & 15)) ? o : osel; op16[((s_) >> 4) * 256] = osel; } while (0)
#define SCAN_BODY(buf_) do { \
            const LAS unsigned char* bp = lds + (buf_) * BUFB + ks * 8; \
            const LAS h2_t* vp = (const LAS h2_t*)(lds + (buf_) * BUFB + 5 * VECB) + rowl; \
            LAS float* op16 = (LAS float*)(lds + OB + (buf_) * (CH * 64)) + rowl * 16 + ks; float osel = 0.f;     \
            h4_t Ar, Aw, Ak, Aa, Ab, Br, Bw, Bk, Ba, Bb, Cr, Cw, Ck, Ca, Cb, Dr, Dw, Dk, Da, Db; h2_t Av, Bv, Cv, Dv; \
            SC_LD(A, 0); SC_LD(B, 1); SC_LD(C, 2); SC_LD(D, 3); \
            SC_FIRST(A); \
            _Pragma("unroll 2") for (int s = 0; s < CH - 4; s += 4) { \
                SC_PAIR(A, B, s + 1); SC_LD(A, s + 4); \
                SC_PAIR(B, C, s + 2); SC_LD(B, s + 5); \
                SC_PAIR(C, D, s + 3); SC_LD(C, s + 6); \
                SC_PAIR(D, A, s + 4); SC_LD(D, s + 7); } \
            SC_PAIR(A, B, CH - 3); SC_PAIR(B, C, CH - 2); SC_PAIR(C, D, CH - 1); SC_LAST(D, CH - 1); } while (0)
#pragma unroll 1
        for (int c = 0; c < NCH; c += 3) { SCAN_ITER(c, 1); if (c + 1 < NCH) SCAN_ITER(c + 1, 2); if (c + 2 < NCH) SCAN_ITER(c + 2, 0); }
#undef SC_LD
#undef SC_FIRST
#undef SC_PAIR
#undef SC_LAST
#undef DPPF
#undef H_LO
#undef H_HI
#undef SC_DOT
#undef SCAN_BODY
#undef SCAN_ITER
#undef LD_CHUNK
#undef ST_CHUNK
        if (wave >= 4) { if (mo_pending) tr_store(mo_d, tq, mo_scr, lane);
            for (; mo_it < n_bg; mo_it += C.G * 4) { const TrDesc d = BG_DESC(mo_it); tr_load(d, tq, lane); tr_store(d, tq, mo_scr, lane); } }
#undef BG_DESC
        if (wave >= 4 && lt < 128) { const int c = NCH; const int step = lt >> 2, q4 = lt & 3; const LAS float* ob_ = (const LAS float*)(lds + OB + ((c - 1) & 1) * (CH * 64)) + (step >> 4) * 256 + (step & 15);
            const f32x4 o = {ob_[(4 * q4 + 0) * 16], ob_[(4 * q4 + 1) * 16], ob_[(4 * q4 + 2) * 16], ob_[(4 * q4 + 3) * 16]};
            *(f32x4*)(Yf + (tb + (size_t)(c - 1) * CH + step) * 1024 + cb + 16 * rg + 4 * q4) = o; }
        __syncthreads();
    }
}

DI void phase_post(const Ctx& C, int l) {
    inptr_t in = C.in; unsigned char* ws = C.ws;
    const float* Yf = (const float*)(ws + WS_H); const bf16_t* LO = (const bf16_t*)(ws + WS_LORAO);
    const bf16_t* SR = (const bf16_t*)(ws + WS_U); const bf16_t* SK = SR + (size_t)2 * NT * 1024; const bf16_t* SV = SR + (size_t)3 * NT * 1024;
    bf16_t* Y = (bf16_t*)(ws + WS_PRW);
    const float* rk = in[20] + (size_t)l * 1024; const float* lnw = in[21] + (size_t)l * 1024; const float* lnb = in[22] + (size_t)l * 1024;
    const int lane = C.lane;
    for (int t = C.gw; t < NT; t += C.ngw) {
#pragma unroll
        for (int j = 0; j < 2; ++j) {
            const int c0 = 8 * lane + 512 * j; const size_t o = (size_t)t * 1024 + c0;
            const f32x4 y0 = *(const f32x4*)(Yf + o), y1 = *(const f32x4*)(Yf + o + 4);
            const u32x4 rr = *(const u32x4*)(SR + o), kq = *(const u32x4*)(SK + o), vq = *(const u32x4*)(SV + o), gq = *(const u32x4*)(LO + (size_t)t * 4096 + 2048 + c0);
            float y[8], rk8[8], lw8[8], lb8[8];
#pragma unroll
            for (int e = 0; e < 2; ++e) { const f32x4 a = *(const f32x4*)(rk + c0 + 4 * e), b = *(const f32x4*)(lnw + c0 + 4 * e), c = *(const f32x4*)(lnb + c0 + 4 * e);
#pragma unroll
                for (int i = 0; i < 4; ++i) { rk8[4 * e + i] = a[i]; lw8[4 * e + i] = b[i]; lb8[4 * e + i] = c[i]; y[4 * e + i] = e ? y1[i] : y0[i]; } }
            float sm = 0.f, bs = 0.f; float r8[8], k8[8], v8[8], g8[8];
#pragma unroll
            for (int e = 0; e < 8; ++e) { r8[e] = (e & 1) ? hfhi(rr[e >> 1]) : hflo(rr[e >> 1]); k8[e] = (e & 1) ? hfhi(kq[e >> 1]) : hflo(kq[e >> 1]);
                v8[e] = (e & 1) ? hfhi(vq[e >> 1]) : hflo(vq[e >> 1]); g8[e] = (e & 1) ? bfhi(gq[e >> 1]) : bflo(gq[e >> 1]);
                sm += y[e]; bs += r8[e] * k8[e] * rk8[e]; }
            sm += DPP_F(sm, 0xB1); sm += DPP_F(sm, 0x4E); sm += DPP_F(sm, 0x141);
            bs += DPP_F(bs, 0xB1); bs += DPP_F(bs, 0x4E); bs += DPP_F(bs, 0x141);
            const float mean = sm * (1.f / 64.f); float vs = 0.f;
#pragma unroll
            for (int e = 0; e < 8; ++e) { y[e] -= mean; vs += y[e] * y[e]; }
            vs += DPP_F(vs, 0xB1); vs += DPP_F(vs, 0x4E); vs += DPP_F(vs, 0x141);
            const float rs = rsqrtf(vs * (1.f / 64.f) + 64e-5f);
            u32x4 ov;
#pragma unroll
            for (int e = 0; e < 4; ++e) { const float o0 = (y[2 * e] * rs * lw8[2 * e] + lb8[2 * e] + bs * v8[2 * e]) * g8[2 * e], o1 = (y[2 * e + 1] * rs * lw8[2 * e + 1] + lb8[2 * e + 1] + bs * v8[2 * e + 1]) * g8[2 * e + 1];
                ov[e] = pk2(o0, o1); }
            *(u32x4*)(Y + (size_t)t * 2048 + c0) = ov;
        }
    }
}

struct AttnP {
    const bf16_t* Q; int qpitch, qcol0;
    const bf16_t* K1; int k1pitch, k1col0;
    const bf16_t* K2; int k2pitch, k2col0;
    const bf16_t* V; int vpitch, vcol0;
    bf16_t* O; int opitch, ocol0;
    size_t qrow0, krow0;
    int q0;
    int nkeys;
    float c1;
    const int* pos; const float* lut;
    float lam, outscale; const float* subw;
    int dbg;
};

template <int DQK, int DK1, int MODE, int KT, int PFD>
DI void attn_unit(LAS unsigned char* lds, const AttnP& P) {
    constexpr int DV = 128, KP = DQK * 2 + 16, VP = DV * 2 + 64;
    constexpr int NBLK = KT / 32;
    constexpr int KTILE = KT * KP, VTILE = KT * VP;
    constexpr int NVT = (MODE == 0) ? 1 : 2;
    constexpr int VSLOT = NVT * VTILE + 256;
    constexpr bool ONEB = (MODE != 2);
    constexpr int KSLOT = 2 * KTILE, NKS = ONEB ? 2 : 1, NVS = ONEB ? 3 : 2;
    constexpr int OFF_V = NKS * KSLOT, OFF_POS = NVT * VTILE, OFF_LUT = OFF_V + NVS * VSLOT, OFF_END = OFF_LUT + 512;
    static_assert(!ONEB || PFD == 1, "one-barrier loop uses a single prefetch set");
    constexpr int OFF_OST = 4 * 17408, OSTP = 272;
    static_assert(OFF_END <= LDS_MAIN && OFF_OST + 4 * 32 * OSTP <= LDS_MAIN, "attention LDS");
    constexpr int KCH = DQK / 8, K1CH = DK1 / 8;
    constexpr int NKC = 2 * KT * KCH, NVC = NVT * KT * 16, NKCH = NKC / 512, NVCH = NVC / 512, NCHK = NKCH + NVCH;
    static_assert(NKC % 512 == 0 && NVC % 512 == 0, "chunks");
    constexpr float NEG = -1e30f, THR = 8.f;
    constexpr int KSTEP = (MODE == 0) ? KT : 2 * KT;
    int tid = threadIdx.x; asm volatile("" : "+v"(tid));
    const int lane = tid & 63, wave = __builtin_amdgcn_readfirstlane(tid >> 6);
    const int qg = wave >> 1, st = wave & 1, r32 = lane & 31, h2 = lane >> 5;
    const int qw0 = P.q0 + 32 * qg;
    const int myq = qw0 + r32;
    bf16x8 qf[DQK / 16];
    {
        const bf16_t* qp = P.Q + (P.qrow0 + myq) * (size_t)P.qpitch + P.qcol0 + ((MODE == 0) ? st * 64 : 0) + 8 * h2;
#pragma unroll
        for (int ks = 0; ks < DQK / 16; ++ks) qf[ks] = *(const bf16x8*)(qp + 16 * ks);
    }
    int mypos = 0, posq0 = 0;
    if constexpr (MODE == 0) { mypos = P.pos[myq]; posq0 = P.pos[qw0]; if (tid < 128) ((LAS float*)(lds + OFF_LUT))[tid] = P.lut[tid]; }
    f32x16 o[4];
#pragma unroll
    for (int d = 0; d < 4; ++d)
#pragma unroll
        for (int i = 0; i < 16; ++i) o[d][i] = 0.f;
    float m_run = NEG, l_run = 0.f;
    const int nsteps = P.nkeys / KSTEP;
    const char* gp[NCHK]; unsigned adv[NCHK]; unsigned ldst[NCHK];
#pragma unroll
    for (int i = 0; i < NKCH; ++i) { const int c = tid + 512 * i; const int s = c / (KT * KCH), rc = c % (KT * KCH), row = rc / KCH, ch = rc % KCH;
        const int key = (MODE == 0) ? row : s * KT + row;
        if (ch < K1CH) { gp[i] = (const char*)(P.K1 + (P.krow0 + key) * (size_t)P.k1pitch + P.k1col0 + ((MODE == 0) ? s * 64 : 0) + ch * 8); adv[i] = (unsigned)(KSTEP * P.k1pitch * 2); }
        else { gp[i] = (const char*)(P.K2 + (P.krow0 + key) * (size_t)P.k2pitch + P.k2col0 + (ch - K1CH) * 8); adv[i] = (unsigned)(KSTEP * P.k2pitch * 2); }
        ldst[i] = (unsigned)(s * KTILE + row * KP + ch * 16); }
#pragma unroll
    for (int i = 0; i < NVCH; ++i) { const int c2 = tid + 512 * i; const int s = c2 / (KT * 16), rc = c2 % (KT * 16), row = rc / 16, ch = rc % 16;
        const int key = (MODE == 0) ? row : s * KT + row;
        gp[NKCH + i] = (const char*)(P.V + (P.krow0 + key) * (size_t)P.vpitch + P.vcol0 + ch * 8); adv[NKCH + i] = (unsigned)(KSTEP * P.vpitch * 2);
        ldst[NKCH + i] = (unsigned)(s * VTILE + row * VP + ch * 16); }
    u32x4 preK[PFD][NKCH], preV[PFD][NVCH]; int prepos[2] = {0, 0};
#define KSET(par) ((PFD == 2) ? ((par) ^ 1) : 0)
#define VSET(par) ((PFD == 2) ? (par) : 0)
#define ATT_PREFETCH_K(set_) do { _Pragma("unroll") for (int i = 0; i < NKCH; ++i) { preK[set_][i] = *(const u32x4*)gp[i]; gp[i] += adv[i]; } } while (0)
#define ATT_PREFETCH_V(set_, step_) do { _Pragma("unroll") for (int i = 0; i < NVCH; ++i) { preV[set_][i] = *(const u32x4*)gp[NKCH + i]; gp[NKCH + i] += adv[NKCH + i]; } \
        if constexpr (MODE == 0) { if (tid < KT) prepos[set_] = P.pos[(step_) * KT + tid]; } } while (0)
#define ATT_STAGE_K(set_, ko_) do { _Pragma("unroll") for (int i = 0; i < NKCH; ++i) *(LAS u32x4*)(lds + (ko_) + ldst[i]) = preK[set_][i]; } while (0)
#define ATT_STAGE_V(set_, vo_) do { _Pragma("unroll") for (int i = 0; i < NVCH; ++i) *(LAS u32x4*)(lds + (vo_) + ldst[NKCH + i]) = preV[set_][i]; \
        if constexpr (MODE == 0) { if (tid < KT) ((LAS int*)(lds + (vo_) + OFF_POS))[tid] = prepos[set_]; } } while (0)
#define ATT_QK(dst, ko_) do { const LAS unsigned char* kb_ = lds + (ko_) + st * KTILE + r32 * KP + 16 * h2; \
        _Pragma("unroll") for (int blk = 0; blk < NBLK; ++blk) { \
            _Pragma("unroll") for (int i = 0; i < 16; ++i) dst[blk][i] = 0.f; \
            _Pragma("unroll") for (int ks = 0; ks < DQK / 16; ++ks) { const bf16x8 kf = *(const LAS bf16x8*)(kb_ + blk * 32 * KP + ks * 32); dst[blk] = __builtin_amdgcn_mfma_f32_32x32x16_bf16(kf, qf[ks], dst[blk], 0, 0, 0); } } } while (0)
#define ATT_VLD(j_) do { const int d_ = (j_) / (2 * NBLK), r_ = (j_) % (2 * NBLK); const LAS unsigned char* vp_ = vb_ + (16 * r_) * VP + d_ * 64; \
            vlo_[(j_) & 1] = __builtin_bit_cast(s16x4, __builtin_amdgcn_ds_read_tr16_b64_v4i16((LAS v4i16_t*)vp_)); \
            vhi_[(j_) & 1] = __builtin_bit_cast(s16x4, __builtin_amdgcn_ds_read_tr16_b64_v4i16((LAS v4i16_t*)(vp_ + 8 * VP))); } while (0)
#define ATT_PV(vo_) do { const int sv_ = (MODE == 0) ? 0 : st; \
        const LAS unsigned char* vb_ = lds + (vo_) + sv_ * VTILE + (4 * h2 + ((lane & 15) >> 2)) * VP + ((lane >> 4) & 1) * 32 + (lane & 3) * 8; \
        s16x4 vlo_[2], vhi_[2]; ATT_VLD(0); \
        _Pragma("unroll") for (int j = 0; j < 8 * NBLK; ++j) { if (j + 1 < 8 * NBLK) ATT_VLD(j + 1); \
            const s16x4 lo_ = vlo_[j & 1], hi_ = vhi_[j & 1]; const bf16x8 vf_ = {lo_[0], lo_[1], lo_[2], lo_[3], hi_[0], hi_[1], hi_[2], hi_[3]}; \
            const int d_ = j / (2 * NBLK), r_ = j % (2 * NBLK); \
            o[d_] = __builtin_amdgcn_mfma_f32_32x32x16_bf16(vf_, pf[r_ >> 1][r_ & 1], o[d_], 0, 0, 0); } } while (0)
    f32x16 sc[NBLK]; bf16x8 pf[NBLK][2]; bool pv_pending = false;
    const bool order_b = (wave & 1) != 0;
    auto att_body = [&](int step, int vo_cur, int vo_prev, int ko_next) {
        const int k0 = step * KSTEP + ((MODE == 0) ? 0 : st * KT);
        const bool valid_next = (step + 1 < nsteps) && (MODE == 2 || k0 + KSTEP <= qw0 + 31);
        const bool valid = (MODE == 2) || (k0 <= qw0 + 31);
        if (!order_b && pv_pending && !(P.dbg & 1)) ATT_PV(vo_prev);
        pv_pending = valid && !order_b;
        if (valid && !(P.dbg & 2)) {
        const bool need_mask = (MODE != 2) && (k0 + KT - 1 > qw0);
        float bb = 0.f; bool near = false;
        if constexpr (MODE == 0) {
            const LAS float* lut = (const LAS float*)(lds + OFF_LUT);
            const LAS int* pk = (const LAS int*)(lds + vo_cur + OFF_POS);
            near = (posq0 - pk[KT - 1]) < 127;
            if (near) {
#pragma unroll
                for (int blk = 0; blk < NBLK; ++blk)
#pragma unroll
                    for (int i = 0; i < 16; ++i) { const int kl = 32 * blk + (i & 3) + 8 * (i >> 2) + 4 * h2; int rel = mypos - pk[kl]; rel = rel < 0 ? 0 : (rel > 127 ? 127 : rel);
                        sc[blk][i] = sc[blk][i] * P.c1 + lut[rel]; }
            } else bb = lut[127];
        }
        if (need_mask) {
#pragma unroll
            for (int blk = 0; blk < NBLK; ++blk)
#pragma unroll
                for (int i = 0; i < 16; ++i) { const int key = k0 + 32 * blk + (i & 3) + 8 * (i >> 2) + 4 * h2; if (key > myq) sc[blk][i] = NEG; }
        }
        const float cc = near ? 1.f : P.c1;
        float mx = sc[0][0];
#pragma unroll
        for (int blk = 0; blk < NBLK; ++blk)
#pragma unroll
            for (int i = 0; i < 16; ++i) mx = fmaxf(mx, sc[blk][i]);
        { const int mi = __builtin_bit_cast(int, mx); auto rr = __builtin_amdgcn_permlane32_swap(mi, mi, false, false); mx = fmaxf(__builtin_bit_cast(float, (int)rr[0]), __builtin_bit_cast(float, (int)rr[1])); }
        mx = mx * cc + bb;
        if (__any(mx > m_run + THR)) {
            const float m_new = fmaxf(m_run, mx);
            const float alpha = __builtin_amdgcn_exp2f(m_run - m_new);
            m_run = m_new; l_run *= alpha;
#pragma unroll
            for (int d = 0; d < 4; ++d)
#pragma unroll
                for (int i = 0; i < 16; ++i) o[d][i] *= alpha;
        }
        const float off = bb - m_run;
        float psum = 0.f;
#pragma unroll
        for (int blk = 0; blk < NBLK; ++blk)
#pragma unroll
            for (int i = 0; i < 16; ++i) { const float p = __builtin_amdgcn_exp2f(__builtin_fmaf(sc[blk][i], cc, off)); sc[blk][i] = p; psum += p; }
        l_run += psum;
#pragma unroll
        for (int blk = 0; blk < NBLK; ++blk)
#pragma unroll
            for (int s16 = 0; s16 < 2; ++s16) { u32x4 w; w.x = pk2(sc[blk][8 * s16 + 0], sc[blk][8 * s16 + 1]); w.y = pk2(sc[blk][8 * s16 + 2], sc[blk][8 * s16 + 3]);
                w.z = pk2(sc[blk][8 * s16 + 4], sc[blk][8 * s16 + 5]); w.w = pk2(sc[blk][8 * s16 + 6], sc[blk][8 * s16 + 7]); pf[blk][s16] = __builtin_bit_cast(bf16x8, w); }
        }
        if (order_b && valid && !(P.dbg & 1)) ATT_PV(vo_cur);
        if (valid_next && !(P.dbg & 4)) ATT_QK(sc, ko_next);
        };
#define ATT_BODY(step, vc, vp) att_body(step, vc, vp, 0)
#define ATT_BAR() asm volatile("s_waitcnt lgkmcnt(0)\n\ts_barrier" ::: "memory")
    if constexpr (ONEB) {
        ATT_PREFETCH_K(0);
        __syncthreads();
        ATT_STAGE_K(0, 0);
        if (nsteps > 1) ATT_PREFETCH_K(0);
        ATT_PREFETCH_V(0, 0);
        if (nsteps > 1) ATT_STAGE_K(0, KSLOT);
        ATT_STAGE_V(0, OFF_V);
        if (nsteps > 2) ATT_PREFETCH_K(0);
        if (nsteps > 1) ATT_PREFETCH_V(0, 1);
        __syncthreads();
        ATT_QK(sc, 0);
        int vo_prev = OFF_V + 2 * VSLOT, vo_cur = OFF_V, vo_next = OFF_V + VSLOT;
        for (int step = 0; step < nsteps; ++step) {
            ATT_BAR();
            const int ko_next = ((step + 1) & 1) * KSLOT, ko_free = (step & 1) * KSLOT;
            if (!(P.dbg & 8)) {
                if (step + 2 < nsteps) ATT_STAGE_K(0, ko_free);
                if (step + 1 < nsteps) ATT_STAGE_V(0, vo_next);
                if (step + 3 < nsteps) ATT_PREFETCH_K(0);
                if (step + 2 < nsteps) ATT_PREFETCH_V(0, step + 2); }
            att_body(step, vo_cur, vo_prev, ko_next);
            const int tmp_ = vo_prev; vo_prev = vo_cur; vo_cur = vo_next; vo_next = tmp_;
        }
        if (pv_pending) ATT_PV(vo_prev);
    } else {
    ATT_PREFETCH_K(0);
    __syncthreads();
    ATT_STAGE_K(0, 0);
    if (nsteps > 1) ATT_PREFETCH_K(KSET(0));
    if (PFD == 2 && nsteps > 2) ATT_PREFETCH_K(0);
    ATT_PREFETCH_V(0, 0);
    if (PFD == 2 && nsteps > 1) ATT_PREFETCH_V(1, 1);
    __syncthreads();
    ATT_QK(sc, 0);
#define ATT_ITER(step, par) do { \
        const int vo_cur = OFF_V + (par) * VSLOT, vo_prev = OFF_V + ((par) ^ 1) * VSLOT; \
        ATT_BAR();                                                  \
        if (!(P.dbg & 8)) { if ((step) + 1 < nsteps) ATT_STAGE_K(KSET(par), 0); \
        ATT_STAGE_V(VSET(par), vo_cur); } \
        ATT_BAR();                                                  \
        if (!(P.dbg & 8)) { if ((step) + 1 + PFD < nsteps) ATT_PREFETCH_K(KSET(par)); \
        if ((step) + PFD < nsteps) ATT_PREFETCH_V(VSET(par), (step) + PFD); } \
        ATT_BODY(step, vo_cur, vo_prev); } while (0)
    for (int step = 0; step < nsteps; step += 2) { ATT_ITER(step, 0); if (step + 1 < nsteps) ATT_ITER(step + 1, 1); }
    if (pv_pending) ATT_PV(OFF_V + ((nsteps - 1) & 1) * VSLOT);
    }
#undef ATT_PREFETCH_K
#undef ATT_PREFETCH_V
#undef ATT_STAGE_K
#undef ATT_STAGE_V
#undef ATT_QK
#undef ATT_PV
#undef ATT_VLD
#undef ATT_ITER
#undef ATT_BAR
#undef ATT_BODY
#undef KSET
#undef VSET
    l_run += __shfl_xor(l_run, 32);
    __syncthreads();
    LAS float* mb = (LAS float*)(lds + qg * 17408);
    if (st == 1) {
        if constexpr (MODE == 0) { const float inv = 1.f / l_run;
#pragma unroll
            for (int d = 0; d < 4; ++d)
#pragma unroll
                for (int i = 0; i < 16; ++i) mb[(d * 16 + i) * 64 + lane] = o[d][i] * inv;
        } else {
#pragma unroll
            for (int d = 0; d < 4; ++d)
#pragma unroll
                for (int i = 0; i < 16; ++i) mb[(d * 16 + i) * 64 + lane] = o[d][i];
            mb[4096 + lane] = m_run; mb[4160 + lane] = l_run;
        }
    }
    __syncthreads();
    if (st == 0) {
        if constexpr (MODE == 0) {
            const float inv = 1.f / l_run; float ss = 0.f;
#pragma unroll
            for (int d = 0; d < 4; ++d)
#pragma unroll
                for (int i = 0; i < 16; ++i) { const float v = o[d][i] * inv - P.lam * mb[(d * 16 + i) * 64 + lane]; o[d][i] = v; ss += v * v; }
            ss += __shfl_xor(ss, 32);
            const float rn = rsqrtf(ss * (1.f / 128.f) + 1e-5f) * P.outscale;
#pragma unroll
            for (int d = 0; d < 4; ++d)
#pragma unroll
                for (int i = 0; i < 16; ++i) { const int dv = 32 * d + (i & 3) + 8 * (i >> 2) + 4 * h2; o[d][i] = o[d][i] * rn * P.subw[dv]; }
        } else {
            const float m1 = mb[4096 + lane], l1 = mb[4160 + lane];
            const float mt = fmaxf(m_run, m1); const float a0 = __builtin_amdgcn_exp2f(m_run - mt), a1 = __builtin_amdgcn_exp2f(m1 - mt);
            const float inv = 1.f / (l_run * a0 + l1 * a1);
#pragma unroll
            for (int d = 0; d < 4; ++d)
#pragma unroll
                for (int i = 0; i < 16; ++i) o[d][i] = (o[d][i] * a0 + mb[(d * 16 + i) * 64 + lane] * a1) * inv;
        }
        LAS unsigned char* og = lds + OFF_OST + qg * (32 * OSTP);
#pragma unroll
        for (int d = 0; d < 4; ++d)
#pragma unroll
            for (int g4 = 0; g4 < 4; ++g4) { u32x2 w; w.x = pk2(o[d][4 * g4 + 0], o[d][4 * g4 + 1]); w.y = pk2(o[d][4 * g4 + 2], o[d][4 * g4 + 3]);
                *(LAS u32x2*)(og + r32 * OSTP + (32 * d + 8 * g4 + 4 * h2) * 2) = w; }
        asm volatile("s_waitcnt lgkmcnt(0)" ::: "memory");
        bf16_t* op = P.O + (P.qrow0 + qw0) * (size_t)P.opitch + P.ocol0;
#pragma unroll
        for (int i = 0; i < 8; ++i) { const int row = 4 * i + (lane >> 4), ch = lane & 15;
            const u32x4 v = *(const LAS u32x4*)(og + row * OSTP + ch * 16);
            *(u32x4*)(op + (size_t)row * P.opitch + ch * 8) = v; }
    }
    __syncthreads();
}

DI void phase_att(const Ctx& C, int l) {
    inptr_t in = C.in; unsigned char* ws = C.ws;
    const int ATT_SEL = C.att_sel & 0xff; const int dbg = C.att_sel >> 8;
    if (ATT_SEL & 1) phase_post(C, l);
    bf16_t* Y = dbg ? (bf16_t*)(ws + WS_H) : (bf16_t*)(ws + WS_PRW); const bf16_t* PATT = (const bf16_t*)(ws + WS_PATT);
    const float lambda_init = 0.8f - 0.6f * expf(-0.3f * (float)l);
    float lam;
    { const float a = wave_sum(in[23][l * 64 + C.lane] * in[24][l * 64 + C.lane]), b = wave_sum(in[25][l * 64 + C.lane] * in[26][l * 64 + C.lane]); lam = expf(a) - expf(b) + lambda_init; }
    if (ATT_SEL & 2) for (int w = C.vcu; w < 256; w += C.G) {
        const int bh = w >> 4, j = w & 15, b = bh >> 2, h = bh & 3;
#pragma unroll 1
        for (int k = 0; k < 2; ++k) { const int qb = k ? 31 - j : j;
            AttnP P; P.Q = PATT; P.qpitch = PATT_COLS; P.qcol0 = h * 128; P.K1 = PATT; P.k1pitch = PATT_COLS; P.k1col0 = 512 + h * 128; P.K2 = PATT; P.k2pitch = 0; P.k2col0 = 0;
            P.V = PATT; P.vpitch = PATT_COLS; P.vcol0 = 1024 + h * 128; P.O = Y; P.opitch = 2048; P.ocol0 = 1024 + h * 128;
            P.qrow0 = (size_t)b * SEQ; P.krow0 = (size_t)b * SEQ; P.q0 = qb * 128; P.nkeys = qb * 128 + 128; P.c1 = 0.125f * LOG2E;
            P.pos = (const int*)in[2] + b * SEQ; P.lut = (const float*)(ws + WS_LUT) + h * 128; P.lam = lam; P.outscale = 1.f - lambda_init; P.subw = in[27] + l * 128; P.dbg = dbg;
            attn_unit<64, 64, 0, 64, 1>(C.lds, P); }
    }
    const bf16_t* QM = (const bf16_t*)(ws + WS_QM); const bf16_t* KVM = (const bf16_t*)(ws + WS_KVM); const bf16_t* KPE = (const bf16_t*)(ws + WS_KPE);
    if (ATT_SEL & 4) for (int w = C.vcu; w < 256; w += C.G) {
        const int bh = w >> 4, j = w & 15, b = bh >> 2, h = bh & 3;
#pragma unroll 1
        for (int k = 0; k < 2; ++k) { const int qb = k ? 31 - j : j;
            AttnP P; P.Q = QM; P.qpitch = 768; P.qcol0 = h * 192; P.K1 = KVM; P.k1pitch = 1024; P.k1col0 = h * 256; P.K2 = KPE; P.k2pitch = 64; P.k2col0 = 0;
            P.V = KVM; P.vpitch = 1024; P.vcol0 = h * 256 + 128; P.O = Y; P.opitch = 2048; P.ocol0 = 1536 + h * 128;
            P.qrow0 = (size_t)b * SEQ; P.krow0 = (size_t)b * SEQ; P.q0 = qb * 128; P.nkeys = qb * 128 + 128; P.c1 = 0.07216878364870322f * LOG2E;
            P.pos = nullptr; P.lut = nullptr; P.lam = 0.f; P.outscale = 0.f; P.subw = nullptr; P.dbg = dbg;
            attn_unit<192, 128, 1, 32, 1>(C.lds, P); }
    }
}

DI void phase_cross(const Ctx& C) {
    unsigned char* ws = C.ws; const int dbg = 0;
    const bf16_t* CAQ = (const bf16_t*)(ws + WS_CAQ); const bf16_t* MKV = (const bf16_t*)(ws + WS_MEMKV); bf16_t* CAO = (bf16_t*)(ws + WS_CAO);
    for (int u = C.vcu; u < 512; u += C.G) {
        const int bh = u >> 5, qb = u & 31, b = bh >> 2, h = bh & 3;
        AttnP P; P.Q = CAQ; P.qpitch = 512; P.qcol0 = h * 128; P.K1 = MKV; P.k1pitch = 1024; P.k1col0 = h * 128; P.K2 = MKV; P.k2pitch = 0; P.k2col0 = 0;
        P.V = MKV; P.vpitch = 1024; P.vcol0 = 512 + h * 128; P.O = CAO; P.opitch = 512; P.ocol0 = h * 128;
        P.qrow0 = (size_t)b * SEQ; P.krow0 = (size_t)b * MEMLEN; P.q0 = qb * 128; P.nkeys = MEMLEN; P.c1 = 0.08838834764831845f * LOG2E;
        P.pos = nullptr; P.lut = nullptr; P.lam = 0.f; P.outscale = 0.f; P.subw = nullptr; P.dbg = dbg;
        attn_unit<128, 128, 2, 64, 1>(C.lds, P);
    }
}

DI void phase_route(const Ctx& C, int l) {
    inptr_t in = C.in; unsigned char* ws = C.ws;
    const float* LG = (const float*)(ws + WS_LOGITS);
    const float* bg = in[39] + l * 4; const float* be = in[41] + l * 32;
    int* EID = (int*)(ws + WS_EID); float* GATE = (float*)(ws + WS_GATE); int* CNT = (int*)(ws + WS_CNT);
    LAS int* hist = (LAS int*)(C.lds);
    const int lane = C.lane;
    for (int wgt = C.wg; wgt < 256; wgt += C.G) {
        if (C.tid < 32) hist[C.tid] = 0;
        __syncthreads();
#pragma unroll 1
        for (int r = 0; r < 8; ++r) {
            const int t = wgt * 64 + C.wave * 8 + r;
            const float raw = (lane < 36) ? LG[(size_t)t * 256 + lane] : 0.f;
            const float g0 = RDL_F(raw, 32), g1 = RDL_F(raw, 33), g2 = RDL_F(raw, 34), g3 = RDL_F(raw, 35);
            int sel = 0; float best = g0 + bg[0];
            if (g1 + bg[1] > best) { best = g1 + bg[1]; sel = 1; }
            if (g2 + bg[2] > best) { best = g2 + bg[2]; sel = 2; }
            if (g3 + bg[3] > best) { best = g3 + bg[3]; sel = 3; }
            const float gm = fmaxf(fmaxf(g0, g1), fmaxf(g2, g3));
            const float e0 = __expf(g0 - gm), e1 = __expf(g1 - gm), e2 = __expf(g2 - gm), e3 = __expf(g3 - gm);
            const float es = sel == 0 ? e0 : (sel == 1 ? e1 : (sel == 2 ? e2 : e3));
            const float pgrp = es / ((e0 + e1) + (e2 + e3));
            float val = (lane < 32 && (lane >> 3) == sel) ? raw + be[lane & 31] : -INFINITY;
            const float m1 = wave_max(val); const int i1 = __ffsll((long long)__ballot(val == m1)) - 1;
            if (lane == i1) val = -INFINITY;
            const float m2 = wave_max(val); const int i2 = __ffsll((long long)__ballot(val == m2)) - 1;
            const float r1 = __shfl(raw, i1), r2 = __shfl(raw, i2);
            const float w1 = 1.f / (1.f + __expf(r2 - r1)), w2 = 1.f - w1;
            if (lane == 0) { EID[2 * t] = i1; EID[2 * t + 1] = i2; GATE[2 * t] = w1 * pgrp; GATE[2 * t + 1] = w2 * pgrp;
                atomicAdd((int*)&hist[i1], 1); atomicAdd((int*)&hist[i2], 1); }
        }
        __syncthreads();
        if (C.tid < 32) CNT[wgt * 32 + C.tid] = hist[C.tid];
        __syncthreads();
    }
}

DI void phase_dispatch(const Ctx& C) {
    unsigned char* ws = C.ws;
    const int* EID = (const int*)(ws + WS_EID); const int* CNT = (const int*)(ws + WS_CNT);
    int* ROWMAP = (int*)(ws + WS_ROWMAP); int* ROWDST = (int*)(ws + WS_ROWDST); int* TILEEXP = (int*)(ws + WS_TILEEXP);
    LAS int* tot = (LAS int*)(C.lds); LAS int* base = tot + 32; LAS int* off = base + 32; LAS int* eid = off + 40; LAS int* posl = eid + 128;
    const int tid = C.tid;
    for (int wgt = C.wg; wgt < 256; wgt += C.G) {
        { LAS int* cl = posl + 128;
#pragma unroll
          for (int i = 0; i < 16; ++i) cl[tid + 512 * i] = CNT[tid + 512 * i];
          __syncthreads();
          if (tid < 32) { int s = 0, bsum = 0; for (int w = 0; w < 256; ++w) { const int c = cl[w * 32 + tid]; if (w == wgt) bsum = s; s += c; } tot[tid] = s; base[tid] = bsum; } }
        if (tid >= 64 && tid < 192) eid[tid - 64] = EID[wgt * 128 + (tid - 64)];
        __syncthreads();
        if (tid == 0) { int o = 0; for (int e = 0; e < 32; ++e) { off[e] = o; o += (tot[e] + 255) & ~255; } off[32] = o; }
        __syncthreads();
        if (tid < 128) { const int e = eid[tid]; int rank = 0; for (int j = 0; j < tid; ++j) rank += (eid[j] == e) ? 1 : 0;
            const int pos = off[e] + base[e] + rank; ROWMAP[pos] = wgt * 64 + (tid >> 1); ROWDST[pos] = wgt * 128 + tid; }
        if (wgt < 32) { const int e = wgt; for (int p = off[e] + tot[e] + tid; p < off[e + 1]; p += 512) { ROWMAP[p] = 0; ROWDST[p] = -1; } }
        if (wgt == 0) { if (tid < 32) { for (int tl = off[tid] >> 8; tl < (off[tid + 1] >> 8); ++tl) TILEEXP[tl] = tid; } if (tid == 0) TILEEXP[200] = off[32] >> 8; }
        __syncthreads();
    }
}

#ifndef PHASE_MASK
#define PHASE_MASK 0x1ffff
#endif
#define IN(k) (lo <= (k) && (k) < hi)
#define EN(j) ((PHASE_MASK >> (j)) & 1)
#define SEAM(k) do { if (IN(k) && IN((k) + 1)) xcd_barrier(bar); } while (0)
#define PH_BEGIN() do { int t_ = threadIdx.x; asm volatile("" : "+v"(t_)); kaptr_t ka_ = (kaptr_t)__builtin_amdgcn_kernarg_segment_ptr(); asm volatile("" : "+s"(ka_)); \
        C.lds = (LAS unsigned char*)lds_raw; C.in = (inptr_t)ka_; C.X = *(float* const CAS*)(ka_ + 360); C.ws = *(unsigned char* const CAS*)(ka_ + 368); \
        C.tid = t_; C.lane = t_ & 63; C.wave = __builtin_amdgcn_readfirstlane(t_ >> 6); { int g_ = gridDim.x, b_ = blockIdx.x; asm volatile("" : "+s"(g_), "+s"(b_)); C.G = g_; C.wg = b_; } C.gw = C.wg * 8 + C.wave; C.ngw = C.G * 8; C.vcu = (C.G % 8 == 0) ? (C.wg % 8) * (C.G / 8) + C.wg / 8 : C.wg; \
        ws = C.ws; in = C.in; } while (0)
constexpr int PPL = 16, NPHASE = 2 * PPL + 1;
template <int l>
DI void run_layer(unsigned char* lds_raw, const XcdBarrier& bar, int lo, int hi, int att_sel = 7) {
    Ctx C; unsigned char* ws; inptr_t in; C.att_sel = att_sel;
    constexpr int pb = l * PPL;

        if (EN(0) && IN(pb + 0)) { PH_BEGIN(); phase_convert(C, l); } SEAM(pb + 0);
        if (EN(1) && IN(pb + 1)) { PH_BEGIN();
            { pg8::Gemm g{(const bf16_t*)(ws + WS_XB), (const bf16_t*)(ws + wofs(l) + WS_WINT), DM, DM, DM, nullptr}; pg8::StaticOrder S; S.init(NT, INP, C.G, C.wg, DM);
              pg8::EpiBf16 E{(bf16_t*)(ws + WS_PRW), RW_COLS, (bf16_t*)(ws + WS_PATT), PATT_COLS, 13, (const float*)(ws + WS_SSQM), 1};
              pg8::gemm_phase<pg8::EpiBf16, pg8::StaticOrder>(C.lds, g, S, E); }
            { pg8::Gemm g{(const bf16_t*)(ws + WS_MEMN), (const bf16_t*)(ws + wofs(l) + WS_CAWKVT), DM, DM, DM, nullptr}; pg8::StaticOrder S; S.init(NMEM, 1024, C.G, (C.wg + C.G / 2) % C.G, DM);
              pg8::EpiBf16 E{(bf16_t*)(ws + WS_MEMKV), 1024, nullptr, 0, 1 << 30, nullptr, 1};
              pg8::gemm_phase<pg8::EpiBf16, pg8::StaticOrder>(C.lds, g, S, E); }
        } SEAM(pb + 1);
        if (EN(2) && IN(pb + 2)) { PH_BEGIN(); phase_ew1(C, l); } SEAM(pb + 2);
        if (EN(3) && IN(pb + 3)) { PH_BEGIN();
            { pg8::Gemm g{(const bf16_t*)(ws + WS_LORAA), (const bf16_t*)(ws + wofs(l) + WS_LORABT), 384, 384, 384, nullptr}; pg8::StaticOrder S; S.init(NT, 4096, C.G, C.wg, 384);
              pg8::EpiBf16 E{(bf16_t*)(ws + WS_LORAO), 4096, nullptr, 0, 1 << 30, nullptr, 1};
              pg8::gemm_phase<pg8::EpiBf16, pg8::StaticOrder>(C.lds, g, S, E); }
            { pg8::Gemm g{(const bf16_t*)(ws + WS_QN), (const bf16_t*)(ws + wofs(l) + WS_WQBT), 384, 384, 384, nullptr}; pg8::StaticOrder S; S.init(NT, 768, C.G, C.wg, 384);
              pg8::EpiBf16 E{(bf16_t*)(ws + WS_QM), 768, nullptr, 0, 1 << 30, nullptr, 1};
              pg8::gemm_phase<pg8::EpiBf16, pg8::StaticOrder>(C.lds, g, S, E); }
            { pg8::Gemm g{(const bf16_t*)(ws + WS_KVN), (const bf16_t*)(ws + wofs(l) + WS_WKVBT), 256, 256, 256, nullptr}; pg8::StaticOrder S; S.init(NT, 1024, C.G, C.wg, 256);
              pg8::EpiBf16 E{(bf16_t*)(ws + WS_KVM), 1024, nullptr, 0, 1 << 30, nullptr, 1};
              pg8::gemm_phase<pg8::EpiBf16, pg8::StaticOrder>(C.lds, g, S, E); }
        } SEAM(pb + 3);
        if (EN(4) && IN(pb + 4)) { PH_BEGIN(); phase_ew2(C, l); } SEAM(pb + 4);
        if (EN(5) && IN(pb + 5)) { PH_BEGIN(); phase_scan(C, l); } SEAM(pb + 5);
        if (EN(6) && IN(pb + 6)) { PH_BEGIN(); phase_att(C, l); } SEAM(pb + 6);
        if (EN(7) && IN(pb + 7)) { PH_BEGIN();
            pg8::Gemm g{(const bf16_t*)(ws + WS_PRW), (const bf16_t*)(ws + wofs(l) + WS_WOUTT), DM, DM, DM, nullptr}; pg8::StaticOrder S; S.init(NT, DM, C.G, C.wg, DM);
            pg8::EpiResid E{l == 0 ? in[0] : nullptr, (const bf16_t*)(ws + WS_XB), (bf16_t*)(ws + WS_XB), DM, (float*)(ws + WS_PARTC)};
            pg8::gemm_phase<pg8::EpiResid, pg8::StaticOrder>(C.lds, g, S, E);
        } SEAM(pb + 7);
        if (EN(8) && IN(pb + 8)) { PH_BEGIN();
            pg8::Gemm g{(const bf16_t*)(ws + WS_XB), (const bf16_t*)(ws + wofs(l) + WS_CAWQT), DM, DM, DM, nullptr}; pg8::StaticOrder S; S.init(NT, 512, C.G, C.wg, DM);
            pg8::EpiBf16 E{(bf16_t*)(ws + WS_CAQ), 512, nullptr, 0, 1 << 30, (const float*)(ws + WS_PARTC), 32};
            pg8::gemm_phase<pg8::EpiBf16, pg8::StaticOrder>(C.lds, g, S, E);
        } SEAM(pb + 8);
        if (EN(9) && IN(pb + 9)) { PH_BEGIN(); phase_cross(C); } SEAM(pb + 9);
        if (EN(10) && IN(pb + 10)) { PH_BEGIN();
            pg8::Gemm g{(const bf16_t*)(ws + WS_CAO), (const bf16_t*)(ws + wofs(l) + WS_CAWOT), 512, 512, 512, nullptr}; pg8::StaticOrder S; S.init(NT, DM, C.G, C.wg, 512);
            pg8::EpiResid E{nullptr, (const bf16_t*)(ws + WS_XB), (bf16_t*)(ws + WS_XB), DM, (float*)(ws + WS_PARTF)};
            pg8::gemm_phase<pg8::EpiResid, pg8::StaticOrder>(C.lds, g, S, E);
        } SEAM(pb + 10);
        if (EN(11) && IN(pb + 11)) { PH_BEGIN();
            pg8::Gemm g{(const bf16_t*)(ws + WS_XB), (const bf16_t*)(ws + (l ? WS_WRB1 : WS_WRB)), DM, DM, DM, nullptr}; pg8::StaticOrder S; S.init(NT, 256, C.G, C.wg, DM);
            pg8::EpiF32 E{(float*)(ws + WS_LOGITS), 256, (const float*)(ws + WS_PARTF), 32, (float*)(ws + WS_SSQF)};
            pg8::gemm_phase<pg8::EpiF32, pg8::StaticOrder>(C.lds, g, S, E);
        } SEAM(pb + 11);
        if (EN(12) && IN(pb + 12)) { PH_BEGIN(); phase_route(C, l); } SEAM(pb + 12);
        if (EN(13) && IN(pb + 13)) { PH_BEGIN(); phase_dispatch(C); } SEAM(pb + 13);
        if (EN(14) && IN(pb + 14)) { PH_BEGIN();
            const int* TE = (const int*)(ws + WS_TILEEXP);
            pg8::Gemm g{(const bf16_t*)(ws + WS_XB), (const bf16_t*)(ws + WS_WGU), DM, DM, DM, (const int*)(ws + WS_ROWMAP)};
            pg8::MoeOrder S{TE, TE[200], 4, C.G, C.wg, DM, (long)1024 * DM};
            pg8::EpiSiluMul E{(bf16_t*)(ws + WS_HID), DEXP, (const float*)(ws + WS_SSQF), (const int*)(ws + WS_ROWMAP)};
            pg8::gemm_phase<pg8::EpiSiluMul, pg8::MoeOrder, true>(C.lds, g, S, E);
        } SEAM(pb + 14);
        if (EN(15) && IN(pb + 15)) { PH_BEGIN();
            const int* TE = (const int*)(ws + WS_TILEEXP);
            pg8::Gemm g{(const bf16_t*)(ws + WS_HID), (const bf16_t*)(ws + WS_WD), DEXP, DEXP, DEXP, nullptr};
            pg8::MoeOrder S{TE, TE[200], 8, C.G, C.wg, DEXP, (long)DM * DEXP};
            pg8::EpiScatter E{(bf16_t*)(ws + WS_C2), DM, (const int*)(ws + WS_ROWDST)};
            pg8::gemm_phase<pg8::EpiScatter, pg8::MoeOrder>(C.lds, g, S, E);
        } SEAM(pb + 15);
    }

__global__ void __launch_bounds__(512, 2) mk_fwd(Args args) {
    extern __shared__ __attribute__((aligned(16))) unsigned char lds_raw[];
    Ctx C;
    unsigned char* ws; inptr_t in;
    PH_BEGIN();
    volatile LAS unsigned* MISC = (volatile LAS unsigned*)(C.lds + LDS_MISC);
    if (C.tid < 64) MISC[C.tid] = 0u;
    __syncthreads();
    const int lo = args.ph_lo, hi = args.ph_hi;
    XcdBarrier bar; bar.bar = (unsigned*)(args.ws + WS_CTL) + CW_BAR; bar.x = 0; bar.st = MISC + 8;
    if (hi - lo > 1) bar = xcd_barrier_post((unsigned*)(args.ws + WS_CTL) + CW_BAR, MISC + 8);
#ifndef PROBE_MASK
#define PROBE_MASK 0
#endif
#if PROBE_MASK
#ifndef PROBE_ATT
#define PROBE_ATT 7
#endif
#define RUNP(k) do { run_layer<0>(lds_raw, bar, (k), (k) + 1); xcd_barrier(bar); if ((PROBE_MASK >> (k)) & 1) { run_layer<0>(lds_raw, bar, (k), (k) + 1, PROBE_ATT); xcd_barrier(bar); } } while (0)
    RUNP(0); RUNP(1); RUNP(2); RUNP(3); RUNP(4); RUNP(5); RUNP(6); RUNP(7); RUNP(8); RUNP(9); RUNP(10); RUNP(11); RUNP(12); RUNP(13); RUNP(14); RUNP(15);
    run_layer<1>(lds_raw, bar, PPL, 2 * PPL); xcd_barrier(bar);
#else
    run_layer<0>(lds_raw, bar, lo, hi);
    run_layer<1>(lds_raw, bar, lo, hi);
#endif
    if (EN(16) && IN(2 * PPL)) { PH_BEGIN();
        const bf16_t* C2 = (const bf16_t*)(ws + WS_C2); const float* gate = (const float*)(ws + WS_GATE);
        for (int m = C.gw; m < NT; m += C.ngw)
            norm_row(nullptr, (const bf16_t*)(ws + WS_XB) + (size_t)m * DM, nullptr, C2 + (size_t)(2 * m) * DM, C2 + (size_t)(2 * m + 1) * DM, gate[2 * m], gate[2 * m + 1], in[4], nullptr, C.X + (size_t)m * DM, C.lane);
    }
#undef IN
#undef SEAM
}

extern "C" void kernel_launch(void* const* d_in, const int* in_sizes, int n_in, void* d_out, int out_size, void* d_ws, size_t ws_size, hipStream_t stream) {
    static int grid = 0;
    if (grid == 0) {
        if (n_in != 45 || out_size != NT * DM || ws_size < WS_END) { grid = -1; return; }
        int dev = 0, cus = 0;
        if (hipGetDevice(&dev) != hipSuccess || hipDeviceGetAttribute(&cus, hipDeviceAttributeMultiprocessorCount, dev) != hipSuccess) { grid = -1; return; }
        if (hipFuncSetAttribute((const void*)mk_fwd, hipFuncAttributeMaxDynamicSharedMemorySize, LDS_BYTES) != hipSuccess) { grid = -1; return; }
        int per_cu = 0;
        (void)hipOccupancyMaxActiveBlocksPerMultiprocessor(&per_cu, (const void*)mk_fwd, 512, LDS_BYTES);
        (void)hipGetLastError();
        grid = cus;
    }
    if (grid < 0) return;
    (void)hipMemsetAsync((char*)d_ws + WS_CTL, 0, 1 * MiB, stream);
    Args a{};
    for (int i = 0; i < 45; ++i) a.in[i] = d_in[i];
    a.out = (float*)d_out; a.ws = (unsigned char*)d_ws;
#if MK_ONE_LAUNCH
    a.ph_lo = 0; a.ph_hi = NPHASE;
    hipLaunchKernelGGL(mk_fwd, dim3(grid), dim3(512), LDS_BYTES, stream, a);
#else
    for (int p = 0; p < NPHASE; ++p) { a.ph_lo = p; a.ph_hi = p + 1; hipLaunchKernelGGL(mk_fwd, dim3(grid), dim3(512), LDS_BYTES, stream, a); }
#endif
}
```

```cpp
#include <hip/hip_runtime.h>
#include <stdint.h>
#include <math.h>

#ifndef MK_ONE_LAUNCH
#define MK_ONE_LAUNCH 1
#endif

#define DI __device__ __forceinline__
#define LAS __attribute__((address_space(3)))
#define GAS __attribute__((address_space(1)))

typedef unsigned short bf16_t;
typedef short bf16x8 __attribute__((ext_vector_type(8)));
typedef short s16x4 __attribute__((ext_vector_type(4)));
typedef float f32x2 __attribute__((ext_vector_type(2)));
typedef float f32x4 __attribute__((ext_vector_type(4)));
typedef float f32x16 __attribute__((ext_vector_type(16)));
typedef unsigned u32x2 __attribute__((ext_vector_type(2)));
typedef unsigned u32x4 __attribute__((ext_vector_type(4)));
typedef __bf16 bf16x2_t __attribute__((ext_vector_type(2)));
typedef short v4i16_t __attribute__((ext_vector_type(4)));
typedef _Float16 h2_t __attribute__((ext_vector_type(2)));
typedef _Float16 h4_t __attribute__((ext_vector_type(4)));

constexpr int NB = 4, SEQ = 4096, DM = 2048, NT = NB * SEQ;
constexpr int MEMLEN = 256, NMEM = NB * MEMLEN;
constexpr int RW_DIM = 1024, RW_COLS = 3328, IN_COLS = 5568, INP = 5632;
constexpr int PATT_COLS = 2304;
constexpr int NEXP = 32, DEXP = 512;
constexpr int MOE_ROWS = 40960;
constexpr float LOG2E = 1.4426950408889634f;

constexpr size_t MiB = 1u << 20, KiB = 1024;
constexpr size_t WS_CTL = 0;
constexpr size_t WS_ROPE = 1 * MiB;
constexpr size_t WS_EID = 5 * MiB;
constexpr size_t WS_GATE = 5 * MiB + 128 * KiB;
constexpr size_t WS_CNT = 5 * MiB + 256 * KiB;
constexpr size_t WS_ROWMAP = 5 * MiB + 320 * KiB;
constexpr size_t WS_ROWDST = 5 * MiB + 512 * KiB;
constexpr size_t WS_TILEEXP = 5 * MiB + 704 * KiB;
constexpr size_t WS_WRB = 7 * MiB;
constexpr size_t WS_LOGITS = 852 * MiB;
constexpr size_t WS_SSQM = 6 * MiB;
constexpr size_t WS_SSQC = 6 * MiB + 64 * KiB;
constexpr size_t WS_SSQF = 6 * MiB + 128 * KiB;
constexpr size_t WS_LUT = 6 * MiB + 512 * KiB;
constexpr size_t WS_WINT = 8 * MiB;
constexpr size_t WS_WOUTT = 30 * MiB;
constexpr size_t WS_CAWQT = 38 * MiB;
constexpr size_t WS_CAWKVT = 40 * MiB;
constexpr size_t WS_CAWOT = 44 * MiB;
constexpr size_t WS_WQBT = 46 * MiB;
constexpr size_t WS_WKVBT = 47 * MiB;
constexpr size_t WS_LORABT = 48 * MiB;
constexpr size_t WS_WGU = 52 * MiB;
constexpr size_t WS_WD = 180 * MiB;
constexpr size_t WS_H = 248 * MiB;
constexpr size_t WS_PRW = 312 * MiB;
constexpr size_t WS_PATT = 416 * MiB;
constexpr size_t WS_U = 488 * MiB;
constexpr size_t WS_HID = 488 * MiB, WS_C2 = 528 * MiB;
constexpr size_t WS_APERM = 312 * MiB;
constexpr size_t WS_LORAA = 680 * MiB;
constexpr size_t WS_LORAO = 692 * MiB;
constexpr size_t WS_VFIRST = 820 * MiB;
constexpr size_t WS_QN = 852 * MiB, WS_KVN = 864 * MiB, WS_QM = 872 * MiB, WS_KVM = 896 * MiB, WS_KPE = 928 * MiB;
constexpr size_t WS_CAQ = 852 * MiB, WS_CAO = 868 * MiB;
constexpr size_t WS_MEMN = 932 * MiB, WS_MEMKV = 936 * MiB;
constexpr size_t WS_XB = 940 * MiB;
constexpr size_t WS_PARTC = 1004 * MiB;
constexpr size_t WS_PARTF = 1006 * MiB;
constexpr size_t WS_L1OFF = 1000 * MiB;
constexpr size_t WS_WRB1 = 1052 * MiB;
constexpr size_t WS_END = 1053 * MiB;
constexpr int CW_BAR = 4096;

constexpr int LDS_MAIN = 131072;
constexpr int LDS_MISC = LDS_MAIN;
constexpr int LDS_BYTES = 147456;

DI unsigned pk2(float lo, float hi) { f32x2 v = {lo, hi}; bf16x2_t b = __builtin_convertvector(v, bf16x2_t); return __builtin_bit_cast(unsigned, b); }
DI bf16_t f2bf(float f) { return (bf16_t)(pk2(f, 0.f) & 0xffffu); }
DI unsigned pkh2(float lo, float hi) { const h2_t v = {(_Float16)lo, (_Float16)hi}; return __builtin_bit_cast(unsigned, v); }
DI float hflo(unsigned u) { return (float)__builtin_bit_cast(h2_t, u)[0]; }
DI float hfhi(unsigned u) { return (float)__builtin_bit_cast(h2_t, u)[1]; }
DI float bf2f(bf16_t b) { return __uint_as_float(((unsigned)b) << 16); }
DI float bflo(unsigned u) { return __uint_as_float(u << 16); }
DI float bfhi(unsigned u) { return __uint_as_float(u & 0xffff0000u); }
#define DPP_F(x, ctl) __builtin_bit_cast(float, __builtin_amdgcn_update_dpp(0, __builtin_bit_cast(int, x), ctl, 0xf, 0xf, true))
#define RDL_F(x, l) __builtin_bit_cast(float, __builtin_amdgcn_readlane(__builtin_bit_cast(int, x), l))
DI float wave_sum(float v) {
    v += DPP_F(v, 0xB1);
    v += DPP_F(v, 0x4E);
    v += DPP_F(v, 0x141);
    v += DPP_F(v, 0x140);
    const float r0 = RDL_F(v, 0), r1 = RDL_F(v, 16), r2 = RDL_F(v, 32), r3 = RDL_F(v, 48);
    return (r0 + r1) + (r2 + r3);
}
DI float wave_max(float v) {
    v = fmaxf(v, DPP_F(v, 0xB1)); v = fmaxf(v, DPP_F(v, 0x4E)); v = fmaxf(v, DPP_F(v, 0x141)); v = fmaxf(v, DPP_F(v, 0x140));
    const float r0 = RDL_F(v, 0), r1 = RDL_F(v, 16), r2 = RDL_F(v, 32), r3 = RDL_F(v, 48);
    return fmaxf(fmaxf(r0, r1), fmaxf(r2, r3));
}
DI float sigmoidf_(float x) { return 1.f / (1.f + __expf(-x)); }

#define XB_TMO      128
#define XB_XCNT(j)  (256  + 64 * (j))
#define XB_XSUB(j)  (1280 + 64 * (j))
#define XB_XGEN(j)  (2304 + 64 * (j))
#define XB_TOP      3328
#define XB_TOPGEN   3392
#define XCD_BAR_WORDS 3456
#define XB_SPIN_CAP (1u << 24)

DI unsigned xb_ld(unsigned* p)              { return __hip_atomic_load(p, __ATOMIC_RELAXED, __HIP_MEMORY_SCOPE_AGENT); }
DI unsigned xb_add(unsigned* p, unsigned v) { return __hip_atomic_fetch_add(p, v, __ATOMIC_RELAXED, __HIP_MEMORY_SCOPE_AGENT); }
DI unsigned xb_xcc_id() { return (unsigned)__builtin_amdgcn_s_getreg((3 << 11) | 20) & 0xFu; }
#define XB_SPIN(cond, bar) do { unsigned _sp = 0; while (cond) { __builtin_amdgcn_s_sleep(1); \
    if ((++_sp & 255u) == 0u) { if (xb_ld(&(bar)[XB_TMO])) break; if (_sp > XB_SPIN_CAP) { atomicAdd(&(bar)[XB_TMO], 1u); break; } } } } while (0)

struct XcdBarrier { unsigned* bar; unsigned x; volatile LAS unsigned* st; };

DI XcdBarrier xcd_barrier_post(unsigned* bar, volatile LAS unsigned* st) {
    XcdBarrier b; b.bar = bar; b.x = xb_xcc_id(); b.st = st;
    if (threadIdx.x == 0) (void)xb_add(&bar[XB_XCNT(b.x)], 1u);
    return b;
}
DI void xcd_barrier_complete(unsigned* bar, unsigned x, unsigned& nloc, unsigned& nx) {
    const unsigned G = gridDim.x * gridDim.y * gridDim.z;
    unsigned sum, cnt, mine, sp = 0u;
    for (;;) {
        sum = 0u; cnt = 0u; mine = 0u;
#pragma unroll
        for (unsigned j = 0; j < 16; ++j) { const unsigned c = xb_ld(&bar[XB_XCNT(j)]); sum += c; cnt += (c > 0u) ? 1u : 0u; mine = (j == x) ? c : mine; }
        if (sum == G) break;
        __builtin_amdgcn_s_sleep(1);
        if ((++sp & 255u) == 0u) { if (xb_ld(&bar[XB_TMO])) break; if (sp > XB_SPIN_CAP) { atomicAdd(&bar[XB_TMO], 1u); break; } }
    }
    nloc = mine > 0u ? mine : 1u; nx = cnt > 0u ? cnt : 1u;
}
DI void xcd_barrier(const XcdBarrier& b) {
    asm volatile("s_waitcnt vmcnt(0)" ::: "memory");
    __syncthreads();
    if (threadIdx.x == 0) {
        unsigned* bar = b.bar;
        __builtin_amdgcn_s_waitcnt(0);
        unsigned nloc = b.st[0], nx = b.st[1];
        if (nloc == 0u) { xcd_barrier_complete(bar, b.x, nloc, nx); b.st[0] = nloc; b.st[1] = nx; }
        const unsigned old = xb_add(&bar[XB_XSUB(b.x)], 1u);
        const unsigned gen = old / nloc;
        if (old + 1u == (gen + 1u) * nloc) {
            __builtin_amdgcn_fence(__ATOMIC_RELEASE, "agent");
            asm volatile("s_waitcnt vmcnt(0)" ::: "memory");
            const unsigned og = xb_add(&bar[XB_TOP], 1u);
            const unsigned tg = og / nx;
            if (og + 1u == (tg + 1u) * nx) xb_add(&bar[XB_TOPGEN], 1u);
            else XB_SPIN(xb_ld(&bar[XB_TOPGEN]) == tg, bar);
            __builtin_amdgcn_fence(__ATOMIC_ACQUIRE, "agent");
            xb_add(&bar[XB_XGEN(b.x)], 1u);
            asm volatile("s_waitcnt vmcnt(0)" ::: "memory");
        } else {
            XB_SPIN(xb_ld(&bar[XB_XGEN(b.x)]) == gen, bar);
            __builtin_amdgcn_fence(__ATOMIC_ACQUIRE, "agent");
            asm volatile("s_waitcnt vmcnt(0)" ::: "memory");
        }
    }
    __syncthreads();
}

namespace pg8 {
constexpr int BM = 256, BK = 64, HALF = 128, HTB = HALF * BK * 2, STAGE_BYTES = 8 * HTB, NXCD = 8, WGM = 8;
__host__ __device__ __forceinline__ int lds_byte(int r, int c) { const int st = (r >> 4) * 2 + (c >> 5), rr = r & 15, cc = c & 31, ob = rr * 64 + cc * 2; return st * 1024 + (ob ^ (((ob >> 9) & 1) << 5)); }
__host__ __device__ __forceinline__ void stage_rc(int b, int& R, int& C) { const int st = b / 1024, sb = b % 1024, swz = sb ^ (((sb >> 9) & 1) << 5); R = (st >> 1) * 16 + swz / 64; C = (st & 1) * 32 + (swz % 64) / 2; }
__host__ __device__ __forceinline__ int perm32(int rho) { const int n = rho >> 4, i = rho & 15; return 8 * (i >> 2) + 4 * n + (i & 3); }

struct Unit { int pm, pn; long bbase; };
struct Gemm { const bf16_t* A; const bf16_t* Bt; int lda, ldb, K; const int* rowmap; };

struct StaticOrder {
    int nM, nN, nwg, G, c, ldb;
    DI void init(int M, int N, int G_, int c_, int ldb_) { nM = M / BM; nN = N / BM; nwg = nM * nN; G = G_; c = c_; ldb = ldb_; }
    DI bool next(int i, Unit& u) const {
        const long L = (long)i * G + c; if (L >= nwg) return false;
        int wgid = (int)L; { const int q = nwg / NXCD, r = nwg % NXCD, xcd = wgid % NXCD, off = wgid / NXCD; wgid = (xcd < r ? xcd * (q + 1) : r * (q + 1) + (xcd - r) * q) + off; }
        const int nig = WGM * nN, gid = wgid / nig, fm = gid * WGM, gsz = (nM - fm) < WGM ? (nM - fm) : WGM;
        u.pm = fm + ((wgid % nig) % gsz); u.pn = (wgid % nig) / gsz; u.bbase = (long)u.pn * BM * ldb; return true;
    }
};
struct MoeOrder {
    const int* tileexp; int ntiles, nN, G, c, ldb; long estride;
    DI bool next(int i, Unit& u) const {
        const long L = (long)i * G + c; if (L >= (long)ntiles * nN) return false;
        const int tile = (int)(L / nN), pn = (int)(L % nN); const int e = tileexp[tile];
        u.pm = tile; u.pn = pn; u.bbase = (long)e * estride + (long)pn * BM * ldb; return true;
    }
};

template <class Epi, class Sched, bool GATHER = false>
DI void gemm_phase(LAS unsigned char* lds, const Gemm g, const Sched& S, const Epi& E) {
    int tid = threadIdx.x; asm volatile("" : "+v"(tid));
    const int wid = __builtin_amdgcn_readfirstlane(tid >> 6), lane = tid & 63, wr = wid >> 2, wc = wid & 3, fr = lane & 15, fq = lane >> 4;
    const int K = g.K, nt = K / BK;
    unsigned voffA[2], voffB[2]; int RA[2], CA[2];
#pragma unroll
    for (int i = 0; i < 2; ++i) { int R, C; stage_rc(tid * 16 + i * 8192, R, C); const int Rb = Epi::PERM ? ((R & ~31) + perm32(R & 31)) : R;
        RA[i] = R; CA[i] = C; voffA[i] = (unsigned)(R * g.lda + C) * 2u; voffB[i] = (unsigned)(Rb * g.ldb + C) * 2u; }
    const size_t kstep = (size_t)(BK * 2);
    const size_t hstepA = (size_t)HALF * g.lda * 2, hstepB = (size_t)HALF * g.ldb * 2;
    const unsigned ldsw = (unsigned)wid * 1024u;
    const int aoff = lds_byte(wr * 64 + fr, fq * 8), boff = lds_byte(wc * 32 + fr, fq * 8);
#define PG8_SA(b, h) (((b) * 2 + (h)) * HTB)
#define PG8_SB(b, h) ((4 + (b) * 2 + (h)) * HTB)
#define PG8_STAGE(bufoff, gbase, voff) do { _Pragma("unroll") for (int _i = 0; _i < 2; ++_i) \
        __builtin_amdgcn_global_load_lds((const unsigned*)((const char*)(gbase) + (voff)[_i]), (LAS unsigned*)(lds + (bufoff) + ldsw + _i * 8192), 16, 0, 0); } while (0)
    unsigned gA[2][2], ngA[2][2];
#define PG8_STAGE_A(b, h, ptr, isnext) do { if constexpr (GATHER) { if (isnext) PG8_STAGE(PG8_SA(b, h), ptr, ngA[h]); else PG8_STAGE(PG8_SA(b, h), ptr, gA[h]); } \
        else PG8_STAGE(PG8_SA(b, h), (ptr) + (h) * hstepA, voffA); } while (0)
#define PG8_GATHER_OFFS(dst, un) do { _Pragma("unroll") for (int h_ = 0; h_ < 2; ++h_) _Pragma("unroll") for (int i_ = 0; i_ < 2; ++i_) \
        dst[h_][i_] = (unsigned)(g.rowmap[(un).pm * BM + h_ * HALF + RA[i_]] * g.lda + CA[i_]) * 2u; } while (0)
#define PG8_LDA(dst, b, h) do { _Pragma("unroll") for (int m = 0; m < 4; ++m) _Pragma("unroll") for (int k = 0; k < 2; ++k) dst[m][k] = *(const LAS bf16x8*)(lds + PG8_SA(b, h) + aoff + m * 2048 + k * 1024); } while (0)
#define PG8_LDB(dst, b, h) do { _Pragma("unroll") for (int n = 0; n < 2; ++n) _Pragma("unroll") for (int k = 0; k < 2; ++k) dst[n][k] = *(const LAS bf16x8*)(lds + PG8_SB(b, h) + boff + n * 2048 + k * 1024); } while (0)
#define PG8_MMA(ai, bj, At, Bt) do { __builtin_amdgcn_s_setprio(1); _Pragma("unroll") for (int m = 0; m < 4; ++m) _Pragma("unroll") for (int n = 0; n < 2; ++n) _Pragma("unroll") for (int k = 0; k < 2; ++k) \
        acc[ai][bj][m][n] = __builtin_amdgcn_mfma_f32_16x16x32_bf16(Bt[n][k], At[m][k], acc[ai][bj][m][n], 0, 0, 0); __builtin_amdgcn_s_setprio(0); } while (0)
#define PG8_WAIT_V(n) asm volatile("s_waitcnt vmcnt(" #n ")" ::: "memory")
#define PG8_WAIT_L(n) asm volatile("s_waitcnt lgkmcnt(" #n ")" ::: "memory")
#define PG8_BAR __builtin_amdgcn_s_barrier()
#define PG8_SCHED __builtin_amdgcn_sched_barrier(0)
    Unit cur, nxt; int ui = 0;
    if (!S.next(0, cur)) return;
    f32x4 acc[2][2][4][2];
#pragma unroll
    for (int a = 0; a < 2; ++a)
#pragma unroll
        for (int b = 0; b < 2; ++b)
#pragma unroll
            for (int m = 0; m < 4; ++m)
#pragma unroll
                for (int n = 0; n < 2; ++n) acc[a][b][m][n] = (f32x4){0.f, 0.f, 0.f, 0.f};
    bf16x8 At[4][2], B0[2][2], B1[2][2];
    const char* cA; const char* cB = (const char*)g.Bt + cur.bbase * 2;
    if constexpr (GATHER) { cA = (const char*)g.A; PG8_GATHER_OFFS(gA, cur); PG8_GATHER_OFFS(ngA, cur); }
    else cA = (const char*)g.A + (size_t)cur.pm * BM * g.lda * 2;
    PG8_STAGE(PG8_SB(0, 0), cB, voffB); PG8_STAGE(PG8_SB(0, 1), cB + hstepB, voffB); PG8_STAGE_A(0, 0, cA, false); PG8_STAGE_A(0, 1, cA, false);
    if (wr == 1) PG8_BAR;
    PG8_WAIT_V(2); PG8_BAR;
    PG8_STAGE(PG8_SB(1, 0), cB + kstep, voffB); PG8_STAGE_A(1, 0, cA + kstep, false); PG8_STAGE(PG8_SB(1, 1), cB + hstepB + kstep, voffB);
    PG8_WAIT_V(6); PG8_BAR;
    for (;;) {
        const bool has_next = S.next(ui + 1, nxt);
        const char* nA; const char* nB = has_next ? (const char*)g.Bt + nxt.bbase * 2 : cB;
        if constexpr (GATHER) { nA = cA; if (has_next) PG8_GATHER_OFFS(ngA, nxt); }
        else nA = has_next ? (const char*)g.A + (size_t)nxt.pm * BM * g.lda * 2 : cA;
        for (int t = 0; t < nt; t += 2) {
            const bool last = (t == nt - 2);
            const char* a1 = cA + (size_t)(t + 1) * kstep;
            const char* a2 = last ? nA : cA + (size_t)(t + 2) * kstep; const char* b2 = last ? nB : cB + (size_t)(t + 2) * kstep;
            const char* a3 = a2 + kstep; const char* b3 = b2 + kstep;
            PG8_LDB(B0, 0, 0); PG8_LDB(B1, 0, 1); PG8_SCHED; PG8_LDA(At, 0, 0); PG8_STAGE_A(1, 1, a1, false);
            PG8_WAIT_V(8); PG8_WAIT_L(0); PG8_BAR; PG8_MMA(0, 0, At, B0); PG8_MMA(0, 1, At, B1); PG8_BAR; PG8_SCHED;
            PG8_LDA(At, 0, 1); PG8_STAGE(PG8_SB(0, 0), b2, voffB); PG8_STAGE(PG8_SB(0, 1), b2 + hstepB, voffB); PG8_STAGE_A(0, 0, a2, last);
            PG8_WAIT_V(8); PG8_WAIT_L(0); PG8_BAR; PG8_MMA(1, 0, At, B0); PG8_MMA(1, 1, At, B1); PG8_BAR; PG8_SCHED;
            PG8_LDB(B0, 1, 0); PG8_LDB(B1, 1, 1); PG8_SCHED; PG8_LDA(At, 1, 0); PG8_STAGE_A(0, 1, a2, last);
            PG8_WAIT_V(8); PG8_WAIT_L(0); PG8_BAR; PG8_MMA(0, 0, At, B0); PG8_MMA(0, 1, At, B1); PG8_BAR; PG8_SCHED;
            PG8_LDA(At, 1, 1); PG8_STAGE(PG8_SB(1, 0), b3, voffB); PG8_STAGE(PG8_SB(1, 1), b3 + hstepB, voffB); PG8_STAGE_A(1, 0, a3, last);
            PG8_WAIT_V(8); PG8_WAIT_L(0); PG8_BAR; PG8_MMA(1, 0, At, B0); PG8_MMA(1, 1, At, B1); PG8_BAR; PG8_SCHED;
        }
        if (wr == 0) PG8_BAR;
        E(acc, cur, wr, wc, fr, fq);
        if (!has_next) break;
#pragma unroll
        for (int a = 0; a < 2; ++a)
#pragma unroll
            for (int b = 0; b < 2; ++b)
#pragma unroll
                for (int m = 0; m < 4; ++m)
#pragma unroll
                    for (int n = 0; n < 2; ++n) acc[a][b][m][n] = (f32x4){0.f, 0.f, 0.f, 0.f};
        cur = nxt; cA = nA; cB = nB; ++ui;
        if constexpr (GATHER) {
#pragma unroll
            for (int h_ = 0; h_ < 2; ++h_)
#pragma unroll
                for (int i_ = 0; i_ < 2; ++i_) gA[h_][i_] = ngA[h_][i_]; }
        if (wr == 1) PG8_BAR;
    }
    PG8_WAIT_V(0);
    PG8_BAR;
#undef PG8_SA
#undef PG8_SB
#undef PG8_STAGE
#undef PG8_STAGE_A
#undef PG8_LDA
#undef PG8_LDB
#undef PG8_MMA
#undef PG8_WAIT_V
#undef PG8_WAIT_L
#undef PG8_BAR
#undef PG8_SCHED
#undef PG8_GATHER_OFFS
}

DI float row_ssq32(const float* part, int row) { const f32x4* p = (const f32x4*)(part + (size_t)row * 32); float t = 0.f;
#pragma unroll
    for (int i = 0; i < 8; ++i) { const f32x4 v = p[i]; t += (v[0] + v[1]) + (v[2] + v[3]); }
    return t; }
DI float row_rstd(const float* ssq, int np, int row) {
    float t;
    if (np == 1) t = ssq[row];
    else { const f32x4* p = (const f32x4*)(ssq + (size_t)row * 32); t = 0.f;
#pragma unroll
        for (int i = 0; i < 8; ++i) { const f32x4 v = p[i]; t += (v[0] + v[1]) + (v[2] + v[3]); } }
    return rsqrtf(t * (1.f / 2048.f) + 1e-6f);
}
struct EpiBf16 {
    static constexpr bool PERM = true;
    bf16_t* O; int ldc; bf16_t* O2; int ldc2; int split_tile; const float* ssq; int np;
    DI void operator()(const f32x4 (&acc)[2][2][4][2], const Unit& u, int wr, int wc, int fr, int fq) const {
        bf16_t* base = O; int ld = ldc; int colt = u.pn * BM;
        if (u.pn >= split_tile) { base = O2; ld = ldc2; colt = (u.pn - split_tile) * BM; }
        const int row0 = u.pm * BM + wr * 64 + fr, col0 = colt + wc * 32 + 8 * fq;
#pragma unroll
        for (int ai = 0; ai < 2; ++ai)
#pragma unroll
            for (int m = 0; m < 4; ++m) { const int row = row0 + ai * HALF + m * 16; bf16_t* rowp = base + (size_t)row * ld + col0;
                const float rs = ssq ? row_rstd(ssq, np, row) : 1.f;
#pragma unroll
                for (int bj = 0; bj < 2; ++bj) { const f32x4 v0 = acc[ai][bj][m][0] * rs, v1 = acc[ai][bj][m][1] * rs;
                    u32x4 w; w.x = pk2(v0[0], v0[1]); w.y = pk2(v0[2], v0[3]); w.z = pk2(v1[0], v1[1]); w.w = pk2(v1[2], v1[3]);
                    *(u32x4*)(rowp + bj * HALF) = w; } }
    }
};
struct EpiResid {
    static constexpr bool PERM = true;
    const float* basef; const bf16_t* baseb; bf16_t* out; int ldc; float* part_out;
    DI void operator()(const f32x4 (&acc)[2][2][4][2], const Unit& u, int wr, int wc, int fr, int fq) const {
        const int row0 = u.pm * BM + wr * 64 + fr, col0 = u.pn * BM + wc * 32 + 8 * fq;
#pragma unroll
        for (int ai = 0; ai < 2; ++ai)
#pragma unroll
            for (int m = 0; m < 4; ++m) { const int row = row0 + ai * HALF + m * 16; const size_t off = (size_t)row * ldc + col0; float sq = 0.f;
#pragma unroll
                for (int bj = 0; bj < 2; ++bj) { f32x4 v0 = acc[ai][bj][m][0], v1 = acc[ai][bj][m][1];
                    if (basef) { v0 += *(const f32x4*)(basef + off + bj * HALF); v1 += *(const f32x4*)(basef + off + bj * HALF + 4); }
                    else { const u32x4 b = *(const u32x4*)(baseb + off + bj * HALF);
                        v0 += (f32x4){bflo(b.x), bfhi(b.x), bflo(b.y), bfhi(b.y)}; v1 += (f32x4){bflo(b.z), bfhi(b.z), bflo(b.w), bfhi(b.w)}; }
                    u32x4 w; w.x = pk2(v0[0], v0[1]); w.y = pk2(v0[2], v0[3]); w.z = pk2(v1[0], v1[1]); w.w = pk2(v1[2], v1[3]);
                    *(u32x4*)(out + off + bj * HALF) = w;
                    const float a0 = bflo(w.x), a1 = bfhi(w.x), a2 = bflo(w.y), a3 = bfhi(w.y), a4 = bflo(w.z), a5 = bfhi(w.z), a6 = bflo(w.w), a7 = bfhi(w.w);
                    sq += ((a0 * a0 + a1 * a1) + (a2 * a2 + a3 * a3)) + ((a4 * a4 + a5 * a5) + (a6 * a6 + a7 * a7)); }
                sq += __shfl_xor(sq, 16); sq += __shfl_xor(sq, 32);
                if (fq == 0) part_out[(size_t)row * 32 + u.pn * 4 + wc] = sq; }
    }
};
struct EpiF32 {
    static constexpr bool PERM = false;
    float* out; int ldc; const float* ssq; int np; float* ssq_pub;
    DI void operator()(const f32x4 (&acc)[2][2][4][2], const Unit& u, int wr, int wc, int fr, int fq) const {
        const int row0 = u.pm * BM + wr * 64 + fr, col0 = u.pn * BM + wc * 32 + 4 * fq;
#pragma unroll
        for (int ai = 0; ai < 2; ++ai)
#pragma unroll
            for (int m = 0; m < 4; ++m) { const int row = row0 + ai * HALF + m * 16; const size_t off = (size_t)row * ldc + col0;
                float rs = 1.f;
                if (ssq) { const float t = (np == 1) ? ssq[row] : row_ssq32(ssq, row); rs = rsqrtf(t * (1.f / 2048.f) + 1e-6f); if (ssq_pub && u.pn == 0 && wc == 0 && fq == 0) ssq_pub[row] = t; }
#pragma unroll
                for (int bj = 0; bj < 2; ++bj)
#pragma unroll
                    for (int n = 0; n < 2; ++n) *(f32x4*)(out + off + bj * HALF + n * 16) = acc[ai][bj][m][n] * rs; }
    }
};
struct EpiSiluMul {
    static constexpr bool PERM = true;
    bf16_t* O; int ldc; const float* ssq; const int* rowmap;
    DI void operator()(const f32x4 (&acc)[2][2][4][2], const Unit& u, int wr, int wc, int fr, int fq) const {
        const int row0 = u.pm * BM + wr * 64 + fr, col0 = (u.pn * BM + wc * 32 + 8 * fq) >> 1;
#pragma unroll
        for (int ai = 0; ai < 2; ++ai)
#pragma unroll
            for (int m = 0; m < 4; ++m) { const int row = row0 + ai * HALF + m * 16; bf16_t* rowp = O + (size_t)row * ldc + col0;
                const float rs = row_rstd(ssq, 1, rowmap[row]);
#pragma unroll
                for (int bj = 0; bj < 2; ++bj) { const f32x4 v0 = acc[ai][bj][m][0] * rs, v1 = acc[ai][bj][m][1] * rs;
                    const float h0 = v0[0] / (1.f + __expf(-v0[0])) * v0[1], h1 = v0[2] / (1.f + __expf(-v0[2])) * v0[3];
                    const float h2 = v1[0] / (1.f + __expf(-v1[0])) * v1[1], h3 = v1[2] / (1.f + __expf(-v1[2])) * v1[3];
                    u32x2 w; w.x = pk2(h0, h1); w.y = pk2(h2, h3);
                    *(u32x2*)(rowp + bj * (HALF / 2)) = w; } }
    }
};
struct EpiScatter {
    static constexpr bool PERM = true;
    bf16_t* O; int ldc; const int* dst;
    DI void operator()(const f32x4 (&acc)[2][2][4][2], const Unit& u, int wr, int wc, int fr, int fq) const {
        const int row0 = u.pm * BM + wr * 64 + fr, col0 = u.pn * BM + wc * 32 + 8 * fq;
#pragma unroll
        for (int ai = 0; ai < 2; ++ai)
#pragma unroll
            for (int m = 0; m < 4; ++m) { const int d = dst[row0 + ai * HALF + m * 16];
                if (d >= 0) { bf16_t* rowp = O + (size_t)d * ldc + col0;
#pragma unroll
                    for (int bj = 0; bj < 2; ++bj) { const f32x4 v0 = acc[ai][bj][m][0], v1 = acc[ai][bj][m][1];
                        u32x4 w; w.x = pk2(v0[0], v0[1]); w.y = pk2(v0[2], v0[3]); w.z = pk2(v1[0], v1[1]); w.w = pk2(v1[2], v1[3]);
                        *(u32x4*)(rowp + bj * HALF) = w; } } }
    }
};
}

struct Args { const void* in[45]; float* out; unsigned char* ws; int ph_lo, ph_hi; };
static_assert(sizeof(void*) == 8 && sizeof(Args) == 384, "Args layout");

#define CAS __attribute__((address_space(4)))
typedef const CAS char* kaptr_t;
typedef const float* const CAS* inptr_t;
struct Ctx {
    LAS unsigned char* lds; unsigned char* ws; inptr_t in; float* X;
    int tid, lane, wave, G, wg, gw, ngw, att_sel, vcu;
};

DI size_t wofs(int l) { return l ? WS_L1OFF : 0; }
struct TrDesc { const float* W; bf16_t* WT; int N, ldk, row_off, row_mul, nblk, item; const float* ks; };
DI void tr_load(const TrDesc& d, float (&tv)[32], int lane) {
    const int kb = d.item / d.nblk, nb = d.item % d.nblk, k0 = 64 * kb, n0 = 32 * nb;
#pragma unroll
    for (int i = 0; i < 32; ++i) { const int kk = 2 * i + (lane >> 5); tv[i] = d.W[(size_t)(k0 + kk) * d.N + n0 + (lane & 31)]; }
}
DI void tr_store(const TrDesc& d, const float (&tv)[32], LAS float* scr, int lane) {
    const int kb = d.item / d.nblk, nb = d.item % d.nblk, k0 = 64 * kb, n0 = 32 * nb;
#pragma unroll
    for (int i = 0; i < 32; ++i) { const int kk = 2 * i + (lane >> 5); scr[kk * 33 + (lane & 31)] = d.ks ? tv[i] * d.ks[k0 + kk] : tv[i]; }
    asm volatile("s_waitcnt lgkmcnt(0)" ::: "memory");
    const int c = lane & 7;
#pragma unroll
    for (int j = 0; j < 4; ++j) { const int n = (lane >> 3) + 8 * j; const LAS float* s = scr + (8 * c) * 33 + n;
        u32x4 o; o.x = pk2(s[0 * 33], s[1 * 33]); o.y = pk2(s[2 * 33], s[3 * 33]); o.z = pk2(s[4 * 33], s[5 * 33]); o.w = pk2(s[6 * 33], s[7 * 33]);
        *(u32x4*)(d.WT + (size_t)(d.row_off + (n0 + n) * d.row_mul) * d.ldk + k0 + 8 * c) = o; }
    asm volatile("s_waitcnt lgkmcnt(0)" ::: "memory");
}

DI void norm_row(const float* xin, const bf16_t* xinb, bf16_t* xout, const bf16_t* c0, const bf16_t* c1, float g0, float g1, const float* w, bf16_t* hout, float* fout, int lane, float* ssq_w = nullptr) {
    f32x4 v[8]; float ss = 0.f;
    if (xin) {
#pragma unroll
        for (int j = 0; j < 8; ++j) { v[j] = ((const f32x4*)xin)[lane + 64 * j]; }
    } else {
#pragma unroll
        for (int j = 0; j < 8; ++j) { const u32x2 a = ((const u32x2*)xinb)[lane + 64 * j]; v[j] = (f32x4){bflo(a.x), bfhi(a.x), bflo(a.y), bfhi(a.y)}; }
    }
    if (c0) {
#pragma unroll
        for (int j = 0; j < 8; ++j) { const u32x2 a = ((const u32x2*)c0)[lane + 64 * j], b = ((const u32x2*)c1)[lane + 64 * j];
            v[j][0] += g0 * bflo(a.x) + g1 * bflo(b.x); v[j][1] += g0 * bfhi(a.x) + g1 * bfhi(b.x);
            v[j][2] += g0 * bflo(a.y) + g1 * bflo(b.y); v[j][3] += g0 * bfhi(a.y) + g1 * bfhi(b.y); }
    }
#pragma unroll
    for (int j = 0; j < 8; ++j) ss += (v[j][0] * v[j][0] + v[j][1] * v[j][1]) + (v[j][2] * v[j][2] + v[j][3] * v[j][3]);
    if (xout) {
#pragma unroll
        for (int j = 0; j < 8; ++j) { u32x2 o; o.x = pk2(v[j][0], v[j][1]); o.y = pk2(v[j][2], v[j][3]); ((u32x2*)xout)[lane + 64 * j] = o; }
    }
    const float sst = wave_sum(ss);
    if (ssq_w) { if (lane == 0) *ssq_w = sst; }
    if (!w) return;
    const float rstd = rsqrtf(sst * (1.f / DM) + 1e-6f);
#pragma unroll
    for (int j = 0; j < 8; ++j) { const f32x4 ww = ((const f32x4*)w)[lane + 64 * j]; const f32x4 y = v[j] * rstd * ww;
        if (hout) { u32x2 o; o.x = pk2(y[0], y[1]); o.y = pk2(y[2], y[3]); ((u32x2*)hout)[lane + 64 * j] = o; }
        if (fout) ((f32x4*)fout)[lane + 64 * j] = y; }
}

constexpr int I_WIN = 32 * 174, I_VR = 32, I_WOUT = 32 * 64, I_CAQ = 32 * 16, I_CAKV = 32 * 32, I_CAO = 8 * 64, I_WQB = 6 * 24, I_WKVB = 4 * 32;
constexpr int N_SMALL_ITEMS = I_WIN + I_VR + I_WOUT + I_CAQ + I_CAKV + I_CAO + I_WQB + I_WKVB;
DI TrDesc small_tr_desc(int l, int r, inptr_t in, unsigned char* wsl) {
    bf16_t* WINT = (bf16_t*)(wsl + WS_WINT);
    if (r < I_WIN) return TrDesc{in[6] + (size_t)l * DM * IN_COLS, WINT, IN_COLS, DM, 0, 1, 174, r, in[5] + (size_t)l * DM}; r -= I_WIN;
    if (r < I_VR) return TrDesc{in[7], WINT, 32, DM, IN_COLS, 1, 1, r, in[5] + DM}; r -= I_VR;
    if (r < I_WOUT) return TrDesc{in[8] + (size_t)l * DM * DM, (bf16_t*)(wsl + WS_WOUTT), DM, DM, 0, 1, 64, r, nullptr}; r -= I_WOUT;
    if (r < I_CAQ) return TrDesc{in[34] + (size_t)l * DM * 512, (bf16_t*)(wsl + WS_CAWQT), 512, DM, 0, 1, 16, r, in[32] + (size_t)l * DM}; r -= I_CAQ;
    if (r < I_CAKV) return TrDesc{in[35] + (size_t)l * DM * 1024, (bf16_t*)(wsl + WS_CAWKVT), 1024, DM, 0, 1, 32, r, nullptr}; r -= I_CAKV;
    if (r < I_CAO) return TrDesc{in[36] + (size_t)l * 512 * DM, (bf16_t*)(wsl + WS_CAWOT), DM, 512, 0, 1, 64, r, nullptr}; r -= I_CAO;
    if (r < I_WQB) return TrDesc{in[29] + (size_t)l * 384 * 768, (bf16_t*)(wsl + WS_WQBT), 768, 384, 0, 1, 24, r, nullptr}; r -= I_WQB;
    return TrDesc{in[31] + (size_t)l * 256 * 1024, (bf16_t*)(wsl + WS_WKVBT), 1024, 256, 0, 1, 32, r, nullptr};
}
constexpr int I_EXP = 512;
constexpr int N_MOE_ITEMS = 3 * NEXP * I_EXP;
DI TrDesc moe_tr_desc(int l, int r, inptr_t in, unsigned char* ws) {
    const int e = r / (3 * I_EXP), q = r % (3 * I_EXP), mat = q / I_EXP, ii = q % I_EXP;
    const size_t eo = ((size_t)l * NEXP + e);
    if (mat == 0) return TrDesc{in[42] + eo * DM * DEXP, (bf16_t*)(ws + WS_WGU) + (size_t)e * 1024 * DM, DEXP, DM, 0, 2, 16, ii, in[37] + (size_t)l * DM};
    if (mat == 1) return TrDesc{in[43] + eo * DM * DEXP, (bf16_t*)(ws + WS_WGU) + (size_t)e * 1024 * DM, DEXP, DM, 1, 2, 16, ii, in[37] + (size_t)l * DM};
    return TrDesc{in[44] + eo * DEXP * DM, (bf16_t*)(ws + WS_WD) + (size_t)e * DM * DEXP, DM, DEXP, 0, 1, 64, ii, nullptr};
}
DI void phase_convert(const Ctx& C, int l) {
    inptr_t in = C.in;
    unsigned char* ws = C.ws;
    LAS float* scr = (LAS float*)(C.lds + C.wave * 16384);
    bf16_t* WINT = (bf16_t*)(ws + WS_WINT);
    const int n_items = (l == 0) ? N_SMALL_ITEMS : 0;
    auto decode = [&](int it) -> TrDesc { return small_tr_desc(0, it, in, ws); };
    {
        const int first = (l == 0 && C.gw >= I_WIN && C.gw < I_WIN + I_VR) ? C.gw + C.ngw : C.gw;
        float ta[32], tb[32];
        int it = first;
        if (it < n_items) { TrDesc d0 = decode(it); tr_load(d0, ta, C.lane);
            for (;;) {
                int it2 = it + C.ngw; if (l == 0 && it2 >= I_WIN && it2 < I_WIN + I_VR) it2 += C.ngw;
                const bool has2 = it2 < n_items; TrDesc d1 = d0;
                if (has2) { d1 = decode(it2); tr_load(d1, tb, C.lane); }
                tr_store(d0, ta, scr, C.lane);
                if (!has2) break;
                int it3 = it2 + C.ngw; if (l == 0 && it3 >= I_WIN && it3 < I_WIN + I_VR) it3 += C.ngw;
                const bool has3 = it3 < n_items;
                if (has3) { d0 = decode(it3); tr_load(d0, ta, C.lane); }
                tr_store(d1, tb, scr, C.lane);
                if (!has3) break;
                it = it3;
            }
        }
    }
    const int gt = C.wg * 512 + C.tid, ngt = C.G * 512;
    if (l == 0) {
        for (int i = gt; i < 64 * DM / 8; i += ngt) ((u32x4*)(WINT + (size_t)IN_COLS * DM))[i] = (u32x4){0u, 0u, 0u, 0u};
        for (int i = gt; i < 32 * DM / 8; i += ngt) ((u32x4*)((bf16_t*)(ws + WS_L1OFF + WS_WINT) + (size_t)(IN_COLS + 32) * DM))[i] = (u32x4){0u, 0u, 0u, 0u};
#pragma unroll 1
        for (int lw = 0; lw < 2; ++lw) {
            bf16_t* LB = (bf16_t*)(ws + wofs(lw) + WS_LORABT);
            const float* w2 = in[12] + (size_t)lw * 64 * 1024; const float* a2 = in[14] + (size_t)lw * 64 * 1024; const float* g2 = in[17] + (size_t)lw * 128 * 1024; const float* v2 = in[16];
            for (int i = gt; i < 4096 * 128; i += ngt) {
                const int n = i >> 7, k = i & 127, blk = n >> 10, c = n & 1023; float v = 0.f;
                if (blk == 0) { if (k < 64) v = w2[k * 1024 + c]; }
                else if (blk == 1) { if (k >= 64) v = a2[(k - 64) * 1024 + c]; }
                else if (blk == 2) { v = g2[k * 1024 + c]; }
                else { if (lw == 1 && k < 32) v = v2[k * 1024 + c]; }
                LB[i] = f2bf(v);
            }
            bf16_t* WRB = (bf16_t*)(ws + (lw ? WS_WRB1 : WS_WRB)); const float* nf = in[37] + (size_t)lw * DM; const float* wg = in[38] + (size_t)lw * DM * 4; const float* we = in[40] + (size_t)lw * DM * 32;
            for (int i = gt; i < 256 * DM; i += ngt) { const int o = i / DM, k = i % DM; const float v = (o < 32) ? we[k * 32 + o] : ((o < 36) ? wg[k * 4 + (o - 32)] : 0.f); WRB[i] = f2bf(v * nf[k]); }
        }
    }
    if (l == 0) {
        float* LUT = (float*)(ws + WS_LUT); const float* rb = in[3];
        for (int i = gt; i < 4 * 128; i += ngt) { const int h = i >> 7, n = i & 127; int bk;
            if (n < 16) bk = n; else { bk = 16 + (int)(log2f((float)n * 0.0625f) * (16.f / 3.f)); if (bk > 31) bk = 31; }
            LUT[i] = rb[bk * 4 + h] * LOG2E; }
        f32x2* RT = (f32x2*)(ws + WS_ROPE); const int* pos = (const int*)in[2];
        for (int i = gt; i < NT * 32; i += ngt) { const int t = i >> 5, j = i & 31; const float invf = powf(10000.f, -(float)j / 32.f); const float ang = (float)pos[t] * invf; float s, c; sincosf(ang, &s, &c); RT[i] = (f32x2){c, s}; }
    }
    for (int m = C.gw; m < NMEM; m += C.ngw) norm_row(in[1] + (size_t)m * DM, nullptr, nullptr, nullptr, nullptr, 0.f, 0.f, in[33] + (size_t)l * DM, (bf16_t*)(ws + WS_MEMN) + (size_t)m * DM, nullptr, C.lane);
    {
        const bf16_t* C2 = (const bf16_t*)(ws + WS_C2); const float* gate = (const float*)(ws + WS_GATE); bf16_t* XB = (bf16_t*)(ws + WS_XB); float* SSQM = (float*)(ws + WS_SSQM);
        for (int m = C.gw; m < NT; m += C.ngw) {
            if (l == 0) norm_row(in[0] + (size_t)m * DM, nullptr, XB + (size_t)m * DM, nullptr, nullptr, 0.f, 0.f, nullptr, nullptr, nullptr, C.lane, SSQM + m);
            else norm_row(nullptr, XB + (size_t)m * DM, XB + (size_t)m * DM, C2 + (size_t)(2 * m) * DM, C2 + (size_t)(2 * m + 1) * DM, gate[2 * m], gate[2 * m + 1], nullptr, nullptr, nullptr, C.lane, SSQM + m);
        }
    }
}

DI void phase_ew1(const Ctx& C, int l) {
    inptr_t in = C.in; unsigned char* ws = C.ws;
    const bf16_t* PRW = (const bf16_t*)(ws + WS_PRW); const bf16_t* PATT = (const bf16_t*)(ws + WS_PATT);
    bf16_t* LA = (bf16_t*)(ws + WS_LORAA); bf16_t* QN = (bf16_t*)(ws + WS_QN); bf16_t* KVN = (bf16_t*)(ws + WS_KVN); bf16_t* KPE = (bf16_t*)(ws + WS_KPE);
    const float* mu = in[9] + (size_t)l * RW_COLS; const float* muv = in[10];
    const float* qnw = in[28] + (size_t)l * 384; const float* kvnw = in[30] + (size_t)l * 256;
    const f32x2* RT = (const f32x2*)(ws + WS_ROPE);
    const int lane = C.lane;
#pragma unroll 4
    for (int t = C.gw; t < NT; t += C.ngw) {
        const bool first = (t % SEQ) == 0;
        const bf16_t* p = PRW + (size_t)t * RW_COLS; const bf16_t* pa = PATT + (size_t)t * PATT_COLS;
#pragma unroll
        for (int j = 0; j < 4; ++j) { const int c = lane + 64 * j, col = 3072 + c;
            const float cur = bf2f(p[col]); const float prev = first ? 0.f : bf2f(p[col - RW_COLS]);
            const float xs = cur + mu[col] * (prev - cur);
            float v; if (c < 64) v = tanhf(xs); else if (c < 128) v = xs; else v = sigmoidf_(xs);
            LA[(size_t)t * 384 + c] = f2bf(v); }
        {
#pragma unroll
            for (int j = 0; j < 2; ++j) { const int c = lane + 64 * j; float v = 0.f;
                if (l == 1 && c < 32) { const float cur = bf2f(pa[2240 + c]); const float prev = first ? 0.f : bf2f(pa[2240 + c - PATT_COLS]); v = cur + muv[c] * (prev - cur); }
                LA[(size_t)t * 384 + 256 + c] = f2bf(v); } }
        float q[6], kv[4]; float sq = 0.f, skv = 0.f;
#pragma unroll
        for (int j = 0; j < 6; ++j) { q[j] = bf2f(pa[1536 + lane + 64 * j]); sq += q[j] * q[j]; }
#pragma unroll
        for (int j = 0; j < 4; ++j) { kv[j] = bf2f(pa[1920 + lane + 64 * j]); skv += kv[j] * kv[j]; }
        const float rq = rsqrtf(wave_sum(sq) * (1.f / 384.f) + 1e-6f), rkv = rsqrtf(wave_sum(skv) * (1.f / 256.f) + 1e-6f);
#pragma unroll
        for (int j = 0; j < 6; ++j) QN[(size_t)t * 384 + lane + 64 * j] = f2bf(q[j] * rq * qnw[lane + 64 * j]);
#pragma unroll
        for (int j = 0; j < 4; ++j) KVN[(size_t)t * 256 + lane + 64 * j] = f2bf(kv[j] * rkv * kvnw[lane + 64 * j]);
        { const float x = bf2f(pa[2176 + lane]); const float xo = __shfl_xor(x, 32); const f32x2 cs = RT[t * 32 + (lane & 31)];
          const float y = (lane < 32) ? (x * cs.x - xo * cs.y) : (x * cs.x + xo * cs.y);
          KPE[(size_t)t * 64 + lane] = f2bf(y); }
    }
}

DI void phase_ew2(const Ctx& C, int l) {
    inptr_t in = C.in; unsigned char* ws = C.ws;
    const bf16_t* PRW = (const bf16_t*)(ws + WS_PRW); const bf16_t* LO = (const bf16_t*)(ws + WS_LORAO);
    bf16_t* SR = (bf16_t*)(ws + WS_U); bf16_t* SW = SR + (size_t)NT * 1024; bf16_t* SK = SW + (size_t)NT * 1024; bf16_t* SV = SK + (size_t)NT * 1024;
    bf16_t* SA = SV + (size_t)NT * 1024; bf16_t* SB = SA + (size_t)NT * 1024; bf16_t* VF = (bf16_t*)(ws + WS_VFIRST);
    const float* mu = in[9] + (size_t)l * RW_COLS; const float* w0 = in[11] + (size_t)l * 1024; const float* a0 = in[13] + (size_t)l * 1024; const float* v0 = in[15];
    const float* kkw = in[18] + (size_t)l * 1024; const float* kaw = in[19] + (size_t)l * 1024;
    const int lane = C.lane;
#pragma unroll 1
    for (int j = 0; j < 2; ++j) {
        const int c0 = 8 * lane + 512 * j;
        float mu8[3][8], w0v[8], a0v[8], kkv[8], kav[8], v0v[8];
#pragma unroll
        for (int e = 0; e < 2; ++e) {
#pragma unroll
            for (int q = 0; q < 3; ++q) { const f32x4 m = *(const f32x4*)(mu + q * 1024 + c0 + 4 * e);
#pragma unroll
                for (int i = 0; i < 4; ++i) mu8[q][4 * e + i] = m[i]; }
            const f32x4 x0 = *(const f32x4*)(w0 + c0 + 4 * e), x1 = *(const f32x4*)(a0 + c0 + 4 * e), x2 = *(const f32x4*)(kkw + c0 + 4 * e), x3 = *(const f32x4*)(kaw + c0 + 4 * e);
            f32x4 x4 = (f32x4){0.f, 0.f, 0.f, 0.f}; if (l == 1) x4 = *(const f32x4*)(v0 + c0 + 4 * e);
#pragma unroll
            for (int i = 0; i < 4; ++i) { w0v[4 * e + i] = x0[i]; a0v[4 * e + i] = x1[i]; kkv[4 * e + i] = x2[i]; kav[4 * e + i] = x3[i]; v0v[4 * e + i] = x4[i]; } }
#pragma unroll 2
        for (int t = C.gw; t < NT; t += C.ngw) {
            const bool first = (t % SEQ) == 0;
            const bf16_t* p = PRW + (size_t)t * RW_COLS; const bf16_t* lo = LO + (size_t)t * 4096;
            float xs[3][8];
#pragma unroll
            for (int q = 0; q < 3; ++q) { const int col = q * 1024 + c0;
                const u32x4 cu = *(const u32x4*)(p + col); u32x4 pv = (u32x4){0u, 0u, 0u, 0u}; if (!first) pv = *(const u32x4*)(p + col - RW_COLS);
#pragma unroll
                for (int e = 0; e < 4; ++e) { const float c_lo = bflo(cu[e]), c_hi = bfhi(cu[e]), p_lo = bflo(pv[e]), p_hi = bfhi(pv[e]);
                    xs[q][2 * e] = c_lo + mu8[q][2 * e] * (p_lo - c_lo); xs[q][2 * e + 1] = c_hi + mu8[q][2 * e + 1] * (p_hi - c_hi); } }
            const u32x4 lw = *(const u32x4*)(lo + c0), la = *(const u32x4*)(lo + 1024 + c0);
            u32x4 lv = (u32x4){0u, 0u, 0u, 0u}, vfv = (u32x4){0u, 0u, 0u, 0u};
            if (l == 1) { lv = *(const u32x4*)(lo + 3072 + c0); vfv = *(const u32x4*)(VF + (size_t)t * 1024 + c0); }
            float omw[8], av[8], kk[8], k2[8], v2[8]; float ssq = 0.f;
#pragma unroll
            for (int e = 0; e < 8; ++e) {
                const float lwf = (e & 1) ? bfhi(lw[e >> 1]) : bflo(lw[e >> 1]), laf = (e & 1) ? bfhi(la[e >> 1]) : bflo(la[e >> 1]);
                const float wi = w0v[e] + lwf;
                omw[e] = 1.f - __expf(-0.6065306597f * sigmoidf_(wi));
                av[e] = sigmoidf_(a0v[e] + laf);
                kk[e] = xs[1][e] * kkv[e]; ssq += kk[e] * kk[e];
                k2[e] = xs[1][e] * (1.f + (av[e] - 1.f) * kav[e]);
                v2[e] = xs[2][e];
                if (l == 1) { const float lvf = (e & 1) ? bfhi(lv[e >> 1]) : bflo(lv[e >> 1]), vff = (e & 1) ? bfhi(vfv[e >> 1]) : bflo(vfv[e >> 1]);
                    v2[e] = xs[2][e] + (vff - xs[2][e]) * sigmoidf_(v0v[e] + lvf); }
            }
            ssq += DPP_F(ssq, 0xB1); ssq += DPP_F(ssq, 0x4E); ssq += DPP_F(ssq, 0x141);
            const float inv = 1.f / fmaxf(sqrtf(ssq), 1e-12f);
            u32x4 oR, oW, oK, oV, oA, oB, oF;
#pragma unroll
            for (int e = 0; e < 4; ++e) { const float ka = kk[2 * e] * inv, kb = kk[2 * e + 1] * inv;
                oR[e] = pkh2(xs[0][2 * e], xs[0][2 * e + 1]); oW[e] = pkh2(1.f - omw[2 * e], 1.f - omw[2 * e + 1]); oK[e] = pkh2(k2[2 * e], k2[2 * e + 1]); oV[e] = pkh2(v2[2 * e], v2[2 * e + 1]);
                oA[e] = pkh2(-ka, -kb); oB[e] = pkh2(ka * av[2 * e], kb * av[2 * e + 1]);     oF[e] = pk2(xs[2][2 * e], xs[2][2 * e + 1]); }
            const size_t o = (size_t)t * 1024 + c0;
            *(u32x4*)(SR + o) = oR; *(u32x4*)(SW + o) = oW; *(u32x4*)(SK + o) = oK; *(u32x4*)(SV + o) = oV; *(u32x4*)(SA + o) = oA; *(u32x4*)(SB + o) = oB;
            if (l == 0) *(u32x4*)(VF + o) = oF;
        }
    }
    bf16_t* QM = (bf16_t*)(ws + WS_QM); const f32x2* RT = (const f32x2*)(ws + WS_ROPE);
    const int gt = C.wg * 512 + C.tid, ngt = C.G * 512;
    for (int i = gt; i < NT * 4 * 32; i += ngt) { const int t = i >> 7, h = (i >> 5) & 3, j = i & 31;
        bf16_t* q = QM + (size_t)t * 768 + h * 192 + 128; const float x1 = bf2f(q[j]), x2 = bf2f(q[j + 32]); const f32x2 cs = RT[t * 32 + j];
        q[j] = f2bf(x1 * cs.x - x2 * cs.y); q[j + 32] = f2bf(x2 * cs.x + x1 * cs.y); }
}

DI float dot2z(h2_t a, h2_t b) { float d; asm("v_dot2_f32_f16 %0, %1, %2, 0" : "=v"(d) : "v"(a), "v"(b)); return d; }
DI float fma_s(float a, float b, float c) { float d; asm("v_fma_f32 %0, %1, %2, %3" : "=v"(d) : "v"(a), "v"(b), "v"(c)); return d; }
#define ROW_ALLREDUCE(x) do { \
    x += __builtin_bit_cast(float, __builtin_amdgcn_update_dpp(0, __builtin_bit_cast(int, x), 0x128, 0xf, 0xf, true)); \
    x += __builtin_bit_cast(float, __builtin_amdgcn_update_dpp(0, __builtin_bit_cast(int, x), 0x124, 0xf, 0xf, true)); \
    x += __builtin_bit_cast(float, __builtin_amdgcn_update_dpp(0, __builtin_bit_cast(int, x), 0x122, 0xf, 0xf, true)); \
    x += __builtin_bit_cast(float, __builtin_amdgcn_update_dpp(0, __builtin_bit_cast(int, x), 0x121, 0xf, 0xf, true)); } while (0)

DI void phase_scan(const Ctx& C, int l) {
    unsigned char* ws = C.ws; inptr_t in = C.in;
    const bf16_t* SR = (const bf16_t*)(ws + WS_U); float* Yf = (float*)(ws + WS_H);
    constexpr int CH = 32, VECB = CH * 128, BUFB = 5 * VECB + CH * 64, OB = 2 * BUFB;
    LAS unsigned char* lds = C.lds;
    const int tid = C.tid, lane = C.lane, wave = C.wave;
    for (int u = C.vcu; u < 256; u += C.G) {
        const int bh = u >> 2, rg = u & 3, b = bh >> 4, h = bh & 15;
        const size_t tb = (size_t)b * SEQ; const int cb = h * 64;
        const int lt = tid - 256;
        u32x4 pre[3][6];
#define LD_CHUNK(set, c_) do { const size_t t_ = tb + (size_t)(c_) * CH + (lt >> 3); const int j_ = lt & 7; \
            _Pragma("unroll") for (int vq = 0; vq < 5; ++vq) { const int arr = (vq < 3) ? vq : vq + 1; \
                pre[set][vq] = *(const u32x4*)(SR + (size_t)arr * NT * 1024 + t_ * 1024 + cb + 8 * j_); } \
            if (lt < 64) { const size_t tv_ = tb + (size_t)(c_) * CH + (lt >> 1); \
                pre[set][5] = *(const u32x4*)(SR + (size_t)3 * NT * 1024 + tv_ * 1024 + cb + 16 * rg + 8 * (lt & 1)); } } while (0)
#define ST_CHUNK(set, buf_) do { const int step_ = lt >> 3, j_ = lt & 7;     \
            _Pragma("unroll") for (int vq = 0; vq < 5; ++vq) *(LAS u32x4*)(lds + (buf_) * BUFB + vq * VECB + step_ * 128 + j_ * 16) = pre[set][vq]; \
            if (lt < 64) { const u32x4 p = pre[set][5]; LAS u32x4* d = (LAS u32x4*)(lds + (buf_) * BUFB + 5 * VECB + (lt >> 1) * 64 + (lt & 1) * 32);     \
                d[0] = (u32x4){(p.x & 0xffffu) | (p.x << 16), (p.x >> 16) | (p.x & 0xffff0000u), (p.y & 0xffffu) | (p.y << 16), (p.y >> 16) | (p.y & 0xffff0000u)}; \
                d[1] = (u32x4){(p.z & 0xffffu) | (p.z << 16), (p.z >> 16) | (p.z & 0xffff0000u), (p.w & 0xffffu) | (p.w << 16), (p.w >> 16) | (p.w & 0xffff0000u)}; } } while (0)
        h2_t S01 = {(_Float16)0.f, (_Float16)0.f}, S23 = {(_Float16)0.f, (_Float16)0.f};
        const int ks = lane & 15, rowl = wave * 4 + (lane >> 4);
        constexpr int NCH = SEQ / CH;
        const int n_bg = N_MOE_ITEMS + (l == 0 ? N_SMALL_ITEMS : 0);
#define BG_DESC(it_) (((it_) < N_MOE_ITEMS) ? moe_tr_desc(l, (it_), in, ws) : small_tr_desc(1, (it_) - N_MOE_ITEMS, in, ws + WS_L1OFF))
        float tq[32]; int mo_it = (C.wg * 4 + (wave - 4)); bool mo_pending = false; TrDesc mo_d{};
        LAS float* mo_scr = (LAS float*)(lds + OB + 2 * CH * 64) + (wave - 4) * (64 * 33);
        if (wave >= 4) { LD_CHUNK(0, 0); LD_CHUNK(1, 1); LD_CHUNK(2, 2); ST_CHUNK(0, 0); LD_CHUNK(0, 3); }
        __syncthreads();
#define SCAN_ITER(c, setn) do { \
            const int buf = (c) & 1; \
            if (wave >= 4) { \
                if ((c) + 1 < NCH) { ST_CHUNK(setn, buf ^ 1); if ((c) + 4 < NCH) LD_CHUNK(setn, (c) + 4); } \
                if ((c) > 0 && lt < 128) { \
                    const int step = lt >> 2, q4 = lt & 3; const LAS float* ob_ = (const LAS float*)(lds + OB + (((c) - 1) & 1) * (CH * 64)) + (step >> 4) * 256 + (step & 15); \
                    const f32x4 o = {ob_[(4 * q4 + 0) * 16], ob_[(4 * q4 + 1) * 16], ob_[(4 * q4 + 2) * 16], ob_[(4 * q4 + 3) * 16]}; \
                    *(f32x4*)(Yf + (tb + (size_t)((c) - 1) * CH + step) * 1024 + cb + 16 * rg + 4 * q4) = o; } \
                if (((c) & 1) == 0) { if (mo_pending) { tr_store(mo_d, tq, mo_scr, lane); mo_pending = false; } \
                    if (mo_it < n_bg) { mo_d = BG_DESC(mo_it); tr_load(mo_d, tq, lane); mo_pending = true; mo_it += C.G * 4; } } \
            } else { SCAN_BODY(buf); } \
            __syncthreads(); } while (0)
#define SC_LD(X, s_) do { const int so_ = ((s_) & (CH - 1)) * 128; X##r = *(const LAS h4_t*)(bp + 0 * VECB + so_); X##w = *(const LAS h4_t*)(bp + 1 * VECB + so_); X##k = *(const LAS h4_t*)(bp + 2 * VECB + so_); \
            X##a = *(const LAS h4_t*)(bp + 3 * VECB + so_); X##b = *(const LAS h4_t*)(bp + 4 * VECB + so_); X##v = vp[((s_) & (CH - 1)) * 16]; } while (0)
#define DPPF(x, ctl) __builtin_bit_cast(float, __builtin_amdgcn_update_dpp(0, __builtin_bit_cast(int, x), ctl, 0xf, 0xf, true))
#define H_LO(x) __builtin_shufflevector(x, x, 0, 1)
#define H_HI(x) __builtin_shufflevector(x, x, 2, 3)
#define SC_DOT(x) __builtin_amdgcn_fdot2(S01, H_LO(x), dot2z(S23, H_HI(x)), false)
#define SC_FIRST(X) do { float sa = SC_DOT(X##a); \
            const h2_t t01 = S01 * H_LO(X##w) + X##v * H_LO(X##k), t23 = S23 * H_HI(X##w) + X##v * H_HI(X##k); \
            ROW_ALLREDUCE(sa); \
            const _Float16 sh = (_Float16)sa; const h2_t sa2 = {sh, sh}; \
            S01 = sa2 * H_LO(X##b) + t01; S23 = sa2 * H_HI(X##b) + t23; } while (0)
#define SC_PAIR(X, Y, s_) do { float o = SC_DOT(X##r); float sa = SC_DOT(Y##a); \
            const h2_t t01 = S01 * H_LO(Y##w) + Y##v * H_LO(Y##k), t23 = S23 * H_HI(Y##w) + Y##v * H_HI(Y##k); \
            sa += DPPF(sa, 0x128); o += DPPF(o, 0x128); sa += DPPF(sa, 0x124); o += DPPF(o, 0x124); sa += DPPF(sa, 0x122); o += DPPF(o, 0x122); sa += DPPF(sa, 0x121); o += DPPF(o, 0x121); \
            const _Float16 sh = (_Float16)sa; const h2_t sa2 = {sh, sh}; \
            S01 = sa2 * H_LO(Y##b) + t01; S23 = sa2 * H_HI(Y##b) + t23; \
            osel = (ks == (((s_) - 1) & 15)) ? o : osel; if ((((s_) - 1) & 15) == 15) op16[(((s_) - 1) >> 4) * 256] = osel; } while (0)
#define SC_LAST(X, s_) do { float o = SC_DOT(X##r); ROW_ALLREDUCE(o); osel = (ks == ((s_) & 15)) ? o : osel; op16[((s_) >> 4) * 256] = osel; } while (0)
#define SCAN_BODY(buf_) do { \
            const LAS unsigned char* bp = lds + (buf_) * BUFB + ks * 8; \
            const LAS h2_t* vp = (const LAS h2_t*)(lds + (buf_) * BUFB + 5 * VECB) + rowl; \
            LAS float* op16 = (LAS float*)(lds + OB + (buf_) * (CH * 64)) + rowl * 16 + ks; float osel = 0.f;     \
            h4_t Ar, Aw, Ak, Aa, Ab, Br, Bw, Bk, Ba, Bb, Cr, Cw, Ck, Ca, Cb, Dr, Dw, Dk, Da, Db; h2_t Av, Bv, Cv, Dv; \
            SC_LD(A, 0); SC_LD(B, 1); SC_LD(C, 2); SC_LD(D, 3); \
            SC_FIRST(A); \
            _Pragma("unroll 2") for (int s = 0; s < CH - 4; s += 4) { \
                SC_PAIR(A, B, s + 1); SC_LD(A, s + 4); \
                SC_PAIR(B, C, s + 2); SC_LD(B, s + 5); \
                SC_PAIR(C, D, s + 3); SC_LD(C, s + 6); \
                SC_PAIR(D, A, s + 4); SC_LD(D, s + 7); } \
            SC_PAIR(A, B, CH - 3); SC_PAIR(B, C, CH - 2); SC_PAIR(C, D, CH - 1); SC_LAST(D, CH - 1); } while (0)
#pragma unroll 1
        for (int c = 0; c < NCH; c += 3) { SCAN_ITER(c, 1); if (c + 1 < NCH) SCAN_ITER(c + 1, 2); if (c + 2 < NCH) SCAN_ITER(c + 2, 0); }
#undef SC_LD
#undef SC_FIRST
#undef SC_PAIR
#undef SC_LAST
#undef DPPF
#undef H_LO
#undef H_HI
#undef SC_DOT
#undef SCAN_BODY
#undef SCAN_ITER
#undef LD_CHUNK
#undef ST_CHUNK
        if (wave >= 4) { if (mo_pending) tr_store(mo_d, tq, mo_scr, lane);
            for (; mo_it < n_bg; mo_it += C.G * 4) { const TrDesc d = BG_DESC(mo_it); tr_load(d, tq, lane); tr_store(d, tq, mo_scr, lane); } }
#undef BG_DESC
        if (wave >= 4 && lt < 128) { const int c = NCH; const int step = lt >> 2, q4 = lt & 3; const LAS float* ob_ = (const LAS float*)(lds + OB + ((c - 1) & 1) * (CH * 64)) + (step >> 4) * 256 + (step & 15);
            const f32x4 o = {ob_[(4 * q4 + 0) * 16], ob_[(4 * q4 + 1) * 16], ob_[(4 * q4 + 2) * 16], ob_[(4 * q4 + 3) * 16]};
            *(f32x4*)(Yf + (tb + (size_t)(c - 1) * CH + step) * 1024 + cb + 16 * rg + 4 * q4) = o; }
        __syncthreads();
    }
}

DI void phase_post(const Ctx& C, int l) {
    inptr_t in = C.in; unsigned char* ws = C.ws;
    const float* Yf = (const float*)(ws + WS_H); const bf16_t* LO = (const bf16_t*)(ws + WS_LORAO);
    const bf16_t* SR = (const bf16_t*)(ws + WS_U); const bf16_t* SK = SR + (size_t)2 * NT * 1024; const bf16_t* SV = SR + (size_t)3 * NT * 1024;
    bf16_t* Y = (bf16_t*)(ws + WS_PRW);
    const float* rk = in[20] + (size_t)l * 1024; const float* lnw = in[21] + (size_t)l * 1024; const float* lnb = in[22] + (size_t)l * 1024;
    const int lane = C.lane;
    for (int t = C.gw; t < NT; t += C.ngw) {
#pragma unroll
        for (int j = 0; j < 2; ++j) {
            const int c0 = 8 * lane + 512 * j; const size_t o = (size_t)t * 1024 + c0;
            const f32x4 y0 = *(const f32x4*)(Yf + o), y1 = *(const f32x4*)(Yf + o + 4);
            const u32x4 rr = *(const u32x4*)(SR + o), kq = *(const u32x4*)(SK + o), vq = *(const u32x4*)(SV + o), gq = *(const u32x4*)(LO + (size_t)t * 4096 + 2048 + c0);
            float y[8], rk8[8], lw8[8], lb8[8];
#pragma unroll
            for (int e = 0; e < 2; ++e) { const f32x4 a = *(const f32x4*)(rk + c0 + 4 * e), b = *(const f32x4*)(lnw + c0 + 4 * e), c = *(const f32x4*)(lnb + c0 + 4 * e);
#pragma unroll
                for (int i = 0; i < 4; ++i) { rk8[4 * e + i] = a[i]; lw8[4 * e + i] = b[i]; lb8[4 * e + i] = c[i]; y[4 * e + i] = e ? y1[i] : y0[i]; } }
            float sm = 0.f, bs = 0.f; float r8[8], k8[8], v8[8], g8[8];
#pragma unroll
            for (int e = 0; e < 8; ++e) { r8[e] = (e & 1) ? hfhi(rr[e >> 1]) : hflo(rr[e >> 1]); k8[e] = (e & 1) ? hfhi(kq[e >> 1]) : hflo(kq[e >> 1]);
                v8[e] = (e & 1) ? hfhi(vq[e >> 1]) : hflo(vq[e >> 1]); g8[e] = (e & 1) ? bfhi(gq[e >> 1]) : bflo(gq[e >> 1]);
                sm += y[e]; bs += r8[e] * k8[e] * rk8[e]; }
            sm += DPP_F(sm, 0xB1); sm += DPP_F(sm, 0x4E); sm += DPP_F(sm, 0x141);
            bs += DPP_F(bs, 0xB1); bs += DPP_F(bs, 0x4E); bs += DPP_F(bs, 0x141);
            const float mean = sm * (1.f / 64.f); float vs = 0.f;
#pragma unroll
            for (int e = 0; e < 8; ++e) { y[e] -= mean; vs += y[e] * y[e]; }
            vs += DPP_F(vs, 0xB1); vs += DPP_F(vs, 0x4E); vs += DPP_F(vs, 0x141);
            const float rs = rsqrtf(vs * (1.f / 64.f) + 64e-5f);
            u32x4 ov;
#pragma unroll
            for (int e = 0; e < 4; ++e) { const float o0 = (y[2 * e] * rs * lw8[2 * e] + lb8[2 * e] + bs * v8[2 * e]) * g8[2 * e], o1 = (y[2 * e + 1] * rs * lw8[2 * e + 1] + lb8[2 * e + 1] + bs * v8[2 * e + 1]) * g8[2 * e + 1];
                ov[e] = pk2(o0, o1); }
            *(u32x4*)(Y + (size_t)t * 2048 + c0) = ov;
        }
    }
}

struct AttnP {
    const bf16_t* Q; int qpitch, qcol0;
    const bf16_t* K1; int k1pitch, k1col0;
    const bf16_t* K2; int k2pitch, k2col0;
    const bf16_t* V; int vpitch, vcol0;
    bf16_t* O; int opitch, ocol0;
    size_t qrow0, krow0;
    int q0;
    int nkeys;
    float c1;
    const int* pos; const float* lut;
    float lam, outscale; const float* subw;
    int dbg;
};

template <int DQK, int DK1, int MODE, int KT, int PFD>
DI void attn_unit(LAS unsigned char* lds, const AttnP& P) {
    constexpr int DV = 128, KP = DQK * 2 + 16, VP = DV * 2 + 64;
    constexpr int NBLK = KT / 32;
    constexpr int KTILE = KT * KP, VTILE = KT * VP;
    constexpr int NVT = (MODE == 0) ? 1 : 2;
    constexpr int VSLOT = NVT * VTILE + 256;
    constexpr bool ONEB = (MODE != 2);
    constexpr int KSLOT = 2 * KTILE, NKS = ONEB ? 2 : 1, NVS = ONEB ? 3 : 2;
    constexpr int OFF_V = NKS * KSLOT, OFF_POS = NVT * VTILE, OFF_LUT = OFF_V + NVS * VSLOT, OFF_END = OFF_LUT + 512;
    static_assert(!ONEB || PFD == 1, "one-barrier loop uses a single prefetch set");
    constexpr int OFF_OST = 4 * 17408, OSTP = 272;
    static_assert(OFF_END <= LDS_MAIN && OFF_OST + 4 * 32 * OSTP <= LDS_MAIN, "attention LDS");
    constexpr int KCH = DQK / 8, K1CH = DK1 / 8;
    constexpr int NKC = 2 * KT * KCH, NVC = NVT * KT * 16, NKCH = NKC / 512, NVCH = NVC / 512, NCHK = NKCH + NVCH;
    static_assert(NKC % 512 == 0 && NVC % 512 == 0, "chunks");
    constexpr float NEG = -1e30f, THR = 8.f;
    constexpr int KSTEP = (MODE == 0) ? KT : 2 * KT;
    int tid = threadIdx.x; asm volatile("" : "+v"(tid));
    const int lane = tid & 63, wave = __builtin_amdgcn_readfirstlane(tid >> 6);
    const int qg = wave >> 1, st = wave & 1, r32 = lane & 31, h2 = lane >> 5;
    const int qw0 = P.q0 + 32 * qg;
    const int myq = qw0 + r32;
    bf16x8 qf[DQK / 16];
    {
        const bf16_t* qp = P.Q + (P.qrow0 + myq) * (size_t)P.qpitch + P.qcol0 + ((MODE == 0) ? st * 64 : 0) + 8 * h2;
#pragma unroll
        for (int ks = 0; ks < DQK / 16; ++ks) qf[ks] = *(const bf16x8*)(qp + 16 * ks);
    }
    int mypos = 0, posq0 = 0;
    if constexpr (MODE == 0) { mypos = P.pos[myq]; posq0 = P.pos[qw0]; if (tid < 128) ((LAS float*)(lds + OFF_LUT))[tid] = P.lut[tid]; }
    f32x16 o[4];
#pragma unroll
    for (int d = 0; d < 4; ++d)
#pragma unroll
        for (int i = 0; i < 16; ++i) o[d][i] = 0.f;
    float m_run = NEG, l_run = 0.f;
    const int nsteps = P.nkeys / KSTEP;
    const char* gp[NCHK]; unsigned adv[NCHK]; unsigned ldst[NCHK];
#pragma unroll
    for (int i = 0; i < NKCH; ++i) { const int c = tid + 512 * i; const int s = c / (KT * KCH), rc = c % (KT * KCH), row = rc / KCH, ch = rc % KCH;
        const int key = (MODE == 0) ? row : s * KT + row;
        if (ch < K1CH) { gp[i] = (const char*)(P.K1 + (P.krow0 + key) * (size_t)P.k1pitch + P.k1col0 + ((MODE == 0) ? s * 64 : 0) + ch * 8); adv[i] = (unsigned)(KSTEP * P.k1pitch * 2); }
        else { gp[i] = (const char*)(P.K2 + (P.krow0 + key) * (size_t)P.k2pitch + P.k2col0 + (ch - K1CH) * 8); adv[i] = (unsigned)(KSTEP * P.k2pitch * 2); }
        ldst[i] = (unsigned)(s * KTILE + row * KP + ch * 16); }
#pragma unroll
    for (int i = 0; i < NVCH; ++i) { const int c2 = tid + 512 * i; const int s = c2 / (KT * 16), rc = c2 % (KT * 16), row = rc / 16, ch = rc % 16;
        const int key = (MODE == 0) ? row : s * KT + row;
        gp[NKCH + i] = (const char*)(P.V + (P.krow0 + key) * (size_t)P.vpitch + P.vcol0 + ch * 8); adv[NKCH + i] = (unsigned)(KSTEP * P.vpitch * 2);
        ldst[NKCH + i] = (unsigned)(s * VTILE + row * VP + ch * 16); }
    u32x4 preK[PFD][NKCH], preV[PFD][NVCH]; int prepos[2] = {0, 0};
#define KSET(par) ((PFD == 2) ? ((par) ^ 1) : 0)
#define VSET(par) ((PFD == 2) ? (par) : 0)
#define ATT_PREFETCH_K(set_) do { _Pragma("unroll") for (int i = 0; i < NKCH; ++i) { preK[set_][i] = *(const u32x4*)gp[i]; gp[i] += adv[i]; } } while (0)
#define ATT_PREFETCH_V(set_, step_) do { _Pragma("unroll") for (int i = 0; i < NVCH; ++i) { preV[set_][i] = *(const u32x4*)gp[NKCH + i]; gp[NKCH + i] += adv[NKCH + i]; } \
        if constexpr (MODE == 0) { if (tid < KT) prepos[set_] = P.pos[(step_) * KT + tid]; } } while (0)
#define ATT_STAGE_K(set_, ko_) do { _Pragma("unroll") for (int i = 0; i < NKCH; ++i) *(LAS u32x4*)(lds + (ko_) + ldst[i]) = preK[set_][i]; } while (0)
#define ATT_STAGE_V(set_, vo_) do { _Pragma("unroll") for (int i = 0; i < NVCH; ++i) *(LAS u32x4*)(lds + (vo_) + ldst[NKCH + i]) = preV[set_][i]; \
        if constexpr (MODE == 0) { if (tid < KT) ((LAS int*)(lds + (vo_) + OFF_POS))[tid] = prepos[set_]; } } while (0)
#define ATT_QK(dst, ko_) do { const LAS unsigned char* kb_ = lds + (ko_) + st * KTILE + r32 * KP + 16 * h2; \
        _Pragma("unroll") for (int blk = 0; blk < NBLK; ++blk) { \
            _Pragma("unroll") for (int i = 0; i < 16; ++i) dst[blk][i] = 0.f; \
            _Pragma("unroll") for (int ks = 0; ks < DQK / 16; ++ks) { const bf16x8 kf = *(const LAS bf16x8*)(kb_ + blk * 32 * KP + ks * 32); dst[blk] = __builtin_amdgcn_mfma_f32_32x32x16_bf16(kf, qf[ks], dst[blk], 0, 0, 0); } } } while (0)
#define ATT_VLD(j_) do { const int d_ = (j_) / (2 * NBLK), r_ = (j_) % (2 * NBLK); const LAS unsigned char* vp_ = vb_ + (16 * r_) * VP + d_ * 64; \
            vlo_[(j_) & 1] = __builtin_bit_cast(s16x4, __builtin_amdgcn_ds_read_tr16_b64_v4i16((LAS v4i16_t*)vp_)); \
            vhi_[(j_) & 1] = __builtin_bit_cast(s16x4, __builtin_amdgcn_ds_read_tr16_b64_v4i16((LAS v4i16_t*)(vp_ + 8 * VP))); } while (0)
#define ATT_PV(vo_) do { const int sv_ = (MODE == 0) ? 0 : st; \
        const LAS unsigned char* vb_ = lds + (vo_) + sv_ * VTILE + (4 * h2 + ((lane & 15) >> 2)) * VP + ((lane >> 4) & 1) * 32 + (lane & 3) * 8; \
        s16x4 vlo_[2], vhi_[2]; ATT_VLD(0); \
        _Pragma("unroll") for (int j = 0; j < 8 * NBLK; ++j) { if (j + 1 < 8 * NBLK) ATT_VLD(j + 1); \
            const s16x4 lo_ = vlo_[j & 1], hi_ = vhi_[j & 1]; const bf16x8 vf_ = {lo_[0], lo_[1], lo_[2], lo_[3], hi_[0], hi_[1], hi_[2], hi_[3]}; \
            const int d_ = j / (2 * NBLK), r_ = j % (2 * NBLK); \
            o[d_] = __builtin_amdgcn_mfma_f32_32x32x16_bf16(vf_, pf[r_ >> 1][r_ & 1], o[d_], 0, 0, 0); } } while (0)
    f32x16 sc[NBLK]; bf16x8 pf[NBLK][2]; bool pv_pending = false;
    const bool order_b = (wave & 1) != 0;
    auto att_body = [&](int step, int vo_cur, int vo_prev, int ko_next) {
        const int k0 = step * KSTEP + ((MODE == 0) ? 0 : st * KT);
        const bool valid_next = (step + 1 < nsteps) && (MODE == 2 || k0 + KSTEP <= qw0 + 31);
        const bool valid = (MODE == 2) || (k0 <= qw0 + 31);
        if (!order_b && pv_pending && !(P.dbg & 1)) ATT_PV(vo_prev);
        pv_pending = valid && !order_b;
        if (valid && !(P.dbg & 2)) {
        const bool need_mask = (MODE != 2) && (k0 + KT - 1 > qw0);
        float bb = 0.f; bool near = false;
        if constexpr (MODE == 0) {
            const LAS float* lut = (const LAS float*)(lds + OFF_LUT);
            const LAS int* pk = (const LAS int*)(lds + vo_cur + OFF_POS);
            near = (posq0 - pk[KT - 1]) < 127;
            if (near) {
#pragma unroll
                for (int blk = 0; blk < NBLK; ++blk)
#pragma unroll
                    for (int i = 0; i < 16; ++i) { const int kl = 32 * blk + (i & 3) + 8 * (i >> 2) + 4 * h2; int rel = mypos - pk[kl]; rel = rel < 0 ? 0 : (rel > 127 ? 127 : rel);
                        sc[blk][i] = sc[blk][i] * P.c1 + lut[rel]; }
            } else bb = lut[127];
        }
        if (need_mask) {
#pragma unroll
            for (int blk = 0; blk < NBLK; ++blk)
#pragma unroll
                for (int i = 0; i < 16; ++i) { const int key = k0 + 32 * blk + (i & 3) + 8 * (i >> 2) + 4 * h2; if (key > myq) sc[blk][i] = NEG; }
        }
        const float cc = near ? 1.f : P.c1;
        float mx = sc[0][0];
#pragma unroll
        for (int blk = 0; blk < NBLK; ++blk)
#pragma unroll
            for (int i = 0; i < 16; ++i) mx = fmaxf(mx, sc[blk][i]);
        { const int mi = __builtin_bit_cast(int, mx); auto rr = __builtin_amdgcn_permlane32_swap(mi, mi, false, false); mx = fmaxf(__builtin_bit_cast(float, (int)rr[0]), __builtin_bit_cast(float, (int)rr[1])); }
        mx = mx * cc + bb;
        if (__any(mx > m_run + THR)) {
            const float m_new = fmaxf(m_run, mx);
            const float alpha = __builtin_amdgcn_exp2f(m_run - m_new);
            m_run = m_new; l_run *= alpha;
#pragma unroll
            for (int d = 0; d < 4; ++d)
#pragma unroll
                for (int i = 0; i < 16; ++i) o[d][i] *= alpha;
        }
        const float off = bb - m_run;
        float psum = 0.f;
#pragma unroll
        for (int blk = 0; blk < NBLK; ++blk)
#pragma unroll
            for (int i = 0; i < 16; ++i) { const float p = __builtin_amdgcn_exp2f(__builtin_fmaf(sc[blk][i], cc, off)); sc[blk][i] = p; psum += p; }
        l_run += psum;
#pragma unroll
        for (int blk = 0; blk < NBLK; ++blk)
#pragma unroll
            for (int s16 = 0; s16 < 2; ++s16) { u32x4 w; w.x = pk2(sc[blk][8 * s16 + 0], sc[blk][8 * s16 + 1]); w.y = pk2(sc[blk][8 * s16 + 2], sc[blk][8 * s16 + 3]);
                w.z = pk2(sc[blk][8 * s16 + 4], sc[blk][8 * s16 + 5]); w.w = pk2(sc[blk][8 * s16 + 6], sc[blk][8 * s16 + 7]); pf[blk][s16] = __builtin_bit_cast(bf16x8, w); }
        }
        if (order_b && valid && !(P.dbg & 1)) ATT_PV(vo_cur);
        if (valid_next && !(P.dbg & 4)) ATT_QK(sc, ko_next);
        };
#define ATT_BODY(step, vc, vp) att_body(step, vc, vp, 0)
#define ATT_BAR() asm volatile("s_waitcnt lgkmcnt(0)\n\ts_barrier" ::: "memory")
    if constexpr (ONEB) {
        ATT_PREFETCH_K(0);
        __syncthreads();
        ATT_STAGE_K(0, 0);
        if (nsteps > 1) ATT_PREFETCH_K(0);
        ATT_PREFETCH_V(0, 0);
        if (nsteps > 1) ATT_STAGE_K(0, KSLOT);
        ATT_STAGE_V(0, OFF_V);
        if (nsteps > 2) ATT_PREFETCH_K(0);
        if (nsteps > 1) ATT_PREFETCH_V(0, 1);
        __syncthreads();
        ATT_QK(sc, 0);
        int vo_prev = OFF_V + 2 * VSLOT, vo_cur = OFF_V, vo_next = OFF_V + VSLOT;
        for (int step = 0; step < nsteps; ++step) {
            ATT_BAR();
            const int ko_next = ((step + 1) & 1) * KSLOT, ko_free = (step & 1) * KSLOT;
            if (!(P.dbg & 8)) {
                if (step + 2 < nsteps) ATT_STAGE_K(0, ko_free);
                if (step + 1 < nsteps) ATT_STAGE_V(0, vo_next);
                if (step + 3 < nsteps) ATT_PREFETCH_K(0);
                if (step + 2 < nsteps) ATT_PREFETCH_V(0, step + 2); }
            att_body(step, vo_cur, vo_prev, ko_next);
            const int tmp_ = vo_prev; vo_prev = vo_cur; vo_cur = vo_next; vo_next = tmp_;
        }
        if (pv_pending) ATT_PV(vo_prev);
    } else {
    ATT_PREFETCH_K(0);
    __syncthreads();
    ATT_STAGE_K(0, 0);
    if (nsteps > 1) ATT_PREFETCH_K(KSET(0));
    if (PFD == 2 && nsteps > 2) ATT_PREFETCH_K(0);
    ATT_PREFETCH_V(0, 0);
    if (PFD == 2 && nsteps > 1) ATT_PREFETCH_V(1, 1);
    __syncthreads();
    ATT_QK(sc, 0);
#define ATT_ITER(step, par) do { \
        const int vo_cur = OFF_V + (par) * VSLOT, vo_prev = OFF_V + ((par) ^ 1) * VSLOT; \
        ATT_BAR();                                                  \
        if (!(P.dbg & 8)) { if ((step) + 1 < nsteps) ATT_STAGE_K(KSET(par), 0); \
        ATT_STAGE_V(VSET(par), vo_cur); } \
        ATT_BAR();                                                  \
        if (!(P.dbg & 8)) { if ((step) + 1 + PFD < nsteps) ATT_PREFETCH_K(KSET(par)); \
        if ((step) + PFD < nsteps) ATT_PREFETCH_V(VSET(par), (step) + PFD); } \
        ATT_BODY(step, vo_cur, vo_prev); } while (0)
    for (int step = 0; step < nsteps; step += 2) { ATT_ITER(step, 0); if (step + 1 < nsteps) ATT_ITER(step + 1, 1); }
    if (pv_pending) ATT_PV(OFF_V + ((nsteps - 1) & 1) * VSLOT);
    }
#undef ATT_PREFETCH_K
#undef ATT_PREFETCH_V
#undef ATT_STAGE_K
#undef ATT_STAGE_V
#undef ATT_QK
#undef ATT_PV
#undef ATT_VLD
#undef ATT_ITER
#undef ATT_BAR
#undef ATT_BODY
#undef KSET
#undef VSET
    l_run += __shfl_xor(l_run, 32);
    __syncthreads();
    LAS float* mb = (LAS float*)(lds + qg * 17408);
    if (st == 1) {
        if constexpr (MODE == 0) { const float inv = 1.f / l_run;
#pragma unroll
            for (int d = 0; d < 4; ++d)
#pragma unroll
                for (int i = 0; i < 16; ++i) mb[(d * 16 + i) * 64 + lane] = o[d][i] * inv;
        } else {
#pragma unroll
            for (int d = 0; d < 4; ++d)
#pragma unroll
                for (int i = 0; i < 16; ++i) mb[(d * 16 + i) * 64 + lane] = o[d][i];
            mb[4096 + lane] = m_run; mb[4160 + lane] = l_run;
        }
    }
    __syncthreads();
    if (st == 0) {
        if constexpr (MODE == 0) {
            const float inv = 1.f / l_run; float ss = 0.f;
#pragma unroll
            for (int d = 0; d < 4; ++d)
#pragma unroll
                for (int i = 0; i < 16; ++i) { const float v = o[d][i] * inv - P.lam * mb[(d * 16 + i) * 64 + lane]; o[d][i] = v; ss += v * v; }
            ss += __shfl_xor(ss, 32);
            const float rn = rsqrtf(ss * (1.f / 128.f) + 1e-5f) * P.outscale;
#pragma unroll
            for (int d = 0; d < 4; ++d)
#pragma unroll
                for (int i = 0; i < 16; ++i) { const int dv = 32 * d + (i & 3) + 8 * (i >> 2) + 4 * h2; o[d][i] = o[d][i] * rn * P.subw[dv]; }
        } else {
            const float m1 = mb[4096 + lane], l1 = mb[4160 + lane];
            const float mt = fmaxf(m_run, m1); const float a0 = __builtin_amdgcn_exp2f(m_run - mt), a1 = __builtin_amdgcn_exp2f(m1 - mt);
            const float inv = 1.f / (l_run * a0 + l1 * a1);
#pragma unroll
            for (int d = 0; d < 4; ++d)
#pragma unroll
                for (int i = 0; i < 16; ++i) o[d][i] = (o[d][i] * a0 + mb[(d * 16 + i) * 64 + lane] * a1) * inv;
        }
        LAS unsigned char* og = lds + OFF_OST + qg * (32 * OSTP);
#pragma unroll
        for (int d = 0; d < 4; ++d)
#pragma unroll
            for (int g4 = 0; g4 < 4; ++g4) { u32x2 w; w.x = pk2(o[d][4 * g4 + 0], o[d][4 * g4 + 1]); w.y = pk2(o[d][4 * g4 + 2], o[d][4 * g4 + 3]);
                *(LAS u32x2*)(og + r32 * OSTP + (32 * d + 8 * g4 + 4 * h2) * 2) = w; }
        asm volatile("s_waitcnt lgkmcnt(0)" ::: "memory");
        bf16_t* op = P.O + (P.qrow0 + qw0) * (size_t)P.opitch + P.ocol0;
#pragma unroll
        for (int i = 0; i < 8; ++i) { const int row = 4 * i + (lane >> 4), ch = lane & 15;
            const u32x4 v = *(const LAS u32x4*)(og + row * OSTP + ch * 16);
            *(u32x4*)(op + (size_t)row * P.opitch + ch * 8) = v; }
    }
    __syncthreads();
}

DI void phase_att(const Ctx& C, int l) {
    inptr_t in = C.in; unsigned char* ws = C.ws;
    const int ATT_SEL = C.att_sel & 0xff; const int dbg = C.att_sel >> 8;
    if (ATT_SEL & 1) phase_post(C, l);
    bf16_t* Y = dbg ? (bf16_t*)(ws + WS_H) : (bf16_t*)(ws + WS_PRW); const bf16_t* PATT = (const bf16_t*)(ws + WS_PATT);
    const float lambda_init = 0.8f - 0.6f * expf(-0.3f * (float)l);
    float lam;
    { const float a = wave_sum(in[23][l * 64 + C.lane] * in[24][l * 64 + C.lane]), b = wave_sum(in[25][l * 64 + C.lane] * in[26][l * 64 + C.lane]); lam = expf(a) - expf(b) + lambda_init; }
    if (ATT_SEL & 2) for (int w = C.vcu; w < 256; w += C.G) {
        const int bh = w >> 4, j = w & 15, b = bh >> 2, h = bh & 3;
#pragma unroll 1
        for (int k = 0; k < 2; ++k) { const int qb = k ? 31 - j : j;
            AttnP P; P.Q = PATT; P.qpitch = PATT_COLS; P.qcol0 = h * 128; P.K1 = PATT; P.k1pitch = PATT_COLS; P.k1col0 = 512 + h * 128; P.K2 = PATT; P.k2pitch = 0; P.k2col0 = 0;
            P.V = PATT; P.vpitch = PATT_COLS; P.vcol0 = 1024 + h * 128; P.O = Y; P.opitch = 2048; P.ocol0 = 1024 + h * 128;
            P.qrow0 = (size_t)b * SEQ; P.krow0 = (size_t)b * SEQ; P.q0 = qb * 128; P.nkeys = qb * 128 + 128; P.c1 = 0.125f * LOG2E;
            P.pos = (const int*)in[2] + b * SEQ; P.lut = (const float*)(ws + WS_LUT) + h * 128; P.lam = lam; P.outscale = 1.f - lambda_init; P.subw = in[27] + l * 128; P.dbg = dbg;
            attn_unit<64, 64, 0, 64, 1>(C.lds, P); }
    }
    const bf16_t* QM = (const bf16_t*)(ws + WS_QM); const bf16_t* KVM = (const bf16_t*)(ws + WS_KVM); const bf16_t* KPE = (const bf16_t*)(ws + WS_KPE);
    if (ATT_SEL & 4) for (int w = C.vcu; w < 256; w += C.G) {
        const int bh = w >> 4, j = w & 15, b = bh >> 2, h = bh & 3;
#pragma unroll 1
        for (int k = 0; k < 2; ++k) { const int qb = k ? 31 - j : j;
            AttnP P; P.Q = QM; P.qpitch = 768; P.qcol0 = h * 192; P.K1 = KVM; P.k1pitch = 1024; P.k1col0 = h * 256; P.K2 = KPE; P.k2pitch = 64; P.k2col0 = 0;
            P.V = KVM; P.vpitch = 1024; P.vcol0 = h * 256 + 128; P.O = Y; P.opitch = 2048; P.ocol0 = 1536 + h * 128;
            P.qrow0 = (size_t)b * SEQ; P.krow0 = (size_t)b * SEQ; P.q0 = qb * 128; P.nkeys = qb * 128 + 128; P.c1 = 0.07216878364870322f * LOG2E;
            P.pos = nullptr; P.lut = nullptr; P.lam = 0.f; P.outscale = 0.f; P.subw = nullptr; P.dbg = dbg;
            attn_unit<192, 128, 1, 32, 1>(C.lds, P); }
    }
}

DI void phase_cross(const Ctx& C) {
    unsigned char* ws = C.ws; const int dbg = 0;
    const bf16_t* CAQ = (const bf16_t*)(ws + WS_CAQ); const bf16_t* MKV = (const bf16_t*)(ws + WS_MEMKV); bf16_t* CAO = (bf16_t*)(ws + WS_CAO);
    for (int u = C.vcu; u < 512; u += C.G) {
        const int bh = u >> 5, qb = u & 31, b = bh >> 2, h = bh & 3;
        AttnP P; P.Q = CAQ; P.qpitch = 512; P.qcol0 = h * 128; P.K1 = MKV; P.k1pitch = 1024; P.k1col0 = h * 128; P.K2 = MKV; P.k2pitch = 0; P.k2col0 = 0;
        P.V = MKV; P.vpitch = 1024; P.vcol0 = 512 + h * 128; P.O = CAO; P.opitch = 512; P.ocol0 = h * 128;
        P.qrow0 = (size_t)b * SEQ; P.krow0 = (size_t)b * MEMLEN; P.q0 = qb * 128; P.nkeys = MEMLEN; P.c1 = 0.08838834764831845f * LOG2E;
        P.pos = nullptr; P.lut = nullptr; P.lam = 0.f; P.outscale = 0.f; P.subw = nullptr; P.dbg = dbg;
        attn_unit<128, 128, 2, 64, 1>(C.lds, P);
    }
}

DI void phase_route(const Ctx& C, int l) {
    inptr_t in = C.in; unsigned char* ws = C.ws;
    const float* LG = (const float*)(ws + WS_LOGITS);
    const float* bg = in[39] + l * 4; const float* be = in[41] + l * 32;
    int* EID = (int*)(ws + WS_EID); float* GATE = (float*)(ws + WS_GATE); int* CNT = (int*)(ws + WS_CNT);
    LAS int* hist = (LAS int*)(C.lds);
    const int lane = C.lane;
    for (int wgt = C.wg; wgt < 256; wgt += C.G) {
        if (C.tid < 32) hist[C.tid] = 0;
        __syncthreads();
#pragma unroll 1
        for (int r = 0; r < 8; ++r) {
            const int t = wgt * 64 + C.wave * 8 + r;
            const float raw = (lane < 36) ? LG[(size_t)t * 256 + lane] : 0.f;
            const float g0 = RDL_F(raw, 32), g1 = RDL_F(raw, 33), g2 = RDL_F(raw, 34), g3 = RDL_F(raw, 35);
            int sel = 0; float best = g0 + bg[0];
            if (g1 + bg[1] > best) { best = g1 + bg[1]; sel = 1; }
            if (g2 + bg[2] > best) { best = g2 + bg[2]; sel = 2; }
            if (g3 + bg[3] > best) { best = g3 + bg[3]; sel = 3; }
            const float gm = fmaxf(fmaxf(g0, g1), fmaxf(g2, g3));
            const float e0 = __expf(g0 - gm), e1 = __expf(g1 - gm), e2 = __expf(g2 - gm), e3 = __expf(g3 - gm);
            const float es = sel == 0 ? e0 : (sel == 1 ? e1 : (sel == 2 ? e2 : e3));
            const float pgrp = es / ((e0 + e1) + (e2 + e3));
            float val = (lane < 32 && (lane >> 3) == sel) ? raw + be[lane & 31] : -INFINITY;
            const float m1 = wave_max(val); const int i1 = __ffsll((long long)__ballot(val == m1)) - 1;
            if (lane == i1) val = -INFINITY;
            const float m2 = wave_max(val); const int i2 = __ffsll((long long)__ballot(val == m2)) - 1;
            const float r1 = __shfl(raw, i1), r2 = __shfl(raw, i2);
            const float w1 = 1.f / (1.f + __expf(r2 - r1)), w2 = 1.f - w1;
            if (lane == 0) { EID[2 * t] = i1; EID[2 * t + 1] = i2; GATE[2 * t] = w1 * pgrp; GATE[2 * t + 1] = w2 * pgrp;
                atomicAdd((int*)&hist[i1], 1); atomicAdd((int*)&hist[i2], 1); }
        }
        __syncthreads();
        if (C.tid < 32) CNT[wgt * 32 + C.tid] = hist[C.tid];
        __syncthreads();
    }
}

DI void phase_dispatch(const Ctx& C) {
    unsigned char* ws = C.ws;
    const int* EID = (const int*)(ws + WS_EID); const int* CNT = (const int*)(ws + WS_CNT);
    int* ROWMAP = (int*)(ws + WS_ROWMAP); int* ROWDST = (int*)(ws + WS_ROWDST); int* TILEEXP = (int*)(ws + WS_TILEEXP);
    LAS int* tot = (LAS int*)(C.lds); LAS int* base = tot + 32; LAS int* off = base + 32; LAS int* eid = off + 40; LAS int* posl = eid + 128;
    const int tid = C.tid;
    for (int wgt = C.wg; wgt < 256; wgt += C.G) {
        { LAS int* cl = posl + 128;
#pragma unroll
          for (int i = 0; i < 16; ++i) cl[tid + 512 * i] = CNT[tid + 512 * i];
          __syncthreads();
          if (tid < 32) { int s = 0, bsum = 0; for (int w = 0; w < 256; ++w) { const int c = cl[w * 32 + tid]; if (w == wgt) bsum = s; s += c; } tot[tid] = s; base[tid] = bsum; } }
        if (tid >= 64 && tid < 192) eid[tid - 64] = EID[wgt * 128 + (tid - 64)];
        __syncthreads();
        if (tid == 0) { int o = 0; for (int e = 0; e < 32; ++e) { off[e] = o; o += (tot[e] + 255) & ~255; } off[32] = o; }
        __syncthreads();
        if (tid < 128) { const int e = eid[tid]; int rank = 0; for (int j = 0; j < tid; ++j) rank += (eid[j] == e) ? 1 : 0;
            const int pos = off[e] + base[e] + rank; ROWMAP[pos] = wgt * 64 + (tid >> 1); ROWDST[pos] = wgt * 128 + tid; }
        if (wgt < 32) { const int e = wgt; for (int p = off[e] + tot[e] + tid; p < off[e + 1]; p += 512) { ROWMAP[p] = 0; ROWDST[p] = -1; } }
        if (wgt == 0) { if (tid < 32) { for (int tl = off[tid] >> 8; tl < (off[tid + 1] >> 8); ++tl) TILEEXP[tl] = tid; } if (tid == 0) TILEEXP[200] = off[32] >> 8; }
        __syncthreads();
    }
}

#ifndef PHASE_MASK
#define PHASE_MASK 0x1ffff
#endif
#define IN(k) (lo <= (k) && (k) < hi)
#define EN(j) ((PHASE_MASK >> (j)) & 1)
#define SEAM(k) do { if (IN(k) && IN((k) + 1)) xcd_barrier(bar); } while (0)
#define PH_BEGIN() do { int t_ = threadIdx.x; asm volatile("" : "+v"(t_)); kaptr_t ka_ = (kaptr_t)__builtin_amdgcn_kernarg_segment_ptr(); asm volatile("" : "+s"(ka_)); \
        C.lds = (LAS unsigned char*)lds_raw; C.in = (inptr_t)ka_; C.X = *(float* const CAS*)(ka_ + 360); C.ws = *(unsigned char* const CAS*)(ka_ + 368); \
        C.tid = t_; C.lane = t_ & 63; C.wave = __builtin_amdgcn_readfirstlane(t_ >> 6); { int g_ = gridDim.x, b_ = blockIdx.x; asm volatile("" : "+s"(g_), "+s"(b_)); C.G = g_; C.wg = b_; } C.gw = C.wg * 8 + C.wave; C.ngw = C.G * 8; C.vcu = (C.G % 8 == 0) ? (C.wg % 8) * (C.G / 8) + C.wg / 8 : C.wg; \
        ws = C.ws; in = C.in; } while (0)
constexpr int PPL = 16, NPHASE = 2 * PPL + 1;
template <int l>
DI void run_layer(unsigned char* lds_raw, const XcdBarrier& bar, int lo, int hi, int att_sel = 7) {
    Ctx C; unsigned char* ws; inptr_t in; C.att_sel = att_sel;
    constexpr int pb = l * PPL;

        if (EN(0) && IN(pb + 0)) { PH_BEGIN(); phase_convert(C, l); } SEAM(pb + 0);
        if (EN(1) && IN(pb + 1)) { PH_BEGIN();
            { pg8::Gemm g{(const bf16_t*)(ws + WS_XB), (const bf16_t*)(ws + wofs(l) + WS_WINT), DM, DM, DM, nullptr}; pg8::StaticOrder S; S.init(NT, INP, C.G, C.wg, DM);
              pg8::EpiBf16 E{(bf16_t*)(ws + WS_PRW), RW_COLS, (bf16_t*)(ws + WS_PATT), PATT_COLS, 13, (const float*)(ws + WS_SSQM), 1};
              pg8::gemm_phase<pg8::EpiBf16, pg8::StaticOrder>(C.lds, g, S, E); }
            { pg8::Gemm g{(const bf16_t*)(ws + WS_MEMN), (const bf16_t*)(ws + wofs(l) + WS_CAWKVT), DM, DM, DM, nullptr}; pg8::StaticOrder S; S.init(NMEM, 1024, C.G, (C.wg + C.G / 2) % C.G, DM);
              pg8::EpiBf16 E{(bf16_t*)(ws + WS_MEMKV), 1024, nullptr, 0, 1 << 30, nullptr, 1};
              pg8::gemm_phase<pg8::EpiBf16, pg8::StaticOrder>(C.lds, g, S, E); }
        } SEAM(pb + 1);
        if (EN(2) && IN(pb + 2)) { PH_BEGIN(); phase_ew1(C, l); } SEAM(pb + 2);
        if (EN(3) && IN(pb + 3)) { PH_BEGIN();
            { pg8::Gemm g{(const bf16_t*)(ws + WS_LORAA), (const bf16_t*)(ws + wofs(l) + WS_LORABT), 384, 128, 128, nullptr}; pg8::StaticOrder S; S.init(NT, 2048, C.G, C.wg, 128);
              pg8::EpiBf16 E{(bf16_t*)(ws + WS_LORAO), 4096, nullptr, 0, 1 << 30, nullptr, 1};
              pg8::gemm_phase<pg8::EpiBf16, pg8::StaticOrder>(C.lds, g, S, E); }
            { pg8::Gemm g{(const bf16_t*)(ws + WS_LORAA) + 128, (const bf16_t*)(ws + wofs(l) + WS_LORABT) + 2048 * 128, 384, 128, 128, nullptr}; pg8::StaticOrder S; S.init(NT, 1024, C.G, C.wg, 128);
              pg8::EpiBf16 E{(bf16_t*)(ws + WS_LORAO) + 2048, 4096, nullptr, 0, 1 << 30, nullptr, 1};
              pg8::gemm_phase<pg8::EpiBf16, pg8::StaticOrder>(C.lds, g, S, E); }
            if (l == 1) { pg8::Gemm g{(const bf16_t*)(ws + WS_LORAA) + 256, (const bf16_t*)(ws + wofs(l) + WS_LORABT) + 3072 * 128, 384, 128, 128, nullptr}; pg8::StaticOrder S; S.init(NT, 1024, C.G, C.wg, 128);
              pg8::EpiBf16 E{(bf16_t*)(ws + WS_LORAO) + 3072, 4096, nullptr, 0, 1 << 30, nullptr, 1};
              pg8::gemm_phase<pg8::EpiBf16, pg8::StaticOrder>(C.lds, g, S, E); }
            { pg8::Gemm g{(const bf16_t*)(ws + WS_QN), (const bf16_t*)(ws + wofs(l) + WS_WQBT), 384, 384, 384, nullptr}; pg8::StaticOrder S; S.init(NT, 768, C.G, C.wg, 384);
              pg8::EpiBf16 E{(bf16_t*)(ws + WS_QM), 768, nullptr, 0, 1 << 30, nullptr, 1};
              pg8::gemm_phase<pg8::EpiBf16, pg8::StaticOrder>(C.lds, g, S, E); }
            { pg8::Gemm g{(const bf16_t*)(ws + WS_KVN), (const bf16_t*)(ws + wofs(l) + WS_WKVBT), 256, 256, 256, nullptr}; pg8::StaticOrder S; S.init(NT, 1024, C.G, C.wg, 256);
              pg8::EpiBf16 E{(bf16_t*)(ws + WS_KVM), 1024, nullptr, 0, 1 << 30, nullptr, 1};
              pg8::gemm_phase<pg8::EpiBf16, pg8::StaticOrder>(C.lds, g, S, E); }
        } SEAM(pb + 3);
        if (EN(4) && IN(pb + 4)) { PH_BEGIN(); phase_ew2(C, l); } SEAM(pb + 4);
        if (EN(5) && IN(pb + 5)) { PH_BEGIN(); phase_scan(C, l); } SEAM(pb + 5);
        if (EN(6) && IN(pb + 6)) { PH_BEGIN(); phase_att(C, l); } SEAM(pb + 6);
        if (EN(7) && IN(pb + 7)) { PH_BEGIN();
            pg8::Gemm g{(const bf16_t*)(ws + WS_PRW), (const bf16_t*)(ws + wofs(l) + WS_WOUTT), DM, DM, DM, nullptr}; pg8::StaticOrder S; S.init(NT, DM, C.G, C.wg, DM);
            pg8::EpiResid E{l == 0 ? in[0] : nullptr, (const bf16_t*)(ws + WS_XB), (bf16_t*)(ws + WS_XB), DM, (float*)(ws + WS_PARTC)};
            pg8::gemm_phase<pg8::EpiResid, pg8::StaticOrder>(C.lds, g, S, E);
        } SEAM(pb + 7);
        if (EN(8) && IN(pb + 8)) { PH_BEGIN();
            pg8::Gemm g{(const bf16_t*)(ws + WS_XB), (const bf16_t*)(ws + wofs(l) + WS_CAWQT), DM, DM, DM, nullptr}; pg8::StaticOrder S; S.init(NT, 512, C.G, C.wg, DM);
            pg8::EpiBf16 E{(bf16_t*)(ws + WS_CAQ), 512, nullptr, 0, 1 << 30, (const float*)(ws + WS_PARTC), 32};
            pg8::gemm_phase<pg8::EpiBf16, pg8::StaticOrder>(C.lds, g, S, E);
        } SEAM(pb + 8);
        if (EN(9) && IN(pb + 9)) { PH_BEGIN(); phase_cross(C); } SEAM(pb + 9);
        if (EN(10) && IN(pb + 10)) { PH_BEGIN();
            pg8::Gemm g{(const bf16_t*)(ws + WS_CAO), (const bf16_t*)(ws + wofs(l) + WS_CAWOT), 512, 512, 512, nullptr}; pg8::StaticOrder S; S.init(NT, DM, C.G, C.wg, 512);
            pg8::EpiResid E{nullptr, (const bf16_t*)(ws + WS_XB), (bf16_t*)(ws + WS_XB), DM, (float*)(ws + WS_PARTF)};
            pg8::gemm_phase<pg8::EpiResid, pg8::StaticOrder>(C.lds, g, S, E);
        } SEAM(pb + 10);
        if (EN(11) && IN(pb + 11)) { PH_BEGIN();
            pg8::Gemm g{(const bf16_t*)(ws + WS_XB), (const bf16_t*)(ws + (l ? WS_WRB1 : WS_WRB)), DM, DM, DM, nullptr}; pg8::StaticOrder S; S.init(NT, 256, C.G, C.wg, DM);
            pg8::EpiF32 E{(float*)(ws + WS_LOGITS), 256, (const float*)(ws + WS_PARTF), 32, (float*)(ws + WS_SSQF)};
            pg8::gemm_phase<pg8::EpiF32, pg8::StaticOrder>(C.lds, g, S, E);
        } SEAM(pb + 11);
        if (EN(12) && IN(pb + 12)) { PH_BEGIN(); phase_route(C, l); } SEAM(pb + 12);
        if (EN(13) && IN(pb + 13)) { PH_BEGIN(); phase_dispatch(C); } SEAM(pb + 13);
        if (EN(14) && IN(pb + 14)) { PH_BEGIN();
            const int* TE = (const int*)(ws + WS_TILEEXP);
            pg8::Gemm g{(const bf16_t*)(ws + WS_XB), (const bf16_t*)(ws + WS_WGU), DM, DM, DM, (const int*)(ws + WS_ROWMAP)};
            pg8::MoeOrder S{TE, TE[200], 4, C.G, C.wg, DM, (long)1024 * DM};
            pg8::EpiSiluMul E{(bf16_t*)(ws + WS_HID), DEXP, (const float*)(ws + WS_SSQF), (const int*)(ws + WS_ROWMAP)};
            pg8::gemm_phase<pg8::EpiSiluMul, pg8::MoeOrder, true>(C.lds, g, S, E);
        } SEAM(pb + 14);
        if (EN(15) && IN(pb + 15)) { PH_BEGIN();
            const int* TE = (const int*)(ws + WS_TILEEXP);
            pg8::Gemm g{(const bf16_t*)(ws + WS_HID), (const bf16_t*)(ws + WS_WD), DEXP, DEXP, DEXP, nullptr};
            pg8::MoeOrder S{TE, TE[200], 8, C.G, C.wg, DEXP, (long)DM * DEXP};
            pg8::EpiScatter E{(bf16_t*)(ws + WS_C2), DM, (const int*)(ws + WS_ROWDST)};
            pg8::gemm_phase<pg8::EpiScatter, pg8::MoeOrder>(C.lds, g, S, E);
        } SEAM(pb + 15);
    }

__global__ void __launch_bounds__(512, 2) mk_fwd(Args args) {
    extern __shared__ __attribute__((aligned(16))) unsigned char lds_raw[];
    Ctx C;
    unsigned char* ws; inptr_t in;
    PH_BEGIN();
    volatile LAS unsigned* MISC = (volatile LAS unsigned*)(C.lds + LDS_MISC);
    if (C.tid < 64) MISC[C.tid] = 0u;
    __syncthreads();
    const int lo = args.ph_lo, hi = args.ph_hi;
    XcdBarrier bar; bar.bar = (unsigned*)(args.ws + WS_CTL) + CW_BAR; bar.x = 0; bar.st = MISC + 8;
    if (hi - lo > 1) bar = xcd_barrier_post((unsigned*)(args.ws + WS_CTL) + CW_BAR, MISC + 8);
#ifndef PROBE_MASK
#define PROBE_MASK 0
#endif
#if PROBE_MASK
#ifndef PROBE_ATT
#define PROBE_ATT 7
#endif
#define RUNP(k) do { run_layer<0>(lds_raw, bar, (k), (k) + 1); xcd_barrier(bar); if ((PROBE_MASK >> (k)) & 1) { run_layer<0>(lds_raw, bar, (k), (k) + 1, PROBE_ATT); xcd_barrier(bar); } } while (0)
    RUNP(0); RUNP(1); RUNP(2); RUNP(3); RUNP(4); RUNP(5); RUNP(6); RUNP(7); RUNP(8); RUNP(9); RUNP(10); RUNP(11); RUNP(12); RUNP(13); RUNP(14); RUNP(15);
    run_layer<1>(lds_raw, bar, PPL, 2 * PPL); xcd_barrier(bar);
#else
    run_layer<0>(lds_raw, bar, lo, hi);
    run_layer<1>(lds_raw, bar, lo, hi);
#endif
    if (EN(16) && IN(2 * PPL)) { PH_BEGIN();
        const bf16_t* C2 = (const bf16_t*)(ws + WS_C2); const float* gate = (const float*)(ws + WS_GATE);
        for (int m = C.gw; m < NT; m += C.ngw)
            norm_row(nullptr, (const bf16_t*)(ws + WS_XB) + (size_t)m * DM, nullptr, C2 + (size_t)(2 * m) * DM, C2 + (size_t)(2 * m + 1) * DM, gate[2 * m], gate[2 * m + 1], in[4], nullptr, C.X + (size_t)m * DM, C.lane);
    }
#undef IN
#undef SEAM
}

extern "C" void kernel_launch(void* const* d_in, const int* in_sizes, int n_in, void* d_out, int out_size, void* d_ws, size_t ws_size, hipStream_t stream) {
    static int grid = 0;
    if (grid == 0) {
        if (n_in != 45 || out_size != NT * DM || ws_size < WS_END) { grid = -1; return; }
        int dev = 0, cus = 0;
        if (hipGetDevice(&dev) != hipSuccess || hipDeviceGetAttribute(&cus, hipDeviceAttributeMultiprocessorCount, dev) != hipSuccess) { grid = -1; return; }
        if (hipFuncSetAttribute((const void*)mk_fwd, hipFuncAttributeMaxDynamicSharedMemorySize, LDS_BYTES) != hipSuccess) { grid = -1; return; }
        int per_cu = 0;
        (void)hipOccupancyMaxActiveBlocksPerMultiprocessor(&per_cu, (const void*)mk_fwd, 512, LDS_BYTES);
        (void)hipGetLastError();
        grid = cus;
    }
    if (grid < 0) return;
    (void)hipMemsetAsync((char*)d_ws + WS_CTL, 0, 1 * MiB, stream);
    Args a{};
    for (int i = 0; i < 45; ++i) a.in[i] = d_in[i];
    a.out = (float*)d_out; a.ws = (unsigned char*)d_ws;
#if MK_ONE_LAUNCH
    a.ph_lo = 0; a.ph_hi = NPHASE;
    hipLaunchKernelGGL(mk_fwd, dim3(grid), dim3(512), LDS_BYTES, stream, a);
#else
    for (int p = 0; p < NPHASE; ++p) { a.ph_lo = p; a.ph_hi = p + 1; hipLaunchKernelGGL(mk_fwd, dim3(grid), dim3(512), LDS_BYTES, stream, a); }
#endif
}
```

```cpp
#include <hip/hip_runtime.h>
#include <stdint.h>
#include <math.h>

#ifndef MK_ONE_LAUNCH
#define MK_ONE_LAUNCH 1
#endif

#define DI __device__ __forceinline__
#define LAS __attribute__((address_space(3)))
#define GAS __attribute__((address_space(1)))

typedef unsigned short bf16_t;
typedef short bf16x8 __attribute__((ext_vector_type(8)));
typedef short s16x4 __attribute__((ext_vector_type(4)));
typedef float f32x2 __attribute__((ext_vector_type(2)));
typedef float f32x4 __attribute__((ext_vector_type(4)));
typedef float f32x16 __attribute__((ext_vector_type(16)));
typedef unsigned u32x2 __attribute__((ext_vector_type(2)));
typedef unsigned u32x4 __attribute__((ext_vector_type(4)));
typedef __bf16 bf16x2_t __attribute__((ext_vector_type(2)));
typedef short v4i16_t __attribute__((ext_vector_type(4)));
typedef _Float16 h2_t __attribute__((ext_vector_type(2)));
typedef _Float16 h4_t __attribute__((ext_vector_type(4)));

constexpr int NB = 4, SEQ = 4096, DM = 2048, NT = NB * SEQ;
constexpr int MEMLEN = 256, NMEM = NB * MEMLEN;
constexpr int RW_DIM = 1024, RW_COLS = 3328, IN_COLS = 5568, INP = 5632;
constexpr int PATT_COLS = 2304;
constexpr int NEXP = 32, DEXP = 512;
constexpr int MOE_ROWS = 40960;
constexpr float LOG2E = 1.4426950408889634f;

constexpr size_t MiB = 1u << 20, KiB = 1024;
constexpr size_t WS_CTL = 0;
constexpr size_t WS_ROPE = 1 * MiB;
constexpr size_t WS_EID = 5 * MiB;
constexpr size_t WS_GATE = 5 * MiB + 128 * KiB;
constexpr size_t WS_CNT = 5 * MiB + 256 * KiB;
constexpr size_t WS_ROWMAP = 5 * MiB + 320 * KiB;
constexpr size_t WS_ROWDST = 5 * MiB + 512 * KiB;
constexpr size_t WS_TILEEXP = 5 * MiB + 704 * KiB;
constexpr size_t WS_WRB = 7 * MiB;
constexpr size_t WS_LOGITS = 852 * MiB;
constexpr size_t WS_SSQM = 6 * MiB;
constexpr size_t WS_SSQC = 6 * MiB + 64 * KiB;
constexpr size_t WS_SSQF = 6 * MiB + 128 * KiB;
constexpr size_t WS_LUT = 6 * MiB + 512 * KiB;
constexpr size_t WS_WINT = 8 * MiB;
constexpr size_t WS_WOUTT = 30 * MiB;
constexpr size_t WS_CAWQT = 38 * MiB;
constexpr size_t WS_CAWKVT = 40 * MiB;
constexpr size_t WS_CAWOT = 44 * MiB;
constexpr size_t WS_WQBT = 46 * MiB;
constexpr size_t WS_WKVBT = 47 * MiB;
constexpr size_t WS_LORABT = 48 * MiB;
constexpr size_t WS_WGU = 52 * MiB;
constexpr size_t WS_WD = 180 * MiB;
constexpr size_t WS_H = 248 * MiB;
constexpr size_t WS_PRW = 312 * MiB;
constexpr size_t WS_PATT = 416 * MiB;
constexpr size_t WS_U = 488 * MiB;
constexpr size_t WS_HID = 488 * MiB, WS_C2 = 528 * MiB;
constexpr size_t WS_APERM = 312 * MiB;
constexpr size_t WS_LORAA = 680 * MiB;
constexpr size_t WS_LORAO = 692 * MiB;
constexpr size_t WS_VFIRST = 820 * MiB;
constexpr size_t WS_QN = 852 * MiB, WS_KVN = 864 * MiB, WS_QM = 872 * MiB, WS_KVM = 896 * MiB, WS_KPE = 928 * MiB;
constexpr size_t WS_CAQ = 852 * MiB, WS_CAO = 868 * MiB;
constexpr size_t WS_MEMN = 932 * MiB, WS_MEMKV = 936 * MiB;
constexpr size_t WS_XB = 940 * MiB;
constexpr size_t WS_PARTC = 1004 * MiB;
constexpr size_t WS_PARTF = 1006 * MiB;
constexpr size_t WS_L1OFF = 1000 * MiB;
constexpr size_t WS_WRB1 = 1052 * MiB;
constexpr size_t WS_END = 1053 * MiB;
constexpr int CW_BAR = 4096;

constexpr int LDS_MAIN = 131072;
constexpr int LDS_MISC = LDS_MAIN;
constexpr int LDS_BYTES = 147456;

DI unsigned pk2(float lo, float hi) { f32x2 v = {lo, hi}; bf16x2_t b = __builtin_convertvector(v, bf16x2_t); return __builtin_bit_cast(unsigned, b); }
DI bf16_t f2bf(float f) { return (bf16_t)(pk2(f, 0.f) & 0xffffu); }
DI unsigned pkh2(float lo, float hi) { const h2_t v = {(_Float16)lo, (_Float16)hi}; return __builtin_bit_cast(unsigned, v); }
DI float hflo(unsigned u) { return (float)__builtin_bit_cast(h2_t, u)[0]; }
DI float hfhi(unsigned u) { return (float)__builtin_bit_cast(h2_t, u)[1]; }
DI float bf2f(bf16_t b) { return __uint_as_float(((unsigned)b) << 16); }
DI float bflo(unsigned u) { return __uint_as_float(u << 16); }
DI float bfhi(unsigned u) { return __uint_as_float(u & 0xffff0000u); }
#define DPP_F(x, ctl) __builtin_bit_cast(float, __builtin_amdgcn_update_dpp(0, __builtin_bit_cast(int, x), ctl, 0xf, 0xf, true))
#define RDL_F(x, l) __builtin_bit_cast(float, __builtin_amdgcn_readlane(__builtin_bit_cast(int, x), l))
DI float wave_sum(float v) {
    v += DPP_F(v, 0xB1);
    v += DPP_F(v, 0x4E);
    v += DPP_F(v, 0x141);
    v += DPP_F(v, 0x140);
    const float r0 = RDL_F(v, 0), r1 = RDL_F(v, 16), r2 = RDL_F(v, 32), r3 = RDL_F(v, 48);
    return (r0 + r1) + (r2 + r3);
}
DI float wave_max(float v) {
    v = fmaxf(v, DPP_F(v, 0xB1)); v = fmaxf(v, DPP_F(v, 0x4E)); v = fmaxf(v, DPP_F(v, 0x141)); v = fmaxf(v, DPP_F(v, 0x140));
    const float r0 = RDL_F(v, 0), r1 = RDL_F(v, 16), r2 = RDL_F(v, 32), r3 = RDL_F(v, 48);
    return fmaxf(fmaxf(r0, r1), fmaxf(r2, r3));
}
DI float sigmoidf_(float x) { return 1.f / (1.f + __expf(-x)); }

#define XB_TMO      128
#define XB_XCNT(j)  (256  + 64 * (j))
#define XB_XSUB(j)  (1280 + 64 * (j))
#define XB_XGEN(j)  (2304 + 64 * (j))
#define XB_TOP      3328
#define XB_TOPGEN   3392
#define XCD_BAR_WORDS 3456
#define XB_SPIN_CAP (1u << 24)

DI unsigned xb_ld(unsigned* p)              { return __hip_atomic_load(p, __ATOMIC_RELAXED, __HIP_MEMORY_SCOPE_AGENT); }
DI unsigned xb_add(unsigned* p, unsigned v) { return __hip_atomic_fetch_add(p, v, __ATOMIC_RELAXED, __HIP_MEMORY_SCOPE_AGENT); }
DI unsigned xb_xcc_id() { return (unsigned)__builtin_amdgcn_s_getreg((3 << 11) | 20) & 0xFu; }
#define XB_SPIN(cond, bar) do { unsigned _sp = 0; while (cond) { __builtin_amdgcn_s_sleep(1); \
    if ((++_sp & 255u) == 0u) { if (xb_ld(&(bar)[XB_TMO])) break; if (_sp > XB_SPIN_CAP) { atomicAdd(&(bar)[XB_TMO], 1u); break; } } } } while (0)

struct XcdBarrier { unsigned* bar; unsigned x; volatile LAS unsigned* st; };

DI XcdBarrier xcd_barrier_post(unsigned* bar, volatile LAS unsigned* st) {
    XcdBarrier b; b.bar = bar; b.x = xb_xcc_id(); b.st = st;
    if (threadIdx.x == 0) (void)xb_add(&bar[XB_XCNT(b.x)], 1u);
    return b;
}
DI void xcd_barrier_complete(unsigned* bar, unsigned x, unsigned& nloc, unsigned& nx) {
    const unsigned G = gridDim.x * gridDim.y * gridDim.z;
    unsigned sum, cnt, mine, sp = 0u;
    for (;;) {
        sum = 0u; cnt = 0u; mine = 0u;
#pragma unroll
        for (unsigned j = 0; j < 16; ++j) { const unsigned c = xb_ld(&bar[XB_XCNT(j)]); sum += c; cnt += (c > 0u) ? 1u : 0u; mine = (j == x) ? c : mine; }
        if (sum == G) break;
        __builtin_amdgcn_s_sleep(1);
        if ((++sp & 255u) == 0u) { if (xb_ld(&bar[XB_TMO])) break; if (sp > XB_SPIN_CAP) { atomicAdd(&bar[XB_TMO], 1u); break; } }
    }
    nloc = mine > 0u ? mine : 1u; nx = cnt > 0u ? cnt : 1u;
}
DI void xcd_barrier(const XcdBarrier& b) {
    asm volatile("s_waitcnt vmcnt(0)" ::: "memory");
    __syncthreads();
    if (threadIdx.x == 0) {
        unsigned* bar = b.bar;
        __builtin_amdgcn_s_waitcnt(0);
        unsigned nloc = b.st[0], nx = b.st[1];
        if (nloc == 0u) { xcd_barrier_complete(bar, b.x, nloc, nx); b.st[0] = nloc; b.st[1] = nx; }
        const unsigned old = xb_add(&bar[XB_XSUB(b.x)], 1u);
        const unsigned gen = old / nloc;
        if (old + 1u == (gen + 1u) * nloc) {
            __builtin_amdgcn_fence(__ATOMIC_RELEASE, "agent");
            asm volatile("s_waitcnt vmcnt(0)" ::: "memory");
            const unsigned og = xb_add(&bar[XB_TOP], 1u);
            const unsigned tg = og / nx;
            if (og + 1u == (tg + 1u) * nx) xb_add(&bar[XB_TOPGEN], 1u);
            else XB_SPIN(xb_ld(&bar[XB_TOPGEN]) == tg, bar);
            __builtin_amdgcn_fence(__ATOMIC_ACQUIRE, "agent");
            xb_add(&bar[XB_XGEN(b.x)], 1u);
            asm volatile("s_waitcnt vmcnt(0)" ::: "memory");
        } else {
            XB_SPIN(xb_ld(&bar[XB_XGEN(b.x)]) == gen, bar);
            __builtin_amdgcn_fence(__ATOMIC_ACQUIRE, "agent");
            asm volatile("s_waitcnt vmcnt(0)" ::: "memory");
        }
    }
    __syncthreads();
}

namespace pg8 {
constexpr int BM = 256, BK = 64, HALF = 128, HTB = HALF * BK * 2, STAGE_BYTES = 8 * HTB, NXCD = 8, WGM = 8;
__host__ __device__ __forceinline__ int lds_byte(int r, int c) { const int st = (r >> 4) * 2 + (c >> 5), rr = r & 15, cc = c & 31, ob = rr * 64 + cc * 2; return st * 1024 + (ob ^ (((ob >> 9) & 1) << 5)); }
__host__ __device__ __forceinline__ void stage_rc(int b, int& R, int& C) { const int st = b / 1024, sb = b % 1024, swz = sb ^ (((sb >> 9) & 1) << 5); R = (st >> 1) * 16 + swz / 64; C = (st & 1) * 32 + (swz % 64) / 2; }
__host__ __device__ __forceinline__ int perm32(int rho) { const int n = rho >> 4, i = rho & 15; return 8 * (i >> 2) + 4 * n + (i & 3); }

struct Unit { int pm, pn; long bbase; };
struct Gemm { const bf16_t* A; const bf16_t* Bt; int lda, ldb, K; const int* rowmap; };

struct StaticOrder {
    int nM, nN, nwg, G, c, ldb;
    DI void init(int M, int N, int G_, int c_, int ldb_) { nM = M / BM; nN = N / BM; nwg = nM * nN; G = G_; c = c_; ldb = ldb_; }
    DI bool next(int i, Unit& u) const {
        const long L = (long)i * G + c; if (L >= nwg) return false;
        int wgid = (int)L; { const int q = nwg / NXCD, r = nwg % NXCD, xcd = wgid % NXCD, off = wgid / NXCD; wgid = (xcd < r ? xcd * (q + 1) : r * (q + 1) + (xcd - r) * q) + off; }
        const int nig = WGM * nN, gid = wgid / nig, fm = gid * WGM, gsz = (nM - fm) < WGM ? (nM - fm) : WGM;
        u.pm = fm + ((wgid % nig) % gsz); u.pn = (wgid % nig) / gsz; u.bbase = (long)u.pn * BM * ldb; return true;
    }
};
struct MoeOrder {
    const int* tileexp; int ntiles, nN, G, c, ldb; long estride;
    DI bool next(int i, Unit& u) const {
        const long L = (long)i * G + c; if (L >= (long)ntiles * nN) return false;
        const int tile = (int)(L / nN), pn = (int)(L % nN); const int e = tileexp[tile];
        u.pm = tile; u.pn = pn; u.bbase = (long)e * estride + (long)pn * BM * ldb; return true;
    }
};

template <class Epi, class Sched, bool GATHER = false>
DI void gemm_phase(LAS unsigned char* lds, const Gemm g, const Sched& S, const Epi& E) {
    int tid = threadIdx.x; asm volatile("" : "+v"(tid));
    const int wid = __builtin_amdgcn_readfirstlane(tid >> 6), lane = tid & 63, wr = wid >> 2, wc = wid & 3, fr = lane & 15, fq = lane >> 4;
    const int K = g.K, nt = K / BK;
    unsigned voffA[2], voffB[2]; int RA[2], CA[2];
#pragma unroll
    for (int i = 0; i < 2; ++i) { int R, C; stage_rc(tid * 16 + i * 8192, R, C); const int Rb = Epi::PERM ? ((R & ~31) + perm32(R & 31)) : R;
        RA[i] = R; CA[i] = C; voffA[i] = (unsigned)(R * g.lda + C) * 2u; voffB[i] = (unsigned)(Rb * g.ldb + C) * 2u; }
    const size_t kstep = (size_t)(BK * 2);
    const size_t hstepA = (size_t)HALF * g.lda * 2, hstepB = (size_t)HALF * g.ldb * 2;
    const unsigned ldsw = (unsigned)wid * 1024u;
    const int aoff = lds_byte(wr * 64 + fr, fq * 8), boff = lds_byte(wc * 32 + fr, fq * 8);
#define PG8_SA(b, h) (((b) * 2 + (h)) * HTB)
#define PG8_SB(b, h) ((4 + (b) * 2 + (h)) * HTB)
#define PG8_STAGE(bufoff, gbase, voff) do { _Pragma("unroll") for (int _i = 0; _i < 2; ++_i) \
        __builtin_amdgcn_global_load_lds((const unsigned*)((const char*)(gbase) + (voff)[_i]), (LAS unsigned*)(lds + (bufoff) + ldsw + _i * 8192), 16, 0, 0); } while (0)
    unsigned gA[2][2], ngA[2][2];
#define PG8_STAGE_A(b, h, ptr, isnext) do { if constexpr (GATHER) { if (isnext) PG8_STAGE(PG8_SA(b, h), ptr, ngA[h]); else PG8_STAGE(PG8_SA(b, h), ptr, gA[h]); } \
        else PG8_STAGE(PG8_SA(b, h), (ptr) + (h) * hstepA, voffA); } while (0)
#define PG8_GATHER_OFFS(dst, un) do { _Pragma("unroll") for (int h_ = 0; h_ < 2; ++h_) _Pragma("unroll") for (int i_ = 0; i_ < 2; ++i_) \
        dst[h_][i_] = (unsigned)(g.rowmap[(un).pm * BM + h_ * HALF + RA[i_]] * g.lda + CA[i_]) * 2u; } while (0)
#define PG8_LDA(dst, b, h) do { _Pragma("unroll") for (int m = 0; m < 4; ++m) _Pragma("unroll") for (int k = 0; k < 2; ++k) dst[m][k] = *(const LAS bf16x8*)(lds + PG8_SA(b, h) + aoff + m * 2048 + k * 1024); } while (0)
#define PG8_LDB(dst, b, h) do { _Pragma("unroll") for (int n = 0; n < 2; ++n) _Pragma("unroll") for (int k = 0; k < 2; ++k) dst[n][k] = *(const LAS bf16x8*)(lds + PG8_SB(b, h) + boff + n * 2048 + k * 1024); } while (0)
#define PG8_MMA(ai, bj, At, Bt) do { __builtin_amdgcn_s_setprio(1); _Pragma("unroll") for (int m = 0; m < 4; ++m) _Pragma("unroll") for (int n = 0; n < 2; ++n) _Pragma("unroll") for (int k = 0; k < 2; ++k) \
        acc[ai][bj][m][n] = __builtin_amdgcn_mfma_f32_16x16x32_bf16(Bt[n][k], At[m][k], acc[ai][bj][m][n], 0, 0, 0); __builtin_amdgcn_s_setprio(0); } while (0)
#define PG8_WAIT_V(n) asm volatile("s_waitcnt vmcnt(" #n ")" ::: "memory")
#define PG8_WAIT_L(n) asm volatile("s_waitcnt lgkmcnt(" #n ")" ::: "memory")
#define PG8_BAR __builtin_amdgcn_s_barrier()
#define PG8_SCHED __builtin_amdgcn_sched_barrier(0)
    Unit cur, nxt; int ui = 0;
    if (!S.next(0, cur)) return;
    f32x4 acc[2][2][4][2];
#pragma unroll
    for (int a = 0; a < 2; ++a)
#pragma unroll
        for (int b = 0; b < 2; ++b)
#pragma unroll
            for (int m = 0; m < 4; ++m)
#pragma unroll
                for (int n = 0; n < 2; ++n) acc[a][b][m][n] = (f32x4){0.f, 0.f, 0.f, 0.f};
    bf16x8 At[4][2], B0[2][2], B1[2][2];
    const char* cA; const char* cB = (const char*)g.Bt + cur.bbase * 2;
    if constexpr (GATHER) { cA = (const char*)g.A; PG8_GATHER_OFFS(gA, cur); PG8_GATHER_OFFS(ngA, cur); }
    else cA = (const char*)g.A + (size_t)cur.pm * BM * g.lda * 2;
    PG8_STAGE(PG8_SB(0, 0), cB, voffB); PG8_STAGE(PG8_SB(0, 1), cB + hstepB, voffB); PG8_STAGE_A(0, 0, cA, false); PG8_STAGE_A(0, 1, cA, false);
    if (wr == 1) PG8_BAR;
    PG8_WAIT_V(2); PG8_BAR;
    PG8_STAGE(PG8_SB(1, 0), cB + kstep, voffB); PG8_STAGE_A(1, 0, cA + kstep, false); PG8_STAGE(PG8_SB(1, 1), cB + hstepB + kstep, voffB);
    PG8_WAIT_V(6); PG8_BAR;
    for (;;) {
        const bool has_next = S.next(ui + 1, nxt);
        const char* nA; const char* nB = has_next ? (const char*)g.Bt + nxt.bbase * 2 : cB;
        if constexpr (GATHER) { nA = cA; if (has_next) PG8_GATHER_OFFS(ngA, nxt); }
        else nA = has_next ? (const char*)g.A + (size_t)nxt.pm * BM * g.lda * 2 : cA;
        for (int t = 0; t < nt; t += 2) {
            const bool last = (t == nt - 2);
            const char* a1 = cA + (size_t)(t + 1) * kstep;
            const char* a2 = last ? nA : cA + (size_t)(t + 2) * kstep; const char* b2 = last ? nB : cB + (size_t)(t + 2) * kstep;
            const char* a3 = a2 + kstep; const char* b3 = b2 + kstep;
            PG8_LDB(B0, 0, 0); PG8_LDB(B1, 0, 1); PG8_SCHED; PG8_LDA(At, 0, 0); PG8_STAGE_A(1, 1, a1, false);
            PG8_WAIT_V(8); PG8_WAIT_L(0); PG8_BAR; PG8_MMA(0, 0, At, B0); PG8_MMA(0, 1, At, B1); PG8_BAR; PG8_SCHED;
            PG8_LDA(At, 0, 1); PG8_STAGE(PG8_SB(0, 0), b2, voffB); PG8_STAGE(PG8_SB(0, 1), b2 + hstepB, voffB); PG8_STAGE_A(0, 0, a2, last);
            PG8_WAIT_V(8); PG8_WAIT_L(0); PG8_BAR; PG8_MMA(1, 0, At, B0); PG8_MMA(1, 1, At, B1); PG8_BAR; PG8_SCHED;
            PG8_LDB(B0, 1, 0); PG8_LDB(B1, 1, 1); PG8_SCHED; PG8_LDA(At, 1, 0); PG8_STAGE_A(0, 1, a2, last);
            PG8_WAIT_V(8); PG8_WAIT_L(0); PG8_BAR; PG8_MMA(0, 0, At, B0); PG8_MMA(0, 1, At, B1); PG8_BAR; PG8_SCHED;
            PG8_LDA(At, 1, 1); PG8_STAGE(PG8_SB(1, 0), b3, voffB); PG8_STAGE(PG8_SB(1, 1), b3 + hstepB, voffB); PG8_STAGE_A(1, 0, a3, last);
            PG8_WAIT_V(8); PG8_WAIT_L(0); PG8_BAR; PG8_MMA(1, 0, At, B0); PG8_MMA(1, 1, At, B1); PG8_BAR; PG8_SCHED;
        }
        if (wr == 0) PG8_BAR;
        E(acc, cur, wr, wc, fr, fq);
        if (!has_next) break;
#pragma unroll
        for (int a = 0; a < 2; ++a)
#pragma unroll
            for (int b = 0; b < 2; ++b)
#pragma unroll
                for (int m = 0; m < 4; ++m)
#pragma unroll
                    for (int n = 0; n < 2; ++n) acc[a][b][m][n] = (f32x4){0.f, 0.f, 0.f, 0.f};
        cur = nxt; cA = nA; cB = nB; ++ui;
        if constexpr (GATHER) {
#pragma unroll
            for (int h_ = 0; h_ < 2; ++h_)
#pragma unroll
                for (int i_ = 0; i_ < 2; ++i_) gA[h_][i_] = ngA[h_][i_]; }
        if (wr == 1) PG8_BAR;
    }
    PG8_WAIT_V(0);
    PG8_BAR;
#undef PG8_SA
#undef PG8_SB
#undef PG8_STAGE
#undef PG8_STAGE_A
#undef PG8_LDA
#undef PG8_LDB
#undef PG8_MMA
#undef PG8_WAIT_V
#undef PG8_WAIT_L
#undef PG8_BAR
#undef PG8_SCHED
#undef PG8_GATHER_OFFS
}

DI float row_ssq32(const float* part, int row) { const f32x4* p = (const f32x4*)(part + (size_t)row * 32); float t = 0.f;
#pragma unroll
    for (int i = 0; i < 8; ++i) { const f32x4 v = p[i]; t += (v[0] + v[1]) + (v[2] + v[3]); }
    return t; }
DI float row_rstd(const float* ssq, int np, int row) {
    float t;
    if (np == 1) t = ssq[row];
    else { const f32x4* p = (const f32x4*)(ssq + (size_t)row * 32); t = 0.f;
#pragma unroll
        for (int i = 0; i < 8; ++i) { const f32x4 v = p[i]; t += (v[0] + v[1]) + (v[2] + v[3]); } }
    return rsqrtf(t * (1.f / 2048.f) + 1e-6f);
}
struct EpiBf16 {
    static constexpr bool PERM = true;
    bf16_t* O; int ldc; bf16_t* O2; int ldc2; int split_tile; const float* ssq; int np;
    DI void operator()(const f32x4 (&acc)[2][2][4][2], const Unit& u, int wr, int wc, int fr, int fq) const {
        bf16_t* base = O; int ld = ldc; int colt = u.pn * BM;
        if (u.pn >= split_tile) { base = O2; ld = ldc2; colt = (u.pn - split_tile) * BM; }
        const int row0 = u.pm * BM + wr * 64 + fr, col0 = colt + wc * 32 + 8 * fq;
#pragma unroll
        for (int ai = 0; ai < 2; ++ai)
#pragma unroll
            for (int m = 0; m < 4; ++m) { const int row = row0 + ai * HALF + m * 16; bf16_t* rowp = base + (size_t)row * ld + col0;
                const float rs = ssq ? row_rstd(ssq, np, row) : 1.f;
#pragma unroll
                for (int bj = 0; bj < 2; ++bj) { const f32x4 v0 = acc[ai][bj][m][0] * rs, v1 = acc[ai][bj][m][1] * rs;
                    u32x4 w; w.x = pk2(v0[0], v0[1]); w.y = pk2(v0[2], v0[3]); w.z = pk2(v1[0], v1[1]); w.w = pk2(v1[2], v1[3]);
                    *(u32x4*)(rowp + bj * HALF) = w; } }
    }
};
struct EpiResid {
    static constexpr bool PERM = true;
    const float* basef; const bf16_t* baseb; bf16_t* out; int ldc; float* part_out;
    DI void operator()(const f32x4 (&acc)[2][2][4][2], const Unit& u, int wr, int wc, int fr, int fq) const {
        const int row0 = u.pm * BM + wr * 64 + fr, col0 = u.pn * BM + wc * 32 + 8 * fq;
#pragma unroll
        for (int ai = 0; ai < 2; ++ai)
#pragma unroll
            for (int m = 0; m < 4; ++m) { const int row = row0 + ai * HALF + m * 16; const size_t off = (size_t)row * ldc + col0; float sq = 0.f;
#pragma unroll
                for (int bj = 0; bj < 2; ++bj) { f32x4 v0 = acc[ai][bj][m][0], v1 = acc[ai][bj][m][1];
                    if (basef) { v0 += *(const f32x4*)(basef + off + bj * HALF); v1 += *(const f32x4*)(basef + off + bj * HALF + 4); }
                    else { const u32x4 b = *(const u32x4*)(baseb + off + bj * HALF);
                        v0 += (f32x4){bflo(b.x), bfhi(b.x), bflo(b.y), bfhi(b.y)}; v1 += (f32x4){bflo(b.z), bfhi(b.z), bflo(b.w), bfhi(b.w)}; }
                    u32x4 w; w.x = pk2(v0[0], v0[1]); w.y = pk2(v0[2], v0[3]); w.z = pk2(v1[0], v1[1]); w.w = pk2(v1[2], v1[3]);
                    *(u32x4*)(out + off + bj * HALF) = w;
                    const float a0 = bflo(w.x), a1 = bfhi(w.x), a2 = bflo(w.y), a3 = bfhi(w.y), a4 = bflo(w.z), a5 = bfhi(w.z), a6 = bflo(w.w), a7 = bfhi(w.w);
                    sq += ((a0 * a0 + a1 * a1) + (a2 * a2 + a3 * a3)) + ((a4 * a4 + a5 * a5) + (a6 * a6 + a7 * a7)); }
                sq += __shfl_xor(sq, 16); sq += __shfl_xor(sq, 32);
                if (fq == 0) part_out[(size_t)row * 32 + u.pn * 4 + wc] = sq; }
    }
};
struct EpiF32 {
    static constexpr bool PERM = false;
    float* out; int ldc; const float* ssq; int np; float* ssq_pub;
    DI void operator()(const f32x4 (&acc)[2][2][4][2], const Unit& u, int wr, int wc, int fr, int fq) const {
        const int row0 = u.pm * BM + wr * 64 + fr, col0 = u.pn * BM + wc * 32 + 4 * fq;
#pragma unroll
        for (int ai = 0; ai < 2; ++ai)
#pragma unroll
            for (int m = 0; m < 4; ++m) { const int row = row0 + ai * HALF + m * 16; const size_t off = (size_t)row * ldc + col0;
                float rs = 1.f;
                if (ssq) { const float t = (np == 1) ? ssq[row] : row_ssq32(ssq, row); rs = rsqrtf(t * (1.f / 2048.f) + 1e-6f); if (ssq_pub && u.pn == 0 && wc == 0 && fq == 0) ssq_pub[row] = t; }
#pragma unroll
                for (int bj = 0; bj < 2; ++bj)
#pragma unroll
                    for (int n = 0; n < 2; ++n) *(f32x4*)(out + off + bj * HALF + n * 16) = acc[ai][bj][m][n] * rs; }
    }
};
struct EpiSiluMul {
    static constexpr bool PERM = true;
    bf16_t* O; int ldc; const float* ssq; const int* rowmap;
    DI void operator()(const f32x4 (&acc)[2][2][4][2], const Unit& u, int wr, int wc, int fr, int fq) const {
        const int row0 = u.pm * BM + wr * 64 + fr, col0 = (u.pn * BM + wc * 32 + 8 * fq) >> 1;
#pragma unroll
        for (int ai = 0; ai < 2; ++ai)
#pragma unroll
            for (int m = 0; m < 4; ++m) { const int row = row0 + ai * HALF + m * 16; bf16_t* rowp = O + (size_t)row * ldc + col0;
                const float rs = row_rstd(ssq, 1, rowmap[row]);
#pragma unroll
                for (int bj = 0; bj < 2; ++bj) { const f32x4 v0 = acc[ai][bj][m][0] * rs, v1 = acc[ai][bj][m][1] * rs;
                    const float h0 = v0[0] / (1.f + __expf(-v0[0])) * v0[1], h1 = v0[2] / (1.f + __expf(-v0[2])) * v0[3];
                    const float h2 = v1[0] / (1.f + __expf(-v1[0])) * v1[1], h3 = v1[2] / (1.f + __expf(-v1[2])) * v1[3];
                    u32x2 w; w.x = pk2(h0, h1); w.y = pk2(h2, h3);
                    *(u32x2*)(rowp + bj * (HALF / 2)) = w; } }
    }
};
struct EpiScatter {
    static constexpr bool PERM = true;
    bf16_t* O; int ldc; const int* dst;
    DI void operator()(const f32x4 (&acc)[2][2][4][2], const Unit& u, int wr, int wc, int fr, int fq) const {
        const int row0 = u.pm * BM + wr * 64 + fr, col0 = u.pn * BM + wc * 32 + 8 * fq;
#pragma unroll
        for (int ai = 0; ai < 2; ++ai)
#pragma unroll
            for (int m = 0; m < 4; ++m) { const int d = dst[row0 + ai * HALF + m * 16];
                if (d >= 0) { bf16_t* rowp = O + (size_t)d * ldc + col0;
#pragma unroll
                    for (int bj = 0; bj < 2; ++bj) { const f32x4 v0 = acc[ai][bj][m][0], v1 = acc[ai][bj][m][1];
                        u32x4 w; w.x = pk2(v0[0], v0[1]); w.y = pk2(v0[2], v0[3]); w.z = pk2(v1[0], v1[1]); w.w = pk2(v1[2], v1[3]);
                        *(u32x4*)(rowp + bj * HALF) = w; } } }
    }
};
}

struct Args { const void* in[45]; float* out; unsigned char* ws; int ph_lo, ph_hi; };
static_assert(sizeof(void*) == 8 && sizeof(Args) == 384, "Args layout");

#define CAS __attribute__((address_space(4)))
typedef const CAS char* kaptr_t;
typedef const float* const CAS* inptr_t;
struct Ctx {
    LAS unsigned char* lds; unsigned char* ws; inptr_t in; float* X;
    int tid, lane, wave, G, wg, gw, ngw, att_sel, vcu;
};

DI size_t wofs(int l) { return l ? WS_L1OFF : 0; }
struct TrDesc { const float* W; bf16_t* WT; int N, ldk, row_off, row_mul, nblk, item; const float* ks; };
DI void tr_load(const TrDesc& d, float (&tv)[32], int lane) {
    const int kb = d.item / d.nblk, nb = d.item % d.nblk, k0 = 64 * kb, n0 = 32 * nb;
#pragma unroll
    for (int i = 0; i < 32; ++i) { const int kk = 2 * i + (lane >> 5); tv[i] = d.W[(size_t)(k0 + kk) * d.N + n0 + (lane & 31)]; }
}
DI void tr_store(const TrDesc& d, const float (&tv)[32], LAS float* scr, int lane) {
    const int kb = d.item / d.nblk, nb = d.item % d.nblk, k0 = 64 * kb, n0 = 32 * nb;
#pragma unroll
    for (int i = 0; i < 32; ++i) { const int kk = 2 * i + (lane >> 5); scr[kk * 33 + (lane & 31)] = d.ks ? tv[i] * d.ks[k0 + kk] : tv[i]; }
    asm volatile("s_waitcnt lgkmcnt(0)" ::: "memory");
    const int c = lane & 7;
#pragma unroll
    for (int j = 0; j < 4; ++j) { const int n = (lane >> 3) + 8 * j; const LAS float* s = scr + (8 * c) * 33 + n;
        u32x4 o; o.x = pk2(s[0 * 33], s[1 * 33]); o.y = pk2(s[2 * 33], s[3 * 33]); o.z = pk2(s[4 * 33], s[5 * 33]); o.w = pk2(s[6 * 33], s[7 * 33]);
        *(u32x4*)(d.WT + (size_t)(d.row_off + (n0 + n) * d.row_mul) * d.ldk + k0 + 8 * c) = o; }
    asm volatile("s_waitcnt lgkmcnt(0)" ::: "memory");
}

DI void norm_row(const float* xin, const bf16_t* xinb, bf16_t* xout, const bf16_t* c0, const bf16_t* c1, float g0, float g1, const float* w, bf16_t* hout, float* fout, int lane, float* ssq_w = nullptr) {
    f32x4 v[8]; float ss = 0.f;
    if (xin) {
#pragma unroll
        for (int j = 0; j < 8; ++j) { v[j] = ((const f32x4*)xin)[lane + 64 * j]; }
    } else {
#pragma unroll
        for (int j = 0; j < 8; ++j) { const u32x2 a = ((const u32x2*)xinb)[lane + 64 * j]; v[j] = (f32x4){bflo(a.x), bfhi(a.x), bflo(a.y), bfhi(a.y)}; }
    }
    if (c0) {
#pragma unroll
        for (int j = 0; j < 8; ++j) { const u32x2 a = ((const u32x2*)c0)[lane + 64 * j], b = ((const u32x2*)c1)[lane + 64 * j];
            v[j][0] += g0 * bflo(a.x) + g1 * bflo(b.x); v[j][1] += g0 * bfhi(a.x) + g1 * bfhi(b.x);
            v[j][2] += g0 * bflo(a.y) + g1 * bflo(b.y); v[j][3] += g0 * bfhi(a.y) + g1 * bfhi(b.y); }
    }
#pragma unroll
    for (int j = 0; j < 8; ++j) ss += (v[j][0] * v[j][0] + v[j][1] * v[j][1]) + (v[j][2] * v[j][2] + v[j][3] * v[j][3]);
    if (xout) {
#pragma unroll
        for (int j = 0; j < 8; ++j) { u32x2 o; o.x = pk2(v[j][0], v[j][1]); o.y = pk2(v[j][2], v[j][3]); ((u32x2*)xout)[lane + 64 * j] = o; }
    }
    const float sst = wave_sum(ss);
    if (ssq_w) { if (lane == 0) *ssq_w = sst; }
    if (!w) return;
    const float rstd = rsqrtf(sst * (1.f / DM) + 1e-6f);
#pragma unroll
    for (int j = 0; j < 8; ++j) { const f32x4 ww = ((const f32x4*)w)[lane + 64 * j]; const f32x4 y = v[j] * rstd * ww;
        if (hout) { u32x2 o; o.x = pk2(y[0], y[1]); o.y = pk2(y[2], y[3]); ((u32x2*)hout)[lane + 64 * j] = o; }
        if (fout) ((f32x4*)fout)[lane + 64 * j] = y; }
}

constexpr int I_WIN = 32 * 174, I_VR = 32, I_WOUT = 32 * 64, I_CAQ = 32 * 16, I_CAKV = 32 * 32, I_CAO = 8 * 64, I_WQB = 6 * 24, I_WKVB = 4 * 32;
constexpr int N_SMALL_ITEMS = I_WIN + I_VR + I_WOUT + I_CAQ + I_CAKV + I_CAO + I_WQB + I_WKVB;
DI TrDesc small_tr_desc(int l, int r, inptr_t in, unsigned char* wsl) {
    bf16_t* WINT = (bf16_t*)(wsl + WS_WINT);
    if (r < I_WIN) return TrDesc{in[6] + (size_t)l * DM * IN_COLS, WINT, IN_COLS, DM, 0, 1, 174, r, in[5] + (size_t)l * DM}; r -= I_WIN;
    if (r < I_VR) return TrDesc{in[7], WINT, 32, DM, IN_COLS, 1, 1, r, in[5] + DM}; r -= I_VR;
    if (r < I_WOUT) return TrDesc{in[8] + (size_t)l * DM * DM, (bf16_t*)(wsl + WS_WOUTT), DM, DM, 0, 1, 64, r, nullptr}; r -= I_WOUT;
    if (r < I_CAQ) return TrDesc{in[34] + (size_t)l * DM * 512, (bf16_t*)(wsl + WS_CAWQT), 512, DM, 0, 1, 16, r, in[32] + (size_t)l * DM}; r -= I_CAQ;
    if (r < I_CAKV) return TrDesc{in[35] + (size_t)l * DM * 1024, (bf16_t*)(wsl + WS_CAWKVT), 1024, DM, 0, 1, 32, r, nullptr}; r -= I_CAKV;
    if (r < I_CAO) return TrDesc{in[36] + (size_t)l * 512 * DM, (bf16_t*)(wsl + WS_CAWOT), DM, 512, 0, 1, 64, r, nullptr}; r -= I_CAO;
    if (r < I_WQB) return TrDesc{in[29] + (size_t)l * 384 * 768, (bf16_t*)(wsl + WS_WQBT), 768, 384, 0, 1, 24, r, nullptr}; r -= I_WQB;
    return TrDesc{in[31] + (size_t)l * 256 * 1024, (bf16_t*)(wsl + WS_WKVBT), 1024, 256, 0, 1, 32, r, nullptr};
}
constexpr int I_EXP = 512;
constexpr int N_MOE_ITEMS = 3 * NEXP * I_EXP;
DI TrDesc moe_tr_desc(int l, int r, inptr_t in, unsigned char* ws) {
    const int e = r / (3 * I_EXP), q = r % (3 * I_EXP), mat = q / I_EXP, ii = q % I_EXP;
    const size_t eo = ((size_t)l * NEXP + e);
    if (mat == 0) return TrDesc{in[42] + eo * DM * DEXP, (bf16_t*)(ws + WS_WGU) + (size_t)e * 1024 * DM, DEXP, DM, 0, 2, 16, ii, in[37] + (size_t)l * DM};
    if (mat == 1) return TrDesc{in[43] + eo * DM * DEXP, (bf16_t*)(ws + WS_WGU) + (size_t)e * 1024 * DM, DEXP, DM, 1, 2, 16, ii, in[37] + (size_t)l * DM};
    return TrDesc{in[44] + eo * DEXP * DM, (bf16_t*)(ws + WS_WD) + (size_t)e * DM * DEXP, DM, DEXP, 0, 1, 64, ii, nullptr};
}
DI void phase_convert(const Ctx& C, int l) {
    inptr_t in = C.in;
    unsigned char* ws = C.ws;
    LAS float* scr = (LAS float*)(C.lds + C.wave * 16384);
    bf16_t* WINT = (bf16_t*)(ws + WS_WINT);
    const int n_items = (l == 0) ? N_SMALL_ITEMS : 0;
    auto decode = [&](int it) -> TrDesc { return small_tr_desc(0, it, in, ws); };
    {
        const int first = (l == 0 && C.gw >= I_WIN && C.gw < I_WIN + I_VR) ? C.gw + C.ngw : C.gw;
        float ta[32], tb[32];
        int it = first;
        if (it < n_items) { TrDesc d0 = decode(it); tr_load(d0, ta, C.lane);
            for (;;) {
                int it2 = it + C.ngw; if (l == 0 && it2 >= I_WIN && it2 < I_WIN + I_VR) it2 += C.ngw;
                const bool has2 = it2 < n_items; TrDesc d1 = d0;
                if (has2) { d1 = decode(it2); tr_load(d1, tb, C.lane); }
                tr_store(d0, ta, scr, C.lane);
                if (!has2) break;
                int it3 = it2 + C.ngw; if (l == 0 && it3 >= I_WIN && it3 < I_WIN + I_VR) it3 += C.ngw;
                const bool has3 = it3 < n_items;
                if (has3) { d0 = decode(it3); tr_load(d0, ta, C.lane); }
                tr_store(d1, tb, scr, C.lane);
                if (!has3) break;
                it = it3;
            }
        }
    }
    const int gt = C.wg * 512 + C.tid, ngt = C.G * 512;
    if (l == 0) {
        for (int i = gt; i < 64 * DM / 8; i += ngt) ((u32x4*)(WINT + (size_t)IN_COLS * DM))[i] = (u32x4){0u, 0u, 0u, 0u};
        for (int i = gt; i < 32 * DM / 8; i += ngt) ((u32x4*)((bf16_t*)(ws + WS_L1OFF + WS_WINT) + (size_t)(IN_COLS + 32) * DM))[i] = (u32x4){0u, 0u, 0u, 0u};
#pragma unroll 1
        for (int lw = 0; lw < 2; ++lw) {
            bf16_t* LB = (bf16_t*)(ws + wofs(lw) + WS_LORABT);
            const float* w2 = in[12] + (size_t)lw * 64 * 1024; const float* a2 = in[14] + (size_t)lw * 64 * 1024; const float* g2 = in[17] + (size_t)lw * 128 * 1024; const float* v2 = in[16];
            for (int i = gt; i < 4096 * 128; i += ngt) {
                const int n = i >> 7, k = i & 127, blk = n >> 10, c = n & 1023; float v = 0.f;
                if (blk == 0) { if (k < 64) v = w2[k * 1024 + c]; }
                else if (blk == 1) { if (k >= 64) v = a2[(k - 64) * 1024 + c]; }
                else if (blk == 2) { v = g2[k * 1024 + c]; }
                else { if (lw == 1 && k < 32) v = v2[k * 1024 + c]; }
                LB[i] = f2bf(v);
            }
            bf16_t* WRB = (bf16_t*)(ws + (lw ? WS_WRB1 : WS_WRB)); const float* nf = in[37] + (size_t)lw * DM; const float* wg = in[38] + (size_t)lw * DM * 4; const float* we = in[40] + (size_t)lw * DM * 32;
            for (int i = gt; i < 256 * DM; i += ngt) { const int o = i / DM, k = i % DM; const float v = (o < 32) ? we[k * 32 + o] : ((o < 36) ? wg[k * 4 + (o - 32)] : 0.f); WRB[i] = f2bf(v * nf[k]); }
        }
    }
    if (l == 0) {
        float* LUT = (float*)(ws + WS_LUT); const float* rb = in[3];
        for (int i = gt; i < 4 * 128; i += ngt) { const int h = i >> 7, n = i & 127; int bk;
            if (n < 16) bk = n; else { bk = 16 + (int)(log2f((float)n * 0.0625f) * (16.f / 3.f)); if (bk > 31) bk = 31; }
            LUT[i] = rb[bk * 4 + h] * LOG2E; }
        f32x2* RT = (f32x2*)(ws + WS_ROPE); const int* pos = (const int*)in[2];
        for (int i = gt; i < NT * 32; i += ngt) { const int t = i >> 5, j = i & 31; const float invf = powf(10000.f, -(float)j / 32.f); const float ang = (float)pos[t] * invf; float s, c; sincosf(ang, &s, &c); RT[i] = (f32x2){c, s}; }
    }
    for (int m = C.gw; m < NMEM; m += C.ngw) norm_row(in[1] + (size_t)m * DM, nullptr, nullptr, nullptr, nullptr, 0.f, 0.f, in[33] + (size_t)l * DM, (bf16_t*)(ws + WS_MEMN) + (size_t)m * DM, nullptr, C.lane);
    {
        const bf16_t* C2 = (const bf16_t*)(ws + WS_C2); const float* gate = (const float*)(ws + WS_GATE); bf16_t* XB = (bf16_t*)(ws + WS_XB); float* SSQM = (float*)(ws + WS_SSQM);
        for (int m = C.gw; m < NT; m += C.ngw) {
            if (l == 0) norm_row(in[0] + (size_t)m * DM, nullptr, XB + (size_t)m * DM, nullptr, nullptr, 0.f, 0.f, nullptr, nullptr, nullptr, C.lane, SSQM + m);
            else norm_row(nullptr, XB + (size_t)m * DM, XB + (size_t)m * DM, C2 + (size_t)(2 * m) * DM, C2 + (size_t)(2 * m + 1) * DM, gate[2 * m], gate[2 * m + 1], nullptr, nullptr, nullptr, C.lane, SSQM + m);
        }
    }
}

DI void phase_ew1(const Ctx& C, int l) {
    inptr_t in = C.in; unsigned char* ws = C.ws;
    const bf16_t* PRW = (const bf16_t*)(ws + WS_PRW); const bf16_t* PATT = (const bf16_t*)(ws + WS_PATT);
    bf16_t* LA = (bf16_t*)(ws + WS_LORAA); bf16_t* QN = (bf16_t*)(ws + WS_QN); bf16_t* KVN = (bf16_t*)(ws + WS_KVN); bf16_t* KPE = (bf16_t*)(ws + WS_KPE);
    const float* mu = in[9] + (size_t)l * RW_COLS; const float* muv = in[10];
    const float* qnw = in[28] + (size_t)l * 384; const float* kvnw = in[30] + (size_t)l * 256;
    const f32x2* RT = (const f32x2*)(ws + WS_ROPE);
    const int lane = C.lane;
#pragma unroll 4
    for (int t = C.gw; t < NT; t += C.ngw) {
        const bool first = (t % SEQ) == 0;
        const bf16_t* p = PRW + (size_t)t * RW_COLS; const bf16_t* pa = PATT + (size_t)t * PATT_COLS;
#pragma unroll
        for (int j = 0; j < 4; ++j) { const int c = lane + 64 * j, col = 3072 + c;
            const float cur = bf2f(p[col]); const float prev = first ? 0.f : bf2f(p[col - RW_COLS]);
            const float xs = cur + mu[col] * (prev - cur);
            float v; if (c < 64) v = tanhf(xs); else if (c < 128) v = xs; else v = sigmoidf_(xs);
            LA[(size_t)t * 384 + c] = f2bf(v); }
        {
#pragma unroll
            for (int j = 0; j < 2; ++j) { const int c = lane + 64 * j; float v = 0.f;
                if (l == 1 && c < 32) { const float cur = bf2f(pa[2240 + c]); const float prev = first ? 0.f : bf2f(pa[2240 + c - PATT_COLS]); v = cur + muv[c] * (prev - cur); }
                LA[(size_t)t * 384 + 256 + c] = f2bf(v); } }
        float q[6], kv[4]; float sq = 0.f, skv = 0.f;
#pragma unroll
        for (int j = 0; j < 6; ++j) { q[j] = bf2f(pa[1536 + lane + 64 * j]); sq += q[j] * q[j]; }
#pragma unroll
        for (int j = 0; j < 4; ++j) { kv[j] = bf2f(pa[1920 + lane + 64 * j]); skv += kv[j] * kv[j]; }
        const float rq = rsqrtf(wave_sum(sq) * (1.f / 384.f) + 1e-6f), rkv = rsqrtf(wave_sum(skv) * (1.f / 256.f) + 1e-6f);
#pragma unroll
        for (int j = 0; j < 6; ++j) QN[(size_t)t * 384 + lane + 64 * j] = f2bf(q[j] * rq * qnw[lane + 64 * j]);
#pragma unroll
        for (int j = 0; j < 4; ++j) KVN[(size_t)t * 256 + lane + 64 * j] = f2bf(kv[j] * rkv * kvnw[lane + 64 * j]);
        { const float x = bf2f(pa[2176 + lane]); const float xo = __shfl_xor(x, 32); const f32x2 cs = RT[t * 32 + (lane & 31)];
          const float y = (lane < 32) ? (x * cs.x - xo * cs.y) : (x * cs.x + xo * cs.y);
          KPE[(size_t)t * 64 + lane] = f2bf(y); }
    }
}

DI void phase_ew2(const Ctx& C, int l) {
    inptr_t in = C.in; unsigned char* ws = C.ws;
    const bf16_t* PRW = (const bf16_t*)(ws + WS_PRW); const bf16_t* LO = (const bf16_t*)(ws + WS_LORAO);
    bf16_t* SR = (bf16_t*)(ws + WS_U); bf16_t* SW = SR + (size_t)NT * 1024; bf16_t* SK = SW + (size_t)NT * 1024; bf16_t* SV = SK + (size_t)NT * 1024;
    bf16_t* SA = SV + (size_t)NT * 1024; bf16_t* SB = SA + (size_t)NT * 1024; bf16_t* VF = (bf16_t*)(ws + WS_VFIRST);
    const float* mu = in[9] + (size_t)l * RW_COLS; const float* w0 = in[11] + (size_t)l * 1024; const float* a0 = in[13] + (size_t)l * 1024; const float* v0 = in[15];
    const float* kkw = in[18] + (size_t)l * 1024; const float* kaw = in[19] + (size_t)l * 1024;
    const int lane = C.lane;
#pragma unroll 1
    for (int j = 0; j < 2; ++j) {
        const int c0 = 8 * lane + 512 * j;
        float mu8[3][8], w0v[8], a0v[8], kkv[8], kav[8], v0v[8];
#pragma unroll
        for (int e = 0; e < 2; ++e) {
#pragma unroll
            for (int q = 0; q < 3; ++q) { const f32x4 m = *(const f32x4*)(mu + q * 1024 + c0 + 4 * e);
#pragma unroll
                for (int i = 0; i < 4; ++i) mu8[q][4 * e + i] = m[i]; }
            const f32x4 x0 = *(const f32x4*)(w0 + c0 + 4 * e), x1 = *(const f32x4*)(a0 + c0 + 4 * e), x2 = *(const f32x4*)(kkw + c0 + 4 * e), x3 = *(const f32x4*)(kaw + c0 + 4 * e);
            f32x4 x4 = (f32x4){0.f, 0.f, 0.f, 0.f}; if (l == 1) x4 = *(const f32x4*)(v0 + c0 + 4 * e);
#pragma unroll
            for (int i = 0; i < 4; ++i) { w0v[4 * e + i] = x0[i]; a0v[4 * e + i] = x1[i]; kkv[4 * e + i] = x2[i]; kav[4 * e + i] = x3[i]; v0v[4 * e + i] = x4[i]; } }
#pragma unroll 2
        for (int t = C.gw; t < NT; t += C.ngw) {
            const bool first = (t % SEQ) == 0;
            const bf16_t* p = PRW + (size_t)t * RW_COLS; const bf16_t* lo = LO + (size_t)t * 4096;
            float xs[3][8];
#pragma unroll
            for (int q = 0; q < 3; ++q) { const int col = q * 1024 + c0;
                const u32x4 cu = *(const u32x4*)(p + col); u32x4 pv = (u32x4){0u, 0u, 0u, 0u}; if (!first) pv = *(const u32x4*)(p + col - RW_COLS);
#pragma unroll
                for (int e = 0; e < 4; ++e) { const float c_lo = bflo(cu[e]), c_hi = bfhi(cu[e]), p_lo = bflo(pv[e]), p_hi = bfhi(pv[e]);
                    xs[q][2 * e] = c_lo + mu8[q][2 * e] * (p_lo - c_lo); xs[q][2 * e + 1] = c_hi + mu8[q][2 * e + 1] * (p_hi - c_hi); } }
            const u32x4 lw = *(const u32x4*)(lo + c0), la = *(const u32x4*)(lo + 1024 + c0);
            u32x4 lv = (u32x4){0u, 0u, 0u, 0u}, vfv = (u32x4){0u, 0u, 0u, 0u};
            if (l == 1) { lv = *(const u32x4*)(lo + 3072 + c0); vfv = *(const u32x4*)(VF + (size_t)t * 1024 + c0); }
            float omw[8], av[8], kk[8], k2[8], v2[8]; float ssq = 0.f;
#pragma unroll
            for (int e = 0; e < 8; ++e) {
                const float lwf = (e & 1) ? bfhi(lw[e >> 1]) : bflo(lw[e >> 1]), laf = (e & 1) ? bfhi(la[e >> 1]) : bflo(la[e >> 1]);
                const float wi = w0v[e] + lwf;
                omw[e] = 1.f - __expf(-0.6065306597f * sigmoidf_(wi));
                av[e] = sigmoidf_(a0v[e] + laf);
                kk[e] = xs[1][e] * kkv[e]; ssq += kk[e] * kk[e];
                k2[e] = xs[1][e] * (1.f + (av[e] - 1.f) * kav[e]);
                v2[e] = xs[2][e];
                if (l == 1) { const float lvf = (e & 1) ? bfhi(lv[e >> 1]) : bflo(lv[e >> 1]), vff = (e & 1) ? bfhi(vfv[e >> 1]) : bflo(vfv[e >> 1]);
                    v2[e] = xs[2][e] + (vff - xs[2][e]) * sigmoidf_(v0v[e] + lvf); }
            }
            ssq += DPP_F(ssq, 0xB1); ssq += DPP_F(ssq, 0x4E); ssq += DPP_F(ssq, 0x141);
            const float inv = 1.f / fmaxf(sqrtf(ssq), 1e-12f);
            u32x4 oR, oW, oK, oV, oA, oB, oF;
#pragma unroll
            for (int e = 0; e < 4; ++e) { const float ka = kk[2 * e] * inv, kb = kk[2 * e + 1] * inv;
                oR[e] = pkh2(xs[0][2 * e], xs[0][2 * e + 1]); oW[e] = pkh2(1.f - omw[2 * e], 1.f - omw[2 * e + 1]); oK[e] = pkh2(k2[2 * e], k2[2 * e + 1]); oV[e] = pkh2(v2[2 * e], v2[2 * e + 1]);
                oA[e] = pkh2(-ka, -kb); oB[e] = pkh2(ka * av[2 * e], kb * av[2 * e + 1]);     oF[e] = pk2(xs[2][2 * e], xs[2][2 * e + 1]); }
            const size_t o = (size_t)t * 1024 + c0;
            *(u32x4*)(SR + o) = oR; *(u32x4*)(SW + o) = oW; *(u32x4*)(SK + o) = oK; *(u32x4*)(SV + o) = oV; *(u32x4*)(SA + o) = oA; *(u32x4*)(SB + o) = oB;
            if (l == 0) *(u32x4*)(VF + o) = oF;
        }
    }
    bf16_t* QM = (bf16_t*)(ws + WS_QM); const f32x2* RT = (const f32x2*)(ws + WS_ROPE);
    const int gt = C.wg * 512 + C.tid, ngt = C.G * 512;
    for (int i = gt; i < NT * 4 * 32; i += ngt) { const int t = i >> 7, h = (i >> 5) & 3, j = i & 31;
        bf16_t* q = QM + (size_t)t * 768 + h * 192 + 128; const float x1 = bf2f(q[j]), x2 = bf2f(q[j + 32]); const f32x2 cs = RT[t * 32 + j];
        q[j] = f2bf(x1 * cs.x - x2 * cs.y); q[j + 32] = f2bf(x2 * cs.x + x1 * cs.y); }
}

DI float dot2z(h2_t a, h2_t b) { float d; asm("v_dot2_f32_f16 %0, %1, %2, 0" : "=v"(d) : "v"(a), "v"(b)); return d; }
DI float fma_s(float a, float b, float c) { float d; asm("v_fma_f32 %0, %1, %2, %3" : "=v"(d) : "v"(a), "v"(b), "v"(c)); return d; }
#define ROW_ALLREDUCE(x) do { \
    x += __builtin_bit_cast(float, __builtin_amdgcn_update_dpp(0, __builtin_bit_cast(int, x), 0x128, 0xf, 0xf, true)); \
    x += __builtin_bit_cast(float, __builtin_amdgcn_update_dpp(0, __builtin_bit_cast(int, x), 0x124, 0xf, 0xf, true)); \
    x += __builtin_bit_cast(float, __builtin_amdgcn_update_dpp(0, __builtin_bit_cast(int, x), 0x122, 0xf, 0xf, true)); \
    x += __builtin_bit_cast(float, __builtin_amdgcn_update_dpp(0, __builtin_bit_cast(int, x), 0x121, 0xf, 0xf, true)); } while (0)

DI void phase_scan(const Ctx& C, int l) {
    unsigned char* ws = C.ws; inptr_t in = C.in;
    const bf16_t* SR = (const bf16_t*)(ws + WS_U); float* Yf = (float*)(ws + WS_H);
    constexpr int CH = 32, VECB = CH * 128, BUFB = 5 * VECB + CH * 64, OB = 2 * BUFB;
    LAS unsigned char* lds = C.lds;
    const int tid = C.tid, lane = C.lane, wave = C.wave;
    for (int u = C.vcu; u < 256; u += C.G) {
        const int bh = u >> 2, rg = u & 3, b = bh >> 4, h = bh & 15;
        const size_t tb = (size_t)b * SEQ; const int cb = h * 64;
        const int lt = tid - 256;
        u32x4 pre[3][6];
#define LD_CHUNK(set, c_) do { const size_t t_ = tb + (size_t)(c_) * CH + (lt >> 3); const int j_ = lt & 7; \
            _Pragma("unroll") for (int vq = 0; vq < 5; ++vq) { const int arr = (vq < 3) ? vq : vq + 1; \
                pre[set][vq] = *(const u32x4*)(SR + (size_t)arr * NT * 1024 + t_ * 1024 + cb + 8 * j_); } \
            if (lt < 64) { const size_t tv_ = tb + (size_t)(c_) * CH + (lt >> 1); \
                pre[set][5] = *(const u32x4*)(SR + (size_t)3 * NT * 1024 + tv_ * 1024 + cb + 16 * rg + 8 * (lt & 1)); } } while (0)
#define ST_CHUNK(set, buf_) do { const int step_ = lt >> 3, j_ = lt & 7;     \
            _Pragma("unroll") for (int vq = 0; vq < 5; ++vq) *(LAS u32x4*)(lds + (buf_) * BUFB + vq * VECB + step_ * 128 + j_ * 16) = pre[set][vq]; \
            if (lt < 64) { const u32x4 p = pre[set][5]; LAS u32x4* d = (LAS u32x4*)(lds + (buf_) * BUFB + 5 * VECB + (lt >> 1) * 64 + (lt & 1) * 32);     \
                d[0] = (u32x4){(p.x & 0xffffu) | (p.x << 16), (p.x >> 16) | (p.x & 0xffff0000u), (p.y & 0xffffu) | (p.y << 16), (p.y >> 16) | (p.y & 0xffff0000u)}; \
                d[1] = (u32x4){(p.z & 0xffffu) | (p.z << 16), (p.z >> 16) | (p.z & 0xffff0000u), (p.w & 0xffffu) | (p.w << 16), (p.w >> 16) | (p.w & 0xffff0000u)}; } } while (0)
        h2_t S01 = {(_Float16)0.f, (_Float16)0.f}, S23 = {(_Float16)0.f, (_Float16)0.f};
        const int ks = lane & 15, rowl = wave * 4 + (lane >> 4);
        constexpr int NCH = SEQ / CH;
        const int n_bg = N_MOE_ITEMS + (l == 0 ? N_SMALL_ITEMS : 0);
#define BG_DESC(it_) (((it_) < N_MOE_ITEMS) ? moe_tr_desc(l, (it_), in, ws) : small_tr_desc(1, (it_) - N_MOE_ITEMS, in, ws + WS_L1OFF))
        float tq[32]; int mo_it = (C.wg * 4 + (wave - 4)); bool mo_pending = false; TrDesc mo_d{};
        LAS float* mo_scr = (LAS float*)(lds + OB + 2 * CH * 64) + (wave - 4) * (64 * 33);
        if (wave >= 4) { LD_CHUNK(0, 0); LD_CHUNK(1, 1); LD_CHUNK(2, 2); ST_CHUNK(0, 0); LD_CHUNK(0, 3); }
        __syncthreads();
#define SCAN_ITER(c, setn) do { \
            const int buf = (c) & 1; \
            if (wave >= 4) { \
                if ((c) + 1 < NCH) { ST_CHUNK(setn, buf ^ 1); if ((c) + 4 < NCH) LD_CHUNK(setn, (c) + 4); } \
                if ((c) > 0 && lt < 128) { \
                    const int step = lt >> 2, q4 = lt & 3; const LAS float* ob_ = (const LAS float*)(lds + OB + (((c) - 1) & 1) * (CH * 64)) + (step >> 4) * 256 + (step & 15); \
                    const f32x4 o = {ob_[(4 * q4 + 0) * 16], ob_[(4 * q4 + 1) * 16], ob_[(4 * q4 + 2) * 16], ob_[(4 * q4 + 3) * 16]}; \
                    *(f32x4*)(Yf + (tb + (size_t)((c) - 1) * CH + step) * 1024 + cb + 16 * rg + 4 * q4) = o; } \
                if (((c) & 1) == 0) { if (mo_pending) { tr_store(mo_d, tq, mo_scr, lane); mo_pending = false; } \
                    if (mo_it < n_bg) { mo_d = BG_DESC(mo_it); tr_load(mo_d, tq, lane); mo_pending = true; mo_it += C.G * 4; } } \
            } else { SCAN_BODY(buf); } \
            __syncthreads(); } while (0)
#define SC_LD(X, s_) do { const int so_ = ((s_) & (CH - 1)) * 128; X##r = *(const LAS h4_t*)(bp + 0 * VECB + so_); X##w = *(const LAS h4_t*)(bp + 1 * VECB + so_); X##k = *(const LAS h4_t*)(bp + 2 * VECB + so_); \
            X##a = *(const LAS h4_t*)(bp + 3 * VECB + so_); X##b = *(const LAS h4_t*)(bp + 4 * VECB + so_); X##v = vp[((s_) & (CH - 1)) * 16]; } while (0)
#define DPPF(x, ctl) __builtin_bit_cast(float, __builtin_amdgcn_update_dpp(0, __builtin_bit_cast(int, x), ctl, 0xf, 0xf, true))
#define H_LO(x) __builtin_shufflevector(x, x, 0, 1)
#define H_HI(x) __builtin_shufflevector(x, x, 2, 3)
#define SC_DOT(x) __builtin_amdgcn_fdot2(S01, H_LO(x), dot2z(S23, H_HI(x)), false)
#define SC_FIRST(X) do { float sa = SC_DOT(X##a); \
            const h2_t t01 = S01 * H_LO(X##w) + X##v * H_LO(X##k), t23 = S23 * H_HI(X##w) + X##v * H_HI(X##k); \
            ROW_ALLREDUCE(sa); \
            const _Float16 sh = (_Float16)sa; const h2_t sa2 = {sh, sh}; \
            S01 = sa2 * H_LO(X##b) + t01; S23 = sa2 * H_HI(X##b) + t23; } while (0)
#define SC_PAIR(X, Y, s_) do { float o = SC_DOT(X##r); float sa = SC_DOT(Y##a); \
            const h2_t t01 = S01 * H_LO(Y##w) + Y##v * H_LO(Y##k), t23 = S23 * H_HI(Y##w) + Y##v * H_HI(Y##k); \
            sa += DPPF(sa, 0x128); o += DPPF(o, 0x128); sa += DPPF(sa, 0x124); o += DPPF(o, 0x124); sa += DPPF(sa, 0x122); o += DPPF(o, 0x122); sa += DPPF(sa, 0x121); o += DPPF(o, 0x121); \
            const _Float16 sh = (_Float16)sa; const h2_t sa2 = {sh, sh}; \
            S01 = sa2 * H_LO(Y##b) + t01; S23 = sa2 * H_HI(Y##b) + t23; \
            osel = (ks == (((s_) - 1) & 15)) ? o : osel; if ((((s_) - 1) & 15) == 15) op16[(((s_) - 1) >> 4) * 256] = osel; } while (0)
#define SC_LAST(X, s_) do { float o = SC_DOT(X##r); ROW_ALLREDUCE(o); osel = (ks == ((s_) & 15)) ? o : osel; op16[((s_) >> 4) * 256] = osel; } while (0)
#define SCAN_BODY(buf_) do { \
            const LAS unsigned char* bp = lds + (buf_) * BUFB + ks * 8; \
            const LAS h2_t* vp = (const LAS h2_t*)(lds + (buf_) * BUFB + 5 * VECB) + rowl; \
            LAS float* op16 = (LAS float*)(lds + OB + (buf_) * (CH * 64)) + rowl * 16 + ks; float osel = 0.f;     \
            h4_t Ar, Aw, Ak, Aa, Ab, Br, Bw, Bk, Ba, Bb, Cr, Cw, Ck, Ca, Cb, Dr, Dw, Dk, Da, Db; h2_t Av, Bv, Cv, Dv; \
            SC_LD(A, 0); SC_LD(B, 1); SC_LD(C, 2); SC_LD(D, 3); \
            SC_FIRST(A); \
            _Pragma("unroll 2") for (int s = 0; s < CH - 4; s += 4) { \
                SC_PAIR(A, B, s + 1); SC_LD(A, s + 4); \
                SC_PAIR(B, C, s + 2); SC_LD(B, s + 5); \
                SC_PAIR(C, D, s + 3); SC_LD(C, s + 6); \
                SC_PAIR(D, A, s + 4); SC_LD(D, s + 7); } \
            SC_PAIR(A, B, CH - 3); SC_PAIR(B, C, CH - 2); SC_PAIR(C, D, CH - 1); SC_LAST(D, CH - 1); } while (0)
#pragma unroll 1
        for (int c = 0; c < NCH; c += 3) { SCAN_ITER(c, 1); if (c + 1 < NCH) SCAN_ITER(c + 1, 2); if (c + 2 < NCH) SCAN_ITER(c + 2, 0); }
#undef SC_LD
#undef SC_FIRST
#undef SC_PAIR
#undef SC_LAST
#undef DPPF
#undef H_LO
#undef H_HI
#undef SC_DOT
#undef SCAN_BODY
#undef SCAN_ITER
#undef LD_CHUNK
#undef ST_CHUNK
        if (wave >= 4) { if (mo_pending) tr_store(mo_d, tq, mo_scr, lane);
            for (; mo_it < n_bg; mo_it += C.G * 4) { const TrDesc d = BG_DESC(mo_it); tr_load(d, tq, lane); tr_store(d, tq, mo_scr, lane); } }
#undef BG_DESC
        if (wave >= 4 && lt < 128) { const int c = NCH; const int step = lt >> 2, q4 = lt & 3; const LAS float* ob_ = (const LAS float*)(lds + OB + ((c - 1) & 1) * (CH * 64)) + (step >> 4) * 256 + (step & 15);
            const f32x4 o = {ob_[(4 * q4 + 0) * 16], ob_[(4 * q4 + 1) * 16], ob_[(4 * q4 + 2) * 16], ob_[(4 * q4 + 3) * 16]};
            *(f32x4*)(Yf + (tb + (size_t)(c - 1) * CH + step) * 1024 + cb + 16 * rg + 4 * q4) = o; }
        __syncthreads();
    }
}

DI void phase_post(const Ctx& C, int l) {
    inptr_t in = C.in; unsigned char* ws = C.ws;
    const float* Yf = (const float*)(ws + WS_H); const bf16_t* LO = (const bf16_t*)(ws + WS_LORAO);
    const bf16_t* SR = (const bf16_t*)(ws + WS_U); const bf16_t* SK = SR + (size_t)2 * NT * 1024; const bf16_t* SV = SR + (size_t)3 * NT * 1024;
    bf16_t* Y = (bf16_t*)(ws + WS_PRW);
    const float* rk = in[20] + (size_t)l * 1024; const float* lnw = in[21] + (size_t)l * 1024; const float* lnb = in[22] + (size_t)l * 1024;
    const int lane = C.lane;
    for (int t = C.gw; t < NT; t += C.ngw) {
#pragma unroll
        for (int j = 0; j < 2; ++j) {
            const int c0 = 8 * lane + 512 * j; const size_t o = (size_t)t * 1024 + c0;
            const f32x4 y0 = *(const f32x4*)(Yf + o), y1 = *(const f32x4*)(Yf + o + 4);
            const u32x4 rr = *(const u32x4*)(SR + o), kq = *(const u32x4*)(SK + o), vq = *(const u32x4*)(SV + o), gq = *(const u32x4*)(LO + (size_t)t * 4096 + 2048 + c0);
            float y[8], rk8[8], lw8[8], lb8[8];
#pragma unroll
            for (int e = 0; e < 2; ++e) { const f32x4 a = *(const f32x4*)(rk + c0 + 4 * e), b = *(const f32x4*)(lnw + c0 + 4 * e), c = *(const f32x4*)(lnb + c0 + 4 * e);
#pragma unroll
                for (int i = 0; i < 4; ++i) { rk8[4 * e + i] = a[i]; lw8[4 * e + i] = b[i]; lb8[4 * e + i] = c[i]; y[4 * e + i] = e ? y1[i] : y0[i]; } }
            float sm = 0.f, bs = 0.f; float r8[8], k8[8], v8[8], g8[8];
#pragma unroll
            for (int e = 0; e < 8; ++e) { r8[e] = (e & 1) ? hfhi(rr[e >> 1]) : hflo(rr[e >> 1]); k8[e] = (e & 1) ? hfhi(kq[e >> 1]) : hflo(kq[e >> 1]);
                v8[e] = (e & 1) ? hfhi(vq[e >> 1]) : hflo(vq[e >> 1]); g8[e] = (e & 1) ? bfhi(gq[e >> 1]) : bflo(gq[e >> 1]);
                sm += y[e]; bs += r8[e] * k8[e] * rk8[e]; }
            sm += DPP_F(sm, 0xB1); sm += DPP_F(sm, 0x4E); sm += DPP_F(sm, 0x141);
            bs += DPP_F(bs, 0xB1); bs += DPP_F(bs, 0x4E); bs += DPP_F(bs, 0x141);
            const float mean = sm * (1.f / 64.f); float vs = 0.f;
#pragma unroll
            for (int e = 0; e < 8; ++e) { y[e] -= mean; vs += y[e] * y[e]; }
            vs += DPP_F(vs, 0xB1); vs += DPP_F(vs, 0x4E); vs += DPP_F(vs, 0x141);
            const float rs = rsqrtf(vs * (1.f / 64.f) + 64e-5f);
            u32x4 ov;
#pragma unroll
            for (int e = 0; e < 4; ++e) { const float o0 = (y[2 * e] * rs * lw8[2 * e] + lb8[2 * e] + bs * v8[2 * e]) * g8[2 * e], o1 = (y[2 * e + 1] * rs * lw8[2 * e + 1] + lb8[2 * e + 1] + bs * v8[2 * e + 1]) * g8[2 * e + 1];
                ov[e] = pk2(o0, o1); }
            *(u32x4*)(Y + (size_t)t * 2048 + c0) = ov;
        }
    }
}

struct AttnP {
    const bf16_t* Q; int qpitch, qcol0;
    const bf16_t* K1; int k1pitch, k1col0;
    const bf16_t* K2; int k2pitch, k2col0;
    const bf16_t* V; int vpitch, vcol0;
    bf16_t* O; int opitch, ocol0;
    size_t qrow0, krow0;
    int q0;
    int nkeys;
    float c1;
    const int* pos; const float* lut;
    float lam, outscale; const float* subw;
    int dbg;
};

template <int DQK, int DK1, int MODE, int KT, int PFD>
DI void attn_unit(LAS unsigned char* lds, const AttnP& P) {
    constexpr int DV = 128, KP = DQK * 2 + 16, VP = DV * 2 + 64;
    constexpr int NBLK = KT / 32;
    constexpr int KTILE = KT * KP, VTILE = KT * VP;
    constexpr int NVT = (MODE == 0) ? 1 : 2;
    constexpr int VSLOT = NVT * VTILE + 256;
    constexpr bool ONEB = (MODE != 2);
    constexpr int KSLOT = 2 * KTILE, NKS = ONEB ? 2 : 1, NVS = ONEB ? 3 : 2;
    constexpr int OFF_V = NKS * KSLOT, OFF_POS = NVT * VTILE, OFF_LUT = OFF_V + NVS * VSLOT, OFF_END = OFF_LUT + 512;
    static_assert(!ONEB || PFD == 1, "one-barrier loop uses a single prefetch set");
    constexpr int OFF_OST = 4 * 17408, OSTP = 272;
    static_assert(OFF_END <= LDS_MAIN && OFF_OST + 4 * 32 * OSTP <= LDS_MAIN, "attention LDS");
    constexpr int KCH = DQK / 8, K1CH = DK1 / 8;
    constexpr int NKC = 2 * KT * KCH, NVC = NVT * KT * 16, NKCH = NKC / 512, NVCH = NVC / 512, NCHK = NKCH + NVCH;
    static_assert(NKC % 512 == 0 && NVC % 512 == 0, "chunks");
    constexpr float NEG = -1e30f, THR = 8.f;
    constexpr int KSTEP = (MODE == 0) ? KT : 2 * KT;
    int tid = threadIdx.x; asm volatile("" : "+v"(tid));
    const int lane = tid & 63, wave = __builtin_amdgcn_readfirstlane(tid >> 6);
    const int qg = wave >> 1, st = wave & 1, r32 = lane & 31, h2 = lane >> 5;
    const int qw0 = P.q0 + 32 * qg;
    const int myq = qw0 + r32;
    bf16x8 qf[DQK / 16];
    {
        const bf16_t* qp = P.Q + (P.qrow0 + myq) * (size_t)P.qpitch + P.qcol0 + ((MODE == 0) ? st * 64 : 0) + 8 * h2;
#pragma unroll
        for (int ks = 0; ks < DQK / 16; ++ks) qf[ks] = *(const bf16x8*)(qp + 16 * ks);
    }
    int mypos = 0, posq0 = 0;
    if constexpr (MODE == 0) { mypos = P.pos[myq]; posq0 = P.pos[qw0]; if (tid < 128) ((LAS float*)(lds + OFF_LUT))[tid] = P.lut[tid]; }
    f32x16 o[4];
#pragma unroll
    for (int d = 0; d < 4; ++d)
#pragma unroll
        for (int i = 0; i < 16; ++i) o[d][i] = 0.f;
    float m_run = NEG, l_run = 0.f;
    const int nsteps = P.nkeys / KSTEP;
    const char* gp[NCHK]; unsigned adv[NCHK]; unsigned ldst[NCHK];
#pragma unroll
    for (int i = 0; i < NKCH; ++i) { const int c = tid + 512 * i; const int s = c / (KT * KCH), rc = c % (KT * KCH), row = rc / KCH, ch = rc % KCH;
        const int key = (MODE == 0) ? row : s * KT + row;
        if (ch < K1CH) { gp[i] = (const char*)(P.K1 + (P.krow0 + key) * (size_t)P.k1pitch + P.k1col0 + ((MODE == 0) ? s * 64 : 0) + ch * 8); adv[i] = (unsigned)(KSTEP * P.k1pitch * 2); }
        else { gp[i] = (const char*)(P.K2 + (P.krow0 + key) * (size_t)P.k2pitch + P.k2col0 + (ch - K1CH) * 8); adv[i] = (unsigned)(KSTEP * P.k2pitch * 2); }
        ldst[i] = (unsigned)(s * KTILE + row * KP + ch * 16); }
#pragma unroll
    for (int i = 0; i < NVCH; ++i) { const int c2 = tid + 512 * i; const int s = c2 / (KT * 16), rc = c2 % (KT * 16), row = rc / 16, ch = rc % 16;
        const int key = (MODE == 0) ? row : s * KT + row;
        gp[NKCH + i] = (const char*)(P.V + (P.krow0 + key) * (size_t)P.vpitch + P.vcol0 + ch * 8); adv[NKCH + i] = (unsigned)(KSTEP * P.vpitch * 2);
        ldst[NKCH + i] = (unsigned)(s * VTILE + row * VP + ch * 16); }
    u32x4 preK[PFD][NKCH], preV[PFD][NVCH]; int prepos[2] = {0, 0};
#define KSET(par) ((PFD == 2) ? ((par) ^ 1) : 0)
#define VSET(par) ((PFD == 2) ? (par) : 0)
#define ATT_PREFETCH_K(set_) do { _Pragma("unroll") for (int i = 0; i < NKCH; ++i) { preK[set_][i] = *(const u32x4*)gp[i]; gp[i] += adv[i]; } } while (0)
#define ATT_PREFETCH_V(set_, step_) do { _Pragma("unroll") for (int i = 0; i < NVCH; ++i) { preV[set_][i] = *(const u32x4*)gp[NKCH + i]; gp[NKCH + i] += adv[NKCH + i]; } \
        if constexpr (MODE == 0) { if (tid < KT) prepos[set_] = P.pos[(step_) * KT + tid]; } } while (0)
#define ATT_STAGE_K(set_, ko_) do { _Pragma("unroll") for (int i = 0; i < NKCH; ++i) *(LAS u32x4*)(lds + (ko_) + ldst[i]) = preK[set_][i]; } while (0)
#define ATT_STAGE_V(set_, vo_) do { _Pragma("unroll") for (int i = 0; i < NVCH; ++i) *(LAS u32x4*)(lds + (vo_) + ldst[NKCH + i]) = preV[set_][i]; \
        if constexpr (MODE == 0) { if (tid < KT) ((LAS int*)(lds + (vo_) + OFF_POS))[tid] = prepos[set_]; } } while (0)
#define ATT_QK(dst, ko_) do { const LAS unsigned char* kb_ = lds + (ko_) + st * KTILE + r32 * KP + 16 * h2; \
        _Pragma("unroll") for (int blk = 0; blk < NBLK; ++blk) { \
            _Pragma("unroll") for (int i = 0; i < 16; ++i) dst[blk][i] = 0.f; \
            _Pragma("unroll") for (int ks = 0; ks < DQK / 16; ++ks) { const bf16x8 kf = *(const LAS bf16x8*)(kb_ + blk * 32 * KP + ks * 32); dst[blk] = __builtin_amdgcn_mfma_f32_32x32x16_bf16(kf, qf[ks], dst[blk], 0, 0, 0); } } } while (0)
#define ATT_VLD(j_) do { const int d_ = (j_) / (2 * NBLK), r_ = (j_) % (2 * NBLK); const LAS unsigned char* vp_ = vb_ + (16 * r_) * VP + d_ * 64; \
            vlo_[(j_) & 1] = __builtin_bit_cast(s16x4, __builtin_amdgcn_ds_read_tr16_b64_v4i16((LAS v4i16_t*)vp_)); \
            vhi_[(j_) & 1] = __builtin_bit_cast(s16x4, __builtin_amdgcn_ds_read_tr16_b64_v4i16((LAS v4i16_t*)(vp_ + 8 * VP))); } while (0)
#define ATT_PV(vo_) do { const int sv_ = (MODE == 0) ? 0 : st; \
        const LAS unsigned char* vb_ = lds + (vo_) + sv_ * VTILE + (4 * h2 + ((lane & 15) >> 2)) * VP + ((lane >> 4) & 1) * 32 + (lane & 3) * 8; \
        s16x4 vlo_[2], vhi_[2]; ATT_VLD(0); \
        _Pragma("unroll") for (int j = 0; j < 8 * NBLK; ++j) { if (j + 1 < 8 * NBLK) ATT_VLD(j + 1); \
            const s16x4 lo_ = vlo_[j & 1], hi_ = vhi_[j & 1]; const bf16x8 vf_ = {lo_[0], lo_[1], lo_[2], lo_[3], hi_[0], hi_[1], hi_[2], hi_[3]}; \
            const int d_ = j / (2 * NBLK), r_ = j % (2 * NBLK); \
            o[d_] = __builtin_amdgcn_mfma_f32_32x32x16_bf16(vf_, pf[r_ >> 1][r_ & 1], o[d_], 0, 0, 0); } } while (0)
    f32x16 sc[NBLK]; bf16x8 pf[NBLK][2]; bool pv_pending = false;
    const bool order_b = (wave & 1) != 0;
    auto att_body = [&](int step, int vo_cur, int vo_prev, int ko_next) {
        const int k0 = step * KSTEP + ((MODE == 0) ? 0 : st * KT);
        const bool valid_next = (step + 1 < nsteps) && (MODE == 2 || k0 + KSTEP <= qw0 + 31);
        const bool valid = (MODE == 2) || (k0 <= qw0 + 31);
        if (!order_b && pv_pending && !(P.dbg & 1)) ATT_PV(vo_prev);
        pv_pending = valid && !order_b;
        if (valid && !(P.dbg & 2)) {
        const bool need_mask = (MODE != 2) && (k0 + KT - 1 > qw0);
        float bb = 0.f; bool near = false;
        if constexpr (MODE == 0) {
            const LAS float* lut = (const LAS float*)(lds + OFF_LUT);
            const LAS int* pk = (const LAS int*)(lds + vo_cur + OFF_POS);
            near = (posq0 - pk[KT - 1]) < 127;
            if (near) {
#pragma unroll
                for (int blk = 0; blk < NBLK; ++blk)
#pragma unroll
                    for (int i = 0; i < 16; ++i) { const int kl = 32 * blk + (i & 3) + 8 * (i >> 2) + 4 * h2; int rel = mypos - pk[kl]; rel = rel < 0 ? 0 : (rel > 127 ? 127 : rel);
                        sc[blk][i] = sc[blk][i] * P.c1 + lut[rel]; }
            } else bb = lut[127];
        }
        if (need_mask) {
#pragma unroll
            for (int blk = 0; blk < NBLK; ++blk)
#pragma unroll
                for (int i = 0; i < 16; ++i) { const int key = k0 + 32 * blk + (i & 3) + 8 * (i >> 2) + 4 * h2; if (key > myq) sc[blk][i] = NEG; }
        }
        const float cc = near ? 1.f : P.c1;
        float mx = sc[0][0];
#pragma unroll
        for (int blk = 0; blk < NBLK; ++blk)
#pragma unroll
            for (int i = 0; i < 16; ++i) mx = fmaxf(mx, sc[blk][i]);
        { const int mi = __builtin_bit_cast(int, mx); auto rr = __builtin_amdgcn_permlane32_swap(mi, mi, false, false); mx = fmaxf(__builtin_bit_cast(float, (int)rr[0]), __builtin_bit_cast(float, (int)rr[1])); }
        mx = mx * cc + bb;
        if (__any(mx > m_run + THR)) {
            const float m_new = fmaxf(m_run, mx);
            const float alpha = __builtin_amdgcn_exp2f(m_run - m_new);
            m_run = m_new; l_run *= alpha;
#pragma unroll
            for (int d = 0; d < 4; ++d)
#pragma unroll
                for (int i = 0; i < 16; ++i) o[d][i] *= alpha;
        }
        const float off = bb - m_run;
        float psum = 0.f;
#pragma unroll
        for (int blk = 0; blk < NBLK; ++blk)
#pragma unroll
            for (int i = 0; i < 16; ++i) { const float p = __builtin_amdgcn_exp2f(__builtin_fmaf(sc[blk][i], cc, off)); sc[blk][i] = p; psum += p; }
        l_run += psum;
#pragma unroll
        for (int blk = 0; blk < NBLK; ++blk)
#pragma unroll
            for (int s16 = 0; s16 < 2; ++s16) { u32x4 w; w.x = pk2(sc[blk][8 * s16 + 0], sc[blk][8 * s16 + 1]); w.y = pk2(sc[blk][8 * s16 + 2], sc[blk][8 * s16 + 3]);
                w.z = pk2(sc[blk][8 * s16 + 4], sc[blk][8 * s16 + 5]); w.w = pk2(sc[blk][8 * s16 + 6], sc[blk][8 * s16 + 7]); pf[blk][s16] = __builtin_bit_cast(bf16x8, w); }
        }
        if (order_b && valid && !(P.dbg & 1)) ATT_PV(vo_cur);
        if (valid_next && !(P.dbg & 4)) ATT_QK(sc, ko_next);
        };
#define ATT_BODY(step, vc, vp) att_body(step, vc, vp, 0)
#define ATT_BAR() asm volatile("s_waitcnt lgkmcnt(0)\n\ts_barrier" ::: "memory")
    if constexpr (ONEB) {
        ATT_PREFETCH_K(0);
        __syncthreads();
        ATT_STAGE_K(0, 0);
        if (nsteps > 1) ATT_PREFETCH_K(0);
        ATT_PREFETCH_V(0, 0);
        if (nsteps > 1) ATT_STAGE_K(0, KSLOT);
        ATT_STAGE_V(0, OFF_V);
        if (nsteps > 2) ATT_PREFETCH_K(0);
        if (nsteps > 1) ATT_PREFETCH_V(0, 1);
        __syncthreads();
        ATT_QK(sc, 0);
        int vo_prev = OFF_V + 2 * VSLOT, vo_cur = OFF_V, vo_next = OFF_V + VSLOT;
        for (int step = 0; step < nsteps; ++step) {
            ATT_BAR();
            const int ko_next = ((step + 1) & 1) * KSLOT, ko_free = (step & 1) * KSLOT;
            if (!(P.dbg & 8)) {
                if (step + 2 < nsteps) ATT_STAGE_K(0, ko_free);
                if (step + 1 < nsteps) ATT_STAGE_V(0, vo_next);
                if (step + 3 < nsteps) ATT_PREFETCH_K(0);
                if (step + 2 < nsteps) ATT_PREFETCH_V(0, step + 2); }
            att_body(step, vo_cur, vo_prev, ko_next);
            const int tmp_ = vo_prev; vo_prev = vo_cur; vo_cur = vo_next; vo_next = tmp_;
        }
        if (pv_pending) ATT_PV(vo_prev);
    } else {
    ATT_PREFETCH_K(0);
    __syncthreads();
    ATT_STAGE_K(0, 0);
    if (nsteps > 1) ATT_PREFETCH_K(KSET(0));
    if (PFD == 2 && nsteps > 2) ATT_PREFETCH_K(0);
    ATT_PREFETCH_V(0, 0);
    if (PFD == 2 && nsteps > 1) ATT_PREFETCH_V(1, 1);
    __syncthreads();
    ATT_QK(sc, 0);
#define ATT_ITER(step, par) do { \
        const int vo_cur = OFF_V + (par) * VSLOT, vo_prev = OFF_V + ((par) ^ 1) * VSLOT; \
        ATT_BAR();                                                  \
        if (!(P.dbg & 8)) { if ((step) + 1 < nsteps) ATT_STAGE_K(KSET(par), 0); \
        ATT_STAGE_V(VSET(par), vo_cur); } \
        ATT_BAR();                                                  \
        if (!(P.dbg & 8)) { if ((step) + 1 + PFD < nsteps) ATT_PREFETCH_K(KSET(par)); \
        if ((step) + PFD < nsteps) ATT_PREFETCH_V(VSET(par), (step) + PFD); } \
        ATT_BODY(step, vo_cur, vo_prev); } while (0)
    for (int step = 0; step < nsteps; step += 2) { ATT_ITER(step, 0); if (step + 1 < nsteps) ATT_ITER(step + 1, 1); }
    if (pv_pending) ATT_PV(OFF_V + ((nsteps - 1) & 1) * VSLOT);
    }
#undef ATT_PREFETCH_K
#undef ATT_PREFETCH_V
#undef ATT_STAGE_K
#undef ATT_STAGE_V
#undef ATT_QK
#undef ATT_PV
#undef ATT_VLD
#undef ATT_ITER
#undef ATT_BAR
#undef ATT_BODY
#undef KSET
#undef VSET
    l_run += __shfl_xor(l_run, 32);
    __syncthreads();
    LAS float* mb = (LAS float*)(lds + qg * 17408);
    if (st == 1) {
        if constexpr (MODE == 0) { const float inv = 1.f / l_run;
#pragma unroll
            for (int d = 0; d < 4; ++d)
#pragma unroll
                for (int i = 0; i < 16; ++i) mb[(d * 16 + i) * 64 + lane] = o[d][i] * inv;
        } else {
#pragma unroll
            for (int d = 0; d < 4; ++d)
#pragma unroll
                for (int i = 0; i < 16; ++i) mb[(d * 16 + i) * 64 + lane] = o[d][i];
            mb[4096 + lane] = m_run; mb[4160 + lane] = l_run;
        }
    }
    __syncthreads();
    if (st == 0) {
        if constexpr (MODE == 0) {
            const float inv = 1.f / l_run; float ss = 0.f;
#pragma unroll
            for (int d = 0; d < 4; ++d)
#pragma unroll
                for (int i = 0; i < 16; ++i) { const float v = o[d][i] * inv - P.lam * mb[(d * 16 + i) * 64 + lane]; o[d][i] = v; ss += v * v; }
            ss += __shfl_xor(ss, 32);
            const float rn = rsqrtf(ss * (1.f / 128.f) + 1e-5f) * P.outscale;
#pragma unroll
            for (int d = 0; d < 4; ++d)
#pragma unroll
                for (int i = 0; i < 16; ++i) { const int dv = 32 * d + (i & 3) + 8 * (i >> 2) + 4 * h2; o[d][i] = o[d][i] * rn * P.subw[dv]; }
        } else {
            const float m1 = mb[4096 + lane], l1 = mb[4160 + lane];
            const float mt = fmaxf(m_run, m1); const float a0 = __builtin_amdgcn_exp2f(m_run - mt), a1 = __builtin_amdgcn_exp2f(m1 - mt);
            const float inv = 1.f / (l_run * a0 + l1 * a1);
#pragma unroll
            for (int d = 0; d < 4; ++d)
#pragma unroll
                for (int i = 0; i < 16; ++i) o[d][i] = (o[d][i] * a0 + mb[(d * 16 + i) * 64 + lane] * a1) * inv;
        }
        LAS unsigned char* og = lds + OFF_OST + qg * (32 * OSTP);
#pragma unroll
        for (int d = 0; d < 4; ++d)
#pragma unroll
            for (int g4 = 0; g4 < 4; ++g4) { u32x2 w; w.x = pk2(o[d][4 * g4 + 0], o[d][4 * g4 + 1]); w.y = pk2(o[d][4 * g4 + 2], o[d][4 * g4 + 3]);
                *(LAS u32x2*)(og + r32 * OSTP + (32 * d + 8 * g4 + 4 * h2) * 2) = w; }
        asm volatile("s_waitcnt lgkmcnt(0)" ::: "memory");
        bf16_t* op = P.O + (P.qrow0 + qw0) * (size_t)P.opitch + P.ocol0;
#pragma unroll
        for (int i = 0; i < 8; ++i) { const int row = 4 * i + (lane >> 4), ch = lane & 15;
            const u32x4 v = *(const LAS u32x4*)(og + row * OSTP + ch * 16);
            *(u32x4*)(op + (size_t)row * P.opitch + ch * 8) = v; }
    }
    __syncthreads();
}

DI void phase_att(const Ctx& C, int l) {
    inptr_t in = C.in; unsigned char* ws = C.ws;
    const int ATT_SEL = C.att_sel & 0xff; const int dbg = C.att_sel >> 8;
    if (ATT_SEL & 1) phase_post(C, l);
    bf16_t* Y = dbg ? (bf16_t*)(ws + WS_H) : (bf16_t*)(ws + WS_PRW); const bf16_t* PATT = (const bf16_t*)(ws + WS_PATT);
    const float lambda_init = 0.8f - 0.6f * expf(-0.3f * (float)l);
    float lam;
    { const float a = wave_sum(in[23][l * 64 + C.lane] * in[24][l * 64 + C.lane]), b = wave_sum(in[25][l * 64 + C.lane] * in[26][l * 64 + C.lane]); lam = expf(a) - expf(b) + lambda_init; }
    if (ATT_SEL & 2) for (int w = C.vcu; w < 256; w += C.G) {
        const int bh = w >> 4, j = w & 15, b = bh >> 2, h = bh & 3;
#pragma unroll 1
        for (int k = 0; k < 2; ++k) { const int qb = k ? 31 - j : j;
            AttnP P; P.Q = PATT; P.qpitch = PATT_COLS; P.qcol0 = h * 128; P.K1 = PATT; P.k1pitch = PATT_COLS; P.k1col0 = 512 + h * 128; P.K2 = PATT; P.k2pitch = 0; P.k2col0 = 0;
            P.V = PATT; P.vpitch = PATT_COLS; P.vcol0 = 1024 + h * 128; P.O = Y; P.opitch = 2048; P.ocol0 = 1024 + h * 128;
            P.qrow0 = (size_t)b * SEQ; P.krow0 = (size_t)b * SEQ; P.q0 = qb * 128; P.nkeys = qb * 128 + 128; P.c1 = 0.125f * LOG2E;
            P.pos = (const int*)in[2] + b * SEQ; P.lut = (const float*)(ws + WS_LUT) + h * 128; P.lam = lam; P.outscale = 1.f - lambda_init; P.subw = in[27] + l * 128; P.dbg = dbg;
            attn_unit<64, 64, 0, 64, 1>(C.lds, P); }
    }
    const bf16_t* QM = (const bf16_t*)(ws + WS_QM); const bf16_t* KVM = (const bf16_t*)(ws + WS_KVM); const bf16_t* KPE = (const bf16_t*)(ws + WS_KPE);
    if (ATT_SEL & 4) for (int w = C.vcu; w < 256; w += C.G) {
        const int bh = w >> 4, j = w & 15, b = bh >> 2, h = bh & 3;
#pragma unroll 1
        for (int k = 0; k < 2; ++k) { const int qb = k ? 31 - j : j;
            AttnP P; P.Q = QM; P.qpitch = 768; P.qcol0 = h * 192; P.K1 = KVM; P.k1pitch = 1024; P.k1col0 = h * 256; P.K2 = KPE; P.k2pitch = 64; P.k2col0 = 0;
            P.V = KVM; P.vpitch = 1024; P.vcol0 = h * 256 + 128; P.O = Y; P.opitch = 2048; P.ocol0 = 1536 + h * 128;
            P.qrow0 = (size_t)b * SEQ; P.krow0 = (size_t)b * SEQ; P.q0 = qb * 128; P.nkeys = qb * 128 + 128; P.c1 = 0.07216878364870322f * LOG2E;
            P.pos = nullptr; P.lut = nullptr; P.lam = 0.f; P.outscale = 0.f; P.subw = nullptr; P.dbg = dbg;
            attn_unit<192, 128, 1, 32, 1>(C.lds, P); }
    }
}

DI void phase_cross(const Ctx& C) {
    unsigned char* ws = C.ws; const int dbg = 0;
    const bf16_t* CAQ = (const bf16_t*)(ws + WS_CAQ); const bf16_t* MKV = (const bf16_t*)(ws + WS_MEMKV); bf16_t* CAO = (bf16_t*)(ws + WS_CAO);
    for (int u = C.vcu; u < 512; u += C.G) {
        const int bh = u >> 5, qb = u & 31, b = bh >> 2, h = bh & 3;
        AttnP P; P.Q = CAQ; P.qpitch = 512; P.qcol0 = h * 128; P.K1 = MKV; P.k1pitch = 1024; P.k1col0 = h * 128; P.K2 = MKV; P.k2pitch = 0; P.k2col0 = 0;
        P.V = MKV; P.vpitch = 1024; P.vcol0 = 512 + h * 128; P.O = CAO; P.opitch = 512; P.ocol0 = h * 128;
        P.qrow0 = (size_t)b * SEQ; P.krow0 = (size_t)b * MEMLEN; P.q0 = qb * 128; P.nkeys = MEMLEN; P.c1 = 0.08838834764831845f * LOG2E;
        P.pos = nullptr; P.lut = nullptr; P.lam = 0.f; P.outscale = 0.f; P.subw = nullptr; P.dbg = dbg;
        attn_unit<128, 128, 2, 64, 1>(C.lds, P);
    }
}

DI void phase_route(const Ctx& C, int l) {
    inptr_t in = C.in; unsigned char* ws = C.ws;
    const float* LG = (const float*)(ws + WS_LOGITS);
    const float* bg = in[39] + l * 4; const float* be = in[41] + l * 32;
    int* EID = (int*)(ws + WS_EID); float* GATE = (float*)(ws + WS_GATE); int* CNT = (int*)(ws + WS_CNT);
    LAS int* hist = (LAS int*)(C.lds);
    const int lane = C.lane;
    for (int wgt = C.wg; wgt < 256; wgt += C.G) {
        if (C.tid < 32) hist[C.tid] = 0;
        __syncthreads();
#pragma unroll 1
        for (int r = 0; r < 8; ++r) {
            const int t = wgt * 64 + C.wave * 8 + r;
            const float raw = (lane < 36) ? LG[(size_t)t * 256 + lane] : 0.f;
            const float g0 = RDL_F(raw, 32), g1 = RDL_F(raw, 33), g2 = RDL_F(raw, 34), g3 = RDL_F(raw, 35);
            int sel = 0; float best = g0 + bg[0];
            if (g1 + bg[1] > best) { best = g1 + bg[1]; sel = 1; }
            if (g2 + bg[2] > best) { best = g2 + bg[2]; sel = 2; }
            if (g3 + bg[3] > best) { best = g3 + bg[3]; sel = 3; }
            const float gm = fmaxf(fmaxf(g0, g1), fmaxf(g2, g3));
            const float e0 = __expf(g0 - gm), e1 = __expf(g1 - gm), e2 = __expf(g2 - gm), e3 = __expf(g3 - gm);
            const float es = sel == 0 ? e0 : (sel == 1 ? e1 : (sel == 2 ? e2 : e3));
            const float pgrp = es / ((e0 + e1) + (e2 + e3));
            float val = (lane < 32 && (lane >> 3) == sel) ? raw + be[lane & 31] : -INFINITY;
            const float m1 = wave_max(val); const int i1 = __ffsll((long long)__ballot(val == m1)) - 1;
            if (lane == i1) val = -INFINITY;
            const float m2 = wave_max(val); const int i2 = __ffsll((long long)__ballot(val == m2)) - 1;
            const float r1 = __shfl(raw, i1), r2 = __shfl(raw, i2);
            const float w1 = 1.f / (1.f + __expf(r2 - r1)), w2 = 1.f - w1;
            if (lane == 0) { EID[2 * t] = i1; EID[2 * t + 1] = i2; GATE[2 * t] = w1 * pgrp; GATE[2 * t + 1] = w2 * pgrp;
                atomicAdd((int*)&hist[i1], 1); atomicAdd((int*)&hist[i2], 1); }
        }
        __syncthreads();
        if (C.tid < 32) CNT[wgt * 32 + C.tid] = hist[C.tid];
        __syncthreads();
    }
}

DI void phase_dispatch(const Ctx& C) {
    unsigned char* ws = C.ws;
    const int* EID = (const int*)(ws + WS_EID); const int* CNT = (const int*)(ws + WS_CNT);
    int* ROWMAP = (int*)(ws + WS_ROWMAP); int* ROWDST = (int*)(ws + WS_ROWDST); int* TILEEXP = (int*)(ws + WS_TILEEXP);
    LAS int* tot = (LAS int*)(C.lds); LAS int* base = tot + 32; LAS int* off = base + 32; LAS int* eid = off + 40; LAS int* posl = eid + 128;
    const int tid = C.tid;
    for (int wgt = C.wg; wgt < 256; wgt += C.G) {
        { LAS int* cl = posl + 128;
#pragma unroll
          for (int i = 0; i < 16; ++i) cl[tid + 512 * i] = CNT[tid + 512 * i];
          __syncthreads();
          if (tid < 32) { int s = 0, bsum = 0; for (int w = 0; w < 256; ++w) { const int c = cl[w * 32 + tid]; if (w == wgt) bsum = s; s += c; } tot[tid] = s; base[tid] = bsum; } }
        if (tid >= 64 && tid < 192) eid[tid - 64] = EID[wgt * 128 + (tid - 64)];
        __syncthreads();
        if (tid == 0) { int o = 0; for (int e = 0; e < 32; ++e) { off[e] = o; o += (tot[e] + 255) & ~255; } off[32] = o; }
        __syncthreads();
        if (tid < 128) { const int e = eid[tid]; int rank = 0; for (int j = 0; j < tid; ++j) rank += (eid[j] == e) ? 1 : 0;
            const int pos = off[e] + base[e] + rank; ROWMAP[pos] = wgt * 64 + (tid >> 1); ROWDST[pos] = wgt * 128 + tid; }
        if (wgt < 32) { const int e = wgt; for (int p = off[e] + tot[e] + tid; p < off[e + 1]; p += 512) { ROWMAP[p] = 0; ROWDST[p] = -1; } }
        if (wgt == 0) { if (tid < 32) { for (int tl = off[tid] >> 8; tl < (off[tid + 1] >> 8); ++tl) TILEEXP[tl] = tid; } if (tid == 0) TILEEXP[200] = off[32] >> 8; }
        __syncthreads();
    }
}

#ifndef PHASE_MASK
#define PHASE_MASK 0x1ffff
#endif
#define IN(k) (lo <= (k) && (k) < hi)
#define EN(j) ((PHASE_MASK >> (j)) & 1)
#define SEAM(k) do { if (IN(k) && IN((k) + 1)) xcd_barrier(bar); } while (0)
#define PH_BEGIN() do { int t_ = threadIdx.x; asm volatile("" : "+v"(t_)); kaptr_t ka_ = (kaptr_t)__builtin_amdgcn_kernarg_segment_ptr(); asm volatile("" : "+s"(ka_)); \
        C.lds = (LAS unsigned char*)lds_raw; C.in = (inptr_t)ka_; C.X = *(float* const CAS*)(ka_ + 360); C.ws = *(unsigned char* const CAS*)(ka_ + 368); \
        C.tid = t_; C.lane = t_ & 63; C.wave = __builtin_amdgcn_readfirstlane(t_ >> 6); { int g_ = gridDim.x, b_ = blockIdx.x; asm volatile("" : "+s"(g_), "+s"(b_)); C.G = g_; C.wg = b_; } C.gw = C.wg * 8 + C.wave; C.ngw = C.G * 8; C.vcu = (C.G % 8 == 0) ? (C.wg % 8) * (C.G / 8) + C.wg / 8 : C.wg; \
        ws = C.ws; in = C.in; } while (0)
constexpr int PPL = 16, NPHASE = 2 * PPL + 1;
template <int l>
DI void run_layer(unsigned char* lds_raw, const XcdBarrier& bar, int lo, int hi, int att_sel = 7) {
    Ctx C; unsigned char* ws; inptr_t in; C.att_sel = att_sel;
    constexpr int pb = l * PPL;

        if (EN(0) && IN(pb + 0)) { PH_BEGIN(); phase_convert(C, l); } SEAM(pb + 0);
        if (EN(1) && IN(pb + 1)) { PH_BEGIN();
            { pg8::Gemm g{(const bf16_t*)(ws + WS_XB), (const bf16_t*)(ws + wofs(l) + WS_WINT), DM, DM, DM, nullptr}; pg8::StaticOrder S; S.init(NT, INP, C.G, C.wg, DM);
              pg8::EpiBf16 E{(bf16_t*)(ws + WS_PRW), RW_COLS, (bf16_t*)(ws + WS_PATT), PATT_COLS, 13, (const float*)(ws + WS_SSQM), 1};
              pg8::gemm_phase<pg8::EpiBf16, pg8::StaticOrder>(C.lds, g, S, E); }
            { pg8::Gemm g{(const bf16_t*)(ws + WS_MEMN), (const bf16_t*)(ws + wofs(l) + WS_CAWKVT), DM, DM, DM, nullptr}; pg8::StaticOrder S; S.init(NMEM, 1024, C.G, (C.wg + C.G / 2) % C.G, DM);
              pg8::EpiBf16 E{(bf16_t*)(ws + WS_MEMKV), 1024, nullptr, 0, 1 << 30, nullptr, 1};
              pg8::gemm_phase<pg8::EpiBf16, pg8::StaticOrder>(C.lds, g, S, E); }
        } SEAM(pb + 1);
        if (EN(2) && IN(pb + 2)) { PH_BEGIN(); phase_ew1(C, l); } SEAM(pb + 2);
        if (EN(3) && IN(pb + 3)) { PH_BEGIN();
            { pg8::Gemm g{(const bf16_t*)(ws + WS_LORAA), (const bf16_t*)(ws + wofs(l) + WS_LORABT), 384, 128, 128, nullptr}; pg8::StaticOrder S; S.init(NT, 2048, C.G, C.wg, 128);
              pg8::EpiBf16 E{(bf16_t*)(ws + WS_LORAO), 4096, nullptr, 0, 1 << 30, nullptr, 1};
              pg8::gemm_phase<pg8::EpiBf16, pg8::StaticOrder>(C.lds, g, S, E); }
            { pg8::Gemm g{(const bf16_t*)(ws + WS_LORAA) + 128, (const bf16_t*)(ws + wofs(l) + WS_LORABT) + 2048 * 128, 384, 128, 128, nullptr}; pg8::StaticOrder S; S.init(NT, 1024, C.G, C.wg, 128);
              pg8::EpiBf16 E{(bf16_t*)(ws + WS_LORAO) + 2048, 4096, nullptr, 0, 1 << 30, nullptr, 1};
              pg8::gemm_phase<pg8::EpiBf16, pg8::StaticOrder>(C.lds, g, S, E); }
            if (l == 1) { pg8::Gemm g{(const bf16_t*)(ws + WS_LORAA) + 256, (const bf16_t*)(ws + wofs(l) + WS_LORABT) + 3072 * 128, 384, 128, 128, nullptr}; pg8::StaticOrder S; S.init(NT, 1024, C.G, C.wg, 128);
              pg8::EpiBf16 E{(bf16_t*)(ws + WS_LORAO) + 3072, 4096, nullptr, 0, 1 << 30, nullptr, 1};
              pg8::gemm_phase<pg8::EpiBf16, pg8::StaticOrder>(C.lds, g, S, E); }
            { pg8::Gemm g{(const bf16_t*)(ws + WS_QN), (const bf16_t*)(ws + wofs(l) + WS_WQBT), 384, 384, 384, nullptr}; pg8::StaticOrder S; S.init(NT, 768, C.G, C.wg, 384);
              pg8::EpiBf16 E{(bf16_t*)(ws + WS_QM), 768, nullptr, 0, 1 << 30, nullptr, 1};
              pg8::gemm_phase<pg8::EpiBf16, pg8::StaticOrder>(C.lds, g, S, E); }
            { pg8::Gemm g{(const bf16_t*)(ws + WS_KVN), (const bf16_t*)(ws + wofs(l) + WS_WKVBT), 256, 256, 256, nullptr}; pg8::StaticOrder S; S.init(NT, 1024, C.G, C.wg, 256);
              pg8::EpiBf16 E{(bf16_t*)(ws + WS_KVM), 1024, nullptr, 0, 1 << 30, nullptr, 1};
              pg8::gemm_phase<pg8::EpiBf16, pg8::StaticOrder>(C.lds, g, S, E); }
        } SEAM(pb + 3);
        if (EN(4) && IN(pb + 4)) { PH_BEGIN(); phase_ew2(C, l); } SEAM(pb + 4);
        if (EN(5) && IN(pb + 5)) { PH_BEGIN(); phase_scan(C, l); } SEAM(pb + 5);
        if (EN(6) && IN(pb + 6)) { PH_BEGIN(); phase_att(C, l); } SEAM(pb + 6);
        if (EN(7) && IN(pb + 7)) { PH_BEGIN();
            pg8::Gemm g{(const bf16_t*)(ws + WS_PRW), (const bf16_t*)(ws + wofs(l) + WS_WOUTT), DM, DM, DM, nullptr}; pg8::StaticOrder S; S.init(NT, DM, C.G, C.wg, DM);
            pg8::EpiResid E{l == 0 ? in[0] : nullptr, (const bf16_t*)(ws + WS_XB), (bf16_t*)(ws + WS_XB), DM, (float*)(ws + WS_PARTC)};
            pg8::gemm_phase<pg8::EpiResid, pg8::StaticOrder>(C.lds, g, S, E);
        } SEAM(pb + 7);
        if (EN(8) && IN(pb + 8)) { PH_BEGIN();
            pg8::Gemm g{(const bf16_t*)(ws + WS_XB), (const bf16_t*)(ws + wofs(l) + WS_CAWQT), DM, DM, DM, nullptr}; pg8::StaticOrder S; S.init(NT, 512, C.G, C.wg, DM);
            pg8::EpiBf16 E{(bf16_t*)(ws + WS_CAQ), 512, nullptr, 0, 1 << 30, (const float*)(ws + WS_PARTC), 32};
            pg8::gemm_phase<pg8::EpiBf16, pg8::StaticOrder>(C.lds, g, S, E);
        } SEAM(pb + 8);
        if (EN(9) && IN(pb + 9)) { PH_BEGIN(); phase_cross(C); } SEAM(pb + 9);
        if (EN(10) && IN(pb + 10)) { PH_BEGIN();
            pg8::Gemm g{(const bf16_t*)(ws + WS_CAO), (const bf16_t*)(ws + wofs(l) + WS_CAWOT), 512, 512, 512, nullptr}; pg8::StaticOrder S; S.init(NT, DM, C.G, C.wg, 512);
            pg8::EpiResid E{nullptr, (const bf16_t*)(ws + WS_XB), (bf16_t*)(ws + WS_XB), DM, (float*)(ws + WS_PARTF)};
            pg8::gemm_phase<pg8::EpiResid, pg8::StaticOrder>(C.lds, g, S, E);
        } SEAM(pb + 10);
        if (EN(11) && IN(pb + 11)) { PH_BEGIN();
            pg8::Gemm g{(const bf16_t*)(ws + WS_XB), (const bf16_t*)(ws + (l ? WS_WRB1 : WS_WRB)), DM, DM, DM, nullptr}; pg8::StaticOrder S; S.init(NT, 256, C.G, C.wg, DM);
            pg8::EpiF32 E{(float*)(ws + WS_LOGITS), 256, (const float*)(ws + WS_PARTF), 32, (float*)(ws + WS_SSQF)};
            pg8::gemm_phase<pg8::EpiF32, pg8::StaticOrder>(C.lds, g, S, E);
        } SEAM(pb + 11);
        if (EN(12) && IN(pb + 12)) { PH_BEGIN(); phase_route(C, l); } SEAM(pb + 12);
        if (EN(13) && IN(pb + 13)) { PH_BEGIN(); phase_dispatch(C); } SEAM(pb + 13);
        if (EN(14) && IN(pb + 14)) { PH_BEGIN();
            const int* TE = (const int*)(ws + WS_TILEEXP);
            pg8::Gemm g{(const bf16_t*)(ws + WS_XB), (const bf16_t*)(ws + WS_WGU), DM, DM, DM, (const int*)(ws + WS_ROWMAP)};
            pg8::MoeOrder S{TE, TE[200], 4, C.G, C.vcu, DM, (long)1024 * DM};
            pg8::EpiSiluMul E{(bf16_t*)(ws + WS_HID), DEXP, (const float*)(ws + WS_SSQF), (const int*)(ws + WS_ROWMAP)};
            pg8::gemm_phase<pg8::EpiSiluMul, pg8::MoeOrder, true>(C.lds, g, S, E);
        } SEAM(pb + 14);
        if (EN(15) && IN(pb + 15)) { PH_BEGIN();
            const int* TE = (const int*)(ws + WS_TILEEXP);
            pg8::Gemm g{(const bf16_t*)(ws + WS_HID), (const bf16_t*)(ws + WS_WD), DEXP, DEXP, DEXP, nullptr};
            pg8::MoeOrder S{TE, TE[200], 8, C.G, C.vcu, DEXP, (long)DM * DEXP};
            pg8::EpiScatter E{(bf16_t*)(ws + WS_C2), DM, (const int*)(ws + WS_ROWDST)};
            pg8::gemm_phase<pg8::EpiScatter, pg8::MoeOrder>(C.lds, g, S, E);
        } SEAM(pb + 15);
    }

__global__ void __launch_bounds__(512, 2) mk_fwd(Args args) {
    extern __shared__ __attribute__((aligned(16))) unsigned char lds_raw[];
    Ctx C;
    unsigned char* ws; inptr_t in;
    PH_BEGIN();
    volatile LAS unsigned* MISC = (volatile LAS unsigned*)(C.lds + LDS_MISC);
    if (C.tid < 64) MISC[C.tid] = 0u;
    __syncthreads();
    const int lo = args.ph_lo, hi = args.ph_hi;
    XcdBarrier bar; bar.bar = (unsigned*)(args.ws + WS_CTL) + CW_BAR; bar.x = 0; bar.st = MISC + 8;
    if (hi - lo > 1) bar = xcd_barrier_post((unsigned*)(args.ws + WS_CTL) + CW_BAR, MISC + 8);
#ifndef PROBE_MASK
#define PROBE_MASK 0
#endif
#if PROBE_MASK
#ifndef PROBE_ATT
#define PROBE_ATT 7
#endif
#define RUNP(k) do { run_layer<0>(lds_raw, bar, (k), (k) + 1); xcd_barrier(bar); if ((PROBE_MASK >> (k)) & 1) { run_layer<0>(lds_raw, bar, (k), (k) + 1, PROBE_ATT); xcd_barrier(bar); } } while (0)
    RUNP(0); RUNP(1); RUNP(2); RUNP(3); RUNP(4); RUNP(5); RUNP(6); RUNP(7); RUNP(8); RUNP(9); RUNP(10); RUNP(11); RUNP(12); RUNP(13); RUNP(14); RUNP(15);
    run_layer<1>(lds_raw, bar, PPL, 2 * PPL); xcd_barrier(bar);
#else
    run_layer<0>(lds_raw, bar, lo, hi);
    run_layer<1>(lds_raw, bar, lo, hi);
#endif
    if (EN(16) && IN(2 * PPL)) { PH_BEGIN();
        const bf16_t* C2 = (const bf16_t*)(ws + WS_C2); const float* gate = (const float*)(ws + WS_GATE);
        for (int m = C.gw; m < NT; m += C.ngw)
            norm_row(nullptr, (const bf16_t*)(ws + WS_XB) + (size_t)m * DM, nullptr, C2 + (size_t)(2 * m) * DM, C2 + (size_t)(2 * m + 1) * DM, gate[2 * m], gate[2 * m + 1], in[4], nullptr, C.X + (size_t)m * DM, C.lane);
    }
#undef IN
#undef SEAM
}

extern "C" void kernel_launch(void* const* d_in, const int* in_sizes, int n_in, void* d_out, int out_size, void* d_ws, size_t ws_size, hipStream_t stream) {
    static int grid = 0;
    if (grid == 0) {
        if (n_in != 45 || out_size != NT * DM || ws_size < WS_END) { grid = -1; return; }
        int dev = 0, cus = 0;
        if (hipGetDevice(&dev) != hipSuccess || hipDeviceGetAttribute(&cus, hipDeviceAttributeMultiprocessorCount, dev) != hipSuccess) { grid = -1; return; }
        if (hipFuncSetAttribute((const void*)mk_fwd, hipFuncAttributeMaxDynamicSharedMemorySize, LDS_BYTES) != hipSuccess) { grid = -1; return; }
        int per_cu = 0;
        (void)hipOccupancyMaxActiveBlocksPerMultiprocessor(&per_cu, (const void*)mk_fwd, 512, LDS_BYTES);
        (void)hipGetLastError();
        grid = cus;
    }
    if (grid < 0) return;
    (void)hipMemsetAsync((char*)d_ws + WS_CTL, 0, 1 * MiB, stream);
    Args a{};
    for (int i = 0; i < 45; ++i) a.in[i] = d_in[i];
    a.out = (float*)d_out; a.ws = (unsigned char*)d_ws;
#if MK_ONE_LAUNCH
    a.ph_lo = 0; a.ph_hi = NPHASE;
    hipLaunchKernelGGL(mk_fwd, dim3(grid), dim3(512), LDS_BYTES, stream, a);
#else
    for (int p = 0; p < NPHASE; ++p) { a.ph_lo = p; a.ph_hi = p + 1; hipLaunchKernelGGL(mk_fwd, dim3(grid), dim3(512), LDS_BYTES, stream, a); }
#endif
}
```

```cpp
#include <hip/hip_runtime.h>
#include <stdint.h>
#include <math.h>

#ifndef MK_ONE_LAUNCH
#define MK_ONE_LAUNCH 1
#endif

#define DI __device__ __forceinline__
#define LAS __attribute__((address_space(3)))
#define GAS __attribute__((address_space(1)))

typedef unsigned short bf16_t;
typedef short bf16x8 __attribute__((ext_vector_type(8)));
typedef short s16x4 __attribute__((ext_vector_type(4)));
typedef float f32x2 __attribute__((ext_vector_type(2)));
typedef float f32x4 __attribute__((ext_vector_type(4)));
typedef float f32x16 __attribute__((ext_vector_type(16)));
typedef unsigned u32x2 __attribute__((ext_vector_type(2)));
typedef unsigned u32x4 __attribute__((ext_vector_type(4)));
typedef __bf16 bf16x2_t __attribute__((ext_vector_type(2)));
typedef short v4i16_t __attribute__((ext_vector_type(4)));
typedef _Float16 h2_t __attribute__((ext_vector_type(2)));
typedef _Float16 h4_t __attribute__((ext_vector_type(4)));

constexpr int NB = 4, SEQ = 4096, DM = 2048, NT = NB * SEQ;
constexpr int MEMLEN = 256, NMEM = NB * MEMLEN;
constexpr int RW_DIM = 1024, RW_COLS = 3328, IN_COLS = 5568, INP = 5632;
constexpr int PATT_COLS = 2304;
constexpr int NEXP = 32, DEXP = 512;
constexpr int MOE_ROWS = 40960;
constexpr float LOG2E = 1.4426950408889634f;

constexpr size_t MiB = 1u << 20, KiB = 1024;
constexpr size_t WS_CTL = 0;
constexpr size_t WS_ROPE = 1 * MiB;
constexpr size_t WS_EID = 5 * MiB;
constexpr size_t WS_GATE = 5 * MiB + 128 * KiB;
constexpr size_t WS_CNT = 5 * MiB + 256 * KiB;
constexpr size_t WS_ROWMAP = 5 * MiB + 320 * KiB;
constexpr size_t WS_ROWDST = 5 * MiB + 512 * KiB;
constexpr size_t WS_TILEEXP = 5 * MiB + 704 * KiB;
constexpr size_t WS_WRB = 7 * MiB;
constexpr size_t WS_LOGITS = 852 * MiB;
constexpr size_t WS_SSQM = 6 * MiB;
constexpr size_t WS_SSQC = 6 * MiB + 64 * KiB;
constexpr size_t WS_SSQF = 6 * MiB + 128 * KiB;
constexpr size_t WS_LUT = 6 * MiB + 512 * KiB;
constexpr size_t WS_WINT = 8 * MiB;
constexpr size_t WS_WOUTT = 30 * MiB;
constexpr size_t WS_CAWQT = 38 * MiB;
constexpr size_t WS_CAWKVT = 40 * MiB;
constexpr size_t WS_CAWOT = 44 * MiB;
constexpr size_t WS_WQBT = 46 * MiB;
constexpr size_t WS_WKVBT = 47 * MiB;
constexpr size_t WS_LORABT = 48 * MiB;
constexpr size_t WS_WGU = 52 * MiB;
constexpr size_t WS_WD = 180 * MiB;
constexpr size_t WS_H = 248 * MiB;
constexpr size_t WS_PRW = 312 * MiB;
constexpr size_t WS_PATT = 416 * MiB;
constexpr size_t WS_U = 488 * MiB;
constexpr size_t WS_HID = 488 * MiB, WS_C2 = 528 * MiB;
constexpr size_t WS_APERM = 312 * MiB;
constexpr size_t WS_LORAA = 680 * MiB;
constexpr size_t WS_LORAO = 692 * MiB;
constexpr size_t WS_VFIRST = 820 * MiB;
constexpr size_t WS_QN = 852 * MiB, WS_KVN = 864 * MiB, WS_QM = 872 * MiB, WS_KVM = 896 * MiB, WS_KPE = 928 * MiB;
constexpr size_t WS_CAQ = 852 * MiB, WS_CAO = 868 * MiB;
constexpr size_t WS_MEMN = 932 * MiB, WS_MEMKV = 936 * MiB;
constexpr size_t WS_XB = 940 * MiB;
constexpr size_t WS_PARTC = 1004 * MiB;
constexpr size_t WS_PARTF = 1006 * MiB;
constexpr size_t WS_L1OFF = 1000 * MiB;
constexpr size_t WS_WRB1 = 1052 * MiB;
constexpr size_t WS_END = 1053 * MiB;
constexpr int CW_BAR = 4096;

constexpr int LDS_MAIN = 131072;
constexpr int LDS_MISC = LDS_MAIN;
constexpr int LDS_BYTES = 147456;

DI unsigned pk2(float lo, float hi) { f32x2 v = {lo, hi}; bf16x2_t b = __builtin_convertvector(v, bf16x2_t); return __builtin_bit_cast(unsigned, b); }
DI bf16_t f2bf(float f) { return (bf16_t)(pk2(f, 0.f) & 0xffffu); }
DI unsigned pkh2(float lo, float hi) { const h2_t v = {(_Float16)lo, (_Float16)hi}; return __builtin_bit_cast(unsigned, v); }
DI float hflo(unsigned u) { return (float)__builtin_bit_cast(h2_t, u)[0]; }
DI float hfhi(unsigned u) { return (float)__builtin_bit_cast(h2_t, u)[1]; }
DI float bf2f(bf16_t b) { return __uint_as_float(((unsigned)b) << 16); }
DI float bflo(unsigned u) { return __uint_as_float(u << 16); }
DI float bfhi(unsigned u) { return __uint_as_float(u & 0xffff0000u); }
#define DPP_F(x, ctl) __builtin_bit_cast(float, __builtin_amdgcn_update_dpp(0, __builtin_bit_cast(int, x), ctl, 0xf, 0xf, true))
#define RDL_F(x, l) __builtin_bit_cast(float, __builtin_amdgcn_readlane(__builtin_bit_cast(int, x), l))
DI float wave_sum(float v) {
    v += DPP_F(v, 0xB1);
    v += DPP_F(v, 0x4E);
    v += DPP_F(v, 0x141);
    v += DPP_F(v, 0x140);
    const float r0 = RDL_F(v, 0), r1 = RDL_F(v, 16), r2 = RDL_F(v, 32), r3 = RDL_F(v, 48);
    return (r0 + r1) + (r2 + r3);
}
DI float wave_max(float v) {
    v = fmaxf(v, DPP_F(v, 0xB1)); v = fmaxf(v, DPP_F(v, 0x4E)); v = fmaxf(v, DPP_F(v, 0x141)); v = fmaxf(v, DPP_F(v, 0x140));
    const float r0 = RDL_F(v, 0), r1 = RDL_F(v, 16), r2 = RDL_F(v, 32), r3 = RDL_F(v, 48);
    return fmaxf(fmaxf(r0, r1), fmaxf(r2, r3));
}
DI float sigmoidf_(float x) { return 1.f / (1.f + __expf(-x)); }

#define XB_TMO      128
#define XB_XCNT(j)  (256  + 64 * (j))
#define XB_XSUB(j)  (1280 + 64 * (j))
#define XB_XGEN(j)  (2304 + 64 * (j))
#define XB_TOP      3328
#define XB_TOPGEN   3392
#define XCD_BAR_WORDS 3456
#define XB_SPIN_CAP (1u << 24)

DI unsigned xb_ld(unsigned* p)              { return __hip_atomic_load(p, __ATOMIC_RELAXED, __HIP_MEMORY_SCOPE_AGENT); }
DI unsigned xb_add(unsigned* p, unsigned v) { return __hip_atomic_fetch_add(p, v, __ATOMIC_RELAXED, __HIP_MEMORY_SCOPE_AGENT); }
DI unsigned xb_xcc_id() { return (unsigned)__builtin_amdgcn_s_getreg((3 << 11) | 20) & 0xFu; }
#define XB_SPIN(cond, bar) do { unsigned _sp = 0; while (cond) { __builtin_amdgcn_s_sleep(1); \
    if ((++_sp & 255u) == 0u) { if (xb_ld(&(bar)[XB_TMO])) break; if (_sp > XB_SPIN_CAP) { atomicAdd(&(bar)[XB_TMO], 1u); break; } } } } while (0)

struct XcdBarrier { unsigned* bar; unsigned x; volatile LAS unsigned* st; };

DI XcdBarrier xcd_barrier_post(unsigned* bar, volatile LAS unsigned* st) {
    XcdBarrier b; b.bar = bar; b.x = xb_xcc_id(); b.st = st;
    if (threadIdx.x == 0) (void)xb_add(&bar[XB_XCNT(b.x)], 1u);
    return b;
}
DI void xcd_barrier_complete(unsigned* bar, unsigned x, unsigned& nloc, unsigned& nx) {
    const unsigned G = gridDim.x * gridDim.y * gridDim.z;
    unsigned sum, cnt, mine, sp = 0u;
    for (;;) {
        sum = 0u; cnt = 0u; mine = 0u;
#pragma unroll
        for (unsigned j = 0; j < 16; ++j) { const unsigned c = xb_ld(&bar[XB_XCNT(j)]); sum += c; cnt += (c > 0u) ? 1u : 0u; mine = (j == x) ? c : mine; }
        if (sum == G) break;
        __builtin_amdgcn_s_sleep(1);
        if ((++sp & 255u) == 0u) { if (xb_ld(&bar[XB_TMO])) break; if (sp > XB_SPIN_CAP) { atomicAdd(&bar[XB_TMO], 1u); break; } }
    }
    nloc = mine > 0u ? mine : 1u; nx = cnt > 0u ? cnt : 1u;
}
DI void xcd_barrier(const XcdBarrier& b) {
    asm volatile("s_waitcnt vmcnt(0)" ::: "memory");
    __syncthreads();
    if (threadIdx.x == 0) {
        unsigned* bar = b.bar;
        __builtin_amdgcn_s_waitcnt(0);
        unsigned nloc = b.st[0], nx = b.st[1];
        if (nloc == 0u) { xcd_barrier_complete(bar, b.x, nloc, nx); b.st[0] = nloc; b.st[1] = nx; }
        const unsigned old = xb_add(&bar[XB_XSUB(b.x)], 1u);
        const unsigned gen = old / nloc;
        if (old + 1u == (gen + 1u) * nloc) {
            __builtin_amdgcn_fence(__ATOMIC_RELEASE, "agent");
            asm volatile("s_waitcnt vmcnt(0)" ::: "memory");
            const unsigned og = xb_add(&bar[XB_TOP], 1u);
            const unsigned tg = og / nx;
            if (og + 1u == (tg + 1u) * nx) xb_add(&bar[XB_TOPGEN], 1u);
            else XB_SPIN(xb_ld(&bar[XB_TOPGEN]) == tg, bar);
            __builtin_amdgcn_fence(__ATOMIC_ACQUIRE, "agent");
            xb_add(&bar[XB_XGEN(b.x)], 1u);
            asm volatile("s_waitcnt vmcnt(0)" ::: "memory");
        } else {
            XB_SPIN(xb_ld(&bar[XB_XGEN(b.x)]) == gen, bar);
            __builtin_amdgcn_fence(__ATOMIC_ACQUIRE, "agent");
            asm volatile("s_waitcnt vmcnt(0)" ::: "memory");
        }
    }
    __syncthreads();
}

namespace pg8 {
constexpr int BM = 256, BK = 64, HALF = 128, HTB = HALF * BK * 2, STAGE_BYTES = 8 * HTB, NXCD = 8, WGM = 8;
__host__ __device__ __forceinline__ int lds_byte(int r, int c) { const int st = (r >> 4) * 2 + (c >> 5), rr = r & 15, cc = c & 31, ob = rr * 64 + cc * 2; return st * 1024 + (ob ^ (((ob >> 9) & 1) << 5)); }
__host__ __device__ __forceinline__ void stage_rc(int b, int& R, int& C) { const int st = b / 1024, sb = b % 1024, swz = sb ^ (((sb >> 9) & 1) << 5); R = (st >> 1) * 16 + swz / 64; C = (st & 1) * 32 + (swz % 64) / 2; }
__host__ __device__ __forceinline__ int perm32(int rho) { const int n = rho >> 4, i = rho & 15; return 8 * (i >> 2) + 4 * n + (i & 3); }

struct Unit { int pm, pn; long bbase; };
struct Gemm { const bf16_t* A; const bf16_t* Bt; int lda, ldb, K; const int* rowmap; };

struct StaticOrder {
    int nM, nN, nwg, G, c, ldb;
    DI void init(int M, int N, int G_, int c_, int ldb_) { nM = M / BM; nN = N / BM; nwg = nM * nN; G = G_; c = c_; ldb = ldb_; }
    DI bool next(int i, Unit& u) const {
        const long L = (long)i * G + c; if (L >= nwg) return false;
        int wgid = (int)L; { const int q = nwg / NXCD, r = nwg % NXCD, xcd = wgid % NXCD, off = wgid / NXCD; wgid = (xcd < r ? xcd * (q + 1) : r * (q + 1) + (xcd - r) * q) + off; }
        const int nig = WGM * nN, gid = wgid / nig, fm = gid * WGM, gsz = (nM - fm) < WGM ? (nM - fm) : WGM;
        u.pm = fm + ((wgid % nig) % gsz); u.pn = (wgid % nig) / gsz; u.bbase = (long)u.pn * BM * ldb; return true;
    }
};
struct MoeOrder {
    const int* tileexp; int ntiles, nN, G, c, ldb; long estride; int cw;
    DI bool next(int i, Unit& u) const {
        const long tot = (long)ntiles * nN; const bool partial = (long)(i + 1) * G > tot;
        const long L = (long)i * G + (partial ? cw : c); if (L >= tot) return false;
        const int tile = (int)(L / nN), pn = (int)(L % nN); const int e = tileexp[tile];
        u.pm = tile; u.pn = pn; u.bbase = (long)e * estride + (long)pn * BM * ldb; return true;
    }
};

template <class Epi, class Sched, bool GATHER = false>
DI void gemm_phase(LAS unsigned char* lds, const Gemm g, const Sched& S, const Epi& E) {
    int tid = threadIdx.x; asm volatile("" : "+v"(tid));
    const int wid = __builtin_amdgcn_readfirstlane(tid >> 6), lane = tid & 63, wr = wid >> 2, wc = wid & 3, fr = lane & 15, fq = lane >> 4;
    const int K = g.K, nt = K / BK;
    unsigned voffA[2], voffB[2]; int RA[2], CA[2];
#pragma unroll
    for (int i = 0; i < 2; ++i) { int R, C; stage_rc(tid * 16 + i * 8192, R, C); const int Rb = Epi::PERM ? ((R & ~31) + perm32(R & 31)) : R;
        RA[i] = R; CA[i] = C; voffA[i] = (unsigned)(R * g.lda + C) * 2u; voffB[i] = (unsigned)(Rb * g.ldb + C) * 2u; }
    const size_t kstep = (size_t)(BK * 2);
    const size_t hstepA = (size_t)HALF * g.lda * 2, hstepB = (size_t)HALF * g.ldb * 2;
    const unsigned ldsw = (unsigned)wid * 1024u;
    const int aoff = lds_byte(wr * 64 + fr, fq * 8), boff = lds_byte(wc * 32 + fr, fq * 8);
#define PG8_SA(b, h) (((b) * 2 + (h)) * HTB)
#define PG8_SB(b, h) ((4 + (b) * 2 + (h)) * HTB)
#define PG8_STAGE(bufoff, gbase, voff) do { _Pragma("unroll") for (int _i = 0; _i < 2; ++_i) \
        __builtin_amdgcn_global_load_lds((const unsigned*)((const char*)(gbase) + (voff)[_i]), (LAS unsigned*)(lds + (bufoff) + ldsw + _i * 8192), 16, 0, 0); } while (0)
    unsigned gA[2][2], ngA[2][2];
#define PG8_STAGE_A(b, h, ptr, isnext) do { if constexpr (GATHER) { if (isnext) PG8_STAGE(PG8_SA(b, h), ptr, ngA[h]); else PG8_STAGE(PG8_SA(b, h), ptr, gA[h]); } \
        else PG8_STAGE(PG8_SA(b, h), (ptr) + (h) * hstepA, voffA); } while (0)
#define PG8_GATHER_OFFS(dst, un) do { _Pragma("unroll") for (int h_ = 0; h_ < 2; ++h_) _Pragma("unroll") for (int i_ = 0; i_ < 2; ++i_) \
        dst[h_][i_] = (unsigned)(g.rowmap[(un).pm * BM + h_ * HALF + RA[i_]] * g.lda + CA[i_]) * 2u; } while (0)
#define PG8_LDA(dst, b, h) do { _Pragma("unroll") for (int m = 0; m < 4; ++m) _Pragma("unroll") for (int k = 0; k < 2; ++k) dst[m][k] = *(const LAS bf16x8*)(lds + PG8_SA(b, h) + aoff + m * 2048 + k * 1024); } while (0)
#define PG8_LDB(dst, b, h) do { _Pragma("unroll") for (int n = 0; n < 2; ++n) _Pragma("unroll") for (int k = 0; k < 2; ++k) dst[n][k] = *(const LAS bf16x8*)(lds + PG8_SB(b, h) + boff + n * 2048 + k * 1024); } while (0)
#define PG8_MMA(ai, bj, At, Bt) do { __builtin_amdgcn_s_setprio(1); _Pragma("unroll") for (int m = 0; m < 4; ++m) _Pragma("unroll") for (int n = 0; n < 2; ++n) _Pragma("unroll") for (int k = 0; k < 2; ++k) \
        acc[ai][bj][m][n] = __builtin_amdgcn_mfma_f32_16x16x32_bf16(Bt[n][k], At[m][k], acc[ai][bj][m][n], 0, 0, 0); __builtin_amdgcn_s_setprio(0); } while (0)
#define PG8_WAIT_V(n) asm volatile("s_waitcnt vmcnt(" #n ")" ::: "memory")
#define PG8_WAIT_L(n) asm volatile("s_waitcnt lgkmcnt(" #n ")" ::: "memory")
#define PG8_BAR __builtin_amdgcn_s_barrier()
#define PG8_SCHED __builtin_amdgcn_sched_barrier(0)
    Unit cur, nxt; int ui = 0;
    if (!S.next(0, cur)) return;
    f32x4 acc[2][2][4][2];
#pragma unroll
    for (int a = 0; a < 2; ++a)
#pragma unroll
        for (int b = 0; b < 2; ++b)
#pragma unroll
            for (int m = 0; m < 4; ++m)
#pragma unroll
                for (int n = 0; n < 2; ++n) acc[a][b][m][n] = (f32x4){0.f, 0.f, 0.f, 0.f};
    bf16x8 At[4][2], B0[2][2], B1[2][2];
    const char* cA; const char* cB = (const char*)g.Bt + cur.bbase * 2;
    if constexpr (GATHER) { cA = (const char*)g.A; PG8_GATHER_OFFS(gA, cur); PG8_GATHER_OFFS(ngA, cur); }
    else cA = (const char*)g.A + (size_t)cur.pm * BM * g.lda * 2;
    PG8_STAGE(PG8_SB(0, 0), cB, voffB); PG8_STAGE(PG8_SB(0, 1), cB + hstepB, voffB); PG8_STAGE_A(0, 0, cA, false); PG8_STAGE_A(0, 1, cA, false);
    if (wr == 1) PG8_BAR;
    PG8_WAIT_V(2); PG8_BAR;
    PG8_STAGE(PG8_SB(1, 0), cB + kstep, voffB); PG8_STAGE_A(1, 0, cA + kstep, false); PG8_STAGE(PG8_SB(1, 1), cB + hstepB + kstep, voffB);
    PG8_WAIT_V(6); PG8_BAR;
    for (;;) {
        const bool has_next = S.next(ui + 1, nxt);
        const char* nA; const char* nB = has_next ? (const char*)g.Bt + nxt.bbase * 2 : cB;
        if constexpr (GATHER) { nA = cA; if (has_next) PG8_GATHER_OFFS(ngA, nxt); }
        else nA = has_next ? (const char*)g.A + (size_t)nxt.pm * BM * g.lda * 2 : cA;
        for (int t = 0; t < nt; t += 2) {
            const bool last = (t == nt - 2);
            const char* a1 = cA + (size_t)(t + 1) * kstep;
            const char* a2 = last ? nA : cA + (size_t)(t + 2) * kstep; const char* b2 = last ? nB : cB + (size_t)(t + 2) * kstep;
            const char* a3 = a2 + kstep; const char* b3 = b2 + kstep;
            PG8_LDB(B0, 0, 0); PG8_LDB(B1, 0, 1); PG8_SCHED; PG8_LDA(At, 0, 0); PG8_STAGE_A(1, 1, a1, false);
            PG8_WAIT_V(8); PG8_WAIT_L(0); PG8_BAR; PG8_MMA(0, 0, At, B0); PG8_MMA(0, 1, At, B1); PG8_BAR; PG8_SCHED;
            PG8_LDA(At, 0, 1); PG8_STAGE(PG8_SB(0, 0), b2, voffB); PG8_STAGE(PG8_SB(0, 1), b2 + hstepB, voffB); PG8_STAGE_A(0, 0, a2, last);
            PG8_WAIT_V(8); PG8_WAIT_L(0); PG8_BAR; PG8_MMA(1, 0, At, B0); PG8_MMA(1, 1, At, B1); PG8_BAR; PG8_SCHED;
            PG8_LDB(B0, 1, 0); PG8_LDB(B1, 1, 1); PG8_SCHED; PG8_LDA(At, 1, 0); PG8_STAGE_A(0, 1, a2, last);
            PG8_WAIT_V(8); PG8_WAIT_L(0); PG8_BAR; PG8_MMA(0, 0, At, B0); PG8_MMA(0, 1, At, B1); PG8_BAR; PG8_SCHED;
            PG8_LDA(At, 1, 1); PG8_STAGE(PG8_SB(1, 0), b3, voffB); PG8_STAGE(PG8_SB(1, 1), b3 + hstepB, voffB); PG8_STAGE_A(1, 0, a3, last);
            PG8_WAIT_V(8); PG8_WAIT_L(0); PG8_BAR; PG8_MMA(1, 0, At, B0); PG8_MMA(1, 1, At, B1); PG8_BAR; PG8_SCHED;
        }
        if (wr == 0) PG8_BAR;
        E(acc, cur, wr, wc, fr, fq);
        if (!has_next) break;
#pragma unroll
        for (int a = 0; a < 2; ++a)
#pragma unroll
            for (int b = 0; b < 2; ++b)
#pragma unroll
                for (int m = 0; m < 4; ++m)
#pragma unroll
                    for (int n = 0; n < 2; ++n) acc[a][b][m][n] = (f32x4){0.f, 0.f, 0.f, 0.f};
        cur = nxt; cA = nA; cB = nB; ++ui;
        if constexpr (GATHER) {
#pragma unroll
            for (int h_ = 0; h_ < 2; ++h_)
#pragma unroll
                for (int i_ = 0; i_ < 2; ++i_) gA[h_][i_] = ngA[h_][i_]; }
        if (wr == 1) PG8_BAR;
    }
    PG8_WAIT_V(0);
    PG8_BAR;
#undef PG8_SA
#undef PG8_SB
#undef PG8_STAGE
#undef PG8_STAGE_A
#undef PG8_LDA
#undef PG8_LDB
#undef PG8_MMA
#undef PG8_WAIT_V
#undef PG8_WAIT_L
#undef PG8_BAR
#undef PG8_SCHED
#undef PG8_GATHER_OFFS
}

DI float row_ssq32(const float* part, int row) { const f32x4* p = (const f32x4*)(part + (size_t)row * 32); float t = 0.f;
#pragma unroll
    for (int i = 0; i < 8; ++i) { const f32x4 v = p[i]; t += (v[0] + v[1]) + (v[2] + v[3]); }
    return t; }
DI float row_rstd(const float* ssq, int np, int row) {
    float t;
    if (np == 1) t = ssq[row];
    else { const f32x4* p = (const f32x4*)(ssq + (size_t)row * 32); t = 0.f;
#pragma unroll
        for (int i = 0; i < 8; ++i) { const f32x4 v = p[i]; t += (v[0] + v[1]) + (v[2] + v[3]); } }
    return rsqrtf(t * (1.f / 2048.f) + 1e-6f);
}
struct EpiBf16 {
    static constexpr bool PERM = true;
    bf16_t* O; int ldc; bf16_t* O2; int ldc2; int split_tile; const float* ssq; int np;
    DI void operator()(const f32x4 (&acc)[2][2][4][2], const Unit& u, int wr, int wc, int fr, int fq) const {
        bf16_t* base = O; int ld = ldc; int colt = u.pn * BM;
        if (u.pn >= split_tile) { base = O2; ld = ldc2; colt = (u.pn - split_tile) * BM; }
        const int row0 = u.pm * BM + wr * 64 + fr, col0 = colt + wc * 32 + 8 * fq;
#pragma unroll
        for (int ai = 0; ai < 2; ++ai)
#pragma unroll
            for (int m = 0; m < 4; ++m) { const int row = row0 + ai * HALF + m * 16; bf16_t* rowp = base + (size_t)row * ld + col0;
                const float rs = ssq ? row_rstd(ssq, np, row) : 1.f;
#pragma unroll
                for (int bj = 0; bj < 2; ++bj) { const f32x4 v0 = acc[ai][bj][m][0] * rs, v1 = acc[ai][bj][m][1] * rs;
                    u32x4 w; w.x = pk2(v0[0], v0[1]); w.y = pk2(v0[2], v0[3]); w.z = pk2(v1[0], v1[1]); w.w = pk2(v1[2], v1[3]);
                    *(u32x4*)(rowp + bj * HALF) = w; } }
    }
};
struct EpiResid {
    static constexpr bool PERM = true;
    const float* basef; const bf16_t* baseb; bf16_t* out; int ldc; float* part_out;
    DI void operator()(const f32x4 (&acc)[2][2][4][2], const Unit& u, int wr, int wc, int fr, int fq) const {
        const int row0 = u.pm * BM + wr * 64 + fr, col0 = u.pn * BM + wc * 32 + 8 * fq;
#pragma unroll
        for (int ai = 0; ai < 2; ++ai)
#pragma unroll
            for (int m = 0; m < 4; ++m) { const int row = row0 + ai * HALF + m * 16; const size_t off = (size_t)row * ldc + col0; float sq = 0.f;
#pragma unroll
                for (int bj = 0; bj < 2; ++bj) { f32x4 v0 = acc[ai][bj][m][0], v1 = acc[ai][bj][m][1];
                    if (basef) { v0 += *(const f32x4*)(basef + off + bj * HALF); v1 += *(const f32x4*)(basef + off + bj * HALF + 4); }
                    else { const u32x4 b = *(const u32x4*)(baseb + off + bj * HALF);
                        v0 += (f32x4){bflo(b.x), bfhi(b.x), bflo(b.y), bfhi(b.y)}; v1 += (f32x4){bflo(b.z), bfhi(b.z), bflo(b.w), bfhi(b.w)}; }
                    u32x4 w; w.x = pk2(v0[0], v0[1]); w.y = pk2(v0[2], v0[3]); w.z = pk2(v1[0], v1[1]); w.w = pk2(v1[2], v1[3]);
                    *(u32x4*)(out + off + bj * HALF) = w;
                    const float a0 = bflo(w.x), a1 = bfhi(w.x), a2 = bflo(w.y), a3 = bfhi(w.y), a4 = bflo(w.z), a5 = bfhi(w.z), a6 = bflo(w.w), a7 = bfhi(w.w);
                    sq += ((a0 * a0 + a1 * a1) + (a2 * a2 + a3 * a3)) + ((a4 * a4 + a5 * a5) + (a6 * a6 + a7 * a7)); }
                sq += __shfl_xor(sq, 16); sq += __shfl_xor(sq, 32);
                if (fq == 0) part_out[(size_t)row * 32 + u.pn * 4 + wc] = sq; }
    }
};
struct EpiF32 {
    static constexpr bool PERM = false;
    float* out; int ldc; const float* ssq; int np; float* ssq_pub;
    DI void operator()(const f32x4 (&acc)[2][2][4][2], const Unit& u, int wr, int wc, int fr, int fq) const {
        const int row0 = u.pm * BM + wr * 64 + fr, col0 = u.pn * BM + wc * 32 + 4 * fq;
#pragma unroll
        for (int ai = 0; ai < 2; ++ai)
#pragma unroll
            for (int m = 0; m < 4; ++m) { const int row = row0 + ai * HALF + m * 16; const size_t off = (size_t)row * ldc + col0;
                float rs = 1.f;
                if (ssq) { const float t = (np == 1) ? ssq[row] : row_ssq32(ssq, row); rs = rsqrtf(t * (1.f / 2048.f) + 1e-6f); if (ssq_pub && u.pn == 0 && wc == 0 && fq == 0) ssq_pub[row] = t; }
#pragma unroll
                for (int bj = 0; bj < 2; ++bj)
#pragma unroll
                    for (int n = 0; n < 2; ++n) *(f32x4*)(out + off + bj * HALF + n * 16) = acc[ai][bj][m][n] * rs; }
    }
};
struct EpiSiluMul {
    static constexpr bool PERM = true;
    bf16_t* O; int ldc; const float* ssq; const int* rowmap;
    DI void operator()(const f32x4 (&acc)[2][2][4][2], const Unit& u, int wr, int wc, int fr, int fq) const {
        const int row0 = u.pm * BM + wr * 64 + fr, col0 = (u.pn * BM + wc * 32 + 8 * fq) >> 1;
#pragma unroll
        for (int ai = 0; ai < 2; ++ai)
#pragma unroll
            for (int m = 0; m < 4; ++m) { const int row = row0 + ai * HALF + m * 16; bf16_t* rowp = O + (size_t)row * ldc + col0;
                const float rs = row_rstd(ssq, 1, rowmap[row]);
#pragma unroll
                for (int bj = 0; bj < 2; ++bj) { const f32x4 v0 = acc[ai][bj][m][0] * rs, v1 = acc[ai][bj][m][1] * rs;
                    const float h0 = v0[0] / (1.f + __expf(-v0[0])) * v0[1], h1 = v0[2] / (1.f + __expf(-v0[2])) * v0[3];
                    const float h2 = v1[0] / (1.f + __expf(-v1[0])) * v1[1], h3 = v1[2] / (1.f + __expf(-v1[2])) * v1[3];
                    u32x2 w; w.x = pk2(h0, h1); w.y = pk2(h2, h3);
                    *(u32x2*)(rowp + bj * (HALF / 2)) = w; } }
    }
};
struct EpiScatter {
    static constexpr bool PERM = true;
    bf16_t* O; int ldc; const int* dst;
    DI void operator()(const f32x4 (&acc)[2][2][4][2], const Unit& u, int wr, int wc, int fr, int fq) const {
        const int row0 = u.pm * BM + wr * 64 + fr, col0 = u.pn * BM + wc * 32 + 8 * fq;
#pragma unroll
        for (int ai = 0; ai < 2; ++ai)
#pragma unroll
            for (int m = 0; m < 4; ++m) { const int d = dst[row0 + ai * HALF + m * 16];
                if (d >= 0) { bf16_t* rowp = O + (size_t)d * ldc + col0;
#pragma unroll
                    for (int bj = 0; bj < 2; ++bj) { const f32x4 v0 = acc[ai][bj][m][0], v1 = acc[ai][bj][m][1];
                        u32x4 w; w.x = pk2(v0[0], v0[1]); w.y = pk2(v0[2], v0[3]); w.z = pk2(v1[0], v1[1]); w.w = pk2(v1[2], v1[3]);
                        *(u32x4*)(rowp + bj * HALF) = w; } } }
    }
};
}

struct Args { const void* in[45]; float* out; unsigned char* ws; int ph_lo, ph_hi; };
static_assert(sizeof(void*) == 8 && sizeof(Args) == 384, "Args layout");

#define CAS __attribute__((address_space(4)))
typedef const CAS char* kaptr_t;
typedef const float* const CAS* inptr_t;
struct Ctx {
    LAS unsigned char* lds; unsigned char* ws; inptr_t in; float* X;
    int tid, lane, wave, G, wg, gw, ngw, att_sel, vcu;
};

DI size_t wofs(int l) { return l ? WS_L1OFF : 0; }
struct TrDesc { const float* W; bf16_t* WT; int N, ldk, row_off, row_mul, nblk, item; const float* ks; };
DI void tr_load(const TrDesc& d, float (&tv)[32], int lane) {
    const int kb = d.item / d.nblk, nb = d.item % d.nblk, k0 = 64 * kb, n0 = 32 * nb;
#pragma unroll
    for (int i = 0; i < 32; ++i) { const int kk = 2 * i + (lane >> 5); tv[i] = d.W[(size_t)(k0 + kk) * d.N + n0 + (lane & 31)]; }
}
DI void tr_store(const TrDesc& d, const float (&tv)[32], LAS float* scr, int lane) {
    const int kb = d.item / d.nblk, nb = d.item % d.nblk, k0 = 64 * kb, n0 = 32 * nb;
#pragma unroll
    for (int i = 0; i < 32; ++i) { const int kk = 2 * i + (lane >> 5); scr[kk * 33 + (lane & 31)] = d.ks ? tv[i] * d.ks[k0 + kk] : tv[i]; }
    asm volatile("s_waitcnt lgkmcnt(0)" ::: "memory");
    const int c = lane & 7;
#pragma unroll
    for (int j = 0; j < 4; ++j) { const int n = (lane >> 3) + 8 * j; const LAS float* s = scr + (8 * c) * 33 + n;
        u32x4 o; o.x = pk2(s[0 * 33], s[1 * 33]); o.y = pk2(s[2 * 33], s[3 * 33]); o.z = pk2(s[4 * 33], s[5 * 33]); o.w = pk2(s[6 * 33], s[7 * 33]);
        *(u32x4*)(d.WT + (size_t)(d.row_off + (n0 + n) * d.row_mul) * d.ldk + k0 + 8 * c) = o; }
    asm volatile("s_waitcnt lgkmcnt(0)" ::: "memory");
}

DI void norm_row(const float* xin, const bf16_t* xinb, bf16_t* xout, const bf16_t* c0, const bf16_t* c1, float g0, float g1, const float* w, bf16_t* hout, float* fout, int lane, float* ssq_w = nullptr) {
    f32x4 v[8]; float ss = 0.f;
    if (xin) {
#pragma unroll
        for (int j = 0; j < 8; ++j) { v[j] = ((const f32x4*)xin)[lane + 64 * j]; }
    } else {
#pragma unroll
        for (int j = 0; j < 8; ++j) { const u32x2 a = ((const u32x2*)xinb)[lane + 64 * j]; v[j] = (f32x4){bflo(a.x), bfhi(a.x), bflo(a.y), bfhi(a.y)}; }
    }
    if (c0) {
#pragma unroll
        for (int j = 0; j < 8; ++j) { const u32x2 a = ((const u32x2*)c0)[lane + 64 * j], b = ((const u32x2*)c1)[lane + 64 * j];
            v[j][0] += g0 * bflo(a.x) + g1 * bflo(b.x); v[j][1] += g0 * bfhi(a.x) + g1 * bfhi(b.x);
            v[j][2] += g0 * bflo(a.y) + g1 * bflo(b.y); v[j][3] += g0 * bfhi(a.y) + g1 * bfhi(b.y); }
    }
#pragma unroll
    for (int j = 0; j < 8; ++j) ss += (v[j][0] * v[j][0] + v[j][1] * v[j][1]) + (v[j][2] * v[j][2] + v[j][3] * v[j][3]);
    if (xout) {
#pragma unroll
        for (int j = 0; j < 8; ++j) { u32x2 o; o.x = pk2(v[j][0], v[j][1]); o.y = pk2(v[j][2], v[j][3]); ((u32x2*)xout)[lane + 64 * j] = o; }
    }
    const float sst = wave_sum(ss);
    if (ssq_w) { if (lane == 0) *ssq_w = sst; }
    if (!w) return;
    const float rstd = rsqrtf(sst * (1.f / DM) + 1e-6f);
#pragma unroll
    for (int j = 0; j < 8; ++j) { const f32x4 ww = ((const f32x4*)w)[lane + 64 * j]; const f32x4 y = v[j] * rstd * ww;
        if (hout) { u32x2 o; o.x = pk2(y[0], y[1]); o.y = pk2(y[2], y[3]); ((u32x2*)hout)[lane + 64 * j] = o; }
        if (fout) ((f32x4*)fout)[lane + 64 * j] = y; }
}

constexpr int I_WIN = 32 * 174, I_VR = 32, I_WOUT = 32 * 64, I_CAQ = 32 * 16, I_CAKV = 32 * 32, I_CAO = 8 * 64, I_WQB = 6 * 24, I_WKVB = 4 * 32;
constexpr int N_SMALL_ITEMS = I_WIN + I_VR + I_WOUT + I_CAQ + I_CAKV + I_CAO + I_WQB + I_WKVB;
DI TrDesc small_tr_desc(int l, int r, inptr_t in, unsigned char* wsl) {
    bf16_t* WINT = (bf16_t*)(wsl + WS_WINT);
    if (r < I_WIN) return TrDesc{in[6] + (size_t)l * DM * IN_COLS, WINT, IN_COLS, DM, 0, 1, 174, r, in[5] + (size_t)l * DM}; r -= I_WIN;
    if (r < I_VR) return TrDesc{in[7], WINT, 32, DM, IN_COLS, 1, 1, r, in[5] + DM}; r -= I_VR;
    if (r < I_WOUT) return TrDesc{in[8] + (size_t)l * DM * DM, (bf16_t*)(wsl + WS_WOUTT), DM, DM, 0, 1, 64, r, nullptr}; r -= I_WOUT;
    if (r < I_CAQ) return TrDesc{in[34] + (size_t)l * DM * 512, (bf16_t*)(wsl + WS_CAWQT), 512, DM, 0, 1, 16, r, in[32] + (size_t)l * DM}; r -= I_CAQ;
    if (r < I_CAKV) return TrDesc{in[35] + (size_t)l * DM * 1024, (bf16_t*)(wsl + WS_CAWKVT), 1024, DM, 0, 1, 32, r, nullptr}; r -= I_CAKV;
    if (r < I_CAO) return TrDesc{in[36] + (size_t)l * 512 * DM, (bf16_t*)(wsl + WS_CAWOT), DM, 512, 0, 1, 64, r, nullptr}; r -= I_CAO;
    if (r < I_WQB) return TrDesc{in[29] + (size_t)l * 384 * 768, (bf16_t*)(wsl + WS_WQBT), 768, 384, 0, 1, 24, r, nullptr}; r -= I_WQB;
    return TrDesc{in[31] + (size_t)l * 256 * 1024, (bf16_t*)(wsl + WS_WKVBT), 1024, 256, 0, 1, 32, r, nullptr};
}
constexpr int I_EXP = 512;
constexpr int N_MOE_ITEMS = 3 * NEXP * I_EXP;
DI TrDesc moe_tr_desc(int l, int r, inptr_t in, unsigned char* ws) {
    const int e = r / (3 * I_EXP), q = r % (3 * I_EXP), mat = q / I_EXP, ii = q % I_EXP;
    const size_t eo = ((size_t)l * NEXP + e);
    if (mat == 0) return TrDesc{in[42] + eo * DM * DEXP, (bf16_t*)(ws + WS_WGU) + (size_t)e * 1024 * DM, DEXP, DM, 0, 2, 16, ii, in[37] + (size_t)l * DM};
    if (mat == 1) return TrDesc{in[43] + eo * DM * DEXP, (bf16_t*)(ws + WS_WGU) + (size_t)e * 1024 * DM, DEXP, DM, 1, 2, 16, ii, in[37] + (size_t)l * DM};
    return TrDesc{in[44] + eo * DEXP * DM, (bf16_t*)(ws + WS_WD) + (size_t)e * DM * DEXP, DM, DEXP, 0, 1, 64, ii, nullptr};
}
DI void phase_convert(const Ctx& C, int l) {
    inptr_t in = C.in;
    unsigned char* ws = C.ws;
    LAS float* scr = (LAS float*)(C.lds + C.wave * 16384);
    bf16_t* WINT = (bf16_t*)(ws + WS_WINT);
    const int n_items = (l == 0) ? N_SMALL_ITEMS : 0;
    auto decode = [&](int it) -> TrDesc { return small_tr_desc(0, it, in, ws); };
    {
        const int first = (l == 0 && C.gw >= I_WIN && C.gw < I_WIN + I_VR) ? C.gw + C.ngw : C.gw;
        float ta[32], tb[32];
        int it = first;
        if (it < n_items) { TrDesc d0 = decode(it); tr_load(d0, ta, C.lane);
            for (;;) {
                int it2 = it + C.ngw; if (l == 0 && it2 >= I_WIN && it2 < I_WIN + I_VR) it2 += C.ngw;
                const bool has2 = it2 < n_items; TrDesc d1 = d0;
                if (has2) { d1 = decode(it2); tr_load(d1, tb, C.lane); }
                tr_store(d0, ta, scr, C.lane);
                if (!has2) break;
                int it3 = it2 + C.ngw; if (l == 0 && it3 >= I_WIN && it3 < I_WIN + I_VR) it3 += C.ngw;
                const bool has3 = it3 < n_items;
                if (has3) { d0 = decode(it3); tr_load(d0, ta, C.lane); }
                tr_store(d1, tb, scr, C.lane);
                if (!has3) break;
                it = it3;
            }
        }
    }
    const int gt = C.wg * 512 + C.tid, ngt = C.G * 512;
    if (l == 0) {
        for (int i = gt; i < 64 * DM / 8; i += ngt) ((u32x4*)(WINT + (size_t)IN_COLS * DM))[i] = (u32x4){0u, 0u, 0u, 0u};
        for (int i = gt; i < 32 * DM / 8; i += ngt) ((u32x4*)((bf16_t*)(ws + WS_L1OFF + WS_WINT) + (size_t)(IN_COLS + 32) * DM))[i] = (u32x4){0u, 0u, 0u, 0u};
#pragma unroll 1
        for (int lw = 0; lw < 2; ++lw) {
            bf16_t* LB = (bf16_t*)(ws + wofs(lw) + WS_LORABT);
            const float* w2 = in[12] + (size_t)lw * 64 * 1024; const float* a2 = in[14] + (size_t)lw * 64 * 1024; const float* g2 = in[17] + (size_t)lw * 128 * 1024; const float* v2 = in[16];
            for (int i = gt; i < 4096 * 128; i += ngt) {
                const int n = i >> 7, k = i & 127, blk = n >> 10, c = n & 1023; float v = 0.f;
                if (blk == 0) { if (k < 64) v = w2[k * 1024 + c]; }
                else if (blk == 1) { if (k >= 64) v = a2[(k - 64) * 1024 + c]; }
                else if (blk == 2) { v = g2[k * 1024 + c]; }
                else { if (lw == 1 && k < 32) v = v2[k * 1024 + c]; }
                LB[i] = f2bf(v);
            }
            bf16_t* WRB = (bf16_t*)(ws + (lw ? WS_WRB1 : WS_WRB)); const float* nf = in[37] + (size_t)lw * DM; const float* wg = in[38] + (size_t)lw * DM * 4; const float* we = in[40] + (size_t)lw * DM * 32;
            for (int i = gt; i < 256 * DM; i += ngt) { const int o = i / DM, k = i % DM; const float v = (o < 32) ? we[k * 32 + o] : ((o < 36) ? wg[k * 4 + (o - 32)] : 0.f); WRB[i] = f2bf(v * nf[k]); }
        }
    }
    if (l == 0) {
        float* LUT = (float*)(ws + WS_LUT); const float* rb = in[3];
        for (int i = gt; i < 4 * 128; i += ngt) { const int h = i >> 7, n = i & 127; int bk;
            if (n < 16) bk = n; else { bk = 16 + (int)(log2f((float)n * 0.0625f) * (16.f / 3.f)); if (bk > 31) bk = 31; }
            LUT[i] = rb[bk * 4 + h] * LOG2E; }
        f32x2* RT = (f32x2*)(ws + WS_ROPE); const int* pos = (const int*)in[2];
        for (int i = gt; i < NT * 32; i += ngt) { const int t = i >> 5, j = i & 31; const float invf = powf(10000.f, -(float)j / 32.f); const float ang = (float)pos[t] * invf; float s, c; sincosf(ang, &s, &c); RT[i] = (f32x2){c, s}; }
    }
    for (int m = C.gw; m < NMEM; m += C.ngw) norm_row(in[1] + (size_t)m * DM, nullptr, nullptr, nullptr, nullptr, 0.f, 0.f, in[33] + (size_t)l * DM, (bf16_t*)(ws + WS_MEMN) + (size_t)m * DM, nullptr, C.lane);
    {
        const bf16_t* C2 = (const bf16_t*)(ws + WS_C2); const float* gate = (const float*)(ws + WS_GATE); bf16_t* XB = (bf16_t*)(ws + WS_XB); float* SSQM = (float*)(ws + WS_SSQM);
        for (int m = C.gw; m < NT; m += C.ngw) {
            if (l == 0) norm_row(in[0] + (size_t)m * DM, nullptr, XB + (size_t)m * DM, nullptr, nullptr, 0.f, 0.f, nullptr, nullptr, nullptr, C.lane, SSQM + m);
            else norm_row(nullptr, XB + (size_t)m * DM, XB + (size_t)m * DM, C2 + (size_t)(2 * m) * DM, C2 + (size_t)(2 * m + 1) * DM, gate[2 * m], gate[2 * m + 1], nullptr, nullptr, nullptr, C.lane, SSQM + m);
        }
    }
}

DI void phase_ew1(const Ctx& C, int l) {
    inptr_t in = C.in; unsigned char* ws = C.ws;
    const bf16_t* PRW = (const bf16_t*)(ws + WS_PRW); const bf16_t* PATT = (const bf16_t*)(ws + WS_PATT);
    bf16_t* LA = (bf16_t*)(ws + WS_LORAA); bf16_t* QN = (bf16_t*)(ws + WS_QN); bf16_t* KVN = (bf16_t*)(ws + WS_KVN); bf16_t* KPE = (bf16_t*)(ws + WS_KPE);
    const float* mu = in[9] + (size_t)l * RW_COLS; const float* muv = in[10];
    const float* qnw = in[28] + (size_t)l * 384; const float* kvnw = in[30] + (size_t)l * 256;
    const f32x2* RT = (const f32x2*)(ws + WS_ROPE);
    const int lane = C.lane;
#pragma unroll 4
    for (int t = C.gw; t < NT; t += C.ngw) {
        const bool first = (t % SEQ) == 0;
        const bf16_t* p = PRW + (size_t)t * RW_COLS; const bf16_t* pa = PATT + (size_t)t * PATT_COLS;
#pragma unroll
        for (int j = 0; j < 4; ++j) { const int c = lane + 64 * j, col = 3072 + c;
            const float cur = bf2f(p[col]); const float prev = first ? 0.f : bf2f(p[col - RW_COLS]);
            const float xs = cur + mu[col] * (prev - cur);
            float v; if (c < 64) v = tanhf(xs); else if (c < 128) v = xs; else v = sigmoidf_(xs);
            LA[(size_t)t * 384 + c] = f2bf(v); }
        {
#pragma unroll
            for (int j = 0; j < 2; ++j) { const int c = lane + 64 * j; float v = 0.f;
                if (l == 1 && c < 32) { const float cur = bf2f(pa[2240 + c]); const float prev = first ? 0.f : bf2f(pa[2240 + c - PATT_COLS]); v = cur + muv[c] * (prev - cur); }
                LA[(size_t)t * 384 + 256 + c] = f2bf(v); } }
        float q[6], kv[4]; float sq = 0.f, skv = 0.f;
#pragma unroll
        for (int j = 0; j < 6; ++j) { q[j] = bf2f(pa[1536 + lane + 64 * j]); sq += q[j] * q[j]; }
#pragma unroll
        for (int j = 0; j < 4; ++j) { kv[j] = bf2f(pa[1920 + lane + 64 * j]); skv += kv[j] * kv[j]; }
        const float rq = rsqrtf(wave_sum(sq) * (1.f / 384.f) + 1e-6f), rkv = rsqrtf(wave_sum(skv) * (1.f / 256.f) + 1e-6f);
#pragma unroll
        for (int j = 0; j < 6; ++j) QN[(size_t)t * 384 + lane + 64 * j] = f2bf(q[j] * rq * qnw[lane + 64 * j]);
#pragma unroll
        for (int j = 0; j < 4; ++j) KVN[(size_t)t * 256 + lane + 64 * j] = f2bf(kv[j] * rkv * kvnw[lane + 64 * j]);
        { const float x = bf2f(pa[2176 + lane]); const float xo = __shfl_xor(x, 32); const f32x2 cs = RT[t * 32 + (lane & 31)];
          const float y = (lane < 32) ? (x * cs.x - xo * cs.y) : (x * cs.x + xo * cs.y);
          KPE[(size_t)t * 64 + lane] = f2bf(y); }
    }
}

DI void phase_ew2(const Ctx& C, int l) {
    inptr_t in = C.in; unsigned char* ws = C.ws;
    const bf16_t* PRW = (const bf16_t*)(ws + WS_PRW); const bf16_t* LO = (const bf16_t*)(ws + WS_LORAO);
    bf16_t* SR = (bf16_t*)(ws + WS_U); bf16_t* SW = SR + (size_t)NT * 1024; bf16_t* SK = SW + (size_t)NT * 1024; bf16_t* SV = SK + (size_t)NT * 1024;
    bf16_t* SA = SV + (size_t)NT * 1024; bf16_t* SB = SA + (size_t)NT * 1024; bf16_t* VF = (bf16_t*)(ws + WS_VFIRST);
    const float* mu = in[9] + (size_t)l * RW_COLS; const float* w0 = in[11] + (size_t)l * 1024; const float* a0 = in[13] + (size_t)l * 1024; const float* v0 = in[15];
    const float* kkw = in[18] + (size_t)l * 1024; const float* kaw = in[19] + (size_t)l * 1024;
    const int lane = C.lane;
#pragma unroll 1
    for (int j = 0; j < 2; ++j) {
        const int c0 = 8 * lane + 512 * j;
        float mu8[3][8], w0v[8], a0v[8], kkv[8], kav[8], v0v[8];
#pragma unroll
        for (int e = 0; e < 2; ++e) {
#pragma unroll
            for (int q = 0; q < 3; ++q) { const f32x4 m = *(const f32x4*)(mu + q * 1024 + c0 + 4 * e);
#pragma unroll
                for (int i = 0; i < 4; ++i) mu8[q][4 * e + i] = m[i]; }
            const f32x4 x0 = *(const f32x4*)(w0 + c0 + 4 * e), x1 = *(const f32x4*)(a0 + c0 + 4 * e), x2 = *(const f32x4*)(kkw + c0 + 4 * e), x3 = *(const f32x4*)(kaw + c0 + 4 * e);
            f32x4 x4 = (f32x4){0.f, 0.f, 0.f, 0.f}; if (l == 1) x4 = *(const f32x4*)(v0 + c0 + 4 * e);
#pragma unroll
            for (int i = 0; i < 4; ++i) { w0v[4 * e + i] = x0[i]; a0v[4 * e + i] = x1[i]; kkv[4 * e + i] = x2[i]; kav[4 * e + i] = x3[i]; v0v[4 * e + i] = x4[i]; } }
#pragma unroll 2
        for (int t = C.gw; t < NT; t += C.ngw) {
            const bool first = (t % SEQ) == 0;
            const bf16_t* p = PRW + (size_t)t * RW_COLS; const bf16_t* lo = LO + (size_t)t * 4096;
            float xs[3][8];
#pragma unroll
            for (int q = 0; q < 3; ++q) { const int col = q * 1024 + c0;
                const u32x4 cu = *(const u32x4*)(p + col); u32x4 pv = (u32x4){0u, 0u, 0u, 0u}; if (!first) pv = *(const u32x4*)(p + col - RW_COLS);
#pragma unroll
                for (int e = 0; e < 4; ++e) { const float c_lo = bflo(cu[e]), c_hi = bfhi(cu[e]), p_lo = bflo(pv[e]), p_hi = bfhi(pv[e]);
                    xs[q][2 * e] = c_lo + mu8[q][2 * e] * (p_lo - c_lo); xs[q][2 * e + 1] = c_hi + mu8[q][2 * e + 1] * (p_hi - c_hi); } }
            const u32x4 lw = *(const u32x4*)(lo + c0), la = *(const u32x4*)(lo + 1024 + c0);
            u32x4 lv = (u32x4){0u, 0u, 0u, 0u}, vfv = (u32x4){0u, 0u, 0u, 0u};
            if (l == 1) { lv = *(const u32x4*)(lo + 3072 + c0); vfv = *(const u32x4*)(VF + (size_t)t * 1024 + c0); }
            float omw[8], av[8], kk[8], k2[8], v2[8]; float ssq = 0.f;
#pragma unroll
            for (int e = 0; e < 8; ++e) {
                const float lwf = (e & 1) ? bfhi(lw[e >> 1]) : bflo(lw[e >> 1]), laf = (e & 1) ? bfhi(la[e >> 1]) : bflo(la[e >> 1]);
                const float wi = w0v[e] + lwf;
                omw[e] = 1.f - __expf(-0.6065306597f * sigmoidf_(wi));
                av[e] = sigmoidf_(a0v[e] + laf);
                kk[e] = xs[1][e] * kkv[e]; ssq += kk[e] * kk[e];
                k2[e] = xs[1][e] * (1.f + (av[e] - 1.f) * kav[e]);
                v2[e] = xs[2][e];
                if (l == 1) { const float lvf = (e & 1) ? bfhi(lv[e >> 1]) : bflo(lv[e >> 1]), vff = (e & 1) ? bfhi(vfv[e >> 1]) : bflo(vfv[e >> 1]);
                    v2[e] = xs[2][e] + (vff - xs[2][e]) * sigmoidf_(v0v[e] + lvf); }
            }
            ssq += DPP_F(ssq, 0xB1); ssq += DPP_F(ssq, 0x4E); ssq += DPP_F(ssq, 0x141);
            const float inv = 1.f / fmaxf(sqrtf(ssq), 1e-12f);
            u32x4 oR, oW, oK, oV, oA, oB, oF;
#pragma unroll
            for (int e = 0; e < 4; ++e) { const float ka = kk[2 * e] * inv, kb = kk[2 * e + 1] * inv;
                oR[e] = pkh2(xs[0][2 * e], xs[0][2 * e + 1]); oW[e] = pkh2(1.f - omw[2 * e], 1.f - omw[2 * e + 1]); oK[e] = pkh2(k2[2 * e], k2[2 * e + 1]); oV[e] = pkh2(v2[2 * e], v2[2 * e + 1]);
                oA[e] = pkh2(-ka, -kb); oB[e] = pkh2(ka * av[2 * e], kb * av[2 * e + 1]);     oF[e] = pk2(xs[2][2 * e], xs[2][2 * e + 1]); }
            const size_t o = (size_t)t * 1024 + c0;
            *(u32x4*)(SR + o) = oR; *(u32x4*)(SW + o) = oW; *(u32x4*)(SK + o) = oK; *(u32x4*)(SV + o) = oV; *(u32x4*)(SA + o) = oA; *(u32x4*)(SB + o) = oB;
            if (l == 0) *(u32x4*)(VF + o) = oF;
        }
    }
    bf16_t* QM = (bf16_t*)(ws + WS_QM); const f32x2* RT = (const f32x2*)(ws + WS_ROPE);
    const int gt = C.wg * 512 + C.tid, ngt = C.G * 512;
    for (int i = gt; i < NT * 4 * 32; i += ngt) { const int t = i >> 7, h = (i >> 5) & 3, j = i & 31;
        bf16_t* q = QM + (size_t)t * 768 + h * 192 + 128; const float x1 = bf2f(q[j]), x2 = bf2f(q[j + 32]); const f32x2 cs = RT[t * 32 + j];
        q[j] = f2bf(x1 * cs.x - x2 * cs.y); q[j + 32] = f2bf(x2 * cs.x + x1 * cs.y); }
}

DI float dot2z(h2_t a, h2_t b) { float d; asm("v_dot2_f32_f16 %0, %1, %2, 0" : "=v"(d) : "v"(a), "v"(b)); return d; }
DI float fma_s(float a, float b, float c) { float d; asm("v_fma_f32 %0, %1, %2, %3" : "=v"(d) : "v"(a), "v"(b), "v"(c)); return d; }
#define ROW_ALLREDUCE(x) do { \
    x += __builtin_bit_cast(float, __builtin_amdgcn_update_dpp(0, __builtin_bit_cast(int, x), 0x128, 0xf, 0xf, true)); \
    x += __builtin_bit_cast(float, __builtin_amdgcn_update_dpp(0, __builtin_bit_cast(int, x), 0x124, 0xf, 0xf, true)); \
    x += __builtin_bit_cast(float, __builtin_amdgcn_update_dpp(0, __builtin_bit_cast(int, x), 0x122, 0xf, 0xf, true)); \
    x += __builtin_bit_cast(float, __builtin_amdgcn_update_dpp(0, __builtin_bit_cast(int, x), 0x121, 0xf, 0xf, true)); } while (0)

DI void phase_scan(const Ctx& C, int l) {
    unsigned char* ws = C.ws; inptr_t in = C.in;
    const bf16_t* SR = (const bf16_t*)(ws + WS_U); float* Yf = (float*)(ws + WS_H);
    constexpr int CH = 32, VECB = CH * 128, BUFB = 5 * VECB + CH * 64, OB = 2 * BUFB;
    LAS unsigned char* lds = C.lds;
    const int tid = C.tid, lane = C.lane, wave = C.wave;
    for (int u = C.vcu; u < 256; u += C.G) {
        const int bh = u >> 2, rg = u & 3, b = bh >> 4, h = bh & 15;
        const size_t tb = (size_t)b * SEQ; const int cb = h * 64;
        const int lt = tid - 256;
        u32x4 pre[3][6];
#define LD_CHUNK(set, c_) do { const size_t t_ = tb + (size_t)(c_) * CH + (lt >> 3); const int j_ = lt & 7; \
            _Pragma("unroll") for (int vq = 0; vq < 5; ++vq) { const int arr = (vq < 3) ? vq : vq + 1; \
                pre[set][vq] = *(const u32x4*)(SR + (size_t)arr * NT * 1024 + t_ * 1024 + cb + 8 * j_); } \
            if (lt < 64) { const size_t tv_ = tb + (size_t)(c_) * CH + (lt >> 1); \
                pre[set][5] = *(const u32x4*)(SR + (size_t)3 * NT * 1024 + tv_ * 1024 + cb + 16 * rg + 8 * (lt & 1)); } } while (0)
#define ST_CHUNK(set, buf_) do { const int step_ = lt >> 3, j_ = lt & 7;     \
            _Pragma("unroll") for (int vq = 0; vq < 5; ++vq) *(LAS u32x4*)(lds + (buf_) * BUFB + vq * VECB + step_ * 128 + j_ * 16) = pre[set][vq]; \
            if (lt < 64) { const u32x4 p = pre[set][5]; LAS u32x4* d = (LAS u32x4*)(lds + (buf_) * BUFB + 5 * VECB + (lt >> 1) * 64 + (lt & 1) * 32);     \
                d[0] = (u32x4){(p.x & 0xffffu) | (p.x << 16), (p.x >> 16) | (p.x & 0xffff0000u), (p.y & 0xffffu) | (p.y << 16), (p.y >> 16) | (p.y & 0xffff0000u)}; \
                d[1] = (u32x4){(p.z & 0xffffu) | (p.z << 16), (p.z >> 16) | (p.z & 0xffff0000u), (p.w & 0xffffu) | (p.w << 16), (p.w >> 16) | (p.w & 0xffff0000u)}; } } while (0)
        h2_t S01 = {(_Float16)0.f, (_Float16)0.f}, S23 = {(_Float16)0.f, (_Float16)0.f};
        const int ks = lane & 15, rowl = wave * 4 + (lane >> 4);
        constexpr int NCH = SEQ / CH;
        const int n_bg = N_MOE_ITEMS + (l == 0 ? N_SMALL_ITEMS : 0);
#define BG_DESC(it_) (((it_) < N_MOE_ITEMS) ? moe_tr_desc(l, (it_), in, ws) : small_tr_desc(1, (it_) - N_MOE_ITEMS, in, ws + WS_L1OFF))
        float tq[32]; int mo_it = (C.wg * 4 + (wave - 4)); bool mo_pending = false; TrDesc mo_d{};
        LAS float* mo_scr = (LAS float*)(lds + OB + 2 * CH * 64) + (wave - 4) * (64 * 33);
        if (wave >= 4) { LD_CHUNK(0, 0); LD_CHUNK(1, 1); LD_CHUNK(2, 2); ST_CHUNK(0, 0); LD_CHUNK(0, 3); }
        __syncthreads();
#define SCAN_ITER(c, setn) do { \
            const int buf = (c) & 1; \
            if (wave >= 4) { \
                if ((c) + 1 < NCH) { ST_CHUNK(setn, buf ^ 1); if ((c) + 4 < NCH) LD_CHUNK(setn, (c) + 4); } \
                if ((c) > 0 && lt < 128) { \
                    const int step = lt >> 2, q4 = lt & 3; const LAS float* ob_ = (const LAS float*)(lds + OB + (((c) - 1) & 1) * (CH * 64)) + (step >> 4) * 256 + (step & 15); \
                    const f32x4 o = {ob_[(4 * q4 + 0) * 16], ob_[(4 * q4 + 1) * 16], ob_[(4 * q4 + 2) * 16], ob_[(4 * q4 + 3) * 16]}; \
                    *(f32x4*)(Yf + (tb + (size_t)((c) - 1) * CH + step) * 1024 + cb + 16 * rg + 4 * q4) = o; } \
                if (((c) & 1) == 0) { if (mo_pending) { tr_store(mo_d, tq, mo_scr, lane); mo_pending = false; } \
                    if (mo_it < n_bg) { mo_d = BG_DESC(mo_it); tr_load(mo_d, tq, lane); mo_pending = true; mo_it += C.G * 4; } } \
            } else { SCAN_BODY(buf); } \
            __syncthreads(); } while (0)
#define SC_LD(X, s_) do { const int so_ = ((s_) & (CH - 1)) * 128; X##r = *(const LAS h4_t*)(bp + 0 * VECB + so_); X##w = *(const LAS h4_t*)(bp + 1 * VECB + so_); X##k = *(const LAS h4_t*)(bp + 2 * VECB + so_); \
            X##a = *(const LAS h4_t*)(bp + 3 * VECB + so_); X##b = *(const LAS h4_t*)(bp + 4 * VECB + so_); X##v = vp[((s_) & (CH - 1)) * 16]; } while (0)
#define DPPF(x, ctl) __builtin_bit_cast(float, __builtin_amdgcn_update_dpp(0, __builtin_bit_cast(int, x), ctl, 0xf, 0xf, true))
#define H_LO(x) __builtin_shufflevector(x, x, 0, 1)
#define H_HI(x) __builtin_shufflevector(x, x, 2, 3)
#define SC_DOT(x) __builtin_amdgcn_fdot2(S01, H_LO(x), dot2z(S23, H_HI(x)), false)
#define SC_FIRST(X) do { float sa = SC_DOT(X##a); \
            const h2_t t01 = S01 * H_LO(X##w) + X##v * H_LO(X##k), t23 = S23 * H_HI(X##w) + X##v * H_HI(X##k); \
            ROW_ALLREDUCE(sa); \
            const _Float16 sh = (_Float16)sa; const h2_t sa2 = {sh, sh}; \
            S01 = sa2 * H_LO(X##b) + t01; S23 = sa2 * H_HI(X##b) + t23; } while (0)
#define SC_PAIR(X, Y, s_) do { float o = SC_DOT(X##r); float sa = SC_DOT(Y##a); \
            const h2_t t01 = S01 * H_LO(Y##w) + Y##v * H_LO(Y##k), t23 = S23 * H_HI(Y##w) + Y##v * H_HI(Y##k); \
            sa += DPPF(sa, 0x128); o += DPPF(o, 0x128); sa += DPPF(sa, 0x124); o += DPPF(o, 0x124); sa += DPPF(sa, 0x122); o += DPPF(o, 0x122); sa += DPPF(sa, 0x121); o += DPPF(o, 0x121); \
            const _Float16 sh = (_Float16)sa; const h2_t sa2 = {sh, sh}; \
            S01 = sa2 * H_LO(Y##b) + t01; S23 = sa2 * H_HI(Y##b) + t23; \
            osel = (ks == (((s_) - 1) & 15)) ? o : osel; if ((((s_) - 1) & 15) == 15) op16[(((s_) - 1) >> 4) * 256] = osel; } while (0)
#define SC_LAST(X, s_) do { float o = SC_DOT(X##r); ROW_ALLREDUCE(o); osel = (ks == ((s_) & 15)) ? o : osel; op16[((s_) >> 4) * 256] = osel; } while (0)
#define SCAN_BODY(buf_) do { \
            const LAS unsigned char* bp = lds + (buf_) * BUFB + ks * 8; \
            const LAS h2_t* vp = (const LAS h2_t*)(lds + (buf_) * BUFB + 5 * VECB) + rowl; \
            LAS float* op16 = (LAS float*)(lds + OB + (buf_) * (CH * 64)) + rowl * 16 + ks; float osel = 0.f;     \
            h4_t Ar, Aw, Ak, Aa, Ab, Br, Bw, Bk, Ba, Bb, Cr, Cw, Ck, Ca, Cb, Dr, Dw, Dk, Da, Db; h2_t Av, Bv, Cv, Dv; \
            SC_LD(A, 0); SC_LD(B, 1); SC_LD(C, 2); SC_LD(D, 3); \
            SC_FIRST(A); \
            _Pragma("unroll 2") for (int s = 0; s < CH - 4; s += 4) { \
                SC_PAIR(A, B, s + 1); SC_LD(A, s + 4); \
                SC_PAIR(B, C, s + 2); SC_LD(B, s + 5); \
                SC_PAIR(C, D, s + 3); SC_LD(C, s + 6); \
                SC_PAIR(D, A, s + 4); SC_LD(D, s + 7); } \
            SC_PAIR(A, B, CH - 3); SC_PAIR(B, C, CH - 2); SC_PAIR(C, D, CH - 1); SC_LAST(D, CH - 1); } while (0)
#pragma unroll 1
        for (int c = 0; c < NCH; c += 3) { SCAN_ITER(c, 1); if (c + 1 < NCH) SCAN_ITER(c + 1, 2); if (c + 2 < NCH) SCAN_ITER(c + 2, 0); }
#undef SC_LD
#undef SC_FIRST
#undef SC_PAIR
#undef SC_LAST
#undef DPPF
#undef H_LO
#undef H_HI
#undef SC_DOT
#undef SCAN_BODY
#undef SCAN_ITER
#undef LD_CHUNK
#undef ST_CHUNK
        if (wave >= 4) { if (mo_pending) tr_store(mo_d, tq, mo_scr, lane);
            for (; mo_it < n_bg; mo_it += C.G * 4) { const TrDesc d = BG_DESC(mo_it); tr_load(d, tq, lane); tr_store(d, tq, mo_scr, lane); } }
#undef BG_DESC
        if (wave >= 4 && lt < 128) { const int c = NCH; const int step = lt >> 2, q4 = lt & 3; const LAS float* ob_ = (const LAS float*)(lds + OB + ((c - 1) & 1) * (CH * 64)) + (step >> 4) * 256 + (step & 15);
            const f32x4 o = {ob_[(4 * q4 + 0) * 16], ob_[(4 * q4 + 1) * 16], ob_[(4 * q4 + 2) * 16], ob_[(4 * q4 + 3) * 16]};
            *(f32x4*)(Yf + (tb + (size_t)(c - 1) * CH + step) * 1024 + cb + 16 * rg + 4 * q4) = o; }
        __syncthreads();
    }
}

DI void phase_post(const Ctx& C, int l) {
    inptr_t in = C.in; unsigned char* ws = C.ws;
    const float* Yf = (const float*)(ws + WS_H); const bf16_t* LO = (const bf16_t*)(ws + WS_LORAO);
    const bf16_t* SR = (const bf16_t*)(ws + WS_U); const bf16_t* SK = SR + (size_t)2 * NT * 1024; const bf16_t* SV = SR + (size_t)3 * NT * 1024;
    bf16_t* Y = (bf16_t*)(ws + WS_PRW);
    const float* rk = in[20] + (size_t)l * 1024; const float* lnw = in[21] + (size_t)l * 1024; const float* lnb = in[22] + (size_t)l * 1024;
    const int lane = C.lane;
    for (int t = C.gw; t < NT; t += C.ngw) {
#pragma unroll
        for (int j = 0; j < 2; ++j) {
            const int c0 = 8 * lane + 512 * j; const size_t o = (size_t)t * 1024 + c0;
            const f32x4 y0 = *(const f32x4*)(Yf + o), y1 = *(const f32x4*)(Yf + o + 4);
            const u32x4 rr = *(const u32x4*)(SR + o), kq = *(const u32x4*)(SK + o), vq = *(const u32x4*)(SV + o), gq = *(const u32x4*)(LO + (size_t)t * 4096 + 2048 + c0);
            float y[8], rk8[8], lw8[8], lb8[8];
#pragma unroll
            for (int e = 0; e < 2; ++e) { const f32x4 a = *(const f32x4*)(rk + c0 + 4 * e), b = *(const f32x4*)(lnw + c0 + 4 * e), c = *(const f32x4*)(lnb + c0 + 4 * e);
#pragma unroll
                for (int i = 0; i < 4; ++i) { rk8[4 * e + i] = a[i]; lw8[4 * e + i] = b[i]; lb8[4 * e + i] = c[i]; y[4 * e + i] = e ? y1[i] : y0[i]; } }
            float sm = 0.f, bs = 0.f; float r8[8], k8[8], v8[8], g8[8];
#pragma unroll
            for (int e = 0; e < 8; ++e) { r8[e] = (e & 1) ? hfhi(rr[e >> 1]) : hflo(rr[e >> 1]); k8[e] = (e & 1) ? hfhi(kq[e >> 1]) : hflo(kq[e >> 1]);
                v8[e] = (e & 1) ? hfhi(vq[e >> 1]) : hflo(vq[e >> 1]); g8[e] = (e & 1) ? bfhi(gq[e >> 1]) : bflo(gq[e >> 1]);
                sm += y[e]; bs += r8[e] * k8[e] * rk8[e]; }
            sm += DPP_F(sm, 0xB1); sm += DPP_F(sm, 0x4E); sm += DPP_F(sm, 0x141);
            bs += DPP_F(bs, 0xB1); bs += DPP_F(bs, 0x4E); bs += DPP_F(bs, 0x141);
            const float mean = sm * (1.f / 64.f); float vs = 0.f;
#pragma unroll
            for (int e = 0; e < 8; ++e) { y[e] -= mean; vs += y[e] * y[e]; }
            vs += DPP_F(vs, 0xB1); vs += DPP_F(vs, 0x4E); vs += DPP_F(vs, 0x141);
            const float rs = rsqrtf(vs * (1.f / 64.f) + 64e-5f);
            u32x4 ov;
#pragma unroll
            for (int e = 0; e < 4; ++e) { const float o0 = (y[2 * e] * rs * lw8[2 * e] + lb8[2 * e] + bs * v8[2 * e]) * g8[2 * e], o1 = (y[2 * e + 1] * rs * lw8[2 * e + 1] + lb8[2 * e + 1] + bs * v8[2 * e + 1]) * g8[2 * e + 1];
                ov[e] = pk2(o0, o1); }
            *(u32x4*)(Y + (size_t)t * 2048 + c0) = ov;
        }
    }
}

struct AttnP {
    const bf16_t* Q; int qpitch, qcol0;
    const bf16_t* K1; int k1pitch, k1col0;
    const bf16_t* K2; int k2pitch, k2col0;
    const bf16_t* V; int vpitch, vcol0;
    bf16_t* O; int opitch, ocol0;
    size_t qrow0, krow0;
    int q0;
    int nkeys;
    float c1;
    const int* pos; const float* lut;
    float lam, outscale; const float* subw;
    int dbg;
};

template <int DQK, int DK1, int MODE, int KT, int PFD>
DI void attn_unit(LAS unsigned char* lds, const AttnP& P) {
    constexpr int DV = 128, KP = DQK * 2 + 16, VP = DV * 2 + 64;
    constexpr int NBLK = KT / 32;
    constexpr int KTILE = KT * KP, VTILE = KT * VP;
    constexpr int NVT = (MODE == 0) ? 1 : 2;
    constexpr int VSLOT = NVT * VTILE + 256;
    constexpr bool ONEB = (MODE != 2);
    constexpr int KSLOT = 2 * KTILE, NKS = ONEB ? 2 : 1, NVS = ONEB ? 3 : 2;
    constexpr int OFF_V = NKS * KSLOT, OFF_POS = NVT * VTILE, OFF_LUT = OFF_V + NVS * VSLOT, OFF_END = OFF_LUT + 512;
    static_assert(!ONEB || PFD == 1, "one-barrier loop uses a single prefetch set");
    constexpr int OFF_OST = 4 * 17408, OSTP = 272;
    static_assert(OFF_END <= LDS_MAIN && OFF_OST + 4 * 32 * OSTP <= LDS_MAIN, "attention LDS");
    constexpr int KCH = DQK / 8, K1CH = DK1 / 8;
    constexpr int NKC = 2 * KT * KCH, NVC = NVT * KT * 16, NKCH = NKC / 512, NVCH = NVC / 512, NCHK = NKCH + NVCH;
    static_assert(NKC % 512 == 0 && NVC % 512 == 0, "chunks");
    constexpr float NEG = -1e30f, THR = 8.f;
    constexpr int KSTEP = (MODE == 0) ? KT : 2 * KT;
    int tid = threadIdx.x; asm volatile("" : "+v"(tid));
    const int lane = tid & 63, wave = __builtin_amdgcn_readfirstlane(tid >> 6);
    const int qg = wave >> 1, st = wave & 1, r32 = lane & 31, h2 = lane >> 5;
    const int qw0 = P.q0 + 32 * qg;
    const int myq = qw0 + r32;
    bf16x8 qf[DQK / 16];
    {
        const bf16_t* qp = P.Q + (P.qrow0 + myq) * (size_t)P.qpitch + P.qcol0 + ((MODE == 0) ? st * 64 : 0) + 8 * h2;
#pragma unroll
        for (int ks = 0; ks < DQK / 16; ++ks) qf[ks] = *(const bf16x8*)(qp + 16 * ks);
    }
    int mypos = 0, posq0 = 0;
    if constexpr (MODE == 0) { mypos = P.pos[myq]; posq0 = P.pos[qw0]; if (tid < 128) ((LAS float*)(lds + OFF_LUT))[tid] = P.lut[tid]; }
    f32x16 o[4];
#pragma unroll
    for (int d = 0; d < 4; ++d)
#pragma unroll
        for (int i = 0; i < 16; ++i) o[d][i] = 0.f;
    float m_run = NEG, l_run = 0.f;
    const int nsteps = P.nkeys / KSTEP;
    const char* gp[NCHK]; unsigned adv[NCHK]; unsigned ldst[NCHK];
#pragma unroll
    for (int i = 0; i < NKCH; ++i) { const int c = tid + 512 * i; const int s = c / (KT * KCH), rc = c % (KT * KCH), row = rc / KCH, ch = rc % KCH;
        const int key = (MODE == 0) ? row : s * KT + row;
        if (ch < K1CH) { gp[i] = (const char*)(P.K1 + (P.krow0 + key) * (size_t)P.k1pitch + P.k1col0 + ((MODE == 0) ? s * 64 : 0) + ch * 8); adv[i] = (unsigned)(KSTEP * P.k1pitch * 2); }
        else { gp[i] = (const char*)(P.K2 + (P.krow0 + key) * (size_t)P.k2pitch + P.k2col0 + (ch - K1CH) * 8); adv[i] = (unsigned)(KSTEP * P.k2pitch * 2); }
        ldst[i] = (unsigned)(s * KTILE + row * KP + ch * 16); }
#pragma unroll
    for (int i = 0; i < NVCH; ++i) { const int c2 = tid + 512 * i; const int s = c2 / (KT * 16), rc = c2 % (KT * 16), row = rc / 16, ch = rc % 16;
        const int key = (MODE == 0) ? row : s * KT + row;
        gp[NKCH + i] = (const char*)(P.V + (P.krow0 + key) * (size_t)P.vpitch + P.vcol0 + ch * 8); adv[NKCH + i] = (unsigned)(KSTEP * P.vpitch * 2);
        ldst[NKCH + i] = (unsigned)(s * VTILE + row * VP + ch * 16); }
    u32x4 preK[PFD][NKCH], preV[PFD][NVCH]; int prepos[2] = {0, 0};
#define KSET(par) ((PFD == 2) ? ((par) ^ 1) : 0)
#define VSET(par) ((PFD == 2) ? (par) : 0)
#define ATT_PREFETCH_K(set_) do { _Pragma("unroll") for (int i = 0; i < NKCH; ++i) { preK[set_][i] = *(const u32x4*)gp[i]; gp[i] += adv[i]; } } while (0)
#define ATT_PREFETCH_V(set_, step_) do { _Pragma("unroll") for (int i = 0; i < NVCH; ++i) { preV[set_][i] = *(const u32x4*)gp[NKCH + i]; gp[NKCH + i] += adv[NKCH + i]; } \
        if constexpr (MODE == 0) { if (tid < KT) prepos[set_] = P.pos[(step_) * KT + tid]; } } while (0)
#define ATT_STAGE_K(set_, ko_) do { _Pragma("unroll") for (int i = 0; i < NKCH; ++i) *(LAS u32x4*)(lds + (ko_) + ldst[i]) = preK[set_][i]; } while (0)
#define ATT_STAGE_V(set_, vo_) do { _Pragma("unroll") for (int i = 0; i < NVCH; ++i) *(LAS u32x4*)(lds + (vo_) + ldst[NKCH + i]) = preV[set_][i]; \
        if constexpr (MODE == 0) { if (tid < KT) ((LAS int*)(lds + (vo_) + OFF_POS))[tid] = prepos[set_]; } } while (0)
#define ATT_QK(dst, ko_) do { const LAS unsigned char* kb_ = lds + (ko_) + st * KTILE + r32 * KP + 16 * h2; \
        _Pragma("unroll") for (int blk = 0; blk < NBLK; ++blk) { \
            _Pragma("unroll") for (int i = 0; i < 16; ++i) dst[blk][i] = 0.f; \
            _Pragma("unroll") for (int ks = 0; ks < DQK / 16; ++ks) { const bf16x8 kf = *(const LAS bf16x8*)(kb_ + blk * 32 * KP + ks * 32); dst[blk] = __builtin_amdgcn_mfma_f32_32x32x16_bf16(kf, qf[ks], dst[blk], 0, 0, 0); } } } while (0)
#define ATT_VLD(j_) do { const int d_ = (j_) / (2 * NBLK), r_ = (j_) % (2 * NBLK); const LAS unsigned char* vp_ = vb_ + (16 * r_) * VP + d_ * 64; \
            vlo_[(j_) & 1] = __builtin_bit_cast(s16x4, __builtin_amdgcn_ds_read_tr16_b64_v4i16((LAS v4i16_t*)vp_)); \
            vhi_[(j_) & 1] = __builtin_bit_cast(s16x4, __builtin_amdgcn_ds_read_tr16_b64_v4i16((LAS v4i16_t*)(vp_ + 8 * VP))); } while (0)
#define ATT_PV(vo_) do { const int sv_ = (MODE == 0) ? 0 : st; \
        const LAS unsigned char* vb_ = lds + (vo_) + sv_ * VTILE + (4 * h2 + ((lane & 15) >> 2)) * VP + ((lane >> 4) & 1) * 32 + (lane & 3) * 8; \
        s16x4 vlo_[2], vhi_[2]; ATT_VLD(0); \
        _Pragma("unroll") for (int j = 0; j < 8 * NBLK; ++j) { if (j + 1 < 8 * NBLK) ATT_VLD(j + 1); \
            const s16x4 lo_ = vlo_[j & 1], hi_ = vhi_[j & 1]; const bf16x8 vf_ = {lo_[0], lo_[1], lo_[2], lo_[3], hi_[0], hi_[1], hi_[2], hi_[3]}; \
            const int d_ = j / (2 * NBLK), r_ = j % (2 * NBLK); \
            o[d_] = __builtin_amdgcn_mfma_f32_32x32x16_bf16(vf_, pf[r_ >> 1][r_ & 1], o[d_], 0, 0, 0); } } while (0)
    f32x16 sc[NBLK]; bf16x8 pf[NBLK][2]; bool pv_pending = false;
    const bool order_b = (wave & 1) != 0;
    auto att_body = [&](int step, int vo_cur, int vo_prev, int ko_next) {
        const int k0 = step * KSTEP + ((MODE == 0) ? 0 : st * KT);
        const bool valid_next = (step + 1 < nsteps) && (MODE == 2 || k0 + KSTEP <= qw0 + 31);
        const bool valid = (MODE == 2) || (k0 <= qw0 + 31);
        if (!order_b && pv_pending && !(P.dbg & 1)) ATT_PV(vo_prev);
        pv_pending = valid && !order_b;
        if (valid && !(P.dbg & 2)) {
        const bool need_mask = (MODE != 2) && (k0 + KT - 1 > qw0);
        float bb = 0.f; bool near = false;
        if constexpr (MODE == 0) {
            const LAS float* lut = (const LAS float*)(lds + OFF_LUT);
            const LAS int* pk = (const LAS int*)(lds + vo_cur + OFF_POS);
            near = (posq0 - pk[KT - 1]) < 127;
            if (near) {
#pragma unroll
                for (int blk = 0; blk < NBLK; ++blk)
#pragma unroll
                    for (int i = 0; i < 16; ++i) { const int kl = 32 * blk + (i & 3) + 8 * (i >> 2) + 4 * h2; int rel = mypos - pk[kl]; rel = rel < 0 ? 0 : (rel > 127 ? 127 : rel);
                        sc[blk][i] = sc[blk][i] * P.c1 + lut[rel]; }
            } else bb = lut[127];
        }
        if (need_mask) {
#pragma unroll
            for (int blk = 0; blk < NBLK; ++blk)
#pragma unroll
                for (int i = 0; i < 16; ++i) { const int key = k0 + 32 * blk + (i & 3) + 8 * (i >> 2) + 4 * h2; if (key > myq) sc[blk][i] = NEG; }
        }
        const float cc = near ? 1.f : P.c1;
        float mx = sc[0][0];
#pragma unroll
        for (int blk = 0; blk < NBLK; ++blk)
#pragma unroll
            for (int i = 0; i < 16; ++i) mx = fmaxf(mx, sc[blk][i]);
        { const int mi = __builtin_bit_cast(int, mx); auto rr = __builtin_amdgcn_permlane32_swap(mi, mi, false, false); mx = fmaxf(__builtin_bit_cast(float, (int)rr[0]), __builtin_bit_cast(float, (int)rr[1])); }
        mx = mx * cc + bb;
        if (__any(mx > m_run + THR)) {
            const float m_new = fmaxf(m_run, mx);
            const float alpha = __builtin_amdgcn_exp2f(m_run - m_new);
            m_run = m_new; l_run *= alpha;
#pragma unroll
            for (int d = 0; d < 4; ++d)
#pragma unroll
                for (int i = 0; i < 16; ++i) o[d][i] *= alpha;
        }
        const float off = bb - m_run;
        float psum = 0.f;
#pragma unroll
        for (int blk = 0; blk < NBLK; ++blk)
#pragma unroll
            for (int i = 0; i < 16; ++i) { const float p = __builtin_amdgcn_exp2f(__builtin_fmaf(sc[blk][i], cc, off)); sc[blk][i] = p; psum += p; }
        l_run += psum;
#pragma unroll
        for (int blk = 0; blk < NBLK; ++blk)
#pragma unroll
            for (int s16 = 0; s16 < 2; ++s16) { u32x4 w; w.x = pk2(sc[blk][8 * s16 + 0], sc[blk][8 * s16 + 1]); w.y = pk2(sc[blk][8 * s16 + 2], sc[blk][8 * s16 + 3]);
                w.z = pk2(sc[blk][8 * s16 + 4], sc[blk][8 * s16 + 5]); w.w = pk2(sc[blk][8 * s16 + 6], sc[blk][8 * s16 + 7]); pf[blk][s16] = __builtin_bit_cast(bf16x8, w); }
        }
        if (order_b && valid && !(P.dbg & 1)) ATT_PV(vo_cur);
        if (valid_next && !(P.dbg & 4)) ATT_QK(sc, ko_next);
        };
#define ATT_BODY(step, vc, vp) att_body(step, vc, vp, 0)
#define ATT_BAR() asm volatile("s_waitcnt lgkmcnt(0)\n\ts_barrier" ::: "memory")
    if constexpr (ONEB) {
        ATT_PREFETCH_K(0);
        __syncthreads();
        ATT_STAGE_K(0, 0);
        if (nsteps > 1) ATT_PREFETCH_K(0);
        ATT_PREFETCH_V(0, 0);
        if (nsteps > 1) ATT_STAGE_K(0, KSLOT);
        ATT_STAGE_V(0, OFF_V);
        if (nsteps > 2) ATT_PREFETCH_K(0);
        if (nsteps > 1) ATT_PREFETCH_V(0, 1);
        __syncthreads();
        ATT_QK(sc, 0);
        int vo_prev = OFF_V + 2 * VSLOT, vo_cur = OFF_V, vo_next = OFF_V + VSLOT;
        for (int step = 0; step < nsteps; ++step) {
            ATT_BAR();
            const int ko_next = ((step + 1) & 1) * KSLOT, ko_free = (step & 1) * KSLOT;
            if (!(P.dbg & 8)) {
                if (step + 2 < nsteps) ATT_STAGE_K(0, ko_free);
                if (step + 1 < nsteps) ATT_STAGE_V(0, vo_next);
                if (step + 3 < nsteps) ATT_PREFETCH_K(0);
                if (step + 2 < nsteps) ATT_PREFETCH_V(0, step + 2); }
            att_body(step, vo_cur, vo_prev, ko_next);
            const int tmp_ = vo_prev; vo_prev = vo_cur; vo_cur = vo_next; vo_next = tmp_;
        }
        if (pv_pending) ATT_PV(vo_prev);
    } else {
    ATT_PREFETCH_K(0);
    __syncthreads();
    ATT_STAGE_K(0, 0);
    if (nsteps > 1) ATT_PREFETCH_K(KSET(0));
    if (PFD == 2 && nsteps > 2) ATT_PREFETCH_K(0);
    ATT_PREFETCH_V(0, 0);
    if (PFD == 2 && nsteps > 1) ATT_PREFETCH_V(1, 1);
    __syncthreads();
    ATT_QK(sc, 0);
#define ATT_ITER(step, par) do { \
        const int vo_cur = OFF_V + (par) * VSLOT, vo_prev = OFF_V + ((par) ^ 1) * VSLOT; \
        ATT_BAR();                                                  \
        if (!(P.dbg & 8)) { if ((step) + 1 < nsteps) ATT_STAGE_K(KSET(par), 0); \
        ATT_STAGE_V(VSET(par), vo_cur); } \
        ATT_BAR();                                                  \
        if (!(P.dbg & 8)) { if ((step) + 1 + PFD < nsteps) ATT_PREFETCH_K(KSET(par)); \
        if ((step) + PFD < nsteps) ATT_PREFETCH_V(VSET(par), (step) + PFD); } \
        ATT_BODY(step, vo_cur, vo_prev); } while (0)
    for (int step = 0; step < nsteps; step += 2) { ATT_ITER(step, 0); if (step + 1 < nsteps) ATT_ITER(step + 1, 1); }
    if (pv_pending) ATT_PV(OFF_V + ((nsteps - 1) & 1) * VSLOT);
    }
#undef ATT_PREFETCH_K
#undef ATT_PREFETCH_V
#undef ATT_STAGE_K
#undef ATT_STAGE_V
#undef ATT_QK
#undef ATT_PV
#undef ATT_VLD
#undef ATT_ITER
#undef ATT_BAR
#undef ATT_BODY
#undef KSET
#undef VSET
    l_run += __shfl_xor(l_run, 32);
    __syncthreads();
    LAS float* mb = (LAS float*)(lds + qg * 17408);
    if (st == 1) {
        if constexpr (MODE == 0) { const float inv = 1.f / l_run;
#pragma unroll
            for (int d = 0; d < 4; ++d)
#pragma unroll
                for (int i = 0; i < 16; ++i) mb[(d * 16 + i) * 64 + lane] = o[d][i] * inv;
        } else {
#pragma unroll
            for (int d = 0; d < 4; ++d)
#pragma unroll
                for (int i = 0; i < 16; ++i) mb[(d * 16 + i) * 64 + lane] = o[d][i];
            mb[4096 + lane] = m_run; mb[4160 + lane] = l_run;
        }
    }
    __syncthreads();
    if (st == 0) {
        if constexpr (MODE == 0) {
            const float inv = 1.f / l_run; float ss = 0.f;
#pragma unroll
            for (int d = 0; d < 4; ++d)
#pragma unroll
                for (int i = 0; i < 16; ++i) { const float v = o[d][i] * inv - P.lam * mb[(d * 16 + i) * 64 + lane]; o[d][i] = v; ss += v * v; }
            ss += __shfl_xor(ss, 32);
            const float rn = rsqrtf(ss * (1.f / 128.f) + 1e-5f) * P.outscale;
#pragma unroll
            for (int d = 0; d < 4; ++d)
#pragma unroll
                for (int i = 0; i < 16; ++i) { const int dv = 32 * d + (i & 3) + 8 * (i >> 2) + 4 * h2; o[d][i] = o[d][i] * rn * P.subw[dv]; }
        } else {
            const float m1 = mb[4096 + lane], l1 = mb[4160 + lane];
            const float mt = fmaxf(m_run, m1); const float a0 = __builtin_amdgcn_exp2f(m_run - mt), a1 = __builtin_amdgcn_exp2f(m1 - mt);
            const float inv = 1.f / (l_run * a0 + l1 * a1);
#pragma unroll
            for (int d = 0; d < 4; ++d)
#pragma unroll
                for (int i = 0; i < 16; ++i) o[d][i] = (o[d][i] * a0 + mb[(d * 16 + i) * 64 + lane] * a1) * inv;
        }
        LAS unsigned char* og = lds + OFF_OST + qg * (32 * OSTP);
#pragma unroll
        for (int d = 0; d < 4; ++d)
#pragma unroll
            for (int g4 = 0; g4 < 4; ++g4) { u32x2 w; w.x = pk2(o[d][4 * g4 + 0], o[d][4 * g4 + 1]); w.y = pk2(o[d][4 * g4 + 2], o[d][4 * g4 + 3]);
                *(LAS u32x2*)(og + r32 * OSTP + (32 * d + 8 * g4 + 4 * h2) * 2) = w; }
        asm volatile("s_waitcnt lgkmcnt(0)" ::: "memory");
        bf16_t* op = P.O + (P.qrow0 + qw0) * (size_t)P.opitch + P.ocol0;
#pragma unroll
        for (int i = 0; i < 8; ++i) { const int row = 4 * i + (lane >> 4), ch = lane & 15;
            const u32x4 v = *(const LAS u32x4*)(og + row * OSTP + ch * 16);
            *(u32x4*)(op + (size_t)row * P.opitch + ch * 8) = v; }
    }
    __syncthreads();
}

DI void phase_att(const Ctx& C, int l) {
    inptr_t in = C.in; unsigned char* ws = C.ws;
    const int ATT_SEL = C.att_sel & 0xff; const int dbg = C.att_sel >> 8;
    if (ATT_SEL & 1) phase_post(C, l);
    bf16_t* Y = dbg ? (bf16_t*)(ws + WS_H) : (bf16_t*)(ws + WS_PRW); const bf16_t* PATT = (const bf16_t*)(ws + WS_PATT);
    const float lambda_init = 0.8f - 0.6f * expf(-0.3f * (float)l);
    float lam;
    { const float a = wave_sum(in[23][l * 64 + C.lane] * in[24][l * 64 + C.lane]), b = wave_sum(in[25][l * 64 + C.lane] * in[26][l * 64 + C.lane]); lam = expf(a) - expf(b) + lambda_init; }
    if (ATT_SEL & 2) for (int w = C.vcu; w < 256; w += C.G) {
        const int bh = w >> 4, j = w & 15, b = bh >> 2, h = bh & 3;
#pragma unroll 1
        for (int k = 0; k < 2; ++k) { const int qb = k ? 31 - j : j;
            AttnP P; P.Q = PATT; P.qpitch = PATT_COLS; P.qcol0 = h * 128; P.K1 = PATT; P.k1pitch = PATT_COLS; P.k1col0 = 512 + h * 128; P.K2 = PATT; P.k2pitch = 0; P.k2col0 = 0;
            P.V = PATT; P.vpitch = PATT_COLS; P.vcol0 = 1024 + h * 128; P.O = Y; P.opitch = 2048; P.ocol0 = 1024 + h * 128;
            P.qrow0 = (size_t)b * SEQ; P.krow0 = (size_t)b * SEQ; P.q0 = qb * 128; P.nkeys = qb * 128 + 128; P.c1 = 0.125f * LOG2E;
            P.pos = (const int*)in[2] + b * SEQ; P.lut = (const float*)(ws + WS_LUT) + h * 128; P.lam = lam; P.outscale = 1.f - lambda_init; P.subw = in[27] + l * 128; P.dbg = dbg;
            attn_unit<64, 64, 0, 64, 1>(C.lds, P); }
    }
    const bf16_t* QM = (const bf16_t*)(ws + WS_QM); const bf16_t* KVM = (const bf16_t*)(ws + WS_KVM); const bf16_t* KPE = (const bf16_t*)(ws + WS_KPE);
    if (ATT_SEL & 4) for (int w = C.vcu; w < 256; w += C.G) {
        const int bh = w >> 4, j = w & 15, b = bh >> 2, h = bh & 3;
#pragma unroll 1
        for (int k = 0; k < 2; ++k) { const int qb = k ? 31 - j : j;
            AttnP P; P.Q = QM; P.qpitch = 768; P.qcol0 = h * 192; P.K1 = KVM; P.k1pitch = 1024; P.k1col0 = h * 256; P.K2 = KPE; P.k2pitch = 64; P.k2col0 = 0;
            P.V = KVM; P.vpitch = 1024; P.vcol0 = h * 256 + 128; P.O = Y; P.opitch = 2048; P.ocol0 = 1536 + h * 128;
            P.qrow0 = (size_t)b * SEQ; P.krow0 = (size_t)b * SEQ; P.q0 = qb * 128; P.nkeys = qb * 128 + 128; P.c1 = 0.07216878364870322f * LOG2E;
            P.pos = nullptr; P.lut = nullptr; P.lam = 0.f; P.outscale = 0.f; P.subw = nullptr; P.dbg = dbg;
            attn_unit<192, 128, 1, 32, 1>(C.lds, P); }
    }
}

DI void phase_cross(const Ctx& C) {
    unsigned char* ws = C.ws; const int dbg = 0;
    const bf16_t* CAQ = (const bf16_t*)(ws + WS_CAQ); const bf16_t* MKV = (const bf16_t*)(ws + WS_MEMKV); bf16_t* CAO = (bf16_t*)(ws + WS_CAO);
    for (int u = C.vcu; u < 512; u += C.G) {
        const int bh = u >> 5, qb = u & 31, b = bh >> 2, h = bh & 3;
        AttnP P; P.Q = CAQ; P.qpitch = 512; P.qcol0 = h * 128; P.K1 = MKV; P.k1pitch = 1024; P.k1col0 = h * 128; P.K2 = MKV; P.k2pitch = 0; P.k2col0 = 0;
        P.V = MKV; P.vpitch = 1024; P.vcol0 = 512 + h * 128; P.O = CAO; P.opitch = 512; P.ocol0 = h * 128;
        P.qrow0 = (size_t)b * SEQ; P.krow0 = (size_t)b * MEMLEN; P.q0 = qb * 128; P.nkeys = MEMLEN; P.c1 = 0.08838834764831845f * LOG2E;
        P.pos = nullptr; P.lut = nullptr; P.lam = 0.f; P.outscale = 0.f; P.subw = nullptr; P.dbg = dbg;
        attn_unit<128, 128, 2, 64, 1>(C.lds, P);
    }
}

DI void phase_route(const Ctx& C, int l) {
    inptr_t in = C.in; unsigned char* ws = C.ws;
    const float* LG = (const float*)(ws + WS_LOGITS);
    const float* bg = in[39] + l * 4; const float* be = in[41] + l * 32;
    int* EID = (int*)(ws + WS_EID); float* GATE = (float*)(ws + WS_GATE); int* CNT = (int*)(ws + WS_CNT);
    LAS int* hist = (LAS int*)(C.lds);
    const int lane = C.lane;
    for (int wgt = C.wg; wgt < 256; wgt += C.G) {
        if (C.tid < 32) hist[C.tid] = 0;
        __syncthreads();
#pragma unroll 1
        for (int r = 0; r < 8; ++r) {
            const int t = wgt * 64 + C.wave * 8 + r;
            const float raw = (lane < 36) ? LG[(size_t)t * 256 + lane] : 0.f;
            const float g0 = RDL_F(raw, 32), g1 = RDL_F(raw, 33), g2 = RDL_F(raw, 34), g3 = RDL_F(raw, 35);
            int sel = 0; float best = g0 + bg[0];
            if (g1 + bg[1] > best) { best = g1 + bg[1]; sel = 1; }
            if (g2 + bg[2] > best) { best = g2 + bg[2]; sel = 2; }
            if (g3 + bg[3] > best) { best = g3 + bg[3]; sel = 3; }
            const float gm = fmaxf(fmaxf(g0, g1), fmaxf(g2, g3));
            const float e0 = __expf(g0 - gm), e1 = __expf(g1 - gm), e2 = __expf(g2 - gm), e3 = __expf(g3 - gm);
            const float es = sel == 0 ? e0 : (sel == 1 ? e1 : (sel == 2 ? e2 : e3));
            const float pgrp = es / ((e0 + e1) + (e2 + e3));
            float val = (lane < 32 && (lane >> 3) == sel) ? raw + be[lane & 31] : -INFINITY;
            const float m1 = wave_max(val); const int i1 = __ffsll((long long)__ballot(val == m1)) - 1;
            if (lane == i1) val = -INFINITY;
            const float m2 = wave_max(val); const int i2 = __ffsll((long long)__ballot(val == m2)) - 1;
            const float r1 = __shfl(raw, i1), r2 = __shfl(raw, i2);
            const float w1 = 1.f / (1.f + __expf(r2 - r1)), w2 = 1.f - w1;
            if (lane == 0) { EID[2 * t] = i1; EID[2 * t + 1] = i2; GATE[2 * t] = w1 * pgrp; GATE[2 * t + 1] = w2 * pgrp;
                atomicAdd((int*)&hist[i1], 1); atomicAdd((int*)&hist[i2], 1); }
        }
        __syncthreads();
        if (C.tid < 32) CNT[wgt * 32 + C.tid] = hist[C.tid];
        __syncthreads();
    }
}

DI void phase_dispatch(const Ctx& C) {
    unsigned char* ws = C.ws;
    const int* EID = (const int*)(ws + WS_EID); const int* CNT = (const int*)(ws + WS_CNT);
    int* ROWMAP = (int*)(ws + WS_ROWMAP); int* ROWDST = (int*)(ws + WS_ROWDST); int* TILEEXP = (int*)(ws + WS_TILEEXP);
    LAS int* tot = (LAS int*)(C.lds); LAS int* base = tot + 32; LAS int* off = base + 32; LAS int* eid = off + 40; LAS int* posl = eid + 128;
    const int tid = C.tid;
    for (int wgt = C.wg; wgt < 256; wgt += C.G) {
        { LAS int* cl = posl + 128;
#pragma unroll
          for (int i = 0; i < 16; ++i) cl[tid + 512 * i] = CNT[tid + 512 * i];
          __syncthreads();
          if (tid < 32) { int s = 0, bsum = 0; for (int w = 0; w < 256; ++w) { const int c = cl[w * 32 + tid]; if (w == wgt) bsum = s; s += c; } tot[tid] = s; base[tid] = bsum; } }
        if (tid >= 64 && tid < 192) eid[tid - 64] = EID[wgt * 128 + (tid - 64)];
        __syncthreads();
        if (tid == 0) { int o = 0; for (int e = 0; e < 32; ++e) { off[e] = o; o += (tot[e] + 255) & ~255; } off[32] = o; }
        __syncthreads();
        if (tid < 128) { const int e = eid[tid]; int rank = 0; for (int j = 0; j < tid; ++j) rank += (eid[j] == e) ? 1 : 0;
            const int pos = off[e] + base[e] + rank; ROWMAP[pos] = wgt * 64 + (tid >> 1); ROWDST[pos] = wgt * 128 + tid; }
        if (wgt < 32) { const int e = wgt; for (int p = off[e] + tot[e] + tid; p < off[e + 1]; p += 512) { ROWMAP[p] = 0; ROWDST[p] = -1; } }
        if (wgt == 0) { if (tid < 32) { for (int tl = off[tid] >> 8; tl < (off[tid + 1] >> 8); ++tl) TILEEXP[tl] = tid; } if (tid == 0) TILEEXP[200] = off[32] >> 8; }
        __syncthreads();
    }
}

#ifndef PHASE_MASK
#define PHASE_MASK 0x1ffff
#endif
#define IN(k) (lo <= (k) && (k) < hi)
#define EN(j) ((PHASE_MASK >> (j)) & 1)
#define SEAM(k) do { if (IN(k) && IN((k) + 1)) xcd_barrier(bar); } while (0)
#define PH_BEGIN() do { int t_ = threadIdx.x; asm volatile("" : "+v"(t_)); kaptr_t ka_ = (kaptr_t)__builtin_amdgcn_kernarg_segment_ptr(); asm volatile("" : "+s"(ka_)); \
        C.lds = (LAS unsigned char*)lds_raw; C.in = (inptr_t)ka_; C.X = *(float* const CAS*)(ka_ + 360); C.ws = *(unsigned char* const CAS*)(ka_ + 368); \
        C.tid = t_; C.lane = t_ & 63; C.wave = __builtin_amdgcn_readfirstlane(t_ >> 6); { int g_ = gridDim.x, b_ = blockIdx.x; asm volatile("" : "+s"(g_), "+s"(b_)); C.G = g_; C.wg = b_; } C.gw = C.wg * 8 + C.wave; C.ngw = C.G * 8; C.vcu = (C.G % 8 == 0) ? (C.wg % 8) * (C.G / 8) + C.wg / 8 : C.wg; \
        ws = C.ws; in = C.in; } while (0)
constexpr int PPL = 16, NPHASE = 2 * PPL + 1;
template <int l>
DI void run_layer(unsigned char* lds_raw, const XcdBarrier& bar, int lo, int hi, int att_sel = 7) {
    Ctx C; unsigned char* ws; inptr_t in; C.att_sel = att_sel;
    constexpr int pb = l * PPL;

        if (EN(0) && IN(pb + 0)) { PH_BEGIN(); phase_convert(C, l); } SEAM(pb + 0);
        if (EN(1) && IN(pb + 1)) { PH_BEGIN();
            { pg8::Gemm g{(const bf16_t*)(ws + WS_XB), (const bf16_t*)(ws + wofs(l) + WS_WINT), DM, DM, DM, nullptr}; pg8::StaticOrder S; S.init(NT, INP, C.G, C.wg, DM);
              pg8::EpiBf16 E{(bf16_t*)(ws + WS_PRW), RW_COLS, (bf16_t*)(ws + WS_PATT), PATT_COLS, 13, (const float*)(ws + WS_SSQM), 1};
              pg8::gemm_phase<pg8::EpiBf16, pg8::StaticOrder>(C.lds, g, S, E); }
            { pg8::Gemm g{(const bf16_t*)(ws + WS_MEMN), (const bf16_t*)(ws + wofs(l) + WS_CAWKVT), DM, DM, DM, nullptr}; pg8::StaticOrder S; S.init(NMEM, 1024, C.G, (C.wg + C.G / 2) % C.G, DM);
              pg8::EpiBf16 E{(bf16_t*)(ws + WS_MEMKV), 1024, nullptr, 0, 1 << 30, nullptr, 1};
              pg8::gemm_phase<pg8::EpiBf16, pg8::StaticOrder>(C.lds, g, S, E); }
        } SEAM(pb + 1);
        if (EN(2) && IN(pb + 2)) { PH_BEGIN(); phase_ew1(C, l); } SEAM(pb + 2);
        if (EN(3) && IN(pb + 3)) { PH_BEGIN();
            { pg8::Gemm g{(const bf16_t*)(ws + WS_LORAA), (const bf16_t*)(ws + wofs(l) + WS_LORABT), 384, 128, 128, nullptr}; pg8::StaticOrder S; S.init(NT, 2048, C.G, C.wg, 128);
              pg8::EpiBf16 E{(bf16_t*)(ws + WS_LORAO), 4096, nullptr, 0, 1 << 30, nullptr, 1};
              pg8::gemm_phase<pg8::EpiBf16, pg8::StaticOrder>(C.lds, g, S, E); }
            { pg8::Gemm g{(const bf16_t*)(ws + WS_LORAA) + 128, (const bf16_t*)(ws + wofs(l) + WS_LORABT) + 2048 * 128, 384, 128, 128, nullptr}; pg8::StaticOrder S; S.init(NT, 1024, C.G, C.wg, 128);
              pg8::EpiBf16 E{(bf16_t*)(ws + WS_LORAO) + 2048, 4096, nullptr, 0, 1 << 30, nullptr, 1};
              pg8::gemm_phase<pg8::EpiBf16, pg8::StaticOrder>(C.lds, g, S, E); }
            if (l == 1) { pg8::Gemm g{(const bf16_t*)(ws + WS_LORAA) + 256, (const bf16_t*)(ws + wofs(l) + WS_LORABT) + 3072 * 128, 384, 128, 128, nullptr}; pg8::StaticOrder S; S.init(NT, 1024, C.G, C.wg, 128);
              pg8::EpiBf16 E{(bf16_t*)(ws + WS_LORAO) + 3072, 4096, nullptr, 0, 1 << 30, nullptr, 1};
              pg8::gemm_phase<pg8::EpiBf16, pg8::StaticOrder>(C.lds, g, S, E); }
            { pg8::Gemm g{(const bf16_t*)(ws + WS_QN), (const bf16_t*)(ws + wofs(l) + WS_WQBT), 384, 384, 384, nullptr}; pg8::StaticOrder S; S.init(NT, 768, C.G, C.wg, 384);
              pg8::EpiBf16 E{(bf16_t*)(ws + WS_QM), 768, nullptr, 0, 1 << 30, nullptr, 1};
              pg8::gemm_phase<pg8::EpiBf16, pg8::StaticOrder>(C.lds, g, S, E); }
            { pg8::Gemm g{(const bf16_t*)(ws + WS_KVN), (const bf16_t*)(ws + wofs(l) + WS_WKVBT), 256, 256, 256, nullptr}; pg8::StaticOrder S; S.init(NT, 1024, C.G, C.wg, 256);
              pg8::EpiBf16 E{(bf16_t*)(ws + WS_KVM), 1024, nullptr, 0, 1 << 30, nullptr, 1};
              pg8::gemm_phase<pg8::EpiBf16, pg8::StaticOrder>(C.lds, g, S, E); }
        } SEAM(pb + 3);
        if (EN(4) && IN(pb + 4)) { PH_BEGIN(); phase_ew2(C, l); } SEAM(pb + 4);
        if (EN(5) && IN(pb + 5)) { PH_BEGIN(); phase_scan(C, l); } SEAM(pb + 5);
        if (EN(6) && IN(pb + 6)) { PH_BEGIN(); phase_att(C, l); } SEAM(pb + 6);
        if (EN(7) && IN(pb + 7)) { PH_BEGIN();
            pg8::Gemm g{(const bf16_t*)(ws + WS_PRW), (const bf16_t*)(ws + wofs(l) + WS_WOUTT), DM, DM, DM, nullptr}; pg8::StaticOrder S; S.init(NT, DM, C.G, C.wg, DM);
            pg8::EpiResid E{nullptr, (const bf16_t*)(ws + WS_XB), (bf16_t*)(ws + WS_XB), DM, (float*)(ws + WS_PARTC)};
            pg8::gemm_phase<pg8::EpiResid, pg8::StaticOrder>(C.lds, g, S, E);
        } SEAM(pb + 7);
        if (EN(8) && IN(pb + 8)) { PH_BEGIN();
            pg8::Gemm g{(const bf16_t*)(ws + WS_XB), (const bf16_t*)(ws + wofs(l) + WS_CAWQT), DM, DM, DM, nullptr}; pg8::StaticOrder S; S.init(NT, 512, C.G, C.wg, DM);
            pg8::EpiBf16 E{(bf16_t*)(ws + WS_CAQ), 512, nullptr, 0, 1 << 30, (const float*)(ws + WS_PARTC), 32};
            pg8::gemm_phase<pg8::EpiBf16, pg8::StaticOrder>(C.lds, g, S, E);
        } SEAM(pb + 8);
        if (EN(9) && IN(pb + 9)) { PH_BEGIN(); phase_cross(C); } SEAM(pb + 9);
        if (EN(10) && IN(pb + 10)) { PH_BEGIN();
            pg8::Gemm g{(const bf16_t*)(ws + WS_CAO), (const bf16_t*)(ws + wofs(l) + WS_CAWOT), 512, 512, 512, nullptr}; pg8::StaticOrder S; S.init(NT, DM, C.G, C.wg, 512);
            pg8::EpiResid E{nullptr, (const bf16_t*)(ws + WS_XB), (bf16_t*)(ws + WS_XB), DM, (float*)(ws + WS_PARTF)};
            pg8::gemm_phase<pg8::EpiResid, pg8::StaticOrder>(C.lds, g, S, E);
        } SEAM(pb + 10);
        if (EN(11) && IN(pb + 11)) { PH_BEGIN();
            pg8::Gemm g{(const bf16_t*)(ws + WS_XB), (const bf16_t*)(ws + (l ? WS_WRB1 : WS_WRB)), DM, DM, DM, nullptr}; pg8::StaticOrder S; S.init(NT, 256, C.G, C.wg, DM);
            pg8::EpiF32 E{(float*)(ws + WS_LOGITS), 256, (const float*)(ws + WS_PARTF), 32, (float*)(ws + WS_SSQF)};
            pg8::gemm_phase<pg8::EpiF32, pg8::StaticOrder>(C.lds, g, S, E);
        } SEAM(pb + 11);
        if (EN(12) && IN(pb + 12)) { PH_BEGIN(); phase_route(C, l); } SEAM(pb + 12);
        if (EN(13) && IN(pb + 13)) { PH_BEGIN(); phase_dispatch(C); } SEAM(pb + 13);
        if (EN(14) && IN(pb + 14)) { PH_BEGIN();
            const int* TE = (const int*)(ws + WS_TILEEXP);
            pg8::Gemm g{(const bf16_t*)(ws + WS_XB), (const bf16_t*)(ws + WS_WGU), DM, DM, DM, (const int*)(ws + WS_ROWMAP)};
            pg8::MoeOrder S{TE, TE[200], 4, C.G, C.vcu, DM, (long)1024 * DM, C.wg};
            pg8::EpiSiluMul E{(bf16_t*)(ws + WS_HID), DEXP, (const float*)(ws + WS_SSQF), (const int*)(ws + WS_ROWMAP)};
            pg8::gemm_phase<pg8::EpiSiluMul, pg8::MoeOrder, true>(C.lds, g, S, E);
        } SEAM(pb + 14);
        if (EN(15) && IN(pb + 15)) { PH_BEGIN();
            const int* TE = (const int*)(ws + WS_TILEEXP);
            pg8::Gemm g{(const bf16_t*)(ws + WS_HID), (const bf16_t*)(ws + WS_WD), DEXP, DEXP, DEXP, nullptr};
            pg8::MoeOrder S{TE, TE[200], 8, C.G, C.vcu, DEXP, (long)DM * DEXP, C.wg};
            pg8::EpiScatter E{(bf16_t*)(ws + WS_C2), DM, (const int*)(ws + WS_ROWDST)};
            pg8::gemm_phase<pg8::EpiScatter, pg8::MoeOrder>(C.lds, g, S, E);
        } SEAM(pb + 15);
    }

__global__ void __launch_bounds__(512, 2) mk_fwd(Args args) {
    extern __shared__ __attribute__((aligned(16))) unsigned char lds_raw[];
    Ctx C;
    unsigned char* ws; inptr_t in;
    PH_BEGIN();
    volatile LAS unsigned* MISC = (volatile LAS unsigned*)(C.lds + LDS_MISC);
    if (C.tid < 64) MISC[C.tid] = 0u;
    __syncthreads();
    const int lo = args.ph_lo, hi = args.ph_hi;
    XcdBarrier bar; bar.bar = (unsigned*)(args.ws + WS_CTL) + CW_BAR; bar.x = 0; bar.st = MISC + 8;
    if (hi - lo > 1) bar = xcd_barrier_post((unsigned*)(args.ws + WS_CTL) + CW_BAR, MISC + 8);
#ifndef PROBE_MASK
#define PROBE_MASK 0
#endif
#if PROBE_MASK
#ifndef PROBE_ATT
#define PROBE_ATT 7
#endif
#define RUNP(k) do { run_layer<0>(lds_raw, bar, (k), (k) + 1); xcd_barrier(bar); if ((PROBE_MASK >> (k)) & 1) { run_layer<0>(lds_raw, bar, (k), (k) + 1, PROBE_ATT); xcd_barrier(bar); } } while (0)
    RUNP(0); RUNP(1); RUNP(2); RUNP(3); RUNP(4); RUNP(5); RUNP(6); RUNP(7); RUNP(8); RUNP(9); RUNP(10); RUNP(11); RUNP(12); RUNP(13); RUNP(14); RUNP(15);
    run_layer<1>(lds_raw, bar, PPL, 2 * PPL); xcd_barrier(bar);
#else
    run_layer<0>(lds_raw, bar, lo, hi);
    run_layer<1>(lds_raw, bar, lo, hi);
#endif
    if (EN(16) && IN(2 * PPL)) { PH_BEGIN();
        const bf16_t* C2 = (const bf16_t*)(ws + WS_C2); const float* gate = (const float*)(ws + WS_GATE);
        for (int m = C.gw; m < NT; m += C.ngw)
            norm_row(nullptr, (const bf16_t*)(ws + WS_XB) + (size_t)m * DM, nullptr, C2 + (size_t)(2 * m) * DM, C2 + (size_t)(2 * m + 1) * DM, gate[2 * m], gate[2 * m + 1], in[4], nullptr, C.X + (size_t)m * DM, C.lane);
    }
#undef IN
#undef SEAM
}

extern "C" void kernel_launch(void* const* d_in, const int* in_sizes, int n_in, void* d_out, int out_size, void* d_ws, size_t ws_size, hipStream_t stream) {
    static int grid = 0;
    if (grid == 0) {
        if (n_in != 45 || out_size != NT * DM || ws_size < WS_END) { grid = -1; return; }
        int dev = 0, cus = 0;
        if (hipGetDevice(&dev) != hipSuccess || hipDeviceGetAttribute(&cus, hipDeviceAttributeMultiprocessorCount, dev) != hipSuccess) { grid = -1; return; }
        if (hipFuncSetAttribute((const void*)mk_fwd, hipFuncAttributeMaxDynamicSharedMemorySize, LDS_BYTES) != hipSuccess) { grid = -1; return; }
        int per_cu = 0;
        (void)hipOccupancyMaxActiveBlocksPerMultiprocessor(&per_cu, (const void*)mk_fwd, 512, LDS_BYTES);
        (void)hipGetLastError();
        grid = cus;
    }
    if (grid < 0) return;
    (void)hipMemsetAsync((char*)d_ws + WS_CTL, 0, 1 * MiB, stream);
    Args a{};
    for (int i = 0; i < 45; ++i) a.in[i] = d_in[i];
    a.out = (float*)d_out; a.ws = (unsigned char*)d_ws;
#if MK_ONE_LAUNCH
    a.ph_lo = 0; a.ph_hi = NPHASE;
    hipLaunchKernelGGL(mk_fwd, dim3(grid), dim3(512), LDS_BYTES, stream, a);
#else
    for (int p = 0; p < NPHASE; ++p) { a.ph_lo = p; a.ph_hi = p + 1; hipLaunchKernelGGL(mk_fwd, dim3(grid), dim3(512), LDS_BYTES, stream, a); }
#endif
}
```

```cpp
#include <hip/hip_runtime.h>
#include <stdint.h>
#include <math.h>

#ifndef MK_ONE_LAUNCH
#define MK_ONE_LAUNCH 1
#endif

#define DI __device__ __forceinline__
#define LAS __attribute__((address_space(3)))
#define GAS __attribute__((address_space(1)))

typedef unsigned short bf16_t;
typedef short bf16x8 __attribute__((ext_vector_type(8)));
typedef short s16x4 __attribute__((ext_vector_type(4)));
typedef float f32x2 __attribute__((ext_vector_type(2)));
typedef float f32x4 __attribute__((ext_vector_type(4)));
typedef float f32x16 __attribute__((ext_vector_type(16)));
typedef unsigned u32x2 __attribute__((ext_vector_type(2)));
typedef unsigned u32x4 __attribute__((ext_vector_type(4)));
typedef __bf16 bf16x2_t __attribute__((ext_vector_type(2)));
typedef short v4i16_t __attribute__((ext_vector_type(4)));
typedef _Float16 h2_t __attribute__((ext_vector_type(2)));
typedef _Float16 h4_t __attribute__((ext_vector_type(4)));

constexpr int NB = 4, SEQ = 4096, DM = 2048, NT = NB * SEQ;
constexpr int MEMLEN = 256, NMEM = NB * MEMLEN;
constexpr int RW_DIM = 1024, RW_COLS = 3328, IN_COLS = 5568, INP = 5632;
constexpr int PATT_COLS = 2304;
constexpr int NEXP = 32, DEXP = 512;
constexpr int MOE_ROWS = 40960;
constexpr float LOG2E = 1.4426950408889634f;

constexpr size_t MiB = 1u << 20, KiB = 1024;
constexpr size_t WS_CTL = 0;
constexpr size_t WS_ROPE = 1 * MiB;
constexpr size_t WS_EID = 5 * MiB;
constexpr size_t WS_GATE = 5 * MiB + 128 * KiB;
constexpr size_t WS_CNT = 5 * MiB + 256 * KiB;
constexpr size_t WS_ROWMAP = 5 * MiB + 320 * KiB;
constexpr size_t WS_ROWDST = 5 * MiB + 512 * KiB;
constexpr size_t WS_TILEEXP = 5 * MiB + 704 * KiB;
constexpr size_t WS_WRB = 7 * MiB;
constexpr size_t WS_LOGITS = 852 * MiB;
constexpr size_t WS_SSQM = 6 * MiB;
constexpr size_t WS_SSQC = 6 * MiB + 64 * KiB;
constexpr size_t WS_SSQF = 6 * MiB + 128 * KiB;
constexpr size_t WS_LUT = 6 * MiB + 512 * KiB;
constexpr size_t WS_WINT = 8 * MiB;
constexpr size_t WS_WOUTT = 30 * MiB;
constexpr size_t WS_CAWQT = 38 * MiB;
constexpr size_t WS_CAWKVT = 40 * MiB;
constexpr size_t WS_CAWOT = 44 * MiB;
constexpr size_t WS_WQBT = 46 * MiB;
constexpr size_t WS_WKVBT = 47 * MiB;
constexpr size_t WS_LORABT = 48 * MiB;
constexpr size_t WS_WGU = 52 * MiB;
constexpr size_t WS_WD = 180 * MiB;
constexpr size_t WS_H = 248 * MiB;
constexpr size_t WS_PRW = 312 * MiB;
constexpr size_t WS_PATT = 416 * MiB;
constexpr size_t WS_U = 488 * MiB;
constexpr size_t WS_HID = 488 * MiB, WS_C2 = 528 * MiB;
constexpr size_t WS_APERM = 312 * MiB;
constexpr size_t WS_LORAA = 680 * MiB;
constexpr size_t WS_LORAO = 692 * MiB;
constexpr size_t WS_VFIRST = 820 * MiB;
constexpr size_t WS_QN = 852 * MiB, WS_KVN = 864 * MiB, WS_QM = 872 * MiB, WS_KVM = 896 * MiB, WS_KPE = 928 * MiB;
constexpr size_t WS_CAQ = 852 * MiB, WS_CAO = 868 * MiB;
constexpr size_t WS_MEMN = 932 * MiB, WS_MEMKV = 936 * MiB;
constexpr size_t WS_XB = 940 * MiB;
constexpr size_t WS_PARTC = 1004 * MiB;
constexpr size_t WS_PARTF = 1006 * MiB;
constexpr size_t WS_L1OFF = 1000 * MiB;
constexpr size_t WS_WRB1 = 1052 * MiB;
constexpr size_t WS_END = 1053 * MiB;
constexpr int CW_BAR = 4096;

constexpr int LDS_MAIN = 131072;
constexpr int LDS_MISC = LDS_MAIN;
constexpr int LDS_BYTES = 147456;

DI unsigned pk2(float lo, float hi) { f32x2 v = {lo, hi}; bf16x2_t b = __builtin_convertvector(v, bf16x2_t); return __builtin_bit_cast(unsigned, b); }
DI bf16_t f2bf(float f) { return (bf16_t)(pk2(f, 0.f) & 0xffffu); }
DI unsigned pkh2(float lo, float hi) { const h2_t v = {(_Float16)lo, (_Float16)hi}; return __builtin_bit_cast(unsigned, v); }
DI float hflo(unsigned u) { return (float)__builtin_bit_cast(h2_t, u)[0]; }
DI float hfhi(unsigned u) { return (float)__builtin_bit_cast(h2_t, u)[1]; }
DI float bf2f(bf16_t b) { return __uint_as_float(((unsigned)b) << 16); }
DI float bflo(unsigned u) { return __uint_as_float(u << 16); }
DI float bfhi(unsigned u) { return __uint_as_float(u & 0xffff0000u); }
#define DPP_F(x, ctl) __builtin_bit_cast(float, __builtin_amdgcn_update_dpp(0, __builtin_bit_cast(int, x), ctl, 0xf, 0xf, true))
#define RDL_F(x, l) __builtin_bit_cast(float, __builtin_amdgcn_readlane(__builtin_bit_cast(int, x), l))
DI float wave_sum(float v) {
    v += DPP_F(v, 0xB1);
    v += DPP_F(v, 0x4E);
    v += DPP_F(v, 0x141);
    v += DPP_F(v, 0x140);
    const float r0 = RDL_F(v, 0), r1 = RDL_F(v, 16), r2 = RDL_F(v, 32), r3 = RDL_F(v, 48);
    return (r0 + r1) + (r2 + r3);
}
DI float wave_max(float v) {
    v = fmaxf(v, DPP_F(v, 0xB1)); v = fmaxf(v, DPP_F(v, 0x4E)); v = fmaxf(v, DPP_F(v, 0x141)); v = fmaxf(v, DPP_F(v, 0x140));
    const float r0 = RDL_F(v, 0), r1 = RDL_F(v, 16), r2 = RDL_F(v, 32), r3 = RDL_F(v, 48);
    return fmaxf(fmaxf(r0, r1), fmaxf(r2, r3));
}
DI float sigmoidf_(float x) { return 1.f / (1.f + __expf(-x)); }

#define XB_TMO      128
#define XB_XCNT(j)  (256  + 64 * (j))
#define XB_XSUB(j)  (1280 + 64 * (j))
#define XB_XGEN(j)  (2304 + 64 * (j))
#define XB_TOP      3328
#define XB_TOPGEN   3392
#define XCD_BAR_WORDS 3456
#define XB_SPIN_CAP (1u << 24)

DI unsigned xb_ld(unsigned* p)              { return __hip_atomic_load(p, __ATOMIC_RELAXED, __HIP_MEMORY_SCOPE_AGENT); }
DI unsigned xb_add(unsigned* p, unsigned v) { return __hip_atomic_fetch_add(p, v, __ATOMIC_RELAXED, __HIP_MEMORY_SCOPE_AGENT); }
DI unsigned xb_xcc_id() { return (unsigned)__builtin_amdgcn_s_getreg((3 << 11) | 20) & 0xFu; }
#define XB_SPIN(cond, bar) do { unsigned _sp = 0; while (cond) { __builtin_amdgcn_s_sleep(1); \
    if ((++_sp & 255u) == 0u) { if (xb_ld(&(bar)[XB_TMO])) break; if (_sp > XB_SPIN_CAP) { atomicAdd(&(bar)[XB_TMO], 1u); break; } } } } while (0)

struct XcdBarrier { unsigned* bar; unsigned x; volatile LAS unsigned* st; };

DI XcdBarrier xcd_barrier_post(unsigned* bar, volatile LAS unsigned* st) {
    XcdBarrier b; b.bar = bar; b.x = xb_xcc_id(); b.st = st;
    if (threadIdx.x == 0) (void)xb_add(&bar[XB_XCNT(b.x)], 1u);
    return b;
}
DI void xcd_barrier_complete(unsigned* bar, unsigned x, unsigned& nloc, unsigned& nx) {
    const unsigned G = gridDim.x * gridDim.y * gridDim.z;
    unsigned sum, cnt, mine, sp = 0u;
    for (;;) {
        sum = 0u; cnt = 0u; mine = 0u;
#pragma unroll
        for (unsigned j = 0; j < 16; ++j) { const unsigned c = xb_ld(&bar[XB_XCNT(j)]); sum += c; cnt += (c > 0u) ? 1u : 0u; mine = (j == x) ? c : mine; }
        if (sum == G) break;
        __builtin_amdgcn_s_sleep(1);
        if ((++sp & 255u) == 0u) { if (xb_ld(&bar[XB_TMO])) break; if (sp > XB_SPIN_CAP) { atomicAdd(&bar[XB_TMO], 1u); break; } }
    }
    nloc = mine > 0u ? mine : 1u; nx = cnt > 0u ? cnt : 1u;
}
DI void xcd_barrier(const XcdBarrier& b) {
    asm volatile("s_waitcnt vmcnt(0)" ::: "memory");
    __syncthreads();
    if (threadIdx.x == 0) {
        unsigned* bar = b.bar;
        __builtin_amdgcn_s_waitcnt(0);
        unsigned nloc = b.st[0], nx = b.st[1];
        if (nloc == 0u) { xcd_barrier_complete(bar, b.x, nloc, nx); b.st[0] = nloc; b.st[1] = nx; }
        const unsigned old = xb_add(&bar[XB_XSUB(b.x)], 1u);
        const unsigned gen = old / nloc;
        if (old + 1u == (gen + 1u) * nloc) {
            __builtin_amdgcn_fence(__ATOMIC_RELEASE, "agent");
            asm volatile("s_waitcnt vmcnt(0)" ::: "memory");
            const unsigned og = xb_add(&bar[XB_TOP], 1u);
            const unsigned tg = og / nx;
            if (og + 1u == (tg + 1u) * nx) xb_add(&bar[XB_TOPGEN], 1u);
            else XB_SPIN(xb_ld(&bar[XB_TOPGEN]) == tg, bar);
            __builtin_amdgcn_fence(__ATOMIC_ACQUIRE, "agent");
            xb_add(&bar[XB_XGEN(b.x)], 1u);
            asm volatile("s_waitcnt vmcnt(0)" ::: "memory");
        } else {
            XB_SPIN(xb_ld(&bar[XB_XGEN(b.x)]) == gen, bar);
            __builtin_amdgcn_fence(__ATOMIC_ACQUIRE, "agent");
            asm volatile("s_waitcnt vmcnt(0)" ::: "memory");
        }
    }
    __syncthreads();
}

namespace pg8 {
constexpr int BM = 256, BK = 64, HALF = 128, HTB = HALF * BK * 2, STAGE_BYTES = 8 * HTB, NXCD = 8, WGM = 8;
__host__ __device__ __forceinline__ int lds_byte(int r, int c) { const int st = (r >> 4) * 2 + (c >> 5), rr = r & 15, cc = c & 31, ob = rr * 64 + cc * 2; return st * 1024 + (ob ^ (((ob >> 9) & 1) << 5)); }
__host__ __device__ __forceinline__ void stage_rc(int b, int& R, int& C) { const int st = b / 1024, sb = b % 1024, swz = sb ^ (((sb >> 9) & 1) << 5); R = (st >> 1) * 16 + swz / 64; C = (st & 1) * 32 + (swz % 64) / 2; }
__host__ __device__ __forceinline__ int perm32(int rho) { const int n = rho >> 4, i = rho & 15; return 8 * (i >> 2) + 4 * n + (i & 3); }

struct Unit { int pm, pn; long bbase; };
struct Gemm { const bf16_t* A; const bf16_t* Bt; int lda, ldb, K; const int* rowmap; };

struct StaticOrder {
    int nM, nN, nwg, G, c, ldb;
    DI void init(int M, int N, int G_, int c_, int ldb_) { nM = M / BM; nN = N / BM; nwg = nM * nN; G = G_; c = c_; ldb = ldb_; }
    DI bool next(int i, Unit& u) const {
        const long L = (long)i * G + c; if (L >= nwg) return false;
        int wgid = (int)L; { const int q = nwg / NXCD, r = nwg % NXCD, xcd = wgid % NXCD, off = wgid / NXCD; wgid = (xcd < r ? xcd * (q + 1) : r * (q + 1) + (xcd - r) * q) + off; }
        const int nig = WGM * nN, gid = wgid / nig, fm = gid * WGM, gsz = (nM - fm) < WGM ? (nM - fm) : WGM;
        u.pm = fm + ((wgid % nig) % gsz); u.pn = (wgid % nig) / gsz; u.bbase = (long)u.pn * BM * ldb; return true;
    }
};
struct MoeOrder {
    const int* tileexp; int ntiles, nN, G, c, ldb; long estride; int cw;
    DI bool next(int i, Unit& u) const {
        const long tot = (long)ntiles * nN; const bool partial = (long)(i + 1) * G > tot;
        const long L = (long)i * G + (partial ? cw : c); if (L >= tot) return false;
        const int tile = (int)(L / nN), pn = (int)(L % nN); const int e = tileexp[tile];
        u.pm = tile; u.pn = pn; u.bbase = (long)e * estride + (long)pn * BM * ldb; return true;
    }
};

template <class Epi, class Sched, bool GATHER = false>
DI void gemm_phase(LAS unsigned char* lds, const Gemm g, const Sched& S, const Epi& E) {
    int tid = threadIdx.x; asm volatile("" : "+v"(tid));
    const int wid = __builtin_amdgcn_readfirstlane(tid >> 6), lane = tid & 63, wr = wid >> 2, wc = wid & 3, fr = lane & 15, fq = lane >> 4;
    const int K = g.K, nt = K / BK;
    unsigned voffA[2], voffB[2]; int RA[2], CA[2];
#pragma unroll
    for (int i = 0; i < 2; ++i) { int R, C; stage_rc(tid * 16 + i * 8192, R, C); const int Rb = Epi::PERM ? ((R & ~31) + perm32(R & 31)) : R;
        RA[i] = R; CA[i] = C; voffA[i] = (unsigned)(R * g.lda + C) * 2u; voffB[i] = (unsigned)(Rb * g.ldb + C) * 2u; }
    const size_t kstep = (size_t)(BK * 2);
    const size_t hstepA = (size_t)HALF * g.lda * 2, hstepB = (size_t)HALF * g.ldb * 2;
    const unsigned ldsw = (unsigned)wid * 1024u;
    const int aoff = lds_byte(wr * 64 + fr, fq * 8), boff = lds_byte(wc * 32 + fr, fq * 8);
#define PG8_SA(b, h) (((b) * 2 + (h)) * HTB)
#define PG8_SB(b, h) ((4 + (b) * 2 + (h)) * HTB)
#define PG8_STAGE(bufoff, gbase, voff) do { _Pragma("unroll") for (int _i = 0; _i < 2; ++_i) \
        __builtin_amdgcn_global_load_lds((const unsigned*)((const char*)(gbase) + (voff)[_i]), (LAS unsigned*)(lds + (bufoff) + ldsw + _i * 8192), 16, 0, 0); } while (0)
    unsigned gA[2][2], ngA[2][2];
#define PG8_STAGE_A(b, h, ptr, isnext) do { if constexpr (GATHER) { if (isnext) PG8_STAGE(PG8_SA(b, h), ptr, ngA[h]); else PG8_STAGE(PG8_SA(b, h), ptr, gA[h]); } \
        else PG8_STAGE(PG8_SA(b, h), (ptr) + (h) * hstepA, voffA); } while (0)
#define PG8_GATHER_OFFS(dst, un) do { _Pragma("unroll") for (int h_ = 0; h_ < 2; ++h_) _Pragma("unroll") for (int i_ = 0; i_ < 2; ++i_) \
        dst[h_][i_] = (unsigned)(g.rowmap[(un).pm * BM + h_ * HALF + RA[i_]] * g.lda + CA[i_]) * 2u; } while (0)
#define PG8_LDA(dst, b, h) do { _Pragma("unroll") for (int m = 0; m < 4; ++m) _Pragma("unroll") for (int k = 0; k < 2; ++k) dst[m][k] = *(const LAS bf16x8*)(lds + PG8_SA(b, h) + aoff + m * 2048 + k * 1024); } while (0)
#define PG8_LDB(dst, b, h) do { _Pragma("unroll") for (int n = 0; n < 2; ++n) _Pragma("unroll") for (int k = 0; k < 2; ++k) dst[n][k] = *(const LAS bf16x8*)(lds + PG8_SB(b, h) + boff + n * 2048 + k * 1024); } while (0)
#define PG8_MMA(ai, bj, At, Bt) do { __builtin_amdgcn_s_setprio(1); _Pragma("unroll") for (int m = 0; m < 4; ++m) _Pragma("unroll") for (int n = 0; n < 2; ++n) _Pragma("unroll") for (int k = 0; k < 2; ++k) \
        acc[ai][bj][m][n] = __builtin_amdgcn_mfma_f32_16x16x32_bf16(Bt[n][k], At[m][k], acc[ai][bj][m][n], 0, 0, 0); __builtin_amdgcn_s_setprio(0); } while (0)
#define PG8_WAIT_V(n) asm volatile("s_waitcnt vmcnt(" #n ")" ::: "memory")
#define PG8_WAIT_L(n) asm volatile("s_waitcnt lgkmcnt(" #n ")" ::: "memory")
#define PG8_BAR __builtin_amdgcn_s_barrier()
#define PG8_SCHED __builtin_amdgcn_sched_barrier(0)
    Unit cur, nxt; int ui = 0;
    if (!S.next(0, cur)) return;
    f32x4 acc[2][2][4][2];
#pragma unroll
    for (int a = 0; a < 2; ++a)
#pragma unroll
        for (int b = 0; b < 2; ++b)
#pragma unroll
            for (int m = 0; m < 4; ++m)
#pragma unroll
                for (int n = 0; n < 2; ++n) acc[a][b][m][n] = (f32x4){0.f, 0.f, 0.f, 0.f};
    bf16x8 At[4][2], B0[2][2], B1[2][2];
    const char* cA; const char* cB = (const char*)g.Bt + cur.bbase * 2;
    if constexpr (GATHER) { cA = (const char*)g.A; PG8_GATHER_OFFS(gA, cur); PG8_GATHER_OFFS(ngA, cur); }
    else cA = (const char*)g.A + (size_t)cur.pm * BM * g.lda * 2;
    PG8_STAGE(PG8_SB(0, 0), cB, voffB); PG8_STAGE(PG8_SB(0, 1), cB + hstepB, voffB); PG8_STAGE_A(0, 0, cA, false); PG8_STAGE_A(0, 1, cA, false);
    if (wr == 1) PG8_BAR;
    PG8_WAIT_V(2); PG8_BAR;
    PG8_STAGE(PG8_SB(1, 0), cB + kstep, voffB); PG8_STAGE_A(1, 0, cA + kstep, false); PG8_STAGE(PG8_SB(1, 1), cB + hstepB + kstep, voffB);
    PG8_WAIT_V(6); PG8_BAR;
    for (;;) {
        const bool has_next = S.next(ui + 1, nxt);
        const char* nA; const char* nB = has_next ? (const char*)g.Bt + nxt.bbase * 2 : cB;
        if constexpr (GATHER) { nA = cA; if (has_next) PG8_GATHER_OFFS(ngA, nxt); }
        else nA = has_next ? (const char*)g.A + (size_t)nxt.pm * BM * g.lda * 2 : cA;
        for (int t = 0; t < nt; t += 2) {
            const bool last = (t == nt - 2);
            const char* a1 = cA + (size_t)(t + 1) * kstep;
            const char* a2 = last ? nA : cA + (size_t)(t + 2) * kstep; const char* b2 = last ? nB : cB + (size_t)(t + 2) * kstep;
            const char* a3 = a2 + kstep; const char* b3 = b2 + kstep;
            PG8_LDB(B0, 0, 0); PG8_LDB(B1, 0, 1); PG8_SCHED; PG8_LDA(At, 0, 0); PG8_STAGE_A(1, 1, a1, false);
            PG8_WAIT_V(8); PG8_WAIT_L(0); PG8_BAR; PG8_MMA(0, 0, At, B0); PG8_MMA(0, 1, At, B1); PG8_BAR; PG8_SCHED;
            PG8_LDA(At, 0, 1); PG8_STAGE(PG8_SB(0, 0), b2, voffB); PG8_STAGE(PG8_SB(0, 1), b2 + hstepB, voffB); PG8_STAGE_A(0, 0, a2, last);
            PG8_WAIT_V(8); PG8_WAIT_L(0); PG8_BAR; PG8_MMA(1, 0, At, B0); PG8_MMA(1, 1, At, B1); PG8_BAR; PG8_SCHED;
            PG8_LDB(B0, 1, 0); PG8_LDB(B1, 1, 1); PG8_SCHED; PG8_LDA(At, 1, 0); PG8_STAGE_A(0, 1, a2, last);
            PG8_WAIT_V(8); PG8_WAIT_L(0); PG8_BAR; PG8_MMA(0, 0, At, B0); PG8_MMA(0, 1, At, B1); PG8_BAR; PG8_SCHED;
            PG8_LDA(At, 1, 1); PG8_STAGE(PG8_SB(1, 0), b3, voffB); PG8_STAGE(PG8_SB(1, 1), b3 + hstepB, voffB); PG8_STAGE_A(1, 0, a3, last);
            PG8_WAIT_V(8); PG8_WAIT_L(0); PG8_BAR; PG8_MMA(1, 0, At, B0); PG8_MMA(1, 1, At, B1); PG8_BAR; PG8_SCHED;
        }
        if (wr == 0) PG8_BAR;
        E(acc, cur, wr, wc, fr, fq);
        if (!has_next) break;
#pragma unroll
        for (int a = 0; a < 2; ++a)
#pragma unroll
            for (int b = 0; b < 2; ++b)
#pragma unroll
                for (int m = 0; m < 4; ++m)
#pragma unroll
                    for (int n = 0; n < 2; ++n) acc[a][b][m][n] = (f32x4){0.f, 0.f, 0.f, 0.f};
        cur = nxt; cA = nA; cB = nB; ++ui;
        if constexpr (GATHER) {
#pragma unroll
            for (int h_ = 0; h_ < 2; ++h_)
#pragma unroll
                for (int i_ = 0; i_ < 2; ++i_) gA[h_][i_] = ngA[h_][i_]; }
        if (wr == 1) PG8_BAR;
    }
    PG8_WAIT_V(0);
    PG8_BAR;
#undef PG8_SA
#undef PG8_SB
#undef PG8_STAGE
#undef PG8_STAGE_A
#undef PG8_LDA
#undef PG8_LDB
#undef PG8_MMA
#undef PG8_WAIT_V
#undef PG8_WAIT_L
#undef PG8_BAR
#undef PG8_SCHED
#undef PG8_GATHER_OFFS
}

DI float row_ssq32(const float* part, int row) { const f32x4* p = (const f32x4*)(part + (size_t)row * 32); float t = 0.f;
#pragma unroll
    for (int i = 0; i < 8; ++i) { const f32x4 v = p[i]; t += (v[0] + v[1]) + (v[2] + v[3]); }
    return t; }
DI float row_rstd(const float* ssq, int np, int row) {
    float t;
    if (np == 1) t = ssq[row];
    else { const f32x4* p = (const f32x4*)(ssq + (size_t)row * 32); t = 0.f;
#pragma unroll
        for (int i = 0; i < 8; ++i) { const f32x4 v = p[i]; t += (v[0] + v[1]) + (v[2] + v[3]); } }
    return rsqrtf(t * (1.f / 2048.f) + 1e-6f);
}
struct EpiBf16 {
    static constexpr bool PERM = true;
    bf16_t* O; int ldc; bf16_t* O2; int ldc2; int split_tile; const float* ssq; int np;
    DI void operator()(const f32x4 (&acc)[2][2][4][2], const Unit& u, int wr, int wc, int fr, int fq) const {
        bf16_t* base = O; int ld = ldc; int colt = u.pn * BM;
        if (u.pn >= split_tile) { base = O2; ld = ldc2; colt = (u.pn - split_tile) * BM; }
        const int row0 = u.pm * BM + wr * 64 + fr, col0 = colt + wc * 32 + 8 * fq;
        float rs8[8];
#pragma unroll
        for (int q = 0; q < 8; ++q) rs8[q] = ssq ? row_rstd(ssq, np, row0 + (q >> 2) * HALF + (q & 3) * 16) : 1.f;
#pragma unroll
        for (int ai = 0; ai < 2; ++ai)
#pragma unroll
            for (int m = 0; m < 4; ++m) { const int row = row0 + ai * HALF + m * 16; bf16_t* rowp = base + (size_t)row * ld + col0;
                const float rs = rs8[ai * 4 + m];
#pragma unroll
                for (int bj = 0; bj < 2; ++bj) { const f32x4 v0 = acc[ai][bj][m][0] * rs, v1 = acc[ai][bj][m][1] * rs;
                    u32x4 w; w.x = pk2(v0[0], v0[1]); w.y = pk2(v0[2], v0[3]); w.z = pk2(v1[0], v1[1]); w.w = pk2(v1[2], v1[3]);
                    *(u32x4*)(rowp + bj * HALF) = w; } }
    }
};
struct EpiResid {
    static constexpr bool PERM = true;
    const bf16_t* baseb; bf16_t* out; int ldc; float* part_out;
    DI void operator()(const f32x4 (&acc)[2][2][4][2], const Unit& u, int wr, int wc, int fr, int fq) const {
        const int row0 = u.pm * BM + wr * 64 + fr, col0 = u.pn * BM + wc * 32 + 8 * fq;
        u32x4 bv[8][2];
#pragma unroll
        for (int q = 0; q < 8; ++q)
#pragma unroll
            for (int bj = 0; bj < 2; ++bj) bv[q][bj] = *(const u32x4*)(baseb + (size_t)(row0 + (q >> 2) * HALF + (q & 3) * 16) * ldc + col0 + bj * HALF);
#pragma unroll
        for (int ai = 0; ai < 2; ++ai)
#pragma unroll
            for (int m = 0; m < 4; ++m) { const int row = row0 + ai * HALF + m * 16; const size_t off = (size_t)row * ldc + col0; float sq = 0.f;
#pragma unroll
                for (int bj = 0; bj < 2; ++bj) { f32x4 v0 = acc[ai][bj][m][0], v1 = acc[ai][bj][m][1];
                    const u32x4 b = bv[ai * 4 + m][bj];
                    v0 += (f32x4){bflo(b.x), bfhi(b.x), bflo(b.y), bfhi(b.y)}; v1 += (f32x4){bflo(b.z), bfhi(b.z), bflo(b.w), bfhi(b.w)};
                    u32x4 w; w.x = pk2(v0[0], v0[1]); w.y = pk2(v0[2], v0[3]); w.z = pk2(v1[0], v1[1]); w.w = pk2(v1[2], v1[3]);
                    *(u32x4*)(out + off + bj * HALF) = w;
                    const float a0 = bflo(w.x), a1 = bfhi(w.x), a2 = bflo(w.y), a3 = bfhi(w.y), a4 = bflo(w.z), a5 = bfhi(w.z), a6 = bflo(w.w), a7 = bfhi(w.w);
                    sq += ((a0 * a0 + a1 * a1) + (a2 * a2 + a3 * a3)) + ((a4 * a4 + a5 * a5) + (a6 * a6 + a7 * a7)); }
                sq += __shfl_xor(sq, 16); sq += __shfl_xor(sq, 32);
                if (fq == 0) part_out[(size_t)row * 32 + u.pn * 4 + wc] = sq; }
    }
};
struct EpiF32 {
    static constexpr bool PERM = false;
    float* out; int ldc; const float* ssq; int np; float* ssq_pub;
    DI void operator()(const f32x4 (&acc)[2][2][4][2], const Unit& u, int wr, int wc, int fr, int fq) const {
        const int row0 = u.pm * BM + wr * 64 + fr, col0 = u.pn * BM + wc * 32 + 4 * fq;
#pragma unroll
        for (int ai = 0; ai < 2; ++ai)
#pragma unroll
            for (int m = 0; m < 4; ++m) { const int row = row0 + ai * HALF + m * 16; const size_t off = (size_t)row * ldc + col0;
                float rs = 1.f;
                if (ssq) { const float t = (np == 1) ? ssq[row] : row_ssq32(ssq, row); rs = rsqrtf(t * (1.f / 2048.f) + 1e-6f); if (ssq_pub && u.pn == 0 && wc == 0 && fq == 0) ssq_pub[row] = t; }
#pragma unroll
                for (int bj = 0; bj < 2; ++bj)
#pragma unroll
                    for (int n = 0; n < 2; ++n) *(f32x4*)(out + off + bj * HALF + n * 16) = acc[ai][bj][m][n] * rs; }
    }
};
struct EpiSiluMul {
    static constexpr bool PERM = true;
    bf16_t* O; int ldc; const float* ssq; const int* rowmap;
    DI void operator()(const f32x4 (&acc)[2][2][4][2], const Unit& u, int wr, int wc, int fr, int fq) const {
        const int row0 = u.pm * BM + wr * 64 + fr, col0 = (u.pn * BM + wc * 32 + 8 * fq) >> 1;
        int tk8[8]; float rs8[8];
#pragma unroll
        for (int q = 0; q < 8; ++q) tk8[q] = rowmap[row0 + (q >> 2) * HALF + (q & 3) * 16];
#pragma unroll
        for (int q = 0; q < 8; ++q) rs8[q] = row_rstd(ssq, 1, tk8[q]);
#pragma unroll
        for (int ai = 0; ai < 2; ++ai)
#pragma unroll
            for (int m = 0; m < 4; ++m) { const int row = row0 + ai * HALF + m * 16; bf16_t* rowp = O + (size_t)row * ldc + col0;
                const float rs = rs8[ai * 4 + m];
#pragma unroll
                for (int bj = 0; bj < 2; ++bj) { const f32x4 v0 = acc[ai][bj][m][0] * rs, v1 = acc[ai][bj][m][1] * rs;
                    const float h0 = v0[0] / (1.f + __expf(-v0[0])) * v0[1], h1 = v0[2] / (1.f + __expf(-v0[2])) * v0[3];
                    const float h2 = v1[0] / (1.f + __expf(-v1[0])) * v1[1], h3 = v1[2] / (1.f + __expf(-v1[2])) * v1[3];
                    u32x2 w; w.x = pk2(h0, h1); w.y = pk2(h2, h3);
                    *(u32x2*)(rowp + bj * (HALF / 2)) = w; } }
    }
};
struct EpiScatter {
    static constexpr bool PERM = true;
    bf16_t* O; int ldc; const int* dst;
    DI void operator()(const f32x4 (&acc)[2][2][4][2], const Unit& u, int wr, int wc, int fr, int fq) const {
        const int row0 = u.pm * BM + wr * 64 + fr, col0 = u.pn * BM + wc * 32 + 8 * fq;
        int d8[8];
#pragma unroll
        for (int q = 0; q < 8; ++q) d8[q] = dst[row0 + (q >> 2) * HALF + (q & 3) * 16];
#pragma unroll
        for (int ai = 0; ai < 2; ++ai)
#pragma unroll
            for (int m = 0; m < 4; ++m) { const int d = d8[ai * 4 + m];
                if (d >= 0) { bf16_t* rowp = O + (size_t)d * ldc + col0;
#pragma unroll
                    for (int bj = 0; bj < 2; ++bj) { const f32x4 v0 = acc[ai][bj][m][0], v1 = acc[ai][bj][m][1];
                        u32x4 w; w.x = pk2(v0[0], v0[1]); w.y = pk2(v0[2], v0[3]); w.z = pk2(v1[0], v1[1]); w.w = pk2(v1[2], v1[3]);
                        *(u32x4*)(rowp + bj * HALF) = w; } } }
    }
};
}

struct Args { const void* in[45]; float* out; unsigned char* ws; int ph_lo, ph_hi; };
static_assert(sizeof(void*) == 8 && sizeof(Args) == 384, "Args layout");

#define CAS __attribute__((address_space(4)))
typedef const CAS char* kaptr_t;
typedef const float* const CAS* inptr_t;
struct Ctx {
    LAS unsigned char* lds; unsigned char* ws; inptr_t in; float* X;
    int tid, lane, wave, G, wg, gw, ngw, att_sel, vcu;
};

DI size_t wofs(int l) { return l ? WS_L1OFF : 0; }
struct TrDesc { const float* W; bf16_t* WT; int N, ldk, row_off, row_mul, nblk, item; const float* ks; };
DI void tr_load(const TrDesc& d, float (&tv)[32], int lane) {
    const int kb = d.item / d.nblk, nb = d.item % d.nblk, k0 = 64 * kb, n0 = 32 * nb;
#pragma unroll
    for (int i = 0; i < 32; ++i) { const int kk = 2 * i + (lane >> 5); tv[i] = d.W[(size_t)(k0 + kk) * d.N + n0 + (lane & 31)]; }
}
DI void tr_store(const TrDesc& d, const float (&tv)[32], LAS float* scr, int lane) {
    const int kb = d.item / d.nblk, nb = d.item % d.nblk, k0 = 64 * kb, n0 = 32 * nb;
#pragma unroll
    for (int i = 0; i < 32; ++i) { const int kk = 2 * i + (lane >> 5); scr[kk * 33 + (lane & 31)] = d.ks ? tv[i] * d.ks[k0 + kk] : tv[i]; }
    asm volatile("s_waitcnt lgkmcnt(0)" ::: "memory");
    const int c = lane & 7;
#pragma unroll
    for (int j = 0; j < 4; ++j) { const int n = (lane >> 3) + 8 * j; const LAS float* s = scr + (8 * c) * 33 + n;
        u32x4 o; o.x = pk2(s[0 * 33], s[1 * 33]); o.y = pk2(s[2 * 33], s[3 * 33]); o.z = pk2(s[4 * 33], s[5 * 33]); o.w = pk2(s[6 * 33], s[7 * 33]);
        *(u32x4*)(d.WT + (size_t)(d.row_off + (n0 + n) * d.row_mul) * d.ldk + k0 + 8 * c) = o; }
    asm volatile("s_waitcnt lgkmcnt(0)" ::: "memory");
}

DI void norm_row(const float* xin, const bf16_t* xinb, bf16_t* xout, const bf16_t* c0, const bf16_t* c1, float g0, float g1, const float* w, bf16_t* hout, float* fout, int lane, float* ssq_w = nullptr) {
    f32x4 v[8]; float ss = 0.f;
    if (xin) {
#pragma unroll
        for (int j = 0; j < 8; ++j) { v[j] = ((const f32x4*)xin)[lane + 64 * j]; }
    } else {
#pragma unroll
        for (int j = 0; j < 8; ++j) { const u32x2 a = ((const u32x2*)xinb)[lane + 64 * j]; v[j] = (f32x4){bflo(a.x), bfhi(a.x), bflo(a.y), bfhi(a.y)}; }
    }
    if (c0) {
#pragma unroll
        for (int j = 0; j < 8; ++j) { const u32x2 a = ((const u32x2*)c0)[lane + 64 * j], b = ((const u32x2*)c1)[lane + 64 * j];
            v[j][0] += g0 * bflo(a.x) + g1 * bflo(b.x); v[j][1] += g0 * bfhi(a.x) + g1 * bfhi(b.x);
            v[j][2] += g0 * bflo(a.y) + g1 * bflo(b.y); v[j][3] += g0 * bfhi(a.y) + g1 * bfhi(b.y); }
    }
#pragma unroll
    for (int j = 0; j < 8; ++j) ss += (v[j][0] * v[j][0] + v[j][1] * v[j][1]) + (v[j][2] * v[j][2] + v[j][3] * v[j][3]);
    if (xout) {
#pragma unroll
        for (int j = 0; j < 8; ++j) { u32x2 o; o.x = pk2(v[j][0], v[j][1]); o.y = pk2(v[j][2], v[j][3]); ((u32x2*)xout)[lane + 64 * j] = o; }
    }
    const float sst = wave_sum(ss);
    if (ssq_w) { if (lane == 0) *ssq_w = sst; }
    if (!w) return;
    const float rstd = rsqrtf(sst * (1.f / DM) + 1e-6f);
#pragma unroll
    for (int j = 0; j < 8; ++j) { const f32x4 ww = ((const f32x4*)w)[lane + 64 * j]; const f32x4 y = v[j] * rstd * ww;
        if (hout) { u32x2 o; o.x = pk2(y[0], y[1]); o.y = pk2(y[2], y[3]); ((u32x2*)hout)[lane + 64 * j] = o; }
        if (fout) ((f32x4*)fout)[lane + 64 * j] = y; }
}

constexpr int I_WIN = 32 * 174, I_VR = 32, I_WOUT = 32 * 64, I_CAQ = 32 * 16, I_CAKV = 32 * 32, I_CAO = 8 * 64, I_WQB = 6 * 24, I_WKVB = 4 * 32;
constexpr int N_SMALL_ITEMS = I_WIN + I_VR + I_WOUT + I_CAQ + I_CAKV + I_CAO + I_WQB + I_WKVB;
DI TrDesc small_tr_desc(int l, int r, inptr_t in, unsigned char* wsl) {
    bf16_t* WINT = (bf16_t*)(wsl + WS_WINT);
    if (r < I_WIN) return TrDesc{in[6] + (size_t)l * DM * IN_COLS, WINT, IN_COLS, DM, 0, 1, 174, r, in[5] + (size_t)l * DM}; r -= I_WIN;
    if (r < I_VR) return TrDesc{in[7], WINT, 32, DM, IN_COLS, 1, 1, r, in[5] + DM}; r -= I_VR;
    if (r < I_WOUT) return TrDesc{in[8] + (size_t)l * DM * DM, (bf16_t*)(wsl + WS_WOUTT), DM, DM, 0, 1, 64, r, nullptr}; r -= I_WOUT;
    if (r < I_CAQ) return TrDesc{in[34] + (size_t)l * DM * 512, (bf16_t*)(wsl + WS_CAWQT), 512, DM, 0, 1, 16, r, in[32] + (size_t)l * DM}; r -= I_CAQ;
    if (r < I_CAKV) return TrDesc{in[35] + (size_t)l * DM * 1024, (bf16_t*)(wsl + WS_CAWKVT), 1024, DM, 0, 1, 32, r, nullptr}; r -= I_CAKV;
    if (r < I_CAO) return TrDesc{in[36] + (size_t)l * 512 * DM, (bf16_t*)(wsl + WS_CAWOT), DM, 512, 0, 1, 64, r, nullptr}; r -= I_CAO;
    if (r < I_WQB) return TrDesc{in[29] + (size_t)l * 384 * 768, (bf16_t*)(wsl + WS_WQBT), 768, 384, 0, 1, 24, r, nullptr}; r -= I_WQB;
    return TrDesc{in[31] + (size_t)l * 256 * 1024, (bf16_t*)(wsl + WS_WKVBT), 1024, 256, 0, 1, 32, r, nullptr};
}
constexpr int I_EXP = 512;
constexpr int N_MOE_ITEMS = 3 * NEXP * I_EXP;
DI TrDesc moe_tr_desc(int l, int r, inptr_t in, unsigned char* ws) {
    const int e = r / (3 * I_EXP), q = r % (3 * I_EXP), mat = q / I_EXP, ii = q % I_EXP;
    const size_t eo = ((size_t)l * NEXP + e);
    if (mat == 0) return TrDesc{in[42] + eo * DM * DEXP, (bf16_t*)(ws + WS_WGU) + (size_t)e * 1024 * DM, DEXP, DM, 0, 2, 16, ii, in[37] + (size_t)l * DM};
    if (mat == 1) return TrDesc{in[43] + eo * DM * DEXP, (bf16_t*)(ws + WS_WGU) + (size_t)e * 1024 * DM, DEXP, DM, 1, 2, 16, ii, in[37] + (size_t)l * DM};
    return TrDesc{in[44] + eo * DEXP * DM, (bf16_t*)(ws + WS_WD) + (size_t)e * DM * DEXP, DM, DEXP, 0, 1, 64, ii, nullptr};
}
DI void phase_convert(const Ctx& C, int l) {
    inptr_t in = C.in;
    unsigned char* ws = C.ws;
    LAS float* scr = (LAS float*)(C.lds + C.wave * 16384);
    bf16_t* WINT = (bf16_t*)(ws + WS_WINT);
    const int n_items = (l == 0) ? N_SMALL_ITEMS : 0;
    auto decode = [&](int it) -> TrDesc { return small_tr_desc(0, it, in, ws); };
    {
        const int first = (l == 0 && C.gw >= I_WIN && C.gw < I_WIN + I_VR) ? C.gw + C.ngw : C.gw;
        float ta[32], tb[32];
        int it = first;
        if (it < n_items) { TrDesc d0 = decode(it); tr_load(d0, ta, C.lane);
            for (;;) {
                int it2 = it + C.ngw; if (l == 0 && it2 >= I_WIN && it2 < I_WIN + I_VR) it2 += C.ngw;
                const bool has2 = it2 < n_items; TrDesc d1 = d0;
                if (has2) { d1 = decode(it2); tr_load(d1, tb, C.lane); }
                tr_store(d0, ta, scr, C.lane);
                if (!has2) break;
                int it3 = it2 + C.ngw; if (l == 0 && it3 >= I_WIN && it3 < I_WIN + I_VR) it3 += C.ngw;
                const bool has3 = it3 < n_items;
                if (has3) { d0 = decode(it3); tr_load(d0, ta, C.lane); }
                tr_store(d1, tb, scr, C.lane);
                if (!has3) break;
                it = it3;
            }
        }
    }
    const int gt = C.wg * 512 + C.tid, ngt = C.G * 512;
    if (l == 0) {
        for (int i = gt; i < 64 * DM / 8; i += ngt) ((u32x4*)(WINT + (size_t)IN_COLS * DM))[i] = (u32x4){0u, 0u, 0u, 0u};
        for (int i = gt; i < 32 * DM / 8; i += ngt) ((u32x4*)((bf16_t*)(ws + WS_L1OFF + WS_WINT) + (size_t)(IN_COLS + 32) * DM))[i] = (u32x4){0u, 0u, 0u, 0u};
#pragma unroll 1
        for (int lw = 0; lw < 2; ++lw) {
            bf16_t* LB = (bf16_t*)(ws + wofs(lw) + WS_LORABT);
            const float* w2 = in[12] + (size_t)lw * 64 * 1024; const float* a2 = in[14] + (size_t)lw * 64 * 1024; const float* g2 = in[17] + (size_t)lw * 128 * 1024; const float* v2 = in[16];
            for (int i = gt; i < 4096 * 128; i += ngt) {
                const int n = i >> 7, k = i & 127, blk = n >> 10, c = n & 1023; float v = 0.f;
                if (blk == 0) { if (k < 64) v = w2[k * 1024 + c]; }
                else if (blk == 1) { if (k >= 64) v = a2[(k - 64) * 1024 + c]; }
                else if (blk == 2) { v = g2[k * 1024 + c]; }
                else { if (lw == 1 && k < 32) v = v2[k * 1024 + c]; }
                LB[i] = f2bf(v);
            }
            bf16_t* WRB = (bf16_t*)(ws + (lw ? WS_WRB1 : WS_WRB)); const float* nf = in[37] + (size_t)lw * DM; const float* wg = in[38] + (size_t)lw * DM * 4; const float* we = in[40] + (size_t)lw * DM * 32;
            for (int i = gt; i < 256 * DM; i += ngt) { const int o = i / DM, k = i % DM; const float v = (o < 32) ? we[k * 32 + o] : ((o < 36) ? wg[k * 4 + (o - 32)] : 0.f); WRB[i] = f2bf(v * nf[k]); }
        }
    }
    if (l == 0) {
        float* LUT = (float*)(ws + WS_LUT); const float* rb = in[3];
        for (int i = gt; i < 4 * 128; i += ngt) { const int h = i >> 7, n = i & 127; int bk;
            if (n < 16) bk = n; else { bk = 16 + (int)(log2f((float)n * 0.0625f) * (16.f / 3.f)); if (bk > 31) bk = 31; }
            LUT[i] = rb[bk * 4 + h] * LOG2E; }
        f32x2* RT = (f32x2*)(ws + WS_ROPE); const int* pos = (const int*)in[2];
        for (int i = gt; i < NT * 32; i += ngt) { const int t = i >> 5, j = i & 31; const float invf = powf(10000.f, -(float)j / 32.f); const float ang = (float)pos[t] * invf; float s, c; sincosf(ang, &s, &c); RT[i] = (f32x2){c, s}; }
    }
    for (int m = C.gw; m < NMEM; m += C.ngw) norm_row(in[1] + (size_t)m * DM, nullptr, nullptr, nullptr, nullptr, 0.f, 0.f, in[33] + (size_t)l * DM, (bf16_t*)(ws + WS_MEMN) + (size_t)m * DM, nullptr, C.lane);
    {
        const bf16_t* C2 = (const bf16_t*)(ws + WS_C2); const float* gate = (const float*)(ws + WS_GATE); bf16_t* XB = (bf16_t*)(ws + WS_XB); float* SSQM = (float*)(ws + WS_SSQM);
        for (int m = C.gw; m < NT; m += C.ngw) {
            if (l == 0) norm_row(in[0] + (size_t)m * DM, nullptr, XB + (size_t)m * DM, nullptr, nullptr, 0.f, 0.f, nullptr, nullptr, nullptr, C.lane, SSQM + m);
            else norm_row(nullptr, XB + (size_t)m * DM, XB + (size_t)m * DM, C2 + (size_t)(2 * m) * DM, C2 + (size_t)(2 * m + 1) * DM, gate[2 * m], gate[2 * m + 1], nullptr, nullptr, nullptr, C.lane, SSQM + m);
        }
    }
}

DI void phase_ew1(const Ctx& C, int l) {
    inptr_t in = C.in; unsigned char* ws = C.ws;
    const bf16_t* PRW = (const bf16_t*)(ws + WS_PRW); const bf16_t* PATT = (const bf16_t*)(ws + WS_PATT);
    bf16_t* LA = (bf16_t*)(ws + WS_LORAA); bf16_t* QN = (bf16_t*)(ws + WS_QN); bf16_t* KVN = (bf16_t*)(ws + WS_KVN); bf16_t* KPE = (bf16_t*)(ws + WS_KPE);
    const float* mu = in[9] + (size_t)l * RW_COLS; const float* muv = in[10];
    const float* qnw = in[28] + (size_t)l * 384; const float* kvnw = in[30] + (size_t)l * 256;
    const f32x2* RT = (const f32x2*)(ws + WS_ROPE);
    const int lane = C.lane;
#pragma unroll 4
    for (int t = C.gw; t < NT; t += C.ngw) {
        const bool first = (t % SEQ) == 0;
        const bf16_t* p = PRW + (size_t)t * RW_COLS; const bf16_t* pa = PATT + (size_t)t * PATT_COLS;
#pragma unroll
        for (int j = 0; j < 4; ++j) { const int c = lane + 64 * j, col = 3072 + c;
            const float cur = bf2f(p[col]); const float prev = first ? 0.f : bf2f(p[col - RW_COLS]);
            const float xs = cur + mu[col] * (prev - cur);
            float v; if (c < 64) v = tanhf(xs); else if (c < 128) v = xs; else v = sigmoidf_(xs);
            LA[(size_t)t * 384 + c] = f2bf(v); }
        {
#pragma unroll
            for (int j = 0; j < 2; ++j) { const int c = lane + 64 * j; float v = 0.f;
                if (l == 1 && c < 32) { const float cur = bf2f(pa[2240 + c]); const float prev = first ? 0.f : bf2f(pa[2240 + c - PATT_COLS]); v = cur + muv[c] * (prev - cur); }
                LA[(size_t)t * 384 + 256 + c] = f2bf(v); } }
        float q[6], kv[4]; float sq = 0.f, skv = 0.f;
#pragma unroll
        for (int j = 0; j < 6; ++j) { q[j] = bf2f(pa[1536 + lane + 64 * j]); sq += q[j] * q[j]; }
#pragma unroll
        for (int j = 0; j < 4; ++j) { kv[j] = bf2f(pa[1920 + lane + 64 * j]); skv += kv[j] * kv[j]; }
        const float rq = rsqrtf(wave_sum(sq) * (1.f / 384.f) + 1e-6f), rkv = rsqrtf(wave_sum(skv) * (1.f / 256.f) + 1e-6f);
#pragma unroll
        for (int j = 0; j < 6; ++j) QN[(size_t)t * 384 + lane + 64 * j] = f2bf(q[j] * rq * qnw[lane + 64 * j]);
#pragma unroll
        for (int j = 0; j < 4; ++j) KVN[(size_t)t * 256 + lane + 64 * j] = f2bf(kv[j] * rkv * kvnw[lane + 64 * j]);
        { const float x = bf2f(pa[2176 + lane]); const float xo = __shfl_xor(x, 32); const f32x2 cs = RT[t * 32 + (lane & 31)];
          const float y = (lane < 32) ? (x * cs.x - xo * cs.y) : (x * cs.x + xo * cs.y);
          KPE[(size_t)t * 64 + lane] = f2bf(y); }
    }
}

DI void phase_ew2(const Ctx& C, int l) {
    inptr_t in = C.in; unsigned char* ws = C.ws;
    const bf16_t* PRW = (const bf16_t*)(ws + WS_PRW); const bf16_t* LO = (const bf16_t*)(ws + WS_LORAO);
    bf16_t* SR = (bf16_t*)(ws + WS_U); bf16_t* SW = SR + (size_t)NT * 1024; bf16_t* SK = SW + (size_t)NT * 1024; bf16_t* SV = SK + (size_t)NT * 1024;
    bf16_t* SA = SV + (size_t)NT * 1024; bf16_t* SB = SA + (size_t)NT * 1024; bf16_t* VF = (bf16_t*)(ws + WS_VFIRST);
    const float* mu = in[9] + (size_t)l * RW_COLS; const float* w0 = in[11] + (size_t)l * 1024; const float* a0 = in[13] + (size_t)l * 1024; const float* v0 = in[15];
    const float* kkw = in[18] + (size_t)l * 1024; const float* kaw = in[19] + (size_t)l * 1024;
    const int lane = C.lane;
#pragma unroll 1
    for (int j = 0; j < 2; ++j) {
        const int c0 = 8 * lane + 512 * j;
        float mu8[3][8], w0v[8], a0v[8], kkv[8], kav[8], v0v[8];
#pragma unroll
        for (int e = 0; e < 2; ++e) {
#pragma unroll
            for (int q = 0; q < 3; ++q) { const f32x4 m = *(const f32x4*)(mu + q * 1024 + c0 + 4 * e);
#pragma unroll
                for (int i = 0; i < 4; ++i) mu8[q][4 * e + i] = m[i]; }
            const f32x4 x0 = *(const f32x4*)(w0 + c0 + 4 * e), x1 = *(const f32x4*)(a0 + c0 + 4 * e), x2 = *(const f32x4*)(kkw + c0 + 4 * e), x3 = *(const f32x4*)(kaw + c0 + 4 * e);
            f32x4 x4 = (f32x4){0.f, 0.f, 0.f, 0.f}; if (l == 1) x4 = *(const f32x4*)(v0 + c0 + 4 * e);
#pragma unroll
            for (int i = 0; i < 4; ++i) { w0v[4 * e + i] = x0[i]; a0v[4 * e + i] = x1[i]; kkv[4 * e + i] = x2[i]; kav[4 * e + i] = x3[i]; v0v[4 * e + i] = x4[i]; } }
#pragma unroll 2
        for (int t = C.gw; t < NT; t += C.ngw) {
            const bool first = (t % SEQ) == 0;
            const bf16_t* p = PRW + (size_t)t * RW_COLS; const bf16_t* lo = LO + (size_t)t * 4096;
            float xs[3][8];
#pragma unroll
            for (int q = 0; q < 3; ++q) { const int col = q * 1024 + c0;
                const u32x4 cu = *(const u32x4*)(p + col); u32x4 pv = (u32x4){0u, 0u, 0u, 0u}; if (!first) pv = *(const u32x4*)(p + col - RW_COLS);
#pragma unroll
                for (int e = 0; e < 4; ++e) { const float c_lo = bflo(cu[e]), c_hi = bfhi(cu[e]), p_lo = bflo(pv[e]), p_hi = bfhi(pv[e]);
                    xs[q][2 * e] = c_lo + mu8[q][2 * e] * (p_lo - c_lo); xs[q][2 * e + 1] = c_hi + mu8[q][2 * e + 1] * (p_hi - c_hi); } }
            const u32x4 lw = *(const u32x4*)(lo + c0), la = *(const u32x4*)(lo + 1024 + c0);
            u32x4 lv = (u32x4){0u, 0u, 0u, 0u}, vfv = (u32x4){0u, 0u, 0u, 0u};
            if (l == 1) { lv = *(const u32x4*)(lo + 3072 + c0); vfv = *(const u32x4*)(VF + (size_t)t * 1024 + c0); }
            float omw[8], av[8], kk[8], k2[8], v2[8]; float ssq = 0.f;
#pragma unroll
            for (int e = 0; e < 8; ++e) {
                const float lwf = (e & 1) ? bfhi(lw[e >> 1]) : bflo(lw[e >> 1]), laf = (e & 1) ? bfhi(la[e >> 1]) : bflo(la[e >> 1]);
                const float wi = w0v[e] + lwf;
                omw[e] = 1.f - __expf(-0.6065306597f * sigmoidf_(wi));
                av[e] = sigmoidf_(a0v[e] + laf);
                kk[e] = xs[1][e] * kkv[e]; ssq += kk[e] * kk[e];
                k2[e] = xs[1][e] * (1.f + (av[e] - 1.f) * kav[e]);
                v2[e] = xs[2][e];
                if (l == 1) { const float lvf = (e & 1) ? bfhi(lv[e >> 1]) : bflo(lv[e >> 1]), vff = (e & 1) ? bfhi(vfv[e >> 1]) : bflo(vfv[e >> 1]);
                    v2[e] = xs[2][e] + (vff - xs[2][e]) * sigmoidf_(v0v[e] + lvf); }
            }
            ssq += DPP_F(ssq, 0xB1); ssq += DPP_F(ssq, 0x4E); ssq += DPP_F(ssq, 0x141);
            const float inv = 1.f / fmaxf(sqrtf(ssq), 1e-12f);
            u32x4 oR, oW, oK, oV, oA, oB, oF;
#pragma unroll
            for (int e = 0; e < 4; ++e) { const float ka = kk[2 * e] * inv, kb = kk[2 * e + 1] * inv;
                oR[e] = pkh2(xs[0][2 * e], xs[0][2 * e + 1]); oW[e] = pkh2(1.f - omw[2 * e], 1.f - omw[2 * e + 1]); oK[e] = pkh2(k2[2 * e], k2[2 * e + 1]); oV[e] = pkh2(v2[2 * e], v2[2 * e + 1]);
                oA[e] = pkh2(-ka, -kb); oB[e] = pkh2(ka * av[2 * e], kb * av[2 * e + 1]);     oF[e] = pk2(xs[2][2 * e], xs[2][2 * e + 1]); }
            const size_t o = (size_t)t * 1024 + c0;
            *(u32x4*)(SR + o) = oR; *(u32x4*)(SW + o) = oW; *(u32x4*)(SK + o) = oK; *(u32x4*)(SV + o) = oV; *(u32x4*)(SA + o) = oA; *(u32x4*)(SB + o) = oB;
            if (l == 0) *(u32x4*)(VF + o) = oF;
        }
    }
    bf16_t* QM = (bf16_t*)(ws + WS_QM); const f32x2* RT = (const f32x2*)(ws + WS_ROPE);
    const int gt = C.wg * 512 + C.tid, ngt = C.G * 512;
    for (int i = gt; i < NT * 4 * 32; i += ngt) { const int t = i >> 7, h = (i >> 5) & 3, j = i & 31;
        bf16_t* q = QM + (size_t)t * 768 + h * 192 + 128; const float x1 = bf2f(q[j]), x2 = bf2f(q[j + 32]); const f32x2 cs = RT[t * 32 + j];
        q[j] = f2bf(x1 * cs.x - x2 * cs.y); q[j + 32] = f2bf(x2 * cs.x + x1 * cs.y); }
}

DI float dot2z(h2_t a, h2_t b) { float d; asm("v_dot2_f32_f16 %0, %1, %2, 0" : "=v"(d) : "v"(a), "v"(b)); return d; }
DI float fma_s(float a, float b, float c) { float d; asm("v_fma_f32 %0, %1, %2, %3" : "=v"(d) : "v"(a), "v"(b), "v"(c)); return d; }
#define ROW_ALLREDUCE(x) do { \
    x += __builtin_bit_cast(float, __builtin_amdgcn_update_dpp(0, __builtin_bit_cast(int, x), 0x128, 0xf, 0xf, true)); \
    x += __builtin_bit_cast(float, __builtin_amdgcn_update_dpp(0, __builtin_bit_cast(int, x), 0x124, 0xf, 0xf, true)); \
    x += __builtin_bit_cast(float, __builtin_amdgcn_update_dpp(0, __builtin_bit_cast(int, x), 0x122, 0xf, 0xf, true)); \
    x += __builtin_bit_cast(float, __builtin_amdgcn_update_dpp(0, __builtin_bit_cast(int, x), 0x121, 0xf, 0xf, true)); } while (0)

DI void phase_scan(const Ctx& C, int l) {
    unsigned char* ws = C.ws; inptr_t in = C.in;
    const bf16_t* SR = (const bf16_t*)(ws + WS_U); bf16_t* Yf = (bf16_t*)(ws + WS_H);
    constexpr int CH = 32, VECB = CH * 128, BUFB = 5 * VECB + CH * 64, OB = 2 * BUFB;
    LAS unsigned char* lds = C.lds;
    const int tid = C.tid, lane = C.lane, wave = C.wave;
    for (int u = C.vcu; u < 256; u += C.G) {
        const int bh = u >> 2, rg = u & 3, b = bh >> 4, h = bh & 15;
        const size_t tb = (size_t)b * SEQ; const int cb = h * 64;
        const int lt = tid - 256;
        u32x4 pre[3][6];
#define LD_CHUNK(set, c_) do { const size_t t_ = tb + (size_t)(c_) * CH + (lt >> 3); const int j_ = lt & 7; \
            _Pragma("unroll") for (int vq = 0; vq < 5; ++vq) { const int arr = (vq < 3) ? vq : vq + 1; \
                pre[set][vq] = *(const u32x4*)(SR + (size_t)arr * NT * 1024 + t_ * 1024 + cb + 8 * j_); } \
            if (lt < 64) { const size_t tv_ = tb + (size_t)(c_) * CH + (lt >> 1); \
                pre[set][5] = *(const u32x4*)(SR + (size_t)3 * NT * 1024 + tv_ * 1024 + cb + 16 * rg + 8 * (lt & 1)); } } while (0)
#define ST_CHUNK(set, buf_) do { const int step_ = lt >> 3, j_ = lt & 7;     \
            _Pragma("unroll") for (int vq = 0; vq < 5; ++vq) *(LAS u32x4*)(lds + (buf_) * BUFB + vq * VECB + step_ * 128 + j_ * 16) = pre[set][vq]; \
            if (lt < 64) { const u32x4 p = pre[set][5]; LAS u32x4* d = (LAS u32x4*)(lds + (buf_) * BUFB + 5 * VECB + (lt >> 1) * 64 + (lt & 1) * 32);     \
                d[0] = (u32x4){(p.x & 0xffffu) | (p.x << 16), (p.x >> 16) | (p.x & 0xffff0000u), (p.y & 0xffffu) | (p.y << 16), (p.y >> 16) | (p.y & 0xffff0000u)}; \
                d[1] = (u32x4){(p.z & 0xffffu) | (p.z << 16), (p.z >> 16) | (p.z & 0xffff0000u), (p.w & 0xffffu) | (p.w << 16), (p.w >> 16) | (p.w & 0xffff0000u)}; } } while (0)
        h2_t S01 = {(_Float16)0.f, (_Float16)0.f}, S23 = {(_Float16)0.f, (_Float16)0.f};
        const int ks = lane & 15, rowl = wave * 4 + (lane >> 4);
        constexpr int NCH = SEQ / CH;
        const int n_bg = N_MOE_ITEMS + (l == 0 ? N_SMALL_ITEMS : 0);
#define BG_DESC(it_) (((it_) < N_MOE_ITEMS) ? moe_tr_desc(l, (it_), in, ws) : small_tr_desc(1, (it_) - N_MOE_ITEMS, in, ws + WS_L1OFF))
        float tq[32]; int mo_it = (C.wg * 4 + (wave - 4)); bool mo_pending = false; TrDesc mo_d{};
        LAS float* mo_scr = (LAS float*)(lds + OB + 2 * CH * 64) + (wave - 4) * (64 * 33);
        if (wave >= 4) { LD_CHUNK(0, 0); LD_CHUNK(1, 1); LD_CHUNK(2, 2); ST_CHUNK(0, 0); LD_CHUNK(0, 3); }
        __syncthreads();
#define SCAN_ITER(c, setn) do { \
            const int buf = (c) & 1; \
            if (wave >= 4) { \
                if ((c) + 1 < NCH) { ST_CHUNK(setn, buf ^ 1); if ((c) + 4 < NCH) LD_CHUNK(setn, (c) + 4); } \
                if ((c) > 0 && lt < 128) { \
                    const int step = lt >> 2, q4 = lt & 3; const LAS float* ob_ = (const LAS float*)(lds + OB + (((c) - 1) & 1) * (CH * 64)) + (step >> 4) * 256 + (step & 15); \
                    const f32x4 o = {ob_[(4 * q4 + 0) * 16], ob_[(4 * q4 + 1) * 16], ob_[(4 * q4 + 2) * 16], ob_[(4 * q4 + 3) * 16]}; \
                    *(u32x2*)(Yf + (tb + (size_t)((c) - 1) * CH + step) * 1024 + cb + 16 * rg + 4 * q4) = (u32x2){pkh2(o[0], o[1]), pkh2(o[2], o[3])}; } \
                if (((c) & 1) == 0) { if (mo_pending) { tr_store(mo_d, tq, mo_scr, lane); mo_pending = false; } \
                    if (mo_it < n_bg) { mo_d = BG_DESC(mo_it); tr_load(mo_d, tq, lane); mo_pending = true; mo_it += C.G * 4; } } \
            } else { SCAN_BODY(buf); } \
            __syncthreads(); } while (0)
#define SC_LD(X, s_) do { const int so_ = ((s_) & (CH - 1)) * 128; X##r = *(const LAS h4_t*)(bp + 0 * VECB + so_); X##w = *(const LAS h4_t*)(bp + 1 * VECB + so_); X##k = *(const LAS h4_t*)(bp + 2 * VECB + so_); \
            X##a = *(const LAS h4_t*)(bp + 3 * VECB + so_); X##b = *(const LAS h4_t*)(bp + 4 * VECB + so_); X##v = vp[((s_) & (CH - 1)) * 16]; } while (0)
#define DPPF(x, ctl) __builtin_bit_cast(float, __builtin_amdgcn_update_dpp(0, __builtin_bit_cast(int, x), ctl, 0xf, 0xf, true))
#define H_LO(x) __builtin_shufflevector(x, x, 0, 1)
#define H_HI(x) __builtin_shufflevector(x, x, 2, 3)
#define SC_DOT(x) __builtin_amdgcn_fdot2(S01, H_LO(x), dot2z(S23, H_HI(x)), false)
#define SC_FIRST(X) do { float sa = SC_DOT(X##a); \
            const h2_t t01 = S01 * H_LO(X##w) + X##v * H_LO(X##k), t23 = S23 * H_HI(X##w) + X##v * H_HI(X##k); \
            ROW_ALLREDUCE(sa); \
            const _Float16 sh = (_Float16)sa; const h2_t sa2 = {sh, sh}; \
            S01 = sa2 * H_LO(X##b) + t01; S23 = sa2 * H_HI(X##b) + t23; } while (0)
#define SC_PAIR(X, Y, s_) do { float o = SC_DOT(X##r); float sa = SC_DOT(Y##a); \
            const h2_t t01 = S01 * H_LO(Y##w) + Y##v * H_LO(Y##k), t23 = S23 * H_HI(Y##w) + Y##v * H_HI(Y##k); \
            sa += DPPF(sa, 0x128); o += DPPF(o, 0x128); sa += DPPF(sa, 0x124); o += DPPF(o, 0x124); sa += DPPF(sa, 0x122); o += DPPF(o, 0x122); sa += DPPF(sa, 0x121); o += DPPF(o, 0x121); \
            const _Float16 sh = (_Float16)sa; const h2_t sa2 = {sh, sh}; \
            S01 = sa2 * H_LO(Y##b) + t01; S23 = sa2 * H_HI(Y##b) + t23; \
            osel = (ks == (((s_) - 1) & 15)) ? o : osel; if ((((s_) - 1) & 15) == 15) op16[(((s_) - 1) >> 4) * 256] = osel; } while (0)
#define SC_LAST(X, s_) do { float o = SC_DOT(X##r); ROW_ALLREDUCE(o); osel = (ks == ((s_) & 15)) ? o : osel; op16[((s_) >> 4) * 256] = osel; } while (0)
#define SCAN_BODY(buf_) do { \
            const LAS unsigned char* bp = lds + (buf_) * BUFB + ks * 8; \
            const LAS h2_t* vp = (const LAS h2_t*)(lds + (buf_) * BUFB + 5 * VECB) + rowl; \
            LAS float* op16 = (LAS float*)(lds + OB + (buf_) * (CH * 64)) + rowl * 16 + ks; float osel = 0.f;     \
            h4_t Ar, Aw, Ak, Aa, Ab, Br, Bw, Bk, Ba, Bb, Cr, Cw, Ck, Ca, Cb, Dr, Dw, Dk, Da, Db; h2_t Av, Bv, Cv, Dv; \
            SC_LD(A, 0); SC_LD(B, 1); SC_LD(C, 2); SC_LD(D, 3); \
            SC_FIRST(A); \
            _Pragma("unroll 2") for (int s = 0; s < CH - 4; s += 4) { \
                SC_PAIR(A, B, s + 1); SC_LD(A, s + 4); \
                SC_PAIR(B, C, s + 2); SC_LD(B, s + 5); \
                SC_PAIR(C, D, s + 3); SC_LD(C, s + 6); \
                SC_PAIR(D, A, s + 4); SC_LD(D, s + 7); } \
            SC_PAIR(A, B, CH - 3); SC_PAIR(B, C, CH - 2); SC_PAIR(C, D, CH - 1); SC_LAST(D, CH - 1); } while (0)
#pragma unroll 1
        for (int c = 0; c < NCH; c += 3) { SCAN_ITER(c, 1); if (c + 1 < NCH) SCAN_ITER(c + 1, 2); if (c + 2 < NCH) SCAN_ITER(c + 2, 0); }
#undef SC_LD
#undef SC_FIRST
#undef SC_PAIR
#undef SC_LAST
#undef DPPF
#undef H_LO
#undef H_HI
#undef SC_DOT
#undef SCAN_BODY
#undef SCAN_ITER
#undef LD_CHUNK
#undef ST_CHUNK
        if (wave >= 4) { if (mo_pending) tr_store(mo_d, tq, mo_scr, lane);
            for (; mo_it < n_bg; mo_it += C.G * 4) { const TrDesc d = BG_DESC(mo_it); tr_load(d, tq, lane); tr_store(d, tq, mo_scr, lane); } }
#undef BG_DESC
        if (wave >= 4 && lt < 128) { const int c = NCH; const int step = lt >> 2, q4 = lt & 3; const LAS float* ob_ = (const LAS float*)(lds + OB + ((c - 1) & 1) * (CH * 64)) + (step >> 4) * 256 + (step & 15);
            const f32x4 o = {ob_[(4 * q4 + 0) * 16], ob_[(4 * q4 + 1) * 16], ob_[(4 * q4 + 2) * 16], ob_[(4 * q4 + 3) * 16]};
            *(u32x2*)(Yf + (tb + (size_t)(c - 1) * CH + step) * 1024 + cb + 16 * rg + 4 * q4) = (u32x2){pkh2(o[0], o[1]), pkh2(o[2], o[3])}; }
        __syncthreads();
    }
}

DI void phase_post(const Ctx& C, int l) {
    inptr_t in = C.in; unsigned char* ws = C.ws;
    const bf16_t* Yf = (const bf16_t*)(ws + WS_H); const bf16_t* LO = (const bf16_t*)(ws + WS_LORAO);
    const bf16_t* SR = (const bf16_t*)(ws + WS_U); const bf16_t* SK = SR + (size_t)2 * NT * 1024; const bf16_t* SV = SR + (size_t)3 * NT * 1024;
    bf16_t* Y = (bf16_t*)(ws + WS_PRW);
    const float* rk = in[20] + (size_t)l * 1024; const float* lnw = in[21] + (size_t)l * 1024; const float* lnb = in[22] + (size_t)l * 1024;
    const int lane = C.lane;
    for (int t = C.gw; t < NT; t += C.ngw) {
#pragma unroll
        for (int j = 0; j < 2; ++j) {
            const int c0 = 8 * lane + 512 * j; const size_t o = (size_t)t * 1024 + c0;
            const u32x4 yq = *(const u32x4*)(Yf + o); const f32x4 y0 = {hflo(yq.x), hfhi(yq.x), hflo(yq.y), hfhi(yq.y)}, y1 = {hflo(yq.z), hfhi(yq.z), hflo(yq.w), hfhi(yq.w)};
            const u32x4 rr = *(const u32x4*)(SR + o), kq = *(const u32x4*)(SK + o), vq = *(const u32x4*)(SV + o), gq = *(const u32x4*)(LO + (size_t)t * 4096 + 2048 + c0);
            float y[8], rk8[8], lw8[8], lb8[8];
#pragma unroll
            for (int e = 0; e < 2; ++e) { const f32x4 a = *(const f32x4*)(rk + c0 + 4 * e), b = *(const f32x4*)(lnw + c0 + 4 * e), c = *(const f32x4*)(lnb + c0 + 4 * e);
#pragma unroll
                for (int i = 0; i < 4; ++i) { rk8[4 * e + i] = a[i]; lw8[4 * e + i] = b[i]; lb8[4 * e + i] = c[i]; y[4 * e + i] = e ? y1[i] : y0[i]; } }
            float sm = 0.f, bs = 0.f; float r8[8], k8[8], v8[8], g8[8];
#pragma unroll
            for (int e = 0; e < 8; ++e) { r8[e] = (e & 1) ? hfhi(rr[e >> 1]) : hflo(rr[e >> 1]); k8[e] = (e & 1) ? hfhi(kq[e >> 1]) : hflo(kq[e >> 1]);
                v8[e] = (e & 1) ? hfhi(vq[e >> 1]) : hflo(vq[e >> 1]); g8[e] = (e & 1) ? bfhi(gq[e >> 1]) : bflo(gq[e >> 1]);
                sm += y[e]; bs += r8[e] * k8[e] * rk8[e]; }
            sm += DPP_F(sm, 0xB1); sm += DPP_F(sm, 0x4E); sm += DPP_F(sm, 0x141);
            bs += DPP_F(bs, 0xB1); bs += DPP_F(bs, 0x4E); bs += DPP_F(bs, 0x141);
            const float mean = sm * (1.f / 64.f); float vs = 0.f;
#pragma unroll
            for (int e = 0; e < 8; ++e) { y[e] -= mean; vs += y[e] * y[e]; }
            vs += DPP_F(vs, 0xB1); vs += DPP_F(vs, 0x4E); vs += DPP_F(vs, 0x141);
            const float rs = rsqrtf(vs * (1.f / 64.f) + 64e-5f);
            u32x4 ov;
#pragma unroll
            for (int e = 0; e < 4; ++e) { const float o0 = (y[2 * e] * rs * lw8[2 * e] + lb8[2 * e] + bs * v8[2 * e]) * g8[2 * e], o1 = (y[2 * e + 1] * rs * lw8[2 * e + 1] + lb8[2 * e + 1] + bs * v8[2 * e + 1]) * g8[2 * e + 1];
                ov[e] = pk2(o0, o1); }
            *(u32x4*)(Y + (size_t)t * 2048 + c0) = ov;
        }
    }
}

struct AttnP {
    const bf16_t* Q; int qpitch, qcol0;
    const bf16_t* K1; int k1pitch, k1col0;
    const bf16_t* K2; int k2pitch, k2col0;
    const bf16_t* V; int vpitch, vcol0;
    bf16_t* O; int opitch, ocol0;
    size_t qrow0, krow0;
    int q0;
    int nkeys;
    float c1;
    const int* pos; const float* lut;
    float lam, outscale; const float* subw;
    int dbg;
};

template <int DQK, int DK1, int MODE, int KT, int PFD>
DI void attn_unit(LAS unsigned char* lds, const AttnP& P) {
    constexpr int DV = 128, KP = DQK * 2 + 16, VP = DV * 2 + 64;
    constexpr int NBLK = KT / 32;
    constexpr int KTILE = KT * KP, VTILE = KT * VP;
    constexpr int NVT = (MODE == 0) ? 1 : 2;
    constexpr int VSLOT = NVT * VTILE + 256;
    constexpr bool ONEB = (MODE != 2);
    constexpr int KSLOT = 2 * KTILE, NKS = ONEB ? 2 : 1, NVS = ONEB ? 3 : 2;
    constexpr int OFF_V = NKS * KSLOT, OFF_POS = NVT * VTILE, OFF_LUT = OFF_V + NVS * VSLOT, OFF_END = OFF_LUT + 512;
    static_assert(!ONEB || PFD == 1, "one-barrier loop uses a single prefetch set");
    constexpr int OFF_OST = 4 * 17408, OSTP = 272;
    static_assert(OFF_END <= LDS_MAIN && OFF_OST + 4 * 32 * OSTP <= LDS_MAIN, "attention LDS");
    constexpr int KCH = DQK / 8, K1CH = DK1 / 8;
    constexpr int NKC = 2 * KT * KCH, NVC = NVT * KT * 16, NKCH = NKC / 512, NVCH = NVC / 512, NCHK = NKCH + NVCH;
    static_assert(NKC % 512 == 0 && NVC % 512 == 0, "chunks");
    constexpr float NEG = -1e30f, THR = 8.f;
    constexpr int KSTEP = (MODE == 0) ? KT : 2 * KT;
    int tid = threadIdx.x; asm volatile("" : "+v"(tid));
    const int lane = tid & 63, wave = __builtin_amdgcn_readfirstlane(tid >> 6);
    const int qg = wave >> 1, st = wave & 1, r32 = lane & 31, h2 = lane >> 5;
    const int qw0 = P.q0 + 32 * qg;
    const int myq = qw0 + r32;
    bf16x8 qf[DQK / 16];
    {
        const bf16_t* qp = P.Q + (P.qrow0 + myq) * (size_t)P.qpitch + P.qcol0 + ((MODE == 0) ? st * 64 : 0) + 8 * h2;
#pragma unroll
        for (int ks = 0; ks < DQK / 16; ++ks) qf[ks] = *(const bf16x8*)(qp + 16 * ks);
    }
    int mypos = 0, posq0 = 0;
    if constexpr (MODE == 0) { mypos = P.pos[myq]; posq0 = P.pos[qw0]; if (tid < 128) ((LAS float*)(lds + OFF_LUT))[tid] = P.lut[tid]; }
    f32x16 o[4];
#pragma unroll
    for (int d = 0; d < 4; ++d)
#pragma unroll
        for (int i = 0; i < 16; ++i) o[d][i] = 0.f;
    float m_run = NEG, l_run = 0.f;
    const int nsteps = P.nkeys / KSTEP;
    const char* gp[NCHK]; unsigned adv[NCHK]; unsigned ldst[NCHK];
#pragma unroll
    for (int i = 0; i < NKCH; ++i) { const int c = tid + 512 * i; const int s = c / (KT * KCH), rc = c % (KT * KCH), row = rc / KCH, ch = rc % KCH;
        const int key = (MODE == 0) ? row : s * KT + row;
        if (ch < K1CH) { gp[i] = (const char*)(P.K1 + (P.krow0 + key) * (size_t)P.k1pitch + P.k1col0 + ((MODE == 0) ? s * 64 : 0) + ch * 8); adv[i] = (unsigned)(KSTEP * P.k1pitch * 2); }
        else { gp[i] = (const char*)(P.K2 + (P.krow0 + key) * (size_t)P.k2pitch + P.k2col0 + (ch - K1CH) * 8); adv[i] = (unsigned)(KSTEP * P.k2pitch * 2); }
        ldst[i] = (unsigned)(s * KTILE + row * KP + ch * 16); }
#pragma unroll
    for (int i = 0; i < NVCH; ++i) { const int c2 = tid + 512 * i; const int s = c2 / (KT * 16), rc = c2 % (KT * 16), row = rc / 16, ch = rc % 16;
        const int key = (MODE == 0) ? row : s * KT + row;
        gp[NKCH + i] = (const char*)(P.V + (P.krow0 + key) * (size_t)P.vpitch + P.vcol0 + ch * 8); adv[NKCH + i] = (unsigned)(KSTEP * P.vpitch * 2);
        ldst[NKCH + i] = (unsigned)(s * VTILE + row * VP + ch * 16); }
    u32x4 preK[PFD][NKCH], preV[PFD][NVCH]; int prepos[2] = {0, 0};
#define KSET(par) ((PFD == 2) ? ((par) ^ 1) : 0)
#define VSET(par) ((PFD == 2) ? (par) : 0)
#define ATT_PREFETCH_K(set_) do { _Pragma("unroll") for (int i = 0; i < NKCH; ++i) { preK[set_][i] = *(const u32x4*)gp[i]; gp[i] += adv[i]; } } while (0)
#define ATT_PREFETCH_V(set_, step_) do { _Pragma("unroll") for (int i = 0; i < NVCH; ++i) { preV[set_][i] = *(const u32x4*)gp[NKCH + i]; gp[NKCH + i] += adv[NKCH + i]; } \
        if constexpr (MODE == 0) { if (tid < KT) prepos[set_] = P.pos[(step_) * KT + tid]; } } while (0)
#define ATT_STAGE_K(set_, ko_) do { _Pragma("unroll") for (int i = 0; i < NKCH; ++i) *(LAS u32x4*)(lds + (ko_) + ldst[i]) = preK[set_][i]; } while (0)
#define ATT_STAGE_V(set_, vo_) do { _Pragma("unroll") for (int i = 0; i < NVCH; ++i) *(LAS u32x4*)(lds + (vo_) + ldst[NKCH + i]) = preV[set_][i]; \
        if constexpr (MODE == 0) { if (tid < KT) ((LAS int*)(lds + (vo_) + OFF_POS))[tid] = prepos[set_]; } } while (0)
#define ATT_QK(dst, ko_) do { const LAS unsigned char* kb_ = lds + (ko_) + st * KTILE + r32 * KP + 16 * h2; \
        _Pragma("unroll") for (int blk = 0; blk < NBLK; ++blk) { \
            _Pragma("unroll") for (int i = 0; i < 16; ++i) dst[blk][i] = 0.f; \
            _Pragma("unroll") for (int ks = 0; ks < DQK / 16; ++ks) { const bf16x8 kf = *(const LAS bf16x8*)(kb_ + blk * 32 * KP + ks * 32); dst[blk] = __builtin_amdgcn_mfma_f32_32x32x16_bf16(kf, qf[ks], dst[blk], 0, 0, 0); } } } while (0)
#define ATT_VLD(j_) do { const int d_ = (j_) / (2 * NBLK), r_ = (j_) % (2 * NBLK); const LAS unsigned char* vp_ = vb_ + (16 * r_) * VP + d_ * 64; \
            vlo_[(j_) & 1] = __builtin_bit_cast(s16x4, __builtin_amdgcn_ds_read_tr16_b64_v4i16((LAS v4i16_t*)vp_)); \
            vhi_[(j_) & 1] = __builtin_bit_cast(s16x4, __builtin_amdgcn_ds_read_tr16_b64_v4i16((LAS v4i16_t*)(vp_ + 8 * VP))); } while (0)
#define ATT_PV(vo_) do { const int sv_ = (MODE == 0) ? 0 : st; \
        const LAS unsigned char* vb_ = lds + (vo_) + sv_ * VTILE + (4 * h2 + ((lane & 15) >> 2)) * VP + ((lane >> 4) & 1) * 32 + (lane & 3) * 8; \
        s16x4 vlo_[2], vhi_[2]; ATT_VLD(0); \
        _Pragma("unroll") for (int j = 0; j < 8 * NBLK; ++j) { if (j + 1 < 8 * NBLK) ATT_VLD(j + 1); \
            const s16x4 lo_ = vlo_[j & 1], hi_ = vhi_[j & 1]; const bf16x8 vf_ = {lo_[0], lo_[1], lo_[2], lo_[3], hi_[0], hi_[1], hi_[2], hi_[3]}; \
            const int d_ = j / (2 * NBLK), r_ = j % (2 * NBLK); \
            o[d_] = __builtin_amdgcn_mfma_f32_32x32x16_bf16(vf_, pf[r_ >> 1][r_ & 1], o[d_], 0, 0, 0); } } while (0)
    f32x16 sc[NBLK]; bf16x8 pf[NBLK][2]; bool pv_pending = false;
    const bool order_b = (wave & 1) != 0;
    auto att_body = [&](int step, int vo_cur, int vo_prev, int ko_next) {
        const int k0 = step * KSTEP + ((MODE == 0) ? 0 : st * KT);
        const bool valid_next = (step + 1 < nsteps) && (MODE == 2 || k0 + KSTEP <= qw0 + 31);
        const bool valid = (MODE == 2) || (k0 <= qw0 + 31);
        if (!order_b && pv_pending && !(P.dbg & 1)) ATT_PV(vo_prev);
        pv_pending = valid && !order_b;
        if (valid && !(P.dbg & 2)) {
        const bool need_mask = (MODE != 2) && (k0 + KT - 1 > qw0);
        float bb = 0.f; bool near = false;
        if constexpr (MODE == 0) {
            const LAS float* lut = (const LAS float*)(lds + OFF_LUT);
            const LAS int* pk = (const LAS int*)(lds + vo_cur + OFF_POS);
            near = (posq0 - pk[KT - 1]) < 127;
            if (near) {
#pragma unroll
                for (int blk = 0; blk < NBLK; ++blk)
#pragma unroll
                    for (int i = 0; i < 16; ++i) { const int kl = 32 * blk + (i & 3) + 8 * (i >> 2) + 4 * h2; int rel = mypos - pk[kl]; rel = rel < 0 ? 0 : (rel > 127 ? 127 : rel);
                        sc[blk][i] = sc[blk][i] * P.c1 + lut[rel]; }
            } else bb = lut[127];
        }
        if (need_mask) {
#pragma unroll
            for (int blk = 0; blk < NBLK; ++blk)
#pragma unroll
                for (int i = 0; i < 16; ++i) { const int key = k0 + 32 * blk + (i & 3) + 8 * (i >> 2) + 4 * h2; if (key > myq) sc[blk][i] = NEG; }
        }
        const float cc = near ? 1.f : P.c1;
        float mx = sc[0][0];
#pragma unroll
        for (int blk = 0; blk < NBLK; ++blk)
#pragma unroll
            for (int i = 0; i < 16; ++i) mx = fmaxf(mx, sc[blk][i]);
        { const int mi = __builtin_bit_cast(int, mx); auto rr = __builtin_amdgcn_permlane32_swap(mi, mi, false, false); mx = fmaxf(__builtin_bit_cast(float, (int)rr[0]), __builtin_bit_cast(float, (int)rr[1])); }
        mx = mx * cc + bb;
        if (__any(mx > m_run + THR)) {
            const float m_new = fmaxf(m_run, mx);
            const float alpha = __builtin_amdgcn_exp2f(m_run - m_new);
            m_run = m_new; l_run *= alpha;
#pragma unroll
            for (int d = 0; d < 4; ++d)
#pragma unroll
                for (int i = 0; i < 16; ++i) o[d][i] *= alpha;
        }
        const float off = bb - m_run;
        float psum = 0.f;
#pragma unroll
        for (int blk = 0; blk < NBLK; ++blk)
#pragma unroll
            for (int i = 0; i < 16; ++i) { const float p = __builtin_amdgcn_exp2f(__builtin_fmaf(sc[blk][i], cc, off)); sc[blk][i] = p; psum += p; }
        l_run += psum;
#pragma unroll
        for (int blk = 0; blk < NBLK; ++blk)
#pragma unroll
            for (int s16 = 0; s16 < 2; ++s16) { u32x4 w; w.x = pk2(sc[blk][8 * s16 + 0], sc[blk][8 * s16 + 1]); w.y = pk2(sc[blk][8 * s16 + 2], sc[blk][8 * s16 + 3]);
                w.z = pk2(sc[blk][8 * s16 + 4], sc[blk][8 * s16 + 5]); w.w = pk2(sc[blk][8 * s16 + 6], sc[blk][8 * s16 + 7]); pf[blk][s16] = __builtin_bit_cast(bf16x8, w); }
        }
        if (order_b && valid && !(P.dbg & 1)) ATT_PV(vo_cur);
        if (valid_next && !(P.dbg & 4)) ATT_QK(sc, ko_next);
        };
#define ATT_BODY(step, vc, vp) att_body(step, vc, vp, 0)
#define ATT_BAR() asm volatile("s_waitcnt lgkmcnt(0)\n\ts_barrier" ::: "memory")
    if constexpr (ONEB) {
        ATT_PREFETCH_K(0);
        __syncthreads();
        ATT_STAGE_K(0, 0);
        if (nsteps > 1) ATT_PREFETCH_K(0);
        ATT_PREFETCH_V(0, 0);
        if (nsteps > 1) ATT_STAGE_K(0, KSLOT);
        ATT_STAGE_V(0, OFF_V);
        if (nsteps > 2) ATT_PREFETCH_K(0);
        if (nsteps > 1) ATT_PREFETCH_V(0, 1);
        __syncthreads();
        ATT_QK(sc, 0);
        int vo_prev = OFF_V + 2 * VSLOT, vo_cur = OFF_V, vo_next = OFF_V + VSLOT;
        for (int step = 0; step < nsteps; ++step) {
            ATT_BAR();
            const int ko_next = ((step + 1) & 1) * KSLOT, ko_free = (step & 1) * KSLOT;
            if (!(P.dbg & 8)) {
                if (step + 2 < nsteps) ATT_STAGE_K(0, ko_free);
                if (step + 1 < nsteps) ATT_STAGE_V(0, vo_next);
                if (step + 3 < nsteps) ATT_PREFETCH_K(0);
                if (step + 2 < nsteps) ATT_PREFETCH_V(0, step + 2); }
            att_body(step, vo_cur, vo_prev, ko_next);
            const int tmp_ = vo_prev; vo_prev = vo_cur; vo_cur = vo_next; vo_next = tmp_;
        }
        if (pv_pending) ATT_PV(vo_prev);
    } else {
    ATT_PREFETCH_K(0);
    __syncthreads();
    ATT_STAGE_K(0, 0);
    if (nsteps > 1) ATT_PREFETCH_K(KSET(0));
    if (PFD == 2 && nsteps > 2) ATT_PREFETCH_K(0);
    ATT_PREFETCH_V(0, 0);
    if (PFD == 2 && nsteps > 1) ATT_PREFETCH_V(1, 1);
    __syncthreads();
    ATT_QK(sc, 0);
#define ATT_ITER(step, par) do { \
        const int vo_cur = OFF_V + (par) * VSLOT, vo_prev = OFF_V + ((par) ^ 1) * VSLOT; \
        ATT_BAR();                                                  \
        if (!(P.dbg & 8)) { if ((step) + 1 < nsteps) ATT_STAGE_K(KSET(par), 0); \
        ATT_STAGE_V(VSET(par), vo_cur); } \
        ATT_BAR();                                                  \
        if (!(P.dbg & 8)) { if ((step) + 1 + PFD < nsteps) ATT_PREFETCH_K(KSET(par)); \
        if ((step) + PFD < nsteps) ATT_PREFETCH_V(VSET(par), (step) + PFD); } \
        ATT_BODY(step, vo_cur, vo_prev); } while (0)
    for (int step = 0; step < nsteps; step += 2) { ATT_ITER(step, 0); if (step + 1 < nsteps) ATT_ITER(step + 1, 1); }
    if (pv_pending) ATT_PV(OFF_V + ((nsteps - 1) & 1) * VSLOT);
    }
#undef ATT_PREFETCH_K
#undef ATT_PREFETCH_V
#undef ATT_STAGE_K
#undef ATT_STAGE_V
#undef ATT_QK
#undef ATT_PV
#undef ATT_VLD
#undef ATT_ITER
#undef ATT_BAR
#undef ATT_BODY
#undef KSET
#undef VSET
    l_run += __shfl_xor(l_run, 32);
    __syncthreads();
    LAS float* mb = (LAS float*)(lds + qg * 17408);
    if (st == 1) {
        if constexpr (MODE == 0) { const float inv = 1.f / l_run;
#pragma unroll
            for (int d = 0; d < 4; ++d)
#pragma unroll
                for (int i = 0; i < 16; ++i) mb[(d * 16 + i) * 64 + lane] = o[d][i] * inv;
        } else {
#pragma unroll
            for (int d = 0; d < 4; ++d)
#pragma unroll
                for (int i = 0; i < 16; ++i) mb[(d * 16 + i) * 64 + lane] = o[d][i];
            mb[4096 + lane] = m_run; mb[4160 + lane] = l_run;
        }
    }
    __syncthreads();
    if (st == 0) {
        if constexpr (MODE == 0) {
            const float inv = 1.f / l_run; float ss = 0.f;
#pragma unroll
            for (int d = 0; d < 4; ++d)
#pragma unroll
                for (int i = 0; i < 16; ++i) { const float v = o[d][i] * inv - P.lam * mb[(d * 16 + i) * 64 + lane]; o[d][i] = v; ss += v * v; }
            ss += __shfl_xor(ss, 32);
            const float rn = rsqrtf(ss * (1.f / 128.f) + 1e-5f) * P.outscale;
#pragma unroll
            for (int d = 0; d < 4; ++d)
#pragma unroll
                for (int i = 0; i < 16; ++i) { const int dv = 32 * d + (i & 3) + 8 * (i >> 2) + 4 * h2; o[d][i] = o[d][i] * rn * P.subw[dv]; }
        } else {
            const float m1 = mb[4096 + lane], l1 = mb[4160 + lane];
            const float mt = fmaxf(m_run, m1); const float a0 = __builtin_amdgcn_exp2f(m_run - mt), a1 = __builtin_amdgcn_exp2f(m1 - mt);
            const float inv = 1.f / (l_run * a0 + l1 * a1);
#pragma unroll
            for (int d = 0; d < 4; ++d)
#pragma unroll
                for (int i = 0; i < 16; ++i) o[d][i] = (o[d][i] * a0 + mb[(d * 16 + i) * 64 + lane] * a1) * inv;
        }
        LAS unsigned char* og = lds + OFF_OST + qg * (32 * OSTP);
#pragma unroll
        for (int d = 0; d < 4; ++d)
#pragma unroll
            for (int g4 = 0; g4 < 4; ++g4) { u32x2 w; w.x = pk2(o[d][4 * g4 + 0], o[d][4 * g4 + 1]); w.y = pk2(o[d][4 * g4 + 2], o[d][4 * g4 + 3]);
                *(LAS u32x2*)(og + r32 * OSTP + (32 * d + 8 * g4 + 4 * h2) * 2) = w; }
        asm volatile("s_waitcnt lgkmcnt(0)" ::: "memory");
        bf16_t* op = P.O + (P.qrow0 + qw0) * (size_t)P.opitch + P.ocol0;
#pragma unroll
        for (int i = 0; i < 8; ++i) { const int row = 4 * i + (lane >> 4), ch = lane & 15;
            const u32x4 v = *(const LAS u32x4*)(og + row * OSTP + ch * 16);
            *(u32x4*)(op + (size_t)row * P.opitch + ch * 8) = v; }
    }
    __syncthreads();
}

DI void phase_att(const Ctx& C, int l) {
    inptr_t in = C.in; unsigned char* ws = C.ws;
    const int ATT_SEL = C.att_sel & 0xff; const int dbg = C.att_sel >> 8;
    if (ATT_SEL & 1) phase_post(C, l);
    bf16_t* Y = dbg ? (bf16_t*)(ws + WS_H) : (bf16_t*)(ws + WS_PRW); const bf16_t* PATT = (const bf16_t*)(ws + WS_PATT);
    const float lambda_init = 0.8f - 0.6f * expf(-0.3f * (float)l);
    float lam;
    { const float a = wave_sum(in[23][l * 64 + C.lane] * in[24][l * 64 + C.lane]), b = wave_sum(in[25][l * 64 + C.lane] * in[26][l * 64 + C.lane]); lam = expf(a) - expf(b) + lambda_init; }
    if (ATT_SEL & 2) for (int w = C.vcu; w < 256; w += C.G) {
        const int bh = w >> 4, j = w & 15, b = bh >> 2, h = bh & 3;
#pragma unroll 1
        for (int k = 0; k < 2; ++k) { const int qb = k ? 31 - j : j;
            AttnP P; P.Q = PATT; P.qpitch = PATT_COLS; P.qcol0 = h * 128; P.K1 = PATT; P.k1pitch = PATT_COLS; P.k1col0 = 512 + h * 128; P.K2 = PATT; P.k2pitch = 0; P.k2col0 = 0;
            P.V = PATT; P.vpitch = PATT_COLS; P.vcol0 = 1024 + h * 128; P.O = Y; P.opitch = 2048; P.ocol0 = 1024 + h * 128;
            P.qrow0 = (size_t)b * SEQ; P.krow0 = (size_t)b * SEQ; P.q0 = qb * 128; P.nkeys = qb * 128 + 128; P.c1 = 0.125f * LOG2E;
            P.pos = (const int*)in[2] + b * SEQ; P.lut = (const float*)(ws + WS_LUT) + h * 128; P.lam = lam; P.outscale = 1.f - lambda_init; P.subw = in[27] + l * 128; P.dbg = dbg;
            attn_unit<64, 64, 0, 64, 1>(C.lds, P); }
    }
    const bf16_t* QM = (const bf16_t*)(ws + WS_QM); const bf16_t* KVM = (const bf16_t*)(ws + WS_KVM); const bf16_t* KPE = (const bf16_t*)(ws + WS_KPE);
    if (ATT_SEL & 4) for (int w = C.vcu; w < 256; w += C.G) {
        const int bh = w >> 4, j = w & 15, b = bh >> 2, h = bh & 3;
#pragma unroll 1
        for (int k = 0; k < 2; ++k) { const int qb = k ? 31 - j : j;
            AttnP P; P.Q = QM; P.qpitch = 768; P.qcol0 = h * 192; P.K1 = KVM; P.k1pitch = 1024; P.k1col0 = h * 256; P.K2 = KPE; P.k2pitch = 64; P.k2col0 = 0;
            P.V = KVM; P.vpitch = 1024; P.vcol0 = h * 256 + 128; P.O = Y; P.opitch = 2048; P.ocol0 = 1536 + h * 128;
            P.qrow0 = (size_t)b * SEQ; P.krow0 = (size_t)b * SEQ; P.q0 = qb * 128; P.nkeys = qb * 128 + 128; P.c1 = 0.07216878364870322f * LOG2E;
            P.pos = nullptr; P.lut = nullptr; P.lam = 0.f; P.outscale = 0.f; P.subw = nullptr; P.dbg = dbg;
            attn_unit<192, 128, 1, 32, 1>(C.lds, P); }
    }
}

DI void phase_cross(const Ctx& C) {
    unsigned char* ws = C.ws; const int dbg = 0;
    const bf16_t* CAQ = (const bf16_t*)(ws + WS_CAQ); const bf16_t* MKV = (const bf16_t*)(ws + WS_MEMKV); bf16_t* CAO = (bf16_t*)(ws + WS_CAO);
    for (int u = C.vcu; u < 512; u += C.G) {
        const int bh = u >> 5, qb = u & 31, b = bh >> 2, h = bh & 3;
        AttnP P; P.Q = CAQ; P.qpitch = 512; P.qcol0 = h * 128; P.K1 = MKV; P.k1pitch = 1024; P.k1col0 = h * 128; P.K2 = MKV; P.k2pitch = 0; P.k2col0 = 0;
        P.V = MKV; P.vpitch = 1024; P.vcol0 = 512 + h * 128; P.O = CAO; P.opitch = 512; P.ocol0 = h * 128;
        P.qrow0 = (size_t)b * SEQ; P.krow0 = (size_t)b * MEMLEN; P.q0 = qb * 128; P.nkeys = MEMLEN; P.c1 = 0.08838834764831845f * LOG2E;
        P.pos = nullptr; P.lut = nullptr; P.lam = 0.f; P.outscale = 0.f; P.subw = nullptr; P.dbg = dbg;
        attn_unit<128, 128, 2, 64, 1>(C.lds, P);
    }
}

DI void phase_route(const Ctx& C, int l) {
    inptr_t in = C.in; unsigned char* ws = C.ws;
    const float* LG = (const float*)(ws + WS_LOGITS);
    const float* bg = in[39] + l * 4; const float* be = in[41] + l * 32;
    int* EID = (int*)(ws + WS_EID); float* GATE = (float*)(ws + WS_GATE); int* CNT = (int*)(ws + WS_CNT);
    LAS int* hist = (LAS int*)(C.lds);
    const int lane = C.lane;
    for (int wgt = C.wg; wgt < 256; wgt += C.G) {
        if (C.tid < 32) hist[C.tid] = 0;
        __syncthreads();
#pragma unroll 1
        for (int r = 0; r < 8; ++r) {
            const int t = wgt * 64 + C.wave * 8 + r;
            const float raw = (lane < 36) ? LG[(size_t)t * 256 + lane] : 0.f;
            const float g0 = RDL_F(raw, 32), g1 = RDL_F(raw, 33), g2 = RDL_F(raw, 34), g3 = RDL_F(raw, 35);
            int sel = 0; float best = g0 + bg[0];
            if (g1 + bg[1] > best) { best = g1 + bg[1]; sel = 1; }
            if (g2 + bg[2] > best) { best = g2 + bg[2]; sel = 2; }
            if (g3 + bg[3] > best) { best = g3 + bg[3]; sel = 3; }
            const float gm = fmaxf(fmaxf(g0, g1), fmaxf(g2, g3));
            const float e0 = __expf(g0 - gm), e1 = __expf(g1 - gm), e2 = __expf(g2 - gm), e3 = __expf(g3 - gm);
            const float es = sel == 0 ? e0 : (sel == 1 ? e1 : (sel == 2 ? e2 : e3));
            const float pgrp = es / ((e0 + e1) + (e2 + e3));
            float val = (lane < 32 && (lane >> 3) == sel) ? raw + be[lane & 31] : -INFINITY;
            const float m1 = wave_max(val); const int i1 = __ffsll((long long)__ballot(val == m1)) - 1;
            if (lane == i1) val = -INFINITY;
            const float m2 = wave_max(val); const int i2 = __ffsll((long long)__ballot(val == m2)) - 1;
            const float r1 = __shfl(raw, i1), r2 = __shfl(raw, i2);
            const float w1 = 1.f / (1.f + __expf(r2 - r1)), w2 = 1.f - w1;
            if (lane == 0) { EID[2 * t] = i1; EID[2 * t + 1] = i2; GATE[2 * t] = w1 * pgrp; GATE[2 * t + 1] = w2 * pgrp;
                atomicAdd((int*)&hist[i1], 1); atomicAdd((int*)&hist[i2], 1); }
        }
        __syncthreads();
        if (C.tid < 32) CNT[wgt * 32 + C.tid] = hist[C.tid];
        __syncthreads();
    }
}

DI void phase_dispatch(const Ctx& C) {
    unsigned char* ws = C.ws;
    const int* EID = (const int*)(ws + WS_EID); const int* CNT = (const int*)(ws + WS_CNT);
    int* ROWMAP = (int*)(ws + WS_ROWMAP); int* ROWDST = (int*)(ws + WS_ROWDST); int* TILEEXP = (int*)(ws + WS_TILEEXP);
    LAS int* tot = (LAS int*)(C.lds); LAS int* base = tot + 32; LAS int* off = base + 32; LAS int* eid = off + 40; LAS int* posl = eid + 128;
    const int tid = C.tid;
    for (int wgt = C.wg; wgt < 256; wgt += C.G) {
        { LAS int* cl = posl + 128;
#pragma unroll
          for (int i = 0; i < 16; ++i) cl[tid + 512 * i] = CNT[tid + 512 * i];
          __syncthreads();
          if (tid < 32) { int s = 0, bsum = 0; for (int w = 0; w < 256; ++w) { const int c = cl[w * 32 + tid]; if (w == wgt) bsum = s; s += c; } tot[tid] = s; base[tid] = bsum; } }
        if (tid >= 64 && tid < 192) eid[tid - 64] = EID[wgt * 128 + (tid - 64)];
        __syncthreads();
        if (tid == 0) { int o = 0; for (int e = 0; e < 32; ++e) { off[e] = o; o += (tot[e] + 255) & ~255; } off[32] = o; }
        __syncthreads();
        if (tid < 128) { const int e = eid[tid]; int rank = 0; for (int j = 0; j < tid; ++j) rank += (eid[j] == e) ? 1 : 0;
            const int pos = off[e] + base[e] + rank; ROWMAP[pos] = wgt * 64 + (tid >> 1); ROWDST[pos] = wgt * 128 + tid; }
        if (wgt < 32) { const int e = wgt; for (int p = off[e] + tot[e] + tid; p < off[e + 1]; p += 512) { ROWMAP[p] = 0; ROWDST[p] = -1; } }
        if (wgt == 0) { if (tid < 32) { for (int tl = off[tid] >> 8; tl < (off[tid + 1] >> 8); ++tl) TILEEXP[tl] = tid; } if (tid == 0) TILEEXP[200] = off[32] >> 8; }
        __syncthreads();
    }
}

#ifndef PHASE_MASK
#define PHASE_MASK 0x1ffff
#endif
#define IN(k) (lo <= (k) && (k) < hi)
#define EN(j) ((PHASE_MASK >> (j)) & 1)
#define SEAM(k) do { if (IN(k) && IN((k) + 1)) xcd_barrier(bar); } while (0)
#define PH_BEGIN() do { int t_ = threadIdx.x; asm volatile("" : "+v"(t_)); kaptr_t ka_ = (kaptr_t)__builtin_amdgcn_kernarg_segment_ptr(); asm volatile("" : "+s"(ka_)); \
        C.lds = (LAS unsigned char*)lds_raw; C.in = (inptr_t)ka_; C.X = *(float* const CAS*)(ka_ + 360); C.ws = *(unsigned char* const CAS*)(ka_ + 368); \
        C.tid = t_; C.lane = t_ & 63; C.wave = __builtin_amdgcn_readfirstlane(t_ >> 6); { int g_ = gridDim.x, b_ = blockIdx.x; asm volatile("" : "+s"(g_), "+s"(b_)); C.G = g_; C.wg = b_; } C.gw = C.wg * 8 + C.wave; C.ngw = C.G * 8; C.vcu = (C.G % 8 == 0) ? (C.wg % 8) * (C.G / 8) + C.wg / 8 : C.wg; \
        ws = C.ws; in = C.in; } while (0)
constexpr int PPL = 16, NPHASE = 2 * PPL + 1;
template <int l>
DI void run_layer(unsigned char* lds_raw, const XcdBarrier& bar, int lo, int hi, int att_sel = 7) {
    Ctx C; unsigned char* ws; inptr_t in; C.att_sel = att_sel;
    constexpr int pb = l * PPL;

        if (EN(0) && IN(pb + 0)) { PH_BEGIN(); phase_convert(C, l); } SEAM(pb + 0);
        if (EN(1) && IN(pb + 1)) { PH_BEGIN();
            { pg8::Gemm g{(const bf16_t*)(ws + WS_XB), (const bf16_t*)(ws + wofs(l) + WS_WINT), DM, DM, DM, nullptr}; pg8::StaticOrder S; S.init(NT, INP, C.G, C.wg, DM);
              pg8::EpiBf16 E{(bf16_t*)(ws + WS_PRW), RW_COLS, (bf16_t*)(ws + WS_PATT), PATT_COLS, 13, (const float*)(ws + WS_SSQM), 1};
              pg8::gemm_phase<pg8::EpiBf16, pg8::StaticOrder>(C.lds, g, S, E); }
            { pg8::Gemm g{(const bf16_t*)(ws + WS_MEMN), (const bf16_t*)(ws + wofs(l) + WS_CAWKVT), DM, DM, DM, nullptr}; pg8::StaticOrder S; S.init(NMEM, 1024, C.G, (C.wg + C.G / 2) % C.G, DM);
              pg8::EpiBf16 E{(bf16_t*)(ws + WS_MEMKV), 1024, nullptr, 0, 1 << 30, nullptr, 1};
              pg8::gemm_phase<pg8::EpiBf16, pg8::StaticOrder>(C.lds, g, S, E); }
        } SEAM(pb + 1);
        if (EN(2) && IN(pb + 2)) { PH_BEGIN(); phase_ew1(C, l); } SEAM(pb + 2);
        if (EN(3) && IN(pb + 3)) { PH_BEGIN();
            { pg8::Gemm g{(const bf16_t*)(ws + WS_LORAA), (const bf16_t*)(ws + wofs(l) + WS_LORABT), 384, 128, 128, nullptr}; pg8::StaticOrder S; S.init(NT, 2048, C.G, C.wg, 128);
              pg8::EpiBf16 E{(bf16_t*)(ws + WS_LORAO), 4096, nullptr, 0, 1 << 30, nullptr, 1};
              pg8::gemm_phase<pg8::EpiBf16, pg8::StaticOrder>(C.lds, g, S, E); }
            { pg8::Gemm g{(const bf16_t*)(ws + WS_LORAA) + 128, (const bf16_t*)(ws + wofs(l) + WS_LORABT) + 2048 * 128, 384, 128, 128, nullptr}; pg8::StaticOrder S; S.init(NT, 1024, C.G, C.wg, 128);
              pg8::EpiBf16 E{(bf16_t*)(ws + WS_LORAO) + 2048, 4096, nullptr, 0, 1 << 30, nullptr, 1};
              pg8::gemm_phase<pg8::EpiBf16, pg8::StaticOrder>(C.lds, g, S, E); }
            if (l == 1) { pg8::Gemm g{(const bf16_t*)(ws + WS_LORAA) + 256, (const bf16_t*)(ws + wofs(l) + WS_LORABT) + 3072 * 128, 384, 128, 128, nullptr}; pg8::StaticOrder S; S.init(NT, 1024, C.G, C.wg, 128);
              pg8::EpiBf16 E{(bf16_t*)(ws + WS_LORAO) + 3072, 4096, nullptr, 0, 1 << 30, nullptr, 1};
              pg8::gemm_phase<pg8::EpiBf16, pg8::StaticOrder>(C.lds, g, S, E); }
            { pg8::Gemm g{(const bf16_t*)(ws + WS_QN), (const bf16_t*)(ws + wofs(l) + WS_WQBT), 384, 384, 384, nullptr}; pg8::StaticOrder S; S.init(NT, 768, C.G, C.wg, 384);
              pg8::EpiBf16 E{(bf16_t*)(ws + WS_QM), 768, nullptr, 0, 1 << 30, nullptr, 1};
              pg8::gemm_phase<pg8::EpiBf16, pg8::StaticOrder>(C.lds, g, S, E); }
            { pg8::Gemm g{(const bf16_t*)(ws + WS_KVN), (const bf16_t*)(ws + wofs(l) + WS_WKVBT), 256, 256, 256, nullptr}; pg8::StaticOrder S; S.init(NT, 1024, C.G, C.wg, 256);
              pg8::EpiBf16 E{(bf16_t*)(ws + WS_KVM), 1024, nullptr, 0, 1 << 30, nullptr, 1};
              pg8::gemm_phase<pg8::EpiBf16, pg8::StaticOrder>(C.lds, g, S, E); }
        } SEAM(pb + 3);
        if (EN(4) && IN(pb + 4)) { PH_BEGIN(); phase_ew2(C, l); } SEAM(pb + 4);
        if (EN(5) && IN(pb + 5)) { PH_BEGIN(); phase_scan(C, l); } SEAM(pb + 5);
        if (EN(6) && IN(pb + 6)) { PH_BEGIN(); phase_att(C, l); } SEAM(pb + 6);
        if (EN(7) && IN(pb + 7)) { PH_BEGIN();
            pg8::Gemm g{(const bf16_t*)(ws + WS_PRW), (const bf16_t*)(ws + wofs(l) + WS_WOUTT), DM, DM, DM, nullptr}; pg8::StaticOrder S; S.init(NT, DM, C.G, C.wg, DM);
            pg8::EpiResid E{(const bf16_t*)(ws + WS_XB), (bf16_t*)(ws + WS_XB), DM, (float*)(ws + WS_PARTC)};
            pg8::gemm_phase<pg8::EpiResid, pg8::StaticOrder>(C.lds, g, S, E);
        } SEAM(pb + 7);
        if (EN(8) && IN(pb + 8)) { PH_BEGIN();
            pg8::Gemm g{(const bf16_t*)(ws + WS_XB), (const bf16_t*)(ws + wofs(l) + WS_CAWQT), DM, DM, DM, nullptr}; pg8::StaticOrder S; S.init(NT, 512, C.G, C.wg, DM);
            pg8::EpiBf16 E{(bf16_t*)(ws + WS_CAQ), 512, nullptr, 0, 1 << 30, (const float*)(ws + WS_PARTC), 32};
            pg8::gemm_phase<pg8::EpiBf16, pg8::StaticOrder>(C.lds, g, S, E);
        } SEAM(pb + 8);
        if (EN(9) && IN(pb + 9)) { PH_BEGIN(); phase_cross(C); } SEAM(pb + 9);
        if (EN(10) && IN(pb + 10)) { PH_BEGIN();
            pg8::Gemm g{(const bf16_t*)(ws + WS_CAO), (const bf16_t*)(ws + wofs(l) + WS_CAWOT), 512, 512, 512, nullptr}; pg8::StaticOrder S; S.init(NT, DM, C.G, C.wg, 512);
            pg8::EpiResid E{(const bf16_t*)(ws + WS_XB), (bf16_t*)(ws + WS_XB), DM, (float*)(ws + WS_PARTF)};
            pg8::gemm_phase<pg8::EpiResid, pg8::StaticOrder>(C.lds, g, S, E);
        } SEAM(pb + 10);
        if (EN(11) && IN(pb + 11)) { PH_BEGIN();
            pg8::Gemm g{(const bf16_t*)(ws + WS_XB), (const bf16_t*)(ws + (l ? WS_WRB1 : WS_WRB)), DM, DM, DM, nullptr}; pg8::StaticOrder S; S.init(NT, 256, C.G, C.wg, DM);
            pg8::EpiF32 E{(float*)(ws + WS_LOGITS), 256, (const float*)(ws + WS_PARTF), 32, (float*)(ws + WS_SSQF)};
            pg8::gemm_phase<pg8::EpiF32, pg8::StaticOrder>(C.lds, g, S, E);
        } SEAM(pb + 11);
        if (EN(12) && IN(pb + 12)) { PH_BEGIN(); phase_route(C, l); } SEAM(pb + 12);
        if (EN(13) && IN(pb + 13)) { PH_BEGIN(); phase_dispatch(C); } SEAM(pb + 13);
        if (EN(14) && IN(pb + 14)) { PH_BEGIN();
            const int* TE = (const int*)(ws + WS_TILEEXP);
            pg8::Gemm g{(const bf16_t*)(ws + WS_XB), (const bf16_t*)(ws + WS_WGU), DM, DM, DM, (const int*)(ws + WS_ROWMAP)};
            pg8::MoeOrder S{TE, TE[200], 4, C.G, C.vcu, DM, (long)1024 * DM, C.wg};
            pg8::EpiSiluMul E{(bf16_t*)(ws + WS_HID), DEXP, (const float*)(ws + WS_SSQF), (const int*)(ws + WS_ROWMAP)};
            pg8::gemm_phase<pg8::EpiSiluMul, pg8::MoeOrder, true>(C.lds, g, S, E);
        } SEAM(pb + 14);
        if (EN(15) && IN(pb + 15)) { PH_BEGIN();
            const int* TE = (const int*)(ws + WS_TILEEXP);
            pg8::Gemm g{(const bf16_t*)(ws + WS_HID), (const bf16_t*)(ws + WS_WD), DEXP, DEXP, DEXP, nullptr};
            pg8::MoeOrder S{TE, TE[200], 8, C.G, C.vcu, DEXP, (long)DM * DEXP, C.wg};
            pg8::EpiScatter E{(bf16_t*)(ws + WS_C2), DM, (const int*)(ws + WS_ROWDST)};
            pg8::gemm_phase<pg8::EpiScatter, pg8::MoeOrder>(C.lds, g, S, E);
        } SEAM(pb + 15);
    }

__global__ void __launch_bounds__(512, 2) mk_fwd(Args args) {
    extern __shared__ __attribute__((aligned(16))) unsigned char lds_raw[];
    Ctx C;
    unsigned char* ws; inptr_t in;
    PH_BEGIN();
    volatile LAS unsigned* MISC = (volatile LAS unsigned*)(C.lds + LDS_MISC);
    if (C.tid < 64) MISC[C.tid] = 0u;
    __syncthreads();
    const int lo = args.ph_lo, hi = args.ph_hi;
    XcdBarrier bar; bar.bar = (unsigned*)(args.ws + WS_CTL) + CW_BAR; bar.x = 0; bar.st = MISC + 8;
    if (hi - lo > 1) bar = xcd_barrier_post((unsigned*)(args.ws + WS_CTL) + CW_BAR, MISC + 8);
#ifndef PROBE_MASK
#define PROBE_MASK 0
#endif
#if PROBE_MASK
#ifndef PROBE_ATT
#define PROBE_ATT 7
#endif
#define RUNP(k) do { run_layer<0>(lds_raw, bar, (k), (k) + 1); xcd_barrier(bar); if ((PROBE_MASK >> (k)) & 1) { run_layer<0>(lds_raw, bar, (k), (k) + 1, PROBE_ATT); xcd_barrier(bar); } } while (0)
    RUNP(0); RUNP(1); RUNP(2); RUNP(3); RUNP(4); RUNP(5); RUNP(6); RUNP(7); RUNP(8); RUNP(9); RUNP(10); RUNP(11); RUNP(12); RUNP(13); RUNP(14); RUNP(15);
    run_layer<1>(lds_raw, bar, PPL, 2 * PPL); xcd_barrier(bar);
#else
    run_layer<0>(lds_raw, bar, lo, hi);
    run_layer<1>(lds_raw, bar, lo, hi);
#endif
    if (EN(16) && IN(2 * PPL)) { PH_BEGIN();
        const bf16_t* C2 = (const bf16_t*)(ws + WS_C2); const float* gate = (const float*)(ws + WS_GATE);
        for (int m = C.gw; m < NT; m += C.ngw)
            norm_row(nullptr, (const bf16_t*)(ws + WS_XB) + (size_t)m * DM, nullptr, C2 + (size_t)(2 * m) * DM, C2 + (size_t)(2 * m + 1) * DM, gate[2 * m], gate[2 * m + 1], in[4], nullptr, C.X + (size_t)m * DM, C.lane);
    }
#undef IN
#undef SEAM
}

extern "C" void kernel_launch(void* const* d_in, const int* in_sizes, int n_in, void* d_out, int out_size, void* d_ws, size_t ws_size, hipStream_t stream) {
    static int grid = 0;
    if (grid == 0) {
        if (n_in != 45 || out_size != NT * DM || ws_size < WS_END) { grid = -1; return; }
        int dev = 0, cus = 0;
        if (hipGetDevice(&dev) != hipSuccess || hipDeviceGetAttribute(&cus, hipDeviceAttributeMultiprocessorCount, dev) != hipSuccess) { grid = -1; return; }
        if (hipFuncSetAttribute((const void*)mk_fwd, hipFuncAttributeMaxDynamicSharedMemorySize, LDS_BYTES) != hipSuccess) { grid = -1; return; }
        int per_cu = 0;
        (void)hipOccupancyMaxActiveBlocksPerMultiprocessor(&per_cu, (const void*)mk_fwd, 512, LDS_BYTES);
        (void)hipGetLastError();
        grid = cus;
    }
    if (grid < 0) return;
    (void)hipMemsetAsync((char*)d_ws + WS_CTL, 0, 1 * MiB, stream);
    Args a{};
    for (int i = 0; i < 45; ++i) a.in[i] = d_in[i];
    a.out = (float*)d_out; a.ws = (unsigned char*)d_ws;
#if MK_ONE_LAUNCH
    a.ph_lo = 0; a.ph_hi = NPHASE;
    hipLaunchKernelGGL(mk_fwd, dim3(grid), dim3(512), LDS_BYTES, stream, a);
#else
    for (int p = 0; p < NPHASE; ++p) { a.ph_lo = p; a.ph_hi = p + 1; hipLaunchKernelGGL(mk_fwd, dim3(grid), dim3(512), LDS_BYTES, stream, a); }
#endif
}
```
